# Optimizing an MI355X kernel written in HIP

```python
import jax, jax.numpy as jnp
from jax import lax
import numpy as np

D_MODEL = 1024
BATCH = 8
SEQ = 4096
DEPTH = 1

CHUNK = 64
D_MIX = D_MODEL
D_RWKV = D_MIX // 2
RWKV_HEAD = 64
RWKV_HEADS = D_RWKV // RWKV_HEAD
D_MLSTM = D_MIX - D_RWKV
MLSTM_HEADS = 4
MLSTM_HEAD = D_MLSTM // MLSTM_HEADS
DECAY_LORA = 64
ICL_LORA = 64
CONV_K = 4
NORM_EPS = 1e-6
RWKV_GN_EPS = 64e-5
MLSTM_LN_EPS = 1e-6

RWKV_SHIFT_SPLITS = (D_RWKV, D_RWKV, D_RWKV, DECAY_LORA, ICL_LORA)
D_RWKV_SHIFT = sum(RWKV_SHIFT_SPLITS)
REST_SPLITS = (D_RWKV,
               D_MLSTM, D_MLSTM, D_MLSTM, D_MLSTM,
               MLSTM_HEADS, MLSTM_HEADS,
               D_MLSTM)
D_IN = D_RWKV_SHIFT + sum(REST_SPLITS)

kernel_name = 'hymba_rwkv7_mlstm_adaln_block'


def _offsets(sizes):
    return [int(s) for s in np.cumsum(sizes)[:-1]]


def _rmsnorm(x, gain):
    xf = x.astype(jnp.float32)
    return xf * lax.rsqrt(jnp.mean(xf * xf, axis=-1, keepdims=True) + NORM_EPS) * gain


def _token_shift_lerp(u, mu):
    prev = jnp.pad(u, ((0, 0), (1, 0), (0, 0)))[:, :-1]
    return u + mu * (prev - u)


def _causal_dwconv(u, w, bias):
    K = w.shape[0]
    T = u.shape[1]
    up = jnp.pad(u, ((0, 0), (K - 1, 0), (0, 0)))
    out = bias
    for j in range(K):
        out = out + w[j] * up[:, j:j + T]
    return out


def _rwkv7_step(S, inp):
    r, w, k, v, kk, a = inp
    sa = jnp.einsum('bhvk,bhk->bhv', S, -kk)
    S = S * w[:, :, None, :] + sa[..., None] * (kk * a)[:, :, None, :] + v[..., None] * k[:, :, None, :]
    y = jnp.einsum('bhvk,bhk->bhv', S, r)
    return S, y


def _rwkv7_branch(u, z, mu, w_decay_up, w_decay0, w_icl_up, a0, k_k, k_a, r_k, gn_w, gn_b):
    B, T, _ = u.shape
    u = _token_shift_lerp(u.astype(jnp.float32), mu)
    r, k, v, wd, ad = jnp.split(u, _offsets(RWKV_SHIFT_SPLITS), axis=-1)
    w_log = -jax.nn.softplus(-(w_decay0 + jnp.tanh(wd) @ w_decay_up)) - 0.5
    decay = jnp.exp(-jnp.exp(w_log))
    a = jax.nn.sigmoid(a0 + ad @ w_icl_up)
    hd = lambda t: t.reshape(B, T, RWKV_HEADS, RWKV_HEAD)
    kk = hd(k * k_k)
    kk = kk / jnp.maximum(jnp.sqrt(jnp.sum(kk * kk, axis=-1, keepdims=True)), 1e-12)
    k = k * (1.0 + (a - 1.0) * k_a)
    r_h, w_h, k_h, v_h, a_h = hd(r), hd(decay), hd(k), hd(v), hd(a)
    xs = tuple(jnp.swapaxes(t, 0, 1) for t in (r_h, w_h, k_h, v_h, kk, a_h))
    S0 = jnp.zeros((B, RWKV_HEADS, RWKV_HEAD, RWKV_HEAD), jnp.float32)
    _, y = lax.scan(_rwkv7_step, S0, xs)
    y = jnp.swapaxes(y, 0, 1)
    mean = jnp.mean(y, axis=-1, keepdims=True)
    var = jnp.mean(jnp.square(y - mean), axis=-1, keepdims=True)
    y = ((y - mean) * lax.rsqrt(var + RWKV_GN_EPS)).reshape(B, T, D_RWKV) * gn_w + gn_b
    bonus = jnp.sum(r_h * k_h * r_k.reshape(RWKV_HEADS, RWKV_HEAD), axis=-1, keepdims=True) * v_h
    y = y + bonus.reshape(B, T, D_RWKV)
    return y * jax.nn.silu(z.astype(jnp.float32))


def _mlstm_chunk_step(carry, inp):
    C, n, m = carry
    q, k, v, ig, lf = inp
    L = q.shape[2]
    b = jnp.cumsum(lf, axis=-1)
    b_last = b[..., -1]
    causal = jnp.tril(jnp.ones((L, L), dtype=bool))
    d_log = jnp.where(causal, b[..., :, None] - b[..., None, :] + ig[..., None, :], -jnp.inf)
    inter_log = b + m[..., None]
    m_t = jnp.maximum(inter_log, jnp.max(d_log, axis=-1))
    d_w = jnp.exp(d_log - m_t[..., None])
    scores = jnp.einsum('bhtd,bhsd->bhts', q, k) * d_w
    inter = jnp.exp(inter_log - m_t)
    num = jnp.einsum('bhts,bhsd->bhtd', scores, v) + inter[..., None] * jnp.einsum('bhvk,bhtk->bhtv', C, q)
    den = jnp.sum(scores, axis=-1) + inter * jnp.einsum('bhk,bhtk->bht', n, q)
    h = num / jnp.maximum(jnp.abs(den), jnp.exp(-m_t))[..., None]
    g = b_last[..., None] - b + ig
    m_new = jnp.maximum(b_last + m, jnp.max(g, axis=-1))
    w_s = jnp.exp(g - m_new[..., None])
    carry_scale = jnp.exp(b_last + m - m_new)
    C = carry_scale[..., None, None] * C + jnp.einsum('bhs,bhsv,bhsk->bhvk', w_s, v, k)
    n = carry_scale[..., None] * n + jnp.einsum('bhs,bhsk->bhk', w_s, k)
    return (C, n, m_new), h


def _mlstm_branch(q, k, v, o, ig, fg, z, conv_w, conv_b, b_i, b_f, ln_w, skip):
    B, T, _ = q.shape
    qk = jax.nn.silu(_causal_dwconv(jnp.concatenate([q, k], axis=-1).astype(jnp.float32), conv_w, conv_b))
    q_c, k_c = jnp.split(qk, 2, axis=-1)
    nc = T // CHUNK
    def chunked(t):
        return t.reshape(B, nc, CHUNK, MLSTM_HEADS, MLSTM_HEAD).transpose(1, 0, 3, 2, 4)
    def chunked_gate(t):
        return t.reshape(B, nc, CHUNK, MLSTM_HEADS).transpose(1, 0, 3, 2)
    i_pre = ig.astype(jnp.float32) + b_i
    log_f = jax.nn.log_sigmoid(fg.astype(jnp.float32) + b_f)
    xs = (chunked(q_c), chunked(k_c) * (MLSTM_HEAD ** -0.5), chunked(v.astype(jnp.float32)),
          chunked_gate(i_pre), chunked_gate(log_f))
    carry0 = (jnp.zeros((B, MLSTM_HEADS, MLSTM_HEAD, MLSTM_HEAD), jnp.float32),
              jnp.zeros((B, MLSTM_HEADS, MLSTM_HEAD), jnp.float32),
              jnp.zeros((B, MLSTM_HEADS), jnp.float32))
    _, h = lax.scan(_mlstm_chunk_step, carry0, xs)
    h = h.transpose(1, 0, 3, 2, 4).reshape(B, T, MLSTM_HEADS, MLSTM_HEAD)
    mean = jnp.mean(h, axis=-1, keepdims=True)
    var = jnp.mean(jnp.square(h - mean), axis=-1, keepdims=True)
    h = ((h - mean) * lax.rsqrt(var + MLSTM_LN_EPS)).reshape(B, T, D_MLSTM) * ln_w
    h = jax.nn.sigmoid(o.astype(jnp.float32)) * h + skip * q_c
    return h * jax.nn.silu(z.astype(jnp.float32))


def setup_inputs(seed: int = 0) -> dict:
    key = jax.random.key(seed)
    ks = jax.random.split(key, 32)
    def nrm(k, shape, scale):
        return jax.random.normal(k, shape, jnp.float32) * scale
    x = nrm(ks[0], (BATCH, SEQ, D_MODEL), 1.0)
    c = nrm(ks[1], (BATCH, D_MODEL), 1.0)
    w_ada = nrm(ks[2], (DEPTH, D_MODEL, 3 * D_MODEL), D_MODEL ** -0.5)
    b_ada = nrm(ks[3], (DEPTH, 3 * D_MODEL), 0.02)
    norm_gain = 1.0 + nrm(ks[4], (DEPTH, D_MODEL), 0.02)
    w_in = nrm(ks[5], (DEPTH, D_MODEL, D_IN), D_MODEL ** -0.5)
    mu_rwkv = jax.random.uniform(ks[6], (DEPTH, D_RWKV_SHIFT), jnp.float32)
    w_decay_up = nrm(ks[7], (DEPTH, DECAY_LORA, D_RWKV), 0.5 * DECAY_LORA ** -0.5)
    w_decay0 = jnp.linspace(-6.5, -1.5, D_RWKV, dtype=jnp.float32)[None] + nrm(ks[8], (DEPTH, D_RWKV), 0.1)
    w_icl_up = nrm(ks[9], (DEPTH, ICL_LORA, D_RWKV), ICL_LORA ** -0.5)
    a0 = nrm(ks[10], (DEPTH, D_RWKV), 0.1)
    k_k = 0.85 + nrm(ks[11], (DEPTH, D_RWKV), 0.02)
    k_a = 1.0 + nrm(ks[12], (DEPTH, D_RWKV), 0.02)
    r_k = nrm(ks[13], (DEPTH, D_RWKV), 0.1)
    rwkv_gn_w = 1.0 + nrm(ks[14], (DEPTH, D_RWKV), 0.02)
    rwkv_gn_b = nrm(ks[15], (DEPTH, D_RWKV), 0.02)
    mlstm_conv_w = nrm(ks[16], (DEPTH, CONV_K, 2 * D_MLSTM), CONV_K ** -0.5)
    mlstm_conv_b = nrm(ks[17], (DEPTH, 2 * D_MLSTM), 0.02)
    mlstm_b_i = nrm(ks[18], (DEPTH, MLSTM_HEADS), 0.1)
    mlstm_b_f = jnp.linspace(3.0, 6.0, MLSTM_HEADS, dtype=jnp.float32)[None] + nrm(ks[19], (DEPTH, MLSTM_HEADS), 0.1)
    mlstm_ln_w = 1.0 + nrm(ks[20], (DEPTH, D_MLSTM), 0.02)
    mlstm_skip = 1.0 + nrm(ks[21], (DEPTH, D_MLSTM), 0.02)
    w_out = nrm(ks[22], (DEPTH, D_MIX, D_MODEL), D_MIX ** -0.5)
    final_gain = 1.0 + nrm(ks[23], (D_MODEL,), 0.02)
    return {'x': x, 'c': c, 'w_ada': w_ada, 'b_ada': b_ada, 'norm_gain': norm_gain, 'w_in': w_in,
            'mu_rwkv': mu_rwkv, 'w_decay_up': w_decay_up, 'w_decay0': w_decay0, 'w_icl_up': w_icl_up,
            'a0': a0, 'k_k': k_k, 'k_a': k_a, 'r_k': r_k, 'rwkv_gn_w': rwkv_gn_w, 'rwkv_gn_b': rwkv_gn_b,
            'mlstm_conv_w': mlstm_conv_w, 'mlstm_conv_b': mlstm_conv_b, 'mlstm_b_i': mlstm_b_i,
            'mlstm_b_f': mlstm_b_f, 'mlstm_ln_w': mlstm_ln_w, 'mlstm_skip': mlstm_skip,
            'w_out': w_out, 'final_gain': final_gain}


def reference(x, c, w_ada, b_ada, norm_gain, w_in, mu_rwkv, w_decay_up, w_decay0, w_icl_up,
              a0, k_k, k_a, r_k, rwkv_gn_w, rwkv_gn_b, mlstm_conv_w, mlstm_conv_b, mlstm_b_i,
              mlstm_b_f, mlstm_ln_w, mlstm_skip, w_out, final_gain):
    h_res = x.astype(jnp.float32)
    c_act = jax.nn.silu(c.astype(jnp.float32))
    for l in range(DEPTH):
        ada = c_act @ w_ada[l] + b_ada[l]
        shift, scale, gate = jnp.split(ada, 3, axis=-1)
        hn = _rmsnorm(h_res, norm_gain[l]) * (1.0 + scale[:, None]) + shift[:, None]
        proj = hn @ w_in[l]
        u_rwkv = proj[..., :D_RWKV_SHIFT]
        z_r, q_m, k_m, v_m, o_m, i_m, f_m, z_m = jnp.split(proj[..., D_RWKV_SHIFT:], _offsets(REST_SPLITS), axis=-1)
        y_r = _rwkv7_branch(u_rwkv, z_r, mu_rwkv[l], w_decay_up[l], w_decay0[l], w_icl_up[l], a0[l],
                            k_k[l], k_a[l], r_k[l], rwkv_gn_w[l], rwkv_gn_b[l])
        y_m = _mlstm_branch(q_m, k_m, v_m, o_m, i_m, f_m, z_m, mlstm_conv_w[l], mlstm_conv_b[l],
                            mlstm_b_i[l], mlstm_b_f[l], mlstm_ln_w[l], mlstm_skip[l])
        mix = jnp.concatenate([y_r, y_m], axis=-1) @ w_out[l]
        h_res = h_res + gate[:, None] * mix
    return _rmsnorm(h_res, final_gain).astype(x.dtype)
```

```cpp
#include <hip/hip_runtime.h>
#include <hip/hip_cooperative_groups.h>
#include <cstdio>
namespace pg8 {
#define PG8_LAS __attribute__((address_space(3)))
typedef unsigned short bf16_t;
typedef short bf16x8 __attribute__((ext_vector_type(8)));
typedef float f32x4 __attribute__((ext_vector_type(4)));
typedef unsigned u32x4 __attribute__((ext_vector_type(4)));
constexpr int BM = 256, BK = 64, HALF = 128, HTB = HALF * BK * 2  , STAGE_BYTES = 8 * HTB, NXCD = 8, WGM = 8;

__host__ __device__ __forceinline__ int lds_byte(int r, int c) { const int st = (r >> 4) * 2 + (c >> 5), rr = r & 15, cc = c & 31, ob = rr * 64 + cc * 2; return st * 1024 + (ob ^ (((ob >> 9) & 1) << 5)); }
__host__ __device__ __forceinline__ void stage_rc(int b, int& R, int& C) { const int st = b / 1024, sb = b % 1024, swz = sb ^ (((sb >> 9) & 1) << 5); R = (st >> 1) * 16 + swz / 64; C = (st & 1) * 32 + (swz % 64) / 2; }
__host__ __device__ __forceinline__ int perm32(int rho) { const int n = rho >> 4, i = rho & 15; return 8 * (i >> 2) + 4 * n + (i & 3); }

struct Unit { int pm, pn; };
struct Gemm { const bf16_t* A; const bf16_t* Bt; int M, N, K; };

struct StaticOrder {
    int nM, nN, nwg, G, c;
    __host__ __device__ void init(int M, int N, int G_, int c_) { nM = M / BM; nN = N / BM; nwg = nM * nN; G = G_; c = c_; }
    __host__ __device__ bool next(int i, Unit& u) const {
        const long L = (long)i * G + c; if (L >= nwg) return false;
        int wgid = (int)L; { const int q = nwg / NXCD, r = nwg % NXCD, xcd = wgid % NXCD, off = wgid / NXCD; wgid = (xcd < r ? xcd * (q + 1) : r * (q + 1) + (xcd - r) * q) + off; }
        const int nig = WGM * nN, gid = wgid / nig, fm = gid * WGM, gsz = (nM - fm) < WGM ? (nM - fm) : WGM;
        u.pm = fm + ((wgid % nig) % gsz); u.pn = (wgid % nig) / gsz; return true;
    }
    __device__ __forceinline__ void a_ready(const Unit&) const {}
    __device__ __forceinline__ void done(const Unit&) const {}
};
struct CountedOrder : StaticOrder {
    const unsigned* ready; unsigned need; unsigned* tmo;
    __device__ __forceinline__ void a_ready(const Unit& u) const {
        if (threadIdx.x < 64) {
            const unsigned long long t0 = __builtin_amdgcn_s_memrealtime(); unsigned polls = 0;
            while ((unsigned)__builtin_amdgcn_readfirstlane(__hip_atomic_load(ready + 64 * u.pm, __ATOMIC_RELAXED, __HIP_MEMORY_SCOPE_AGENT)) < need) {
                if ((++polls & 255u) == 0u && __builtin_amdgcn_readfirstlane(__hip_atomic_load(tmo, __ATOMIC_RELAXED, __HIP_MEMORY_SCOPE_AGENT)) != 0u) break;
                if (__builtin_amdgcn_s_memrealtime() - t0 > 2000000ull) {
                    if (threadIdx.x == 0) { unsigned expect = 0u; __hip_atomic_compare_exchange_strong(tmo + 1, &expect, 0x600u | (unsigned)(u.pm & 0xff), __ATOMIC_RELAXED, __ATOMIC_RELAXED, __HIP_MEMORY_SCOPE_AGENT); __hip_atomic_store(tmo, 1u, __ATOMIC_RELAXED, __HIP_MEMORY_SCOPE_AGENT); }
                    break; }
                __builtin_amdgcn_s_sleep(2); }
            __builtin_amdgcn_fence(__ATOMIC_ACQUIRE, "agent");
            asm volatile("s_waitcnt vmcnt(0)" ::: "memory");
        }
#if !defined(BROKEN_HOOK_NO_BARRIER)
        asm volatile("" ::: "memory"); __builtin_amdgcn_s_barrier(); asm volatile("" ::: "memory");
#endif
    }
};

__device__ __forceinline__ unsigned cvt_pk_bf16(float lo, float hi) { unsigned r; asm volatile("v_cvt_pk_bf16_f32 %0, %1, %2" : "=v"(r) : "v"(lo), "v"(hi)); return r; }
typedef float f32x2 __attribute__((ext_vector_type(2)));
__device__ __forceinline__ f32x2 gelu_pk(f32x2 v) {
    const f32x2 av = __builtin_elementwise_abs(v), d = av * 0.2316418882f + 1.0f;
    f32x2 t; t.x = __builtin_amdgcn_rcpf(d.x); t.y = __builtin_amdgcn_rcpf(d.y);
    f32x2 q = t * 0.5307027145f + (-0.7265760135f); q = q * t + 0.7107068705f; q = q * t + (-0.142248368f); q = q * t + 0.127414796f; q = q * t;
    const f32x2 s = (v * v) * (-0.72134752044f);
    f32x2 e; e.x = __builtin_amdgcn_exp2f(s.x); e.y = __builtin_amdgcn_exp2f(s.y);
    const f32x2 m = v * (q * e), r = v - m;
    f32x2 o; o.x = v.x < 0.f ? m.x : r.x; o.y = v.y < 0.f ? m.y : r.y; return o;
}

struct EpiF32 {
    static constexpr bool PERM = false, AFTER_DRAIN = false;
    float* C; int ldc; const float* bias;
    __device__ __forceinline__ void operator()(const f32x4 (&acc)[2][2][4][2], const Unit& u, int wr, int wc, int fr, int fq) const {
        const int row0 = u.pm * BM + wr * 64 + fr, col0 = u.pn * BM + wc * 32 + 4 * fq;
        f32x4 bv[2][2];
#pragma unroll
        for (int bj = 0; bj < 2; ++bj)
#pragma unroll
            for (int n = 0; n < 2; ++n) bv[bj][n] = bias ? *(const f32x4*)(bias + col0 + bj * HALF + n * 16) : (f32x4){0.f, 0.f, 0.f, 0.f};
#pragma unroll
        for (int ai = 0; ai < 2; ++ai)
#pragma unroll
            for (int m = 0; m < 4; ++m) { float* rowp = C + (size_t)(row0 + ai * HALF + m * 16) * ldc + col0;
#pragma unroll
                for (int bj = 0; bj < 2; ++bj)
#pragma unroll
                    for (int n = 0; n < 2; ++n) *(f32x4*)(rowp + bj * HALF + n * 16) = acc[ai][bj][m][n] + bv[bj][n]; }
    }
};
template <int ACT  > struct EpiBf16 {
    static constexpr bool PERM = true, AFTER_DRAIN = false;
    bf16_t* O; int ldc; const float* bias; int split_cols; size_t split_stride;
    __device__ __forceinline__ void operator()(const f32x4 (&acc)[2][2][4][2], const Unit& u, int wr, int wc, int fr, int fq) const {
        const int row0 = u.pm * BM + wr * 64 + fr; int colt = u.pn * BM; bf16_t* base = O;
        if (split_cols) { const int t = colt / split_cols; base += (size_t)t * split_stride; colt -= t * split_cols; }
        const int col0 = colt + wc * 32 + 8 * fq, bcol0 = u.pn * BM + wc * 32 + 8 * fq;
        f32x4 bv[2][2];
#pragma unroll
        for (int bj = 0; bj < 2; ++bj)
#pragma unroll
            for (int n = 0; n < 2; ++n) bv[bj][n] = bias ? *(const f32x4*)(bias + bcol0 + bj * HALF + 4 * n) : (f32x4){0.f, 0.f, 0.f, 0.f};
#pragma unroll
        for (int ai = 0; ai < 2; ++ai)
#pragma unroll
            for (int m = 0; m < 4; ++m) { bf16_t* rowp = base + (size_t)(row0 + ai * HALF + m * 16) * ldc + col0;
#pragma unroll
                for (int bj = 0; bj < 2; ++bj) { f32x4 v0 = acc[ai][bj][m][0] + bv[bj][0], v1 = acc[ai][bj][m][1] + bv[bj][1];
                    if (ACT == 1) { f32x2 a = gelu_pk((f32x2){v0[0], v0[1]}), b = gelu_pk((f32x2){v0[2], v0[3]}), c = gelu_pk((f32x2){v1[0], v1[1]}), d = gelu_pk((f32x2){v1[2], v1[3]});
                        v0 = (f32x4){a.x, a.y, b.x, b.y}; v1 = (f32x4){c.x, c.y, d.x, d.y}; }
                    if (ACT == 2) {
#pragma unroll
                        for (int j = 0; j < 4; ++j) { v0[j] = 0.5f * v0[j] * (1.0f + erff(v0[j] * 0.70710678f)); v1[j] = 0.5f * v1[j] * (1.0f + erff(v1[j] * 0.70710678f)); } }
                    u32x4 w; w.x = cvt_pk_bf16(v0[0], v0[1]); w.y = cvt_pk_bf16(v0[2], v0[3]); w.z = cvt_pk_bf16(v1[0], v1[1]); w.w = cvt_pk_bf16(v1[2], v1[3]);
                    *(u32x4*)(rowp + bj * HALF) = w; } }
    }
};

struct PanelStats {
    unsigned* xbuf;
    unsigned* cnt;
    unsigned* tmo;
    int ntn; float eps;
    unsigned code;
    __device__ __forceinline__ bool run(const f32x4 (&v)[2][2][4][2], const Unit& u, int wr, int wc, int fr, int fq, PG8_LAS unsigned char* lds, int wid, int lane) const {
        typedef float f32x2v __attribute__((ext_vector_type(2)));
        PG8_LAS f32x2v* P = (PG8_LAS f32x2v*)lds;
        PG8_LAS f32x2v* S = (PG8_LAS f32x2v*)(lds + 8192);
        PG8_LAS unsigned* flag = (PG8_LAS unsigned*)(lds + 8192 + 2048);
#pragma unroll
        for (int ai = 0; ai < 2; ++ai)
#pragma unroll
            for (int m = 0; m < 4; ++m) {
                float s = 0.f;
#pragma unroll
                for (int bj = 0; bj < 2; ++bj)
#pragma unroll
                    for (int n = 0; n < 2; ++n) { const f32x4 x = v[ai][bj][m][n]; s += (x[0] + x[1]) + (x[2] + x[3]); }
                s += __shfl_xor(s, 16); s += __shfl_xor(s, 32);
                const float mw = s * (1.0f / 64.0f); float q = 0.f;
#pragma unroll
                for (int bj = 0; bj < 2; ++bj)
#pragma unroll
                    for (int n = 0; n < 2; ++n) { const f32x4 d = v[ai][bj][m][n] - mw; q += (d[0] * d[0] + d[1] * d[1]) + (d[2] * d[2] + d[3] * d[3]); }
                q += __shfl_xor(q, 16); q += __shfl_xor(q, 32);
                if (fq == 0) P[(ai * HALF + wr * 64 + m * 16 + fr) * 4 + wc] = (f32x2v){mw, q};
            }
        asm volatile("s_waitcnt lgkmcnt(0)" ::: "memory"); __builtin_amdgcn_s_barrier(); asm volatile("" ::: "memory");
#if defined(BROKEN_NO_WAIT)
        if (blockIdx.x >= 64) { const long long t0 = clock64(); while (clock64() - t0 < 60000) __builtin_amdgcn_s_sleep(8); }
#endif
        const int row = wid * 32 + (lane & 31);
        if (lane < 32) {
            const f32x2v a = P[row * 4 + 0], b = P[row * 4 + 1], c = P[row * 4 + 2], d = P[row * 4 + 3];
            const float mt = (a.x + b.x + c.x + d.x) * 0.25f;
            const float da = a.x - mt, db = b.x - mt, dc = c.x - mt, dd = d.x - mt;
            const float m2 = (a.y + b.y) + (c.y + d.y) + 64.0f * ((da * da + db * db) + (dc * dc + dd * dd));
            unsigned long long* slot = (unsigned long long*)xbuf + ((size_t)(u.pm * BM + row) * 4 + u.pn);
            __hip_atomic_store(slot, ((unsigned long long)__float_as_uint(m2) << 32) | __float_as_uint(mt), __ATOMIC_RELAXED, __HIP_MEMORY_SCOPE_AGENT);
        }
        asm volatile("s_waitcnt vmcnt(0)" ::: "memory");
        if (lane == 0) __hip_atomic_fetch_add(cnt + 64 * u.pm, 1u, __ATOMIC_RELAXED, __HIP_MEMORY_SCOPE_AGENT);
        if (wid == 0) {
            bool dead = false; const unsigned long long t0 = __builtin_amdgcn_s_memrealtime(); const unsigned want = 8u * (unsigned)ntn;
            for (;;) {
#if defined(BROKEN_NO_WAIT)
                break;
#endif
                if ((unsigned)__builtin_amdgcn_readfirstlane(__hip_atomic_load(cnt + 64 * u.pm, __ATOMIC_RELAXED, __HIP_MEMORY_SCOPE_AGENT)) >= want) break;
                if (__builtin_amdgcn_s_memrealtime() - t0 > 2000000ull) {
                    if (lane == 0) { unsigned expect = 0u; __hip_atomic_compare_exchange_strong(tmo + 1, &expect, code | (unsigned)(u.pm & 0xff), __ATOMIC_RELAXED, __ATOMIC_RELAXED, __HIP_MEMORY_SCOPE_AGENT);
                                     __hip_atomic_store(tmo, 1u, __ATOMIC_RELAXED, __HIP_MEMORY_SCOPE_AGENT); }
                    dead = true; break; }
                __builtin_amdgcn_s_sleep(2);
            }
            __builtin_amdgcn_fence(__ATOMIC_ACQUIRE, "agent");
            if (lane == 0) flag[0] = dead ? 1u : 0u;
        }
        asm volatile("s_waitcnt vmcnt(0) lgkmcnt(0)" ::: "memory"); __builtin_amdgcn_s_barrier(); asm volatile("" ::: "memory");
        const bool bad = flag[0] != 0u;
        if (lane < 32) {
            const unsigned long long* slot = (const unsigned long long*)xbuf + (size_t)(u.pm * BM + row) * 4; float mt[4], m2[4]; float ms = 0.f;
#pragma unroll
            for (int t = 0; t < 4; ++t) { if (t < ntn) { const unsigned long long w = __hip_atomic_load(slot + t, __ATOMIC_RELAXED, __HIP_MEMORY_SCOPE_AGENT); mt[t] = __uint_as_float((unsigned)w); m2[t] = __uint_as_float((unsigned)(w >> 32)); } else { mt[t] = 0.f; m2[t] = 0.f; } ms += mt[t]; }
            const float mean = ms / (float)ntn; float q = 0.f;
#pragma unroll
            for (int t = 0; t < 4; ++t) if (t < ntn) { const float dm = mt[t] - mean; q += m2[t] + 256.0f * dm * dm; }
            S[row] = (f32x2v){mean, 1.0f / sqrtf(q / (256.0f * (float)ntn) + eps)};
        }
        asm volatile("s_waitcnt lgkmcnt(0)" ::: "memory"); __builtin_amdgcn_s_barrier(); asm volatile("" ::: "memory");
        return bad;
    }
};
struct EpiLnRes {
    static constexpr bool PERM = false, AFTER_DRAIN = true;
    const float* base; float* out; int ldc; const float* bias; PanelStats st; unsigned poison;
    __device__ __forceinline__ void refuse(size_t i0, size_t stride, int M, int N) const { const float q = __builtin_nanf(""); for (size_t i = i0; i < (size_t)M * N; i += stride) out[(i / N) * ldc + i % N] = q;
        if (i0 == 0) { unsigned expect = 0u; __hip_atomic_compare_exchange_strong(st.tmo + 1, &expect, 0x7f0u, __ATOMIC_RELAXED, __ATOMIC_RELAXED, __HIP_MEMORY_SCOPE_AGENT); __hip_atomic_store(st.tmo, 1u, __ATOMIC_RELAXED, __HIP_MEMORY_SCOPE_AGENT); } }
    __device__ __forceinline__ void fused(f32x4 (&acc)[2][2][4][2], const Unit& u, int wr, int wc, int fr, int fq, PG8_LAS unsigned char* lds, int wid, int lane) const {
        typedef float f32x2v __attribute__((ext_vector_type(2)));
        const PG8_LAS f32x2v* S = (const PG8_LAS f32x2v*)(lds + 8192);
        const int col0 = u.pn * BM + wc * 32 + 4 * fq;
#pragma unroll
        for (int bj = 0; bj < 2; ++bj)
#pragma unroll
            for (int n = 0; n < 2; ++n) { const f32x4 bv = bias ? *(const f32x4*)(bias + col0 + bj * HALF + n * 16) : (f32x4){0.f, 0.f, 0.f, 0.f};
#pragma unroll
                for (int ai = 0; ai < 2; ++ai)
#pragma unroll
                    for (int m = 0; m < 4; ++m) acc[ai][bj][m][n] += bv; }
        const bool bad = st.run(acc, u, wr, wc, fr, fq, lds, wid, lane) || poison != 0u;
        const float qnan = __builtin_nanf("");
#pragma unroll
        for (int ai = 0; ai < 2; ++ai)
#pragma unroll
            for (int m = 0; m < 4; ++m) { const int r = ai * HALF + wr * 64 + m * 16 + fr; const f32x2v sr = S[r]; const size_t off = (size_t)(u.pm * BM + r) * ldc + col0;
#pragma unroll
                for (int bj = 0; bj < 2; ++bj)
#pragma unroll
                    for (int n = 0; n < 2; ++n) { const f32x4 bs = *(const f32x4*)(base + off + bj * HALF + n * 16); f32x4 o = bs + (acc[ai][bj][m][n] - sr.x) * sr.y;
                        if (bad) o = (f32x4){qnan, qnan, qnan, qnan}; *(f32x4*)(out + off + bj * HALF + n * 16) = o; }
                asm volatile("" ::: "memory"); }
    }
};
struct EpiLnResLn {
    static constexpr bool PERM = false, AFTER_DRAIN = true;
    const float* base; float* out; bf16_t* xn; int ldc; const float* bias; PanelStats st1, st2; unsigned poison;
    __device__ __forceinline__ void refuse(size_t i0, size_t stride, int M, int N) const { const float q = __builtin_nanf(""); for (size_t i = i0; i < (size_t)M * N; i += stride) { const size_t o = (i / N) * ldc + i % N; out[o] = q; xn[o] = (bf16_t)0x7fc0u; }
        if (i0 == 0) { unsigned expect = 0u; __hip_atomic_compare_exchange_strong(st1.tmo + 1, &expect, 0x7f0u, __ATOMIC_RELAXED, __ATOMIC_RELAXED, __HIP_MEMORY_SCOPE_AGENT); __hip_atomic_store(st1.tmo, 1u, __ATOMIC_RELAXED, __HIP_MEMORY_SCOPE_AGENT); } }
    __device__ __forceinline__ void fused(f32x4 (&acc)[2][2][4][2], const Unit& u, int wr, int wc, int fr, int fq, PG8_LAS unsigned char* lds, int wid, int lane) const {
        typedef float f32x2v __attribute__((ext_vector_type(2))); typedef unsigned u32x2v __attribute__((ext_vector_type(2)));
        const PG8_LAS f32x2v* S = (const PG8_LAS f32x2v*)(lds + 8192);
        const int col0 = u.pn * BM + wc * 32 + 4 * fq;
#pragma unroll
        for (int bj = 0; bj < 2; ++bj)
#pragma unroll
            for (int n = 0; n < 2; ++n) { const f32x4 bv = bias ? *(const f32x4*)(bias + col0 + bj * HALF + n * 16) : (f32x4){0.f, 0.f, 0.f, 0.f};
#pragma unroll
                for (int ai = 0; ai < 2; ++ai)
#pragma unroll
                    for (int m = 0; m < 4; ++m) acc[ai][bj][m][n] += bv; }
        bool bad = st1.run(acc, u, wr, wc, fr, fq, lds, wid, lane) || poison != 0u;
        const float qnan = __builtin_nanf("");
#pragma unroll
        for (int ai = 0; ai < 2; ++ai)
#pragma unroll
            for (int m = 0; m < 4; ++m) { const int r = ai * HALF + wr * 64 + m * 16 + fr; const f32x2v sr = S[r]; const size_t off = (size_t)(u.pm * BM + r) * ldc + col0;
#pragma unroll
                for (int bj = 0; bj < 2; ++bj)
#pragma unroll
                    for (int n = 0; n < 2; ++n) { const f32x4 bs = *(const f32x4*)(base + off + bj * HALF + n * 16); acc[ai][bj][m][n] = bs + (acc[ai][bj][m][n] - sr.x) * sr.y; }
                asm volatile("" : "+v"(acc[ai][0][m][0]), "+v"(acc[ai][0][m][1]), "+v"(acc[ai][1][m][0]), "+v"(acc[ai][1][m][1]));
                if (m & 1) asm volatile("" ::: "memory"); }
        const bool bad1 = bad;
        bad = st2.run(acc, u, wr, wc, fr, fq, lds, wid, lane) || bad;
#pragma unroll
        for (int ai = 0; ai < 2; ++ai)
#pragma unroll
            for (int m = 0; m < 4; ++m) { const int r = ai * HALF + wr * 64 + m * 16 + fr; const f32x2v sr = S[r]; const size_t off = (size_t)(u.pm * BM + r) * ldc + col0;
#pragma unroll
                for (int bj = 0; bj < 2; ++bj)
#pragma unroll
                    for (int n = 0; n < 2; ++n) { const f32x4 x1 = acc[ai][bj][m][n]; *(f32x4*)(out + off + bj * HALF + n * 16) = bad1 ? (f32x4){qnan, qnan, qnan, qnan} : x1;
                        const f32x4 o = (x1 - sr.x) * sr.y; u32x2v w; w.x = cvt_pk_bf16(o[0], o[1]); w.y = cvt_pk_bf16(o[2], o[3]);
                        if (bad) { w.x = 0x7fc07fc0u; w.y = 0x7fc07fc0u; } *(u32x2v*)(xn + off + bj * HALF + n * 16) = w; }
                asm volatile("" ::: "memory"); }
    }
};

template <class Epi, class Sched, bool STAMP = false>
__device__ __forceinline__ void gemm_phase(PG8_LAS unsigned char* lds, const Gemm g, const Sched& S, const Epi& E, unsigned long long* stamps) {
    const int tid = threadIdx.x, wid = __builtin_amdgcn_readfirstlane(tid >> 6), lane = tid & 63, wr = wid >> 2, wc = wid & 3, fr = lane & 15, fq = lane >> 4;
    const int K = g.K, nt = K / BK;
    int ts_lo = 0, ts_hi = 0, nts = 0; const unsigned long long rt_entry = STAMP ? (unsigned long long)wall_clock64() : 0ull;
#define PG8_STAMP() do { if (STAMP && wid == 0 && nts < 64) { const unsigned long long _c = (unsigned long long)clock64(); \
        ts_lo = (lane == nts) ? (int)(unsigned)_c : ts_lo; ts_hi = (lane == nts) ? (int)(unsigned)(_c >> 32) : ts_hi; ++nts; } } while (0)
    PG8_STAMP();
    unsigned voffA[2], voffB[2];
#pragma unroll
    for (int i = 0; i < 2; ++i) { int R, C; stage_rc(tid * 16 + i * 8192, R, C); const int Rb = Epi::PERM ? ((R & ~31) + perm32(R & 31)) : R;
        voffA[i] = (unsigned)(R * K + C) * 2u; voffB[i] = (unsigned)(Rb * K + C) * 2u; }
    const size_t kstep = (size_t)(BK * 2);
    const size_t hstep = (size_t)HALF * K * 2;
    const size_t tstep = 2 * hstep;
    const unsigned ldsw = (unsigned)wid * 1024u;
    const int aoff = lds_byte(wr * 64 + fr, fq * 8), boff = lds_byte(wc * 32 + fr, fq * 8);
#define PG8_SA(b, h) (((b) * 2 + (h)) * HTB)
#define PG8_SB(b, h) ((4 + (b) * 2 + (h)) * HTB)
#define PG8_STAGE(bufoff, gbase, voff) do { _Pragma("unroll") for (int _i = 0; _i < 2; ++_i) \
        __builtin_amdgcn_global_load_lds((const unsigned*)((const char*)(gbase) + (voff)[_i]), (PG8_LAS unsigned*)(lds + (bufoff) + ldsw + _i * 8192), 16, 0, 0); } while (0)
#define PG8_LDA(dst, b, h) do { _Pragma("unroll") for (int m = 0; m < 4; ++m) _Pragma("unroll") for (int k = 0; k < 2; ++k) dst[m][k] = *(const PG8_LAS bf16x8*)(lds + PG8_SA(b, h) + aoff + m * 2048 + k * 1024); } while (0)
#define PG8_LDB(dst, b, h) do { _Pragma("unroll") for (int n = 0; n < 2; ++n) _Pragma("unroll") for (int k = 0; k < 2; ++k) dst[n][k] = *(const PG8_LAS bf16x8*)(lds + PG8_SB(b, h) + boff + n * 2048 + k * 1024); } while (0)
#define PG8_MMA(ai, bj, At, Bt) do { __builtin_amdgcn_s_setprio(1); _Pragma("unroll") for (int m = 0; m < 4; ++m) _Pragma("unroll") for (int n = 0; n < 2; ++n) _Pragma("unroll") for (int k = 0; k < 2; ++k) \
        acc[ai][bj][m][n] = __builtin_amdgcn_mfma_f32_16x16x32_bf16(Bt[n][k], At[m][k], acc[ai][bj][m][n], 0, 0, 0); __builtin_amdgcn_s_setprio(0); } while (0)
#define PG8_WAIT_V(n) asm volatile("s_waitcnt vmcnt(" #n ")" ::: "memory")
#define PG8_WAIT_L(n) asm volatile("s_waitcnt lgkmcnt(" #n ")" ::: "memory")
#define PG8_BAR __builtin_amdgcn_s_barrier()
#define PG8_SCHED __builtin_amdgcn_sched_barrier(0)
    Unit cur, nxt; int ui = 0;
    if (!S.next(0, cur)) return;
    f32x4 acc[2][2][4][2];
#pragma unroll
    for (int a = 0; a < 2; ++a)
#pragma unroll
        for (int b = 0; b < 2; ++b)
#pragma unroll
            for (int m = 0; m < 4; ++m)
#pragma unroll
                for (int n = 0; n < 2; ++n) acc[a][b][m][n] = (f32x4){0.f, 0.f, 0.f, 0.f};
    bf16x8 At[4][2], B0[2][2], B1[2][2];
    const char* cA = (const char*)g.A + (size_t)cur.pm * tstep; const char* cB = (const char*)g.Bt + (size_t)cur.pn * tstep;
    S.a_ready(cur);
    PG8_STAGE(PG8_SB(0, 0), cB, voffB); PG8_STAGE(PG8_SA(0, 0), cA, voffA); PG8_STAGE(PG8_SB(0, 1), cB + hstep, voffB); PG8_STAGE(PG8_SA(0, 1), cA + hstep, voffA);
    if (wr == 1) PG8_BAR;
    PG8_WAIT_V(4); PG8_BAR;
    PG8_STAGE(PG8_SB(1, 0), cB + kstep, voffB); PG8_STAGE(PG8_SA(1, 0), cA + kstep, voffA); PG8_STAGE(PG8_SB(1, 1), cB + hstep + kstep, voffB);
    PG8_WAIT_V(6); PG8_BAR;
    PG8_STAMP();
    for (;;) {
        const bool has_next = S.next(ui + 1, nxt);
        const char* nA = has_next ? (const char*)g.A + (size_t)nxt.pm * tstep : cA; const char* nB = has_next ? (const char*)g.Bt + (size_t)nxt.pn * tstep : cB;
        for (int t = 0; t < nt; t += 2) {
            const bool last = (t == nt - 2);
            const char* a1 = cA + (size_t)(t + 1) * kstep;
            const char* a2 = last ? nA : cA + (size_t)(t + 2) * kstep; const char* b2 = last ? nB : cB + (size_t)(t + 2) * kstep;
            const char* a3 = a2 + kstep; const char* b3 = b2 + kstep;
            if (last && has_next) S.a_ready(nxt);
            PG8_LDB(B0, 0, 0); PG8_SCHED; PG8_LDA(At, 0, 0); PG8_STAGE(PG8_SA(1, 1), a1 + hstep, voffA);
            PG8_WAIT_L(8); PG8_BAR; PG8_WAIT_L(0); PG8_MMA(0, 0, At, B0); PG8_BAR; PG8_SCHED;
            PG8_LDB(B1, 0, 1); PG8_STAGE(PG8_SB(0, 0), b2, voffB);
            PG8_BAR; PG8_WAIT_L(0); PG8_MMA(0, 1, At, B1); PG8_BAR;
            PG8_LDA(At, 0, 1); PG8_STAGE(PG8_SA(0, 0), a2, voffA);
            PG8_BAR; PG8_WAIT_L(0); PG8_MMA(1, 0, At, B0); PG8_BAR; PG8_SCHED;
            PG8_STAGE(PG8_SB(0, 1), b2 + hstep, voffB);
            PG8_WAIT_V(6); PG8_BAR; PG8_MMA(1, 1, At, B1); PG8_BAR;
            PG8_LDB(B0, 1, 0); PG8_SCHED; PG8_LDA(At, 1, 0); PG8_STAGE(PG8_SA(0, 1), a2 + hstep, voffA);
            PG8_WAIT_L(8); PG8_BAR; PG8_WAIT_L(0); PG8_MMA(0, 0, At, B0); PG8_BAR; PG8_SCHED;
            PG8_LDB(B1, 1, 1); PG8_STAGE(PG8_SB(1, 0), b3, voffB);
            PG8_BAR; PG8_WAIT_L(0); PG8_MMA(0, 1, At, B1); PG8_BAR;
            PG8_LDA(At, 1, 1); PG8_STAGE(PG8_SA(1, 0), a3, voffA);
            PG8_BAR; PG8_WAIT_L(0); PG8_MMA(1, 0, At, B0); PG8_BAR; PG8_SCHED;
            PG8_STAGE(PG8_SB(1, 1), b3 + hstep, voffB);
            PG8_WAIT_V(6); PG8_BAR; PG8_MMA(1, 1, At, B1); PG8_BAR;
        }
        PG8_STAMP();
        if constexpr (!Epi::AFTER_DRAIN) { E(acc, cur, wr, wc, fr, fq); S.done(cur); }
        PG8_STAMP();
        if (!has_next) break;
#pragma unroll
        for (int a = 0; a < 2; ++a)
#pragma unroll
            for (int b = 0; b < 2; ++b)
#pragma unroll
                for (int m = 0; m < 4; ++m)
#pragma unroll
                    for (int n = 0; n < 2; ++n) acc[a][b][m][n] = (f32x4){0.f, 0.f, 0.f, 0.f};
        cur = nxt; cA = nA; cB = nB; ++ui;
    }
    PG8_WAIT_V(0);
    if (wr == 0) PG8_BAR;
    PG8_BAR;
    if constexpr (Epi::AFTER_DRAIN) { E.fused(acc, cur, wr, wc, fr, fq, lds, wid, lane); S.done(cur); }
    PG8_STAMP();
    if (STAMP && wid == 0) { stamps[lane] = lane < nts ? (((unsigned long long)(unsigned)ts_hi << 32) | (unsigned)ts_lo) : 0ull;
        if (lane == 62) stamps[62] = rt_entry; if (lane == 63) stamps[63] = (unsigned long long)wall_clock64(); }
#undef PG8_STAMP
#undef PG8_SA
#undef PG8_SB
#undef PG8_STAGE
#undef PG8_LDA
#undef PG8_LDB
#undef PG8_MMA
#undef PG8_WAIT_V
#undef PG8_WAIT_L
#undef PG8_BAR
#undef PG8_SCHED
}
}

namespace cg = cooperative_groups;
typedef unsigned short bf16_t;
typedef short bf16x8 __attribute__((ext_vector_type(8)));
typedef float f32x4 __attribute__((ext_vector_type(4)));
typedef unsigned u32x4 __attribute__((ext_vector_type(4)));
typedef unsigned u32x2 __attribute__((ext_vector_type(2)));

constexpr int NB = 8, NT = 4096, DM = 1024, NTOK = NB * NT;
constexpr int DIN = 4744, NPAD = 4864;
constexpr int C_R = 0, C_K = 512, C_V = 1024, C_WD = 1536, C_AD = 1600, C_ZR = 1664, C_Q = 2176, C_KM = 2688, C_VM = 3200, C_O = 3712, C_I = 4224, C_F = 4228, C_ZM = 4232;
constexpr int NTHR = 512, NWV = 8;
constexpr int LDS_BYTES = 147456;
constexpr int NPHASE = 8;

constexpr size_t MiB = 1u << 20;
constexpr size_t WS_CTL = 0, CTL_BYTES = 1 * MiB;
constexpr size_t WS_ADA = 1 * MiB;
constexpr size_t WS_WIN = 2 * MiB;
constexpr size_t WS_WOUT = 12 * MiB;
constexpr size_t WS_X = 16 * MiB;
constexpr size_t WS_PROJ = 144 * MiB;
constexpr size_t WS_Y = 448 * MiB;
constexpr size_t WS_END = 512 * MiB;

struct Params { const float* in[24]; float* out; unsigned char* ws; int ph_lo, ph_hi; };

struct Ctx {
    const float *x, *c, *w_ada, *b_ada, *norm_gain, *w_in, *mu, *w_dup, *w_d0, *w_iup, *a0, *k_k, *k_a, *r_k, *gn_w, *gn_b, *conv_w, *conv_b, *b_i, *b_f, *ln_w, *skip, *w_out, *fgain;
    float* out; float* sumsq; float* ada; bf16_t *win_t, *wout_t, *hn, *proj, *y; float *wd, *aa;
    unsigned char* lds; int tid, lane, wid, gw, ngw;
};

__device__ __forceinline__ float bf2f(bf16_t v) { return __uint_as_float(((unsigned)v) << 16); }
__device__ __forceinline__ bf16_t f2bf(float f) { unsigned u = __float_as_uint(f); u += 0x7fffu + ((u >> 16) & 1u); return (bf16_t)(u >> 16); }
__device__ __forceinline__ unsigned pk2(float lo, float hi) { return (unsigned)f2bf(lo) | ((unsigned)f2bf(hi) << 16); }
__device__ __forceinline__ void unpack8(const u32x4 v, float* o) {
    o[0] = __uint_as_float(v.x << 16); o[1] = __uint_as_float(v.x & 0xffff0000u); o[2] = __uint_as_float(v.y << 16); o[3] = __uint_as_float(v.y & 0xffff0000u);
    o[4] = __uint_as_float(v.z << 16); o[5] = __uint_as_float(v.z & 0xffff0000u); o[6] = __uint_as_float(v.w << 16); o[7] = __uint_as_float(v.w & 0xffff0000u);
}
__device__ __forceinline__ u32x4 pack8(const float* v) { u32x4 o; o.x = pk2(v[0], v[1]); o.y = pk2(v[2], v[3]); o.z = pk2(v[4], v[5]); o.w = pk2(v[6], v[7]); return o; }
__device__ __forceinline__ float wave_sum(float v) {
#pragma unroll
    for (int o = 1; o < 64; o <<= 1) v += __shfl_xor(v, o);
    return v;
}
__device__ __forceinline__ float sigmoidf_(float z) { return 1.0f / (1.0f + expf(-z)); }
__device__ __forceinline__ float siluf_(float z) { return z / (1.0f + expf(-z)); }
template <int CTRL> __device__ __forceinline__ float dppf(float v) { return __int_as_float(__builtin_amdgcn_update_dpp(0, __float_as_int(v), CTRL, 0xF, 0xF, true)); }
__device__ __forceinline__ float row16_sum(float v) {
    v += dppf<0xB1>(v); v += dppf<0x4E>(v); v += dppf<0x141>(v); v += dppf<0x140>(v); return v;
}

__device__ __forceinline__ void transpose_item(const float* W, int K, int N, bf16_t* WT, float* scr, int item, int nblk, int lane) {
    const int kb = item / nblk, nb = item % nblk, k0 = 64 * kb, n0 = 32 * nb;
#pragma unroll 8
    for (int i = 0; i < 32; ++i) { const int kk = 2 * i + (lane >> 5); const int n = n0 + (lane & 31); scr[kk * 33 + (lane & 31)] = (n < N) ? W[(size_t)(k0 + kk) * N + n] : 0.f; }
    __builtin_amdgcn_s_waitcnt(0); asm volatile("" ::: "memory");
    const int c = lane & 7;
#pragma unroll
    for (int j = 0; j < 4; ++j) { const int n = (lane >> 3) + 8 * j; const float* s = scr + (8 * c) * 33 + n;
        u32x4 o; o.x = pk2(s[0 * 33], s[1 * 33]); o.y = pk2(s[2 * 33], s[3 * 33]); o.z = pk2(s[4 * 33], s[5 * 33]); o.w = pk2(s[6 * 33], s[7 * 33]);
        *(u32x4*)(WT + (size_t)(n0 + n) * K + k0 + 8 * c) = o; }
    __builtin_amdgcn_s_waitcnt(0); asm volatile("" ::: "memory");
}
__device__ __forceinline__ void phase0(const Ctx& C) {
    for (int it = C.gw; it < 1536; it += C.ngw) {
        const int j0 = 2 * it; float acc[8][2];
#pragma unroll
        for (int b = 0; b < 8; ++b) { acc[b][0] = 0.f; acc[b][1] = 0.f; }
        for (int kk = 0; kk < 16; ++kk) { const int k = kk * 64 + C.lane; const float2 w = *(const float2*)(C.w_ada + (size_t)k * 3072 + j0);
#pragma unroll
            for (int b = 0; b < 8; ++b) { const float s = siluf_(C.c[b * 1024 + k]); acc[b][0] += s * w.x; acc[b][1] += s * w.y; } }
#pragma unroll
        for (int b = 0; b < 8; ++b) { const float s0 = wave_sum(acc[b][0]), s1 = wave_sum(acc[b][1]);
            if (C.lane == 0) { C.ada[b * 3072 + j0] = s0 + C.b_ada[j0]; C.ada[b * 3072 + j0 + 1] = s1 + C.b_ada[j0 + 1]; } }
    }
    float* scr = (float*)(C.lds + C.wid * 16384);
    constexpr int NBI = NPAD / 32, I_IN = 16 * NBI, I_OUT = 16 * 32;
    for (int it = C.gw; it < I_IN + I_OUT; it += C.ngw) {
        if (it < I_IN) transpose_item(C.w_in, 1024, DIN, C.win_t, scr, it, NBI, C.lane);
        else transpose_item(C.w_out, 1024, 1024, C.wout_t, scr, it - I_IN, 32, C.lane);
    }
}

__device__ __forceinline__ void phase1(const Ctx& C) {
    f32x4 g[4];
#pragma unroll
    for (int j = 0; j < 4; ++j) g[j] = *(const f32x4*)(C.norm_gain + 4 * C.lane + 256 * j);
    for (int m = C.gw; m < NTOK; m += C.ngw) {
        const int b = m >> 12; const f32x4* xr = (const f32x4*)(C.x + (size_t)m * DM) + C.lane;
        f32x4 v[4]; float s = 0.f;
#pragma unroll
        for (int j = 0; j < 4; ++j) { v[j] = xr[64 * j]; s += (v[j].x * v[j].x + v[j].y * v[j].y) + (v[j].z * v[j].z + v[j].w * v[j].w); }
        const float rs = 1.0f / sqrtf(wave_sum(s) * (1.0f / DM) + 1e-6f);
        u32x2* o = (u32x2*)(C.hn + (size_t)m * DM) + C.lane;
#pragma unroll
        for (int j = 0; j < 4; ++j) {
            const f32x4 sh = *(const f32x4*)(C.ada + b * 3072 + 4 * C.lane + 256 * j), sc = *(const f32x4*)(C.ada + b * 3072 + 1024 + 4 * C.lane + 256 * j);
            const f32x4 h = v[j] * rs * g[j] * (sc + 1.0f) + sh;
            u32x2 w; w.x = pk2(h.x, h.y); w.y = pk2(h.z, h.w); o[64 * j] = w; }
    }
}

__device__ __forceinline__ void phase3(const Ctx& C) {
    float* TW = (float*)C.lds;
    float* TA = TW + 64 * 32;
    const int tid = C.tid;
    for (int tile = blockIdx.x; tile < NTOK / 32; tile += gridDim.x) {
        const int m0 = tile * 32;
        __syncthreads();
        for (int e = tid; e < 32 * 128; e += NTHR) {
            const int tok = e >> 7, j = e & 127; const int m = m0 + tok; const int col = C_WD + j;
            const float cur = bf2f(C.proj[(size_t)m * NPAD + col]);
            const float prv = (m & (NT - 1)) ? bf2f(C.proj[(size_t)(m - 1) * NPAD + col]) : 0.f;
            const float u = cur + C.mu[col] * (prv - cur);
            if (j < 64) TW[j * 32 + tok] = tanhf(u); else TA[(j - 64) * 32 + tok] = u;
        }
        __syncthreads();
        float aw[32], ai[32];
#pragma unroll
        for (int i = 0; i < 32; ++i) { aw[i] = 0.f; ai[i] = 0.f; }
        for (int k = 0; k < 64; ++k) {
            const float wu = C.w_dup[k * 512 + tid], iu = C.w_iup[k * 512 + tid];
#pragma unroll
            for (int q = 0; q < 8; ++q) { const f32x4 tw = *(const f32x4*)(TW + k * 32 + 4 * q), ta = *(const f32x4*)(TA + k * 32 + 4 * q);
                aw[4 * q] += tw.x * wu; aw[4 * q + 1] += tw.y * wu; aw[4 * q + 2] += tw.z * wu; aw[4 * q + 3] += tw.w * wu;
                ai[4 * q] += ta.x * iu; ai[4 * q + 1] += ta.y * iu; ai[4 * q + 2] += ta.z * iu; ai[4 * q + 3] += ta.w * iu; }
        }
        const float d0 = C.w_d0[tid], a0 = C.a0[tid];
#pragma unroll
        for (int i = 0; i < 32; ++i) {
            const float sg = sigmoidf_(d0 + aw[i]);
            C.wd[(size_t)(m0 + i) * 512 + tid] = expf(-0.6065306597126334f * sg);
            C.aa[(size_t)(m0 + i) * 512 + tid] = sigmoidf_(a0 + ai[i]);
        }
    }
}

__device__ __forceinline__ void rwkv_item(const Ctx& C, int b, int h, int half) {
    float* Lkk = (float*)C.lds; float* Lw = Lkk + 4096; float* Lb = Lw + 4096; float* Lk = Lb + 4096; float* Lr = Lk + 4096; float* Lv = Lr + 4096; float* Ly = Lv + 4096;
    const int tid = C.tid, lane = C.lane, wid = C.wid;
    const int tt = tid >> 3, cg8 = tid & 7, ch0 = h * 64 + 8 * cg8;
    float mur[8], muk[8], muv[8], kkw[8], kaw[8];
#pragma unroll
    for (int i = 0; i < 8; ++i) { mur[i] = C.mu[C_R + ch0 + i]; muk[i] = C.mu[C_K + ch0 + i]; muv[i] = C.mu[C_V + ch0 + i]; kkw[i] = C.k_k[ch0 + i]; kaw[i] = C.k_a[ch0 + i]; }
    const int kp = lane & 15, vr = lane >> 4, vrow = wid * 4 + vr;
    float S0 = 0.f, S1 = 0.f, S2 = 0.f, S3 = 0.f;
    for (int ck = 0; ck < NT / 64; ++ck) {
        const int m = b * NT + ck * 64 + tt;
        {
            const bf16_t* pc = C.proj + (size_t)m * NPAD; const bool hp = (ck | tt) != 0;
            float r[8], k[8], v[8], pr[8], pk[8], pv[8];
            unpack8(*(const u32x4*)(pc + C_R + ch0), r); unpack8(*(const u32x4*)(pc + C_K + ch0), k); unpack8(*(const u32x4*)(pc + C_V + ch0), v);
            if (hp) { unpack8(*(const u32x4*)(pc - NPAD + C_R + ch0), pr); unpack8(*(const u32x4*)(pc - NPAD + C_K + ch0), pk); unpack8(*(const u32x4*)(pc - NPAD + C_V + ch0), pv); }
            else {
#pragma unroll
                for (int i = 0; i < 8; ++i) { pr[i] = 0.f; pk[i] = 0.f; pv[i] = 0.f; } }
            float w[8], a[8];
            { const f32x4 w0 = *(const f32x4*)(C.wd + (size_t)m * 512 + ch0), w1 = *(const f32x4*)(C.wd + (size_t)m * 512 + ch0 + 4);
              const f32x4 a0 = *(const f32x4*)(C.aa + (size_t)m * 512 + ch0), a1 = *(const f32x4*)(C.aa + (size_t)m * 512 + ch0 + 4);
              w[0] = w0.x; w[1] = w0.y; w[2] = w0.z; w[3] = w0.w; w[4] = w1.x; w[5] = w1.y; w[6] = w1.z; w[7] = w1.w;
              a[0] = a0.x; a[1] = a0.y; a[2] = a0.z; a[3] = a0.w; a[4] = a1.x; a[5] = a1.y; a[6] = a1.z; a[7] = a1.w; }
            float kk[8], ss = 0.f;
#pragma unroll
            for (int i = 0; i < 8; ++i) { r[i] += mur[i] * (pr[i] - r[i]); k[i] += muk[i] * (pk[i] - k[i]); v[i] += muv[i] * (pv[i] - v[i]); kk[i] = k[i] * kkw[i]; ss += kk[i] * kk[i]; }
            ss += __shfl_xor(ss, 1); ss += __shfl_xor(ss, 2); ss += __shfl_xor(ss, 4);
            const float inv = 1.0f / fmaxf(sqrtf(ss), 1e-12f);
            float bb[8];
#pragma unroll
            for (int i = 0; i < 8; ++i) { kk[i] *= inv; bb[i] = kk[i] * a[i]; k[i] = k[i] * (1.0f + (a[i] - 1.0f) * kaw[i]); }
            const int o = tt * 64 + 8 * cg8;
            *(f32x4*)(Lkk + o) = (f32x4){kk[0], kk[1], kk[2], kk[3]}; *(f32x4*)(Lkk + o + 4) = (f32x4){kk[4], kk[5], kk[6], kk[7]};
            *(f32x4*)(Lw + o) = (f32x4){w[0], w[1], w[2], w[3]}; *(f32x4*)(Lw + o + 4) = (f32x4){w[4], w[5], w[6], w[7]};
            *(f32x4*)(Lb + o) = (f32x4){bb[0], bb[1], bb[2], bb[3]}; *(f32x4*)(Lb + o + 4) = (f32x4){bb[4], bb[5], bb[6], bb[7]};
            *(f32x4*)(Lk + o) = (f32x4){k[0], k[1], k[2], k[3]}; *(f32x4*)(Lk + o + 4) = (f32x4){k[4], k[5], k[6], k[7]};
            *(f32x4*)(Lr + o) = (f32x4){r[0], r[1], r[2], r[3]}; *(f32x4*)(Lr + o + 4) = (f32x4){r[4], r[5], r[6], r[7]};
            *(f32x4*)(Lv + o) = (f32x4){v[0], v[1], v[2], v[3]}; *(f32x4*)(Lv + o + 4) = (f32x4){v[4], v[5], v[6], v[7]};
        }
        __syncthreads();
#pragma unroll 4
        for (int t = 0; t < 64; ++t) {
            const f32x4 kk = *(const f32x4*)(Lkk + t * 64 + 4 * kp), w = *(const f32x4*)(Lw + t * 64 + 4 * kp), bb = *(const f32x4*)(Lb + t * 64 + 4 * kp);
            const f32x4 k = *(const f32x4*)(Lk + t * 64 + 4 * kp), r = *(const f32x4*)(Lr + t * 64 + 4 * kp);
            const float vv = Lv[t * 64 + half * 32 + vrow];
            float sa = (S0 * kk.x + S1 * kk.y) + (S2 * kk.z + S3 * kk.w);
            sa = -row16_sum(sa);
            S0 = S0 * w.x + sa * bb.x + vv * k.x; S1 = S1 * w.y + sa * bb.y + vv * k.y; S2 = S2 * w.z + sa * bb.z + vv * k.z; S3 = S3 * w.w + sa * bb.w + vv * k.w;
            float y = (S0 * r.x + S1 * r.y) + (S2 * r.z + S3 * r.w);
            y = row16_sum(y);
            if (kp == 0) Ly[t * 32 + vrow] = y;
        }
        __syncthreads();
        {
            const f32x4 yv = *(const f32x4*)(Ly + tt * 32 + 4 * cg8);
            u32x2 o; o.x = pk2(yv.x, yv.y); o.y = pk2(yv.z, yv.w);
            *(u32x2*)(C.y + (size_t)m * DM + h * 64 + half * 32 + 4 * cg8) = o;
        }
    }
    __syncthreads();
}

__device__ __forceinline__ void mlstm_item(const Ctx& C, int b, int hm, int sl) {
    bf16_t* LQ = (bf16_t*)C.lds;
    bf16_t* LK = LQ + 64 * 136;
    bf16_t* LKt = LK + 64 * 136;
    bf16_t* LVt = LKt + 128 * 72;
    bf16_t* LWVt = LVt + 48 * 72;
    bf16_t* LP = LWVt + 48 * 72;
    bf16_t* LCb = LP + 64 * 72;
    float* Le = (float*)(LCb + 48 * 136); float* Lmx = Le + 64; float* Lin = Lmx + 64; float* Lcl = Lin + 64; float* Lws = Lcl + 64; float* Lden = Lws + 64;
    const int tid = C.tid, lane = C.lane, wid = C.wid, fr = lane & 15, fq = lane >> 4;
    for (int e = tid; e < 48 * 136; e += NTHR) LCb[e] = 0;
    for (int e = tid; e < 48 * 72; e += NTHR) { LVt[e] = (e >= 32 * 72 && e < 32 * 72 + 64) ? (bf16_t)0x3f80 : (bf16_t)0; LWVt[e] = 0; }
    const int tt = tid >> 3, cg8 = tid & 7, d0 = 16 * cg8;
    const float bi = C.b_i[hm], bfv = C.b_f[hm];
    f32x4 Cst[3];
#pragma unroll
    for (int i = 0; i < 3; ++i) Cst[i] = (f32x4){0.f, 0.f, 0.f, 0.f};
    float mst = 0.f;
    __syncthreads();
    for (int ck = 0; ck < NT / 64; ++ck) {
        const int mbase = b * NT + ck * 64;
        float carry, m_new;
        {
            const bf16_t* pr = C.proj + (size_t)(mbase + lane) * NPAD;
            const float ig = bf2f(pr[C_I + hm]) + bi; const float fp = bf2f(pr[C_F + hm]) + bfv;
            const float lf = (fp >= 0.f) ? -log1pf(expf(-fp)) : fp - log1pf(expf(fp));
            float bc = lf;
#pragma unroll
            for (int o = 1; o < 64; o <<= 1) { const float t = __shfl_up(bc, o); if (lane >= o) bc += t; }
            const float e = ig - bc; float pm = e;
#pragma unroll
            for (int o = 1; o < 64; o <<= 1) { const float t = __shfl_up(pm, o); if (lane >= o) pm = fmaxf(pm, t); }
            const float mx = fmaxf(mst, pm);
            const float pml = __shfl(pm, 63), bl = __shfl(bc, 63);
            const float mxl = fmaxf(mst, pml);
            carry = expf(mst - mxl); m_new = bl + mxl;
            if (wid == 0) { Le[lane] = e; Lmx[lane] = mx; Lin[lane] = expf(mst - mx); Lcl[lane] = expf(-(bc + mx)); Lws[lane] = expf(e - mxl); }
        }
        __syncthreads();
        {
            const int t = ck * 64 + tt; const size_t m = (size_t)(mbase + tt);
            float aq[16], ak[16];
#pragma unroll
            for (int i = 0; i < 16; ++i) { aq[i] = C.conv_b[hm * 128 + d0 + i]; ak[i] = C.conv_b[512 + hm * 128 + d0 + i]; }
#pragma unroll
            for (int j = 0; j < 4; ++j) {
                if (t - 3 + j >= 0) {
                    const bf16_t* pr = C.proj + (m - 3 + j) * NPAD;
                    float q[16], k[16];
                    unpack8(*(const u32x4*)(pr + C_Q + hm * 128 + d0), q); unpack8(*(const u32x4*)(pr + C_Q + hm * 128 + d0 + 8), q + 8);
                    unpack8(*(const u32x4*)(pr + C_KM + hm * 128 + d0), k); unpack8(*(const u32x4*)(pr + C_KM + hm * 128 + d0 + 8), k + 8);
#pragma unroll
                    for (int i = 0; i < 16; ++i) { aq[i] += C.conv_w[j * 1024 + hm * 128 + d0 + i] * q[i]; ak[i] += C.conv_w[j * 1024 + 512 + hm * 128 + d0 + i] * k[i]; }
                }
            }
#pragma unroll
            for (int i = 0; i < 16; ++i) { aq[i] = siluf_(aq[i]); ak[i] = siluf_(ak[i]) * 0.08838834764831845f; }
            *(u32x4*)(LQ + tt * 136 + d0) = pack8(aq); *(u32x4*)(LQ + tt * 136 + d0 + 8) = pack8(aq + 8);
            *(u32x4*)(LK + tt * 136 + d0) = pack8(ak); *(u32x4*)(LK + tt * 136 + d0 + 8) = pack8(ak + 8);
#pragma unroll
            for (int i = 0; i < 16; ++i) LKt[(d0 + i) * 72 + tt] = f2bf(ak[i]);
            const bf16_t* pv = C.proj + m * NPAD + C_VM + hm * 128 + sl * 32 + 4 * cg8;
            const u32x2 vv = *(const u32x2*)pv; const float ws = Lws[tt];
            const float v0 = __uint_as_float(vv.x << 16), v1 = __uint_as_float(vv.x & 0xffff0000u), v2 = __uint_as_float(vv.y << 16), v3 = __uint_as_float(vv.y & 0xffff0000u);
            LVt[(4 * cg8 + 0) * 72 + tt] = (bf16_t)(vv.x & 0xffff); LVt[(4 * cg8 + 1) * 72 + tt] = (bf16_t)(vv.x >> 16); LVt[(4 * cg8 + 2) * 72 + tt] = (bf16_t)(vv.y & 0xffff); LVt[(4 * cg8 + 3) * 72 + tt] = (bf16_t)(vv.y >> 16);
            LWVt[(4 * cg8 + 0) * 72 + tt] = f2bf(v0 * ws); LWVt[(4 * cg8 + 1) * 72 + tt] = f2bf(v1 * ws); LWVt[(4 * cg8 + 2) * 72 + tt] = f2bf(v2 * ws); LWVt[(4 * cg8 + 3) * 72 + tt] = f2bf(v3 * ws);
            if (cg8 == 0) LWVt[32 * 72 + tt] = f2bf(ws);
        }
        __syncthreads();
        {
            const int ti = wid >> 1;
#pragma unroll
            for (int jj = 0; jj < 2; ++jj) {
                const int sj = 2 * (wid & 1) + jj;
                f32x4 acc = (f32x4){0.f, 0.f, 0.f, 0.f};
                if (sj <= ti) {
#pragma unroll
                    for (int ks = 0; ks < 4; ++ks) {
                        const bf16x8 a = *(const bf16x8*)(LQ + (16 * ti + fr) * 136 + 32 * ks + 8 * fq);
                        const bf16x8 bb = *(const bf16x8*)(LK + (16 * sj + fr) * 136 + 32 * ks + 8 * fq);
                        acc = __builtin_amdgcn_mfma_f32_16x16x32_bf16(a, bb, acc, 0, 0, 0);
                    }
                }
                const int s = 16 * sj + fr; const float es = Le[s];
#pragma unroll
                for (int r = 0; r < 4; ++r) { const int t = 16 * ti + 4 * fq + r; const float dw = (s <= t) ? expf(es - Lmx[t]) : 0.f; LP[t * 72 + s] = f2bf(acc[r] * dw); }
            }
        }
        __syncthreads();
        f32x4 num[2]; const int ti = wid >> 1; const int nvt = (wid & 1) ? 1 : 2;
        {
#pragma unroll
            for (int q = 0; q < 2; ++q) {
                num[q] = (f32x4){0.f, 0.f, 0.f, 0.f};
                if (q < nvt) {
                    const int vt = (wid & 1) ? 1 : (q == 0 ? 0 : 2);
                    f32x4 a1 = (f32x4){0.f, 0.f, 0.f, 0.f}, a2 = (f32x4){0.f, 0.f, 0.f, 0.f};
#pragma unroll
                    for (int ks = 0; ks < 2; ++ks) {
                        const bf16x8 a = *(const bf16x8*)(LP + (16 * ti + fr) * 72 + 32 * ks + 8 * fq);
                        const bf16x8 bb = *(const bf16x8*)(LVt + (16 * vt + fr) * 72 + 32 * ks + 8 * fq);
                        a1 = __builtin_amdgcn_mfma_f32_16x16x32_bf16(a, bb, a1, 0, 0, 0);
                    }
#pragma unroll
                    for (int ks = 0; ks < 4; ++ks) {
                        const bf16x8 a = *(const bf16x8*)(LQ + (16 * ti + fr) * 136 + 32 * ks + 8 * fq);
                        const bf16x8 bb = *(const bf16x8*)(LCb + (16 * vt + fr) * 136 + 32 * ks + 8 * fq);
                        a2 = __builtin_amdgcn_mfma_f32_16x16x32_bf16(a, bb, a2, 0, 0, 0);
                    }
#pragma unroll
                    for (int r = 0; r < 4; ++r) { const int t = 16 * ti + 4 * fq + r; num[q][r] = a1[r] + Lin[t] * a2[r]; }
                    if (vt == 2 && fr == 0) {
#pragma unroll
                        for (int r = 0; r < 4; ++r) { const int t = 16 * ti + 4 * fq + r; Lden[t] = fmaxf(fabsf(num[q][r]), Lcl[t]); }
                    }
                }
            }
        }
        __syncthreads();
        {
            const int vt = (wid & 1);
#pragma unroll
            for (int r = 0; r < 4; ++r) { const int t = 16 * ti + 4 * fq + r;
                C.y[(size_t)(mbase + t) * DM + 512 + hm * 128 + sl * 32 + 16 * vt + fr] = f2bf(num[0][r] / Lden[t]); }
#pragma unroll
            for (int vt2 = 0; vt2 < 3; ++vt2) {
                f32x4 acc = Cst[vt2] * carry;
#pragma unroll
                for (int ks = 0; ks < 2; ++ks) {
                    const bf16x8 a = *(const bf16x8*)(LWVt + (16 * vt2 + fr) * 72 + 32 * ks + 8 * fq);
                    const bf16x8 bb = *(const bf16x8*)(LKt + (16 * wid + fr) * 72 + 32 * ks + 8 * fq);
                    acc = __builtin_amdgcn_mfma_f32_16x16x32_bf16(a, bb, acc, 0, 0, 0);
                }
                Cst[vt2] = acc;
#pragma unroll
                for (int r = 0; r < 4; ++r) LCb[(16 * vt2 + 4 * fq + r) * 136 + 16 * wid + fr] = f2bf(acc[r]);
            }
        }
        mst = m_new;
        __syncthreads();
    }
}

__device__ __forceinline__ void phase4(const Ctx& C) {
    for (int item = blockIdx.x; item < 256; item += gridDim.x) {
        if (item < 128) rwkv_item(C, item >> 4, (item >> 1) & 7, item & 1);
        else { const int i = item - 128; mlstm_item(C, i >> 4, (i >> 2) & 3, i & 3); }
        __syncthreads();
    }
}

__device__ __forceinline__ void phase5(const Ctx& C) {
    const int lane = C.lane;
    for (int m = C.gw; m < NTOK; m += C.ngw) {
        const bool hp = (m & (NT - 1)) != 0; const int t = m & (NT - 1);
        const bf16_t* pc = C.proj + (size_t)m * NPAD; bf16_t* yr = C.y + (size_t)m * DM;
        float outr[8], outm[8];
        {
            const int c0 = 8 * lane;
            float y[8], r[8], k[8], v[8], pr[8], pk[8], pv[8], z[8];
            unpack8(*(const u32x4*)(yr + c0), y);
            unpack8(*(const u32x4*)(pc + C_R + c0), r); unpack8(*(const u32x4*)(pc + C_K + c0), k); unpack8(*(const u32x4*)(pc + C_V + c0), v); unpack8(*(const u32x4*)(pc + C_ZR + c0), z);
            if (hp) { unpack8(*(const u32x4*)(pc - NPAD + C_R + c0), pr); unpack8(*(const u32x4*)(pc - NPAD + C_K + c0), pk); unpack8(*(const u32x4*)(pc - NPAD + C_V + c0), pv); }
            else {
#pragma unroll
                for (int i = 0; i < 8; ++i) { pr[i] = 0.f; pk[i] = 0.f; pv[i] = 0.f; } }
            const f32x4 a0 = *(const f32x4*)(C.aa + (size_t)m * 512 + c0), a1 = *(const f32x4*)(C.aa + (size_t)m * 512 + c0 + 4);
            const float a[8] = {a0.x, a0.y, a0.z, a0.w, a1.x, a1.y, a1.z, a1.w};
            float s = 0.f, bs = 0.f;
#pragma unroll
            for (int i = 0; i < 8; ++i) {
                r[i] += C.mu[C_R + c0 + i] * (pr[i] - r[i]); k[i] += C.mu[C_K + c0 + i] * (pk[i] - k[i]); v[i] += C.mu[C_V + c0 + i] * (pv[i] - v[i]);
                k[i] = k[i] * (1.0f + (a[i] - 1.0f) * C.k_a[c0 + i]);
                bs += r[i] * k[i] * C.r_k[c0 + i]; s += y[i]; }
            s += __shfl_xor(s, 1); s += __shfl_xor(s, 2); s += __shfl_xor(s, 4);
            bs += __shfl_xor(bs, 1); bs += __shfl_xor(bs, 2); bs += __shfl_xor(bs, 4);
            const float mean = s * (1.0f / 64.0f); float q = 0.f;
#pragma unroll
            for (int i = 0; i < 8; ++i) { y[i] -= mean; q += y[i] * y[i]; }
            q += __shfl_xor(q, 1); q += __shfl_xor(q, 2); q += __shfl_xor(q, 4);
            const float rstd = 1.0f / sqrtf(q * (1.0f / 64.0f) + 64e-5f);
#pragma unroll
            for (int i = 0; i < 8; ++i) { const float yn = y[i] * rstd * C.gn_w[c0 + i] + C.gn_b[c0 + i]; outr[i] = (yn + bs * v[i]) * siluf_(z[i]); }
        }
        {
            const int c0 = 8 * lane;
            float h[8], o[8], z[8], qc[8];
            unpack8(*(const u32x4*)(yr + 512 + c0), h); unpack8(*(const u32x4*)(pc + C_O + c0), o); unpack8(*(const u32x4*)(pc + C_ZM + c0), z);
#pragma unroll
            for (int i = 0; i < 8; ++i) qc[i] = C.conv_b[c0 + i];
#pragma unroll
            for (int j = 0; j < 4; ++j) {
                if (t - 3 + j >= 0) { float q[8]; unpack8(*(const u32x4*)(pc - (size_t)(3 - j) * NPAD + C_Q + c0), q);
#pragma unroll
                    for (int i = 0; i < 8; ++i) qc[i] += C.conv_w[j * 1024 + c0 + i] * q[i]; }
            }
            float s = 0.f;
#pragma unroll
            for (int i = 0; i < 8; ++i) s += h[i];
            s += __shfl_xor(s, 1); s += __shfl_xor(s, 2); s += __shfl_xor(s, 4); s += __shfl_xor(s, 8);
            const float mean = s * (1.0f / 128.0f); float q = 0.f;
#pragma unroll
            for (int i = 0; i < 8; ++i) { h[i] -= mean; q += h[i] * h[i]; }
            q += __shfl_xor(q, 1); q += __shfl_xor(q, 2); q += __shfl_xor(q, 4); q += __shfl_xor(q, 8);
            const float rstd = 1.0f / sqrtf(q * (1.0f / 128.0f) + 1e-6f);
#pragma unroll
            for (int i = 0; i < 8; ++i) { const float hn = h[i] * rstd * C.ln_w[c0 + i]; outm[i] = (sigmoidf_(o[i]) * hn + C.skip[c0 + i] * siluf_(qc[i])) * siluf_(z[i]); }
        }
        *(u32x4*)(yr + 8 * lane) = pack8(outr);
        *(u32x4*)(yr + 512 + 8 * lane) = pack8(outm);
    }
}

struct EpiOut {
    static constexpr bool PERM = false, AFTER_DRAIN = false;
    const float* x; float* out; const float* gate; float* sumsq;
    __device__ __forceinline__ void operator()(const f32x4 (&acc)[2][2][4][2], const pg8::Unit& u, int wr, int wc, int fr, int fq) const {
        const int row0 = u.pm * 256 + wr * 64 + fr, col0 = u.pn * 256 + wc * 32 + 4 * fq; const int b = (u.pm * 256) >> 12;
        f32x4 g[2][2];
#pragma unroll
        for (int bj = 0; bj < 2; ++bj)
#pragma unroll
            for (int n = 0; n < 2; ++n) g[bj][n] = *(const f32x4*)(gate + b * 3072 + col0 + bj * 128 + n * 16);
#pragma unroll
        for (int ai = 0; ai < 2; ++ai)
#pragma unroll
            for (int m = 0; m < 4; ++m) { const int row = row0 + ai * 128 + m * 16; const size_t off = (size_t)row * DM + col0; float ss = 0.f;
#pragma unroll
                for (int bj = 0; bj < 2; ++bj)
#pragma unroll
                    for (int n = 0; n < 2; ++n) { const f32x4 xv = *(const f32x4*)(x + off + bj * 128 + n * 16); const f32x4 o = xv + g[bj][n] * acc[ai][bj][m][n];
                        *(f32x4*)(out + off + bj * 128 + n * 16) = o; ss += (o.x * o.x + o.y * o.y) + (o.z * o.z + o.w * o.w); }
                ss += __shfl_xor(ss, 16); ss += __shfl_xor(ss, 32);
                if (fq == 0) atomicAdd(sumsq + row, ss); }
    }
};

__device__ __forceinline__ void phase7(const Ctx& C) {
    f32x4 g[4];
#pragma unroll
    for (int j = 0; j < 4; ++j) g[j] = *(const f32x4*)(C.fgain + 4 * C.lane + 256 * j);
    for (int m = C.gw; m < NTOK; m += C.ngw) {
        const float rs = 1.0f / sqrtf(C.sumsq[m] * (1.0f / DM) + 1e-6f);
        f32x4* o = (f32x4*)(C.out + (size_t)m * DM) + C.lane;
#pragma unroll
        for (int j = 0; j < 4; ++j) o[64 * j] = o[64 * j] * rs * g[j];
    }
}

__global__ void __launch_bounds__(NTHR, 2) fwd_kernel(Params p) {
    extern __shared__ __attribute__((aligned(16))) unsigned char lds_raw[];
    cg::grid_group grid = cg::this_grid();
    Ctx C;
    C.x = p.in[0]; C.c = p.in[1]; C.w_ada = p.in[2]; C.b_ada = p.in[3]; C.norm_gain = p.in[4]; C.w_in = p.in[5]; C.mu = p.in[6]; C.w_dup = p.in[7]; C.w_d0 = p.in[8]; C.w_iup = p.in[9];
    C.a0 = p.in[10]; C.k_k = p.in[11]; C.k_a = p.in[12]; C.r_k = p.in[13]; C.gn_w = p.in[14]; C.gn_b = p.in[15]; C.conv_w = p.in[16]; C.conv_b = p.in[17]; C.b_i = p.in[18]; C.b_f = p.in[19];
    C.ln_w = p.in[20]; C.skip = p.in[21]; C.w_out = p.in[22]; C.fgain = p.in[23];
    C.out = p.out; unsigned char* ws = p.ws;
    C.sumsq = (float*)(ws + WS_CTL); C.ada = (float*)(ws + WS_ADA); C.win_t = (bf16_t*)(ws + WS_WIN); C.wout_t = (bf16_t*)(ws + WS_WOUT);
    C.hn = (bf16_t*)(ws + WS_X); C.wd = (float*)(ws + WS_X); C.aa = (float*)(ws + WS_X + 64 * MiB); C.proj = (bf16_t*)(ws + WS_PROJ); C.y = (bf16_t*)(ws + WS_Y);
    C.lds = lds_raw; C.tid = threadIdx.x; C.lane = C.tid & 63; C.wid = __builtin_amdgcn_readfirstlane(C.tid >> 6);
    C.gw = blockIdx.x * NWV + C.wid; C.ngw = gridDim.x * NWV;
    const int lo = p.ph_lo, hi = p.ph_hi;
#define RUN(k) (lo <= (k) && (k) < hi)
#define SEAM(k) do { if (RUN(k) && RUN((k) + 1)) grid.sync(); } while (0)
    if (RUN(0)) phase0(C);
    SEAM(0);
    if (RUN(1)) phase1(C);
    SEAM(1);
    if (RUN(2)) {
        pg8::Gemm g{C.hn, C.win_t, NTOK, NPAD, DM}; pg8::StaticOrder S; S.init(NTOK, NPAD, (int)gridDim.x, (int)blockIdx.x);
        pg8::EpiBf16<0> E{C.proj, NPAD, nullptr, 0, 0};
        pg8::gemm_phase<pg8::EpiBf16<0>, pg8::StaticOrder, false>((PG8_LAS unsigned char*)lds_raw, g, S, E, nullptr);
    }
    SEAM(2);
    if (RUN(3)) phase3(C);
    SEAM(3);
    if (RUN(4)) phase4(C);
    SEAM(4);
    if (RUN(5)) phase5(C);
    SEAM(5);
    if (RUN(6)) {
        pg8::Gemm g{C.y, C.wout_t, NTOK, DM, DM}; pg8::StaticOrder S; S.init(NTOK, DM, (int)gridDim.x, (int)blockIdx.x);
        EpiOut E{C.x, C.out, C.ada + 2048, C.sumsq};
        pg8::gemm_phase<EpiOut, pg8::StaticOrder, false>((PG8_LAS unsigned char*)lds_raw, g, S, E, nullptr);
    }
    SEAM(6);
    if (RUN(7)) phase7(C);
#undef RUN
#undef SEAM
}

#ifndef N_LAUNCHES
#define N_LAUNCHES 8
#endif
extern "C" void kernel_launch(void* const* d_in, const int* in_sizes, int n_in, void* d_out, int out_size, void* d_ws, size_t ws_size, hipStream_t stream) {
    static int grid = 0;
    if (grid == 0) {
        if (n_in != 24 || out_size != NTOK * DM || ws_size < WS_END) { fprintf(stderr, "kernel_launch: unexpected shapes (n_in %d, out %d, ws %zu < %zu)\n", n_in, out_size, ws_size, (size_t)WS_END); grid = -1; return; }
        int dev = 0, cus = 0, per_cu = 0;
        hipGetDevice(&dev); hipDeviceGetAttribute(&cus, hipDeviceAttributeMultiprocessorCount, dev);
        if (hipFuncSetAttribute((const void*)fwd_kernel, hipFuncAttributeMaxDynamicSharedMemorySize, LDS_BYTES) != hipSuccess) { fprintf(stderr, "kernel_launch: hipFuncSetAttribute failed\n"); grid = -1; return; }
        if (hipOccupancyMaxActiveBlocksPerMultiprocessor(&per_cu, (const void*)fwd_kernel, NTHR, LDS_BYTES) != hipSuccess || per_cu < 1) { fprintf(stderr, "kernel_launch: occupancy query says %d\n", per_cu); per_cu = 1; }
        (void)hipGetLastError();
        grid = cus;
        fprintf(stderr, "kernel_launch: grid %d, per_cu %d\n", grid, per_cu);
    }
    if (grid < 0) return;
    hipMemsetAsync((char*)d_ws + WS_CTL, 0, CTL_BYTES, stream);
    Params p{};
    for (int i = 0; i < 24; ++i) p.in[i] = (const float*)d_in[i];
    p.out = (float*)d_out; p.ws = (unsigned char*)d_ws;
    if (N_LAUNCHES == 1) {
        p.ph_lo = 0; p.ph_hi = NPHASE; void* args[] = {&p};
        hipError_t e = hipLaunchCooperativeKernel((const void*)fwd_kernel, dim3(grid), dim3(NTHR), args, LDS_BYTES, stream);
        if (e != hipSuccess) fprintf(stderr, "cooperative launch failed: %s (grid %d)\n", hipGetErrorString(e), grid);
    } else {
        for (int ph = 0; ph < NPHASE; ++ph) { p.ph_lo = ph; p.ph_hi = ph + 1; hipLaunchKernelGGL(fwd_kernel, dim3(grid), dim3(NTHR), LDS_BYTES, stream, p); }
    }
}
```

```cpp
#include <hip/hip_runtime.h>
#include <hip/hip_cooperative_groups.h>
#include <cstdio>
#define PROBE_REP -1
#define PROBE_SUB 0
namespace pg8 {
#define PG8_LAS __attribute__((address_space(3)))
typedef unsigned short bf16_t;
typedef short bf16x8 __attribute__((ext_vector_type(8)));
typedef float f32x4 __attribute__((ext_vector_type(4)));
typedef unsigned u32x4 __attribute__((ext_vector_type(4)));
constexpr int BM = 256, BK = 64, HALF = 128, HTB = HALF * BK * 2  , STAGE_BYTES = 8 * HTB, NXCD = 8, WGM = 8;

__host__ __device__ __forceinline__ int lds_byte(int r, int c) { const int st = (r >> 4) * 2 + (c >> 5), rr = r & 15, cc = c & 31, ob = rr * 64 + cc * 2; return st * 1024 + (ob ^ (((ob >> 9) & 1) << 5)); }
__host__ __device__ __forceinline__ void stage_rc(int b, int& R, int& C) { const int st = b / 1024, sb = b % 1024, swz = sb ^ (((sb >> 9) & 1) << 5); R = (st >> 1) * 16 + swz / 64; C = (st & 1) * 32 + (swz % 64) / 2; }
__host__ __device__ __forceinline__ int perm32(int rho) { const int n = rho >> 4, i = rho & 15; return 8 * (i >> 2) + 4 * n + (i & 3); }

struct Unit { int pm, pn; };
struct Gemm { const bf16_t* A; const bf16_t* Bt; int M, N, K; };

struct StaticOrder {
    int nM, nN, nwg, G, c;
    __host__ __device__ void init(int M, int N, int G_, int c_) { nM = M / BM; nN = N / BM; nwg = nM * nN; G = G_; c = c_; }
    __host__ __device__ bool next(int i, Unit& u) const {
        const long L = (long)i * G + c; if (L >= nwg) return false;
        int wgid = (int)L; { const int q = nwg / NXCD, r = nwg % NXCD, xcd = wgid % NXCD, off = wgid / NXCD; wgid = (xcd < r ? xcd * (q + 1) : r * (q + 1) + (xcd - r) * q) + off; }
        const int nig = WGM * nN, gid = wgid / nig, fm = gid * WGM, gsz = (nM - fm) < WGM ? (nM - fm) : WGM;
        u.pm = fm + ((wgid % nig) % gsz); u.pn = (wgid % nig) / gsz; return true;
    }
    __device__ __forceinline__ void a_ready(const Unit&) const {}
    __device__ __forceinline__ void done(const Unit&) const {}
};
struct CountedOrder : StaticOrder {
    const unsigned* ready; unsigned need; unsigned* tmo;
    __device__ __forceinline__ void a_ready(const Unit& u) const {
        if (threadIdx.x < 64) {
            const unsigned long long t0 = __builtin_amdgcn_s_memrealtime(); unsigned polls = 0;
            while ((unsigned)__builtin_amdgcn_readfirstlane(__hip_atomic_load(ready + 64 * u.pm, __ATOMIC_RELAXED, __HIP_MEMORY_SCOPE_AGENT)) < need) {
                if ((++polls & 255u) == 0u && __builtin_amdgcn_readfirstlane(__hip_atomic_load(tmo, __ATOMIC_RELAXED, __HIP_MEMORY_SCOPE_AGENT)) != 0u) break;
                if (__builtin_amdgcn_s_memrealtime() - t0 > 2000000ull) {
                    if (threadIdx.x == 0) { unsigned expect = 0u; __hip_atomic_compare_exchange_strong(tmo + 1, &expect, 0x600u | (unsigned)(u.pm & 0xff), __ATOMIC_RELAXED, __ATOMIC_RELAXED, __HIP_MEMORY_SCOPE_AGENT); __hip_atomic_store(tmo, 1u, __ATOMIC_RELAXED, __HIP_MEMORY_SCOPE_AGENT); }
                    break; }
                __builtin_amdgcn_s_sleep(2); }
            __builtin_amdgcn_fence(__ATOMIC_ACQUIRE, "agent");
            asm volatile("s_waitcnt vmcnt(0)" ::: "memory");
        }
#if !defined(BROKEN_HOOK_NO_BARRIER)
        asm volatile("" ::: "memory"); __builtin_amdgcn_s_barrier(); asm volatile("" ::: "memory");
#endif
    }
};

__device__ __forceinline__ unsigned cvt_pk_bf16(float lo, float hi) { unsigned r; asm volatile("v_cvt_pk_bf16_f32 %0, %1, %2" : "=v"(r) : "v"(lo), "v"(hi)); return r; }
typedef float f32x2 __attribute__((ext_vector_type(2)));
__device__ __forceinline__ f32x2 gelu_pk(f32x2 v) {
    const f32x2 av = __builtin_elementwise_abs(v), d = av * 0.2316418882f + 1.0f;
    f32x2 t; t.x = __builtin_amdgcn_rcpf(d.x); t.y = __builtin_amdgcn_rcpf(d.y);
    f32x2 q = t * 0.5307027145f + (-0.7265760135f); q = q * t + 0.7107068705f; q = q * t + (-0.142248368f); q = q * t + 0.127414796f; q = q * t;
    const f32x2 s = (v * v) * (-0.72134752044f);
    f32x2 e; e.x = __builtin_amdgcn_exp2f(s.x); e.y = __builtin_amdgcn_exp2f(s.y);
    const f32x2 m = v * (q * e), r = v - m;
    f32x2 o; o.x = v.x < 0.f ? m.x : r.x; o.y = v.y < 0.f ? m.y : r.y; return o;
}

struct EpiF32 {
    static constexpr bool PERM = false, AFTER_DRAIN = false;
    float* C; int ldc; const float* bias;
    __device__ __forceinline__ void operator()(const f32x4 (&acc)[2][2][4][2], const Unit& u, int wr, int wc, int fr, int fq) const {
        const int row0 = u.pm * BM + wr * 64 + fr, col0 = u.pn * BM + wc * 32 + 4 * fq;
        f32x4 bv[2][2];
#pragma unroll
        for (int bj = 0; bj < 2; ++bj)
#pragma unroll
            for (int n = 0; n < 2; ++n) bv[bj][n] = bias ? *(const f32x4*)(bias + col0 + bj * HALF + n * 16) : (f32x4){0.f, 0.f, 0.f, 0.f};
#pragma unroll
        for (int ai = 0; ai < 2; ++ai)
#pragma unroll
            for (int m = 0; m < 4; ++m) { float* rowp = C + (size_t)(row0 + ai * HALF + m * 16) * ldc + col0;
#pragma unroll
                for (int bj = 0; bj < 2; ++bj)
#pragma unroll
                    for (int n = 0; n < 2; ++n) *(f32x4*)(rowp + bj * HALF + n * 16) = acc[ai][bj][m][n] + bv[bj][n]; }
    }
};
template <int ACT  > struct EpiBf16 {
    static constexpr bool PERM = true, AFTER_DRAIN = false;
    bf16_t* O; int ldc; const float* bias; int split_cols; size_t split_stride;
    __device__ __forceinline__ void operator()(const f32x4 (&acc)[2][2][4][2], const Unit& u, int wr, int wc, int fr, int fq) const {
        const int row0 = u.pm * BM + wr * 64 + fr; int colt = u.pn * BM; bf16_t* base = O;
        if (split_cols) { const int t = colt / split_cols; base += (size_t)t * split_stride; colt -= t * split_cols; }
        const int col0 = colt + wc * 32 + 8 * fq, bcol0 = u.pn * BM + wc * 32 + 8 * fq;
        f32x4 bv[2][2];
#pragma unroll
        for (int bj = 0; bj < 2; ++bj)
#pragma unroll
            for (int n = 0; n < 2; ++n) bv[bj][n] = bias ? *(const f32x4*)(bias + bcol0 + bj * HALF + 4 * n) : (f32x4){0.f, 0.f, 0.f, 0.f};
#pragma unroll
        for (int ai = 0; ai < 2; ++ai)
#pragma unroll
            for (int m = 0; m < 4; ++m) { bf16_t* rowp = base + (size_t)(row0 + ai * HALF + m * 16) * ldc + col0;
#pragma unroll
                for (int bj = 0; bj < 2; ++bj) { f32x4 v0 = acc[ai][bj][m][0] + bv[bj][0], v1 = acc[ai][bj][m][1] + bv[bj][1];
                    if (ACT == 1) { f32x2 a = gelu_pk((f32x2){v0[0], v0[1]}), b = gelu_pk((f32x2){v0[2], v0[3]}), c = gelu_pk((f32x2){v1[0], v1[1]}), d = gelu_pk((f32x2){v1[2], v1[3]});
                        v0 = (f32x4){a.x, a.y, b.x, b.y}; v1 = (f32x4){c.x, c.y, d.x, d.y}; }
                    if (ACT == 2) {
#pragma unroll
                        for (int j = 0; j < 4; ++j) { v0[j] = 0.5f * v0[j] * (1.0f + erff(v0[j] * 0.70710678f)); v1[j] = 0.5f * v1[j] * (1.0f + erff(v1[j] * 0.70710678f)); } }
                    u32x4 w; w.x = cvt_pk_bf16(v0[0], v0[1]); w.y = cvt_pk_bf16(v0[2], v0[3]); w.z = cvt_pk_bf16(v1[0], v1[1]); w.w = cvt_pk_bf16(v1[2], v1[3]);
                    *(u32x4*)(rowp + bj * HALF) = w; } }
    }
};

struct PanelStats {
    unsigned* xbuf;
    unsigned* cnt;
    unsigned* tmo;
    int ntn; float eps;
    unsigned code;
    __device__ __forceinline__ bool run(const f32x4 (&v)[2][2][4][2], const Unit& u, int wr, int wc, int fr, int fq, PG8_LAS unsigned char* lds, int wid, int lane) const {
        typedef float f32x2v __attribute__((ext_vector_type(2)));
        PG8_LAS f32x2v* P = (PG8_LAS f32x2v*)lds;
        PG8_LAS f32x2v* S = (PG8_LAS f32x2v*)(lds + 8192);
        PG8_LAS unsigned* flag = (PG8_LAS unsigned*)(lds + 8192 + 2048);
#pragma unroll
        for (int ai = 0; ai < 2; ++ai)
#pragma unroll
            for (int m = 0; m < 4; ++m) {
                float s = 0.f;
#pragma unroll
                for (int bj = 0; bj < 2; ++bj)
#pragma unroll
                    for (int n = 0; n < 2; ++n) { const f32x4 x = v[ai][bj][m][n]; s += (x[0] + x[1]) + (x[2] + x[3]); }
                s += __shfl_xor(s, 16); s += __shfl_xor(s, 32);
                const float mw = s * (1.0f / 64.0f); float q = 0.f;
#pragma unroll
                for (int bj = 0; bj < 2; ++bj)
#pragma unroll
                    for (int n = 0; n < 2; ++n) { const f32x4 d = v[ai][bj][m][n] - mw; q += (d[0] * d[0] + d[1] * d[1]) + (d[2] * d[2] + d[3] * d[3]); }
                q += __shfl_xor(q, 16); q += __shfl_xor(q, 32);
                if (fq == 0) P[(ai * HALF + wr * 64 + m * 16 + fr) * 4 + wc] = (f32x2v){mw, q};
            }
        asm volatile("s_waitcnt lgkmcnt(0)" ::: "memory"); __builtin_amdgcn_s_barrier(); asm volatile("" ::: "memory");
#if defined(BROKEN_NO_WAIT)
        if (blockIdx.x >= 64) { const long long t0 = clock64(); while (clock64() - t0 < 60000) __builtin_amdgcn_s_sleep(8); }
#endif
        const int row = wid * 32 + (lane & 31);
        if (lane < 32) {
            const f32x2v a = P[row * 4 + 0], b = P[row * 4 + 1], c = P[row * 4 + 2], d = P[row * 4 + 3];
            const float mt = (a.x + b.x + c.x + d.x) * 0.25f;
            const float da = a.x - mt, db = b.x - mt, dc = c.x - mt, dd = d.x - mt;
            const float m2 = (a.y + b.y) + (c.y + d.y) + 64.0f * ((da * da + db * db) + (dc * dc + dd * dd));
            unsigned long long* slot = (unsigned long long*)xbuf + ((size_t)(u.pm * BM + row) * 4 + u.pn);
            __hip_atomic_store(slot, ((unsigned long long)__float_as_uint(m2) << 32) | __float_as_uint(mt), __ATOMIC_RELAXED, __HIP_MEMORY_SCOPE_AGENT);
        }
        asm volatile("s_waitcnt vmcnt(0)" ::: "memory");
        if (lane == 0) __hip_atomic_fetch_add(cnt + 64 * u.pm, 1u, __ATOMIC_RELAXED, __HIP_MEMORY_SCOPE_AGENT);
        if (wid == 0) {
            bool dead = false; const unsigned long long t0 = __builtin_amdgcn_s_memrealtime(); const unsigned want = 8u * (unsigned)ntn;
            for (;;) {
#if defined(BROKEN_NO_WAIT)
                break;
#endif
                if ((unsigned)__builtin_amdgcn_readfirstlane(__hip_atomic_load(cnt + 64 * u.pm, __ATOMIC_RELAXED, __HIP_MEMORY_SCOPE_AGENT)) >= want) break;
                if (__builtin_amdgcn_s_memrealtime() - t0 > 2000000ull) {
                    if (lane == 0) { unsigned expect = 0u; __hip_atomic_compare_exchange_strong(tmo + 1, &expect, code | (unsigned)(u.pm & 0xff), __ATOMIC_RELAXED, __ATOMIC_RELAXED, __HIP_MEMORY_SCOPE_AGENT);
                                     __hip_atomic_store(tmo, 1u, __ATOMIC_RELAXED, __HIP_MEMORY_SCOPE_AGENT); }
                    dead = true; break; }
                __builtin_amdgcn_s_sleep(2);
            }
            __builtin_amdgcn_fence(__ATOMIC_ACQUIRE, "agent");
            if (lane == 0) flag[0] = dead ? 1u : 0u;
        }
        asm volatile("s_waitcnt vmcnt(0) lgkmcnt(0)" ::: "memory"); __builtin_amdgcn_s_barrier(); asm volatile("" ::: "memory");
        const bool bad = flag[0] != 0u;
        if (lane < 32) {
            const unsigned long long* slot = (const unsigned long long*)xbuf + (size_t)(u.pm * BM + row) * 4; float mt[4], m2[4]; float ms = 0.f;
#pragma unroll
            for (int t = 0; t < 4; ++t) { if (t < ntn) { const unsigned long long w = __hip_atomic_load(slot + t, __ATOMIC_RELAXED, __HIP_MEMORY_SCOPE_AGENT); mt[t] = __uint_as_float((unsigned)w); m2[t] = __uint_as_float((unsigned)(w >> 32)); } else { mt[t] = 0.f; m2[t] = 0.f; } ms += mt[t]; }
            const float mean = ms / (float)ntn; float q = 0.f;
#pragma unroll
            for (int t = 0; t < 4; ++t) if (t < ntn) { const float dm = mt[t] - mean; q += m2[t] + 256.0f * dm * dm; }
            S[row] = (f32x2v){mean, 1.0f / sqrtf(q / (256.0f * (float)ntn) + eps)};
        }
        asm volatile("s_waitcnt lgkmcnt(0)" ::: "memory"); __builtin_amdgcn_s_barrier(); asm volatile("" ::: "memory");
        return bad;
    }
};
struct EpiLnRes {
    static constexpr bool PERM = false, AFTER_DRAIN = true;
    const float* base; float* out; int ldc; const float* bias; PanelStats st; unsigned poison;
    __device__ __forceinline__ void refuse(size_t i0, size_t stride, int M, int N) const { const float q = __builtin_nanf(""); for (size_t i = i0; i < (size_t)M * N; i += stride) out[(i / N) * ldc + i % N] = q;
        if (i0 == 0) { unsigned expect = 0u; __hip_atomic_compare_exchange_strong(st.tmo + 1, &expect, 0x7f0u, __ATOMIC_RELAXED, __ATOMIC_RELAXED, __HIP_MEMORY_SCOPE_AGENT); __hip_atomic_store(st.tmo, 1u, __ATOMIC_RELAXED, __HIP_MEMORY_SCOPE_AGENT); } }
    __device__ __forceinline__ void fused(f32x4 (&acc)[2][2][4][2], const Unit& u, int wr, int wc, int fr, int fq, PG8_LAS unsigned char* lds, int wid, int lane) const {
        typedef float f32x2v __attribute__((ext_vector_type(2)));
        const PG8_LAS f32x2v* S = (const PG8_LAS f32x2v*)(lds + 8192);
        const int col0 = u.pn * BM + wc * 32 + 4 * fq;
#pragma unroll
        for (int bj = 0; bj < 2; ++bj)
#pragma unroll
            for (int n = 0; n < 2; ++n) { const f32x4 bv = bias ? *(const f32x4*)(bias + col0 + bj * HALF + n * 16) : (f32x4){0.f, 0.f, 0.f, 0.f};
#pragma unroll
                for (int ai = 0; ai < 2; ++ai)
#pragma unroll
                    for (int m = 0; m < 4; ++m) acc[ai][bj][m][n] += bv; }
        const bool bad = st.run(acc, u, wr, wc, fr, fq, lds, wid, lane) || poison != 0u;
        const float qnan = __builtin_nanf("");
#pragma unroll
        for (int ai = 0; ai < 2; ++ai)
#pragma unroll
            for (int m = 0; m < 4; ++m) { const int r = ai * HALF + wr * 64 + m * 16 + fr; const f32x2v sr = S[r]; const size_t off = (size_t)(u.pm * BM + r) * ldc + col0;
#pragma unroll
                for (int bj = 0; bj < 2; ++bj)
#pragma unroll
                    for (int n = 0; n < 2; ++n) { const f32x4 bs = *(const f32x4*)(base + off + bj * HALF + n * 16); f32x4 o = bs + (acc[ai][bj][m][n] - sr.x) * sr.y;
                        if (bad) o = (f32x4){qnan, qnan, qnan, qnan}; *(f32x4*)(out + off + bj * HALF + n * 16) = o; }
                asm volatile("" ::: "memory"); }
    }
};
struct EpiLnResLn {
    static constexpr bool PERM = false, AFTER_DRAIN = true;
    const float* base; float* out; bf16_t* xn; int ldc; const float* bias; PanelStats st1, st2; unsigned poison;
    __device__ __forceinline__ void refuse(size_t i0, size_t stride, int M, int N) const { const float q = __builtin_nanf(""); for (size_t i = i0; i < (size_t)M * N; i += stride) { const size_t o = (i / N) * ldc + i % N; out[o] = q; xn[o] = (bf16_t)0x7fc0u; }
        if (i0 == 0) { unsigned expect = 0u; __hip_atomic_compare_exchange_strong(st1.tmo + 1, &expect, 0x7f0u, __ATOMIC_RELAXED, __ATOMIC_RELAXED, __HIP_MEMORY_SCOPE_AGENT); __hip_atomic_store(st1.tmo, 1u, __ATOMIC_RELAXED, __HIP_MEMORY_SCOPE_AGENT); } }
    __device__ __forceinline__ void fused(f32x4 (&acc)[2][2][4][2], const Unit& u, int wr, int wc, int fr, int fq, PG8_LAS unsigned char* lds, int wid, int lane) const {
        typedef float f32x2v __attribute__((ext_vector_type(2))); typedef unsigned u32x2v __attribute__((ext_vector_type(2)));
        const PG8_LAS f32x2v* S = (const PG8_LAS f32x2v*)(lds + 8192);
        const int col0 = u.pn * BM + wc * 32 + 4 * fq;
#pragma unroll
        for (int bj = 0; bj < 2; ++bj)
#pragma unroll
            for (int n = 0; n < 2; ++n) { const f32x4 bv = bias ? *(const f32x4*)(bias + col0 + bj * HALF + n * 16) : (f32x4){0.f, 0.f, 0.f, 0.f};
#pragma unroll
                for (int ai = 0; ai < 2; ++ai)
#pragma unroll
                    for (int m = 0; m < 4; ++m) acc[ai][bj][m][n] += bv; }
        bool bad = st1.run(acc, u, wr, wc, fr, fq, lds, wid, lane) || poison != 0u;
        const float qnan = __builtin_nanf("");
#pragma unroll
        for (int ai = 0; ai < 2; ++ai)
#pragma unroll
            for (int m = 0; m < 4; ++m) { const int r = ai * HALF + wr * 64 + m * 16 + fr; const f32x2v sr = S[r]; const size_t off = (size_t)(u.pm * BM + r) * ldc + col0;
#pragma unroll
                for (int bj = 0; bj < 2; ++bj)
#pragma unroll
                    for (int n = 0; n < 2; ++n) { const f32x4 bs = *(const f32x4*)(base + off + bj * HALF + n * 16); acc[ai][bj][m][n] = bs + (acc[ai][bj][m][n] - sr.x) * sr.y; }
                asm volatile("" : "+v"(acc[ai][0][m][0]), "+v"(acc[ai][0][m][1]), "+v"(acc[ai][1][m][0]), "+v"(acc[ai][1][m][1]));
                if (m & 1) asm volatile("" ::: "memory"); }
        const bool bad1 = bad;
        bad = st2.run(acc, u, wr, wc, fr, fq, lds, wid, lane) || bad;
#pragma unroll
        for (int ai = 0; ai < 2; ++ai)
#pragma unroll
            for (int m = 0; m < 4; ++m) { const int r = ai * HALF + wr * 64 + m * 16 + fr; const f32x2v sr = S[r]; const size_t off = (size_t)(u.pm * BM + r) * ldc + col0;
#pragma unroll
                for (int bj = 0; bj < 2; ++bj)
#pragma unroll
                    for (int n = 0; n < 2; ++n) { const f32x4 x1 = acc[ai][bj][m][n]; *(f32x4*)(out + off + bj * HALF + n * 16) = bad1 ? (f32x4){qnan, qnan, qnan, qnan} : x1;
                        const f32x4 o = (x1 - sr.x) * sr.y; u32x2v w; w.x = cvt_pk_bf16(o[0], o[1]); w.y = cvt_pk_bf16(o[2], o[3]);
                        if (bad) { w.x = 0x7fc07fc0u; w.y = 0x7fc07fc0u; } *(u32x2v*)(xn + off + bj * HALF + n * 16) = w; }
                asm volatile("" ::: "memory"); }
    }
};

template <class Epi, class Sched, bool STAMP = false>
__device__ __forceinline__ void gemm_phase(PG8_LAS unsigned char* lds, const Gemm g, const Sched& S, const Epi& E, unsigned long long* stamps) {
    const int tid = threadIdx.x, wid = __builtin_amdgcn_readfirstlane(tid >> 6), lane = tid & 63, wr = wid >> 2, wc = wid & 3, fr = lane & 15, fq = lane >> 4;
    const int K = g.K, nt = K / BK;
    int ts_lo = 0, ts_hi = 0, nts = 0; const unsigned long long rt_entry = STAMP ? (unsigned long long)wall_clock64() : 0ull;
#define PG8_STAMP() do { if (STAMP && wid == 0 && nts < 64) { const unsigned long long _c = (unsigned long long)clock64(); \
        ts_lo = (lane == nts) ? (int)(unsigned)_c : ts_lo; ts_hi = (lane == nts) ? (int)(unsigned)(_c >> 32) : ts_hi; ++nts; } } while (0)
    PG8_STAMP();
    unsigned voffA[2], voffB[2];
#pragma unroll
    for (int i = 0; i < 2; ++i) { int R, C; stage_rc(tid * 16 + i * 8192, R, C); const int Rb = Epi::PERM ? ((R & ~31) + perm32(R & 31)) : R;
        voffA[i] = (unsigned)(R * K + C) * 2u; voffB[i] = (unsigned)(Rb * K + C) * 2u; }
    const size_t kstep = (size_t)(BK * 2);
    const size_t hstep = (size_t)HALF * K * 2;
    const size_t tstep = 2 * hstep;
    const unsigned ldsw = (unsigned)wid * 1024u;
    const int aoff = lds_byte(wr * 64 + fr, fq * 8), boff = lds_byte(wc * 32 + fr, fq * 8);
#define PG8_SA(b, h) (((b) * 2 + (h)) * HTB)
#define PG8_SB(b, h) ((4 + (b) * 2 + (h)) * HTB)
#define PG8_STAGE(bufoff, gbase, voff) do { _Pragma("unroll") for (int _i = 0; _i < 2; ++_i) \
        __builtin_amdgcn_global_load_lds((const unsigned*)((const char*)(gbase) + (voff)[_i]), (PG8_LAS unsigned*)(lds + (bufoff) + ldsw + _i * 8192), 16, 0, 0); } while (0)
#define PG8_LDA(dst, b, h) do { _Pragma("unroll") for (int m = 0; m < 4; ++m) _Pragma("unroll") for (int k = 0; k < 2; ++k) dst[m][k] = *(const PG8_LAS bf16x8*)(lds + PG8_SA(b, h) + aoff + m * 2048 + k * 1024); } while (0)
#define PG8_LDB(dst, b, h) do { _Pragma("unroll") for (int n = 0; n < 2; ++n) _Pragma("unroll") for (int k = 0; k < 2; ++k) dst[n][k] = *(const PG8_LAS bf16x8*)(lds + PG8_SB(b, h) + boff + n * 2048 + k * 1024); } while (0)
#define PG8_MMA(ai, bj, At, Bt) do { __builtin_amdgcn_s_setprio(1); _Pragma("unroll") for (int m = 0; m < 4; ++m) _Pragma("unroll") for (int n = 0; n < 2; ++n) _Pragma("unroll") for (int k = 0; k < 2; ++k) \
        acc[ai][bj][m][n] = __builtin_amdgcn_mfma_f32_16x16x32_bf16(Bt[n][k], At[m][k], acc[ai][bj][m][n], 0, 0, 0); __builtin_amdgcn_s_setprio(0); } while (0)
#define PG8_WAIT_V(n) asm volatile("s_waitcnt vmcnt(" #n ")" ::: "memory")
#define PG8_WAIT_L(n) asm volatile("s_waitcnt lgkmcnt(" #n ")" ::: "memory")
#define PG8_BAR __builtin_amdgcn_s_barrier()
#define PG8_SCHED __builtin_amdgcn_sched_barrier(0)
    Unit cur, nxt; int ui = 0;
    if (!S.next(0, cur)) return;
    f32x4 acc[2][2][4][2];
#pragma unroll
    for (int a = 0; a < 2; ++a)
#pragma unroll
        for (int b = 0; b < 2; ++b)
#pragma unroll
            for (int m = 0; m < 4; ++m)
#pragma unroll
                for (int n = 0; n < 2; ++n) acc[a][b][m][n] = (f32x4){0.f, 0.f, 0.f, 0.f};
    bf16x8 At[4][2], B0[2][2], B1[2][2];
    const char* cA = (const char*)g.A + (size_t)cur.pm * tstep; const char* cB = (const char*)g.Bt + (size_t)cur.pn * tstep;
    S.a_ready(cur);
    PG8_STAGE(PG8_SB(0, 0), cB, voffB); PG8_STAGE(PG8_SA(0, 0), cA, voffA); PG8_STAGE(PG8_SB(0, 1), cB + hstep, voffB); PG8_STAGE(PG8_SA(0, 1), cA + hstep, voffA);
    if (wr == 1) PG8_BAR;
    PG8_WAIT_V(4); PG8_BAR;
    PG8_STAGE(PG8_SB(1, 0), cB + kstep, voffB); PG8_STAGE(PG8_SA(1, 0), cA + kstep, voffA); PG8_STAGE(PG8_SB(1, 1), cB + hstep + kstep, voffB);
    PG8_WAIT_V(6); PG8_BAR;
    PG8_STAMP();
    for (;;) {
        const bool has_next = S.next(ui + 1, nxt);
        const char* nA = has_next ? (const char*)g.A + (size_t)nxt.pm * tstep : cA; const char* nB = has_next ? (const char*)g.Bt + (size_t)nxt.pn * tstep : cB;
        for (int t = 0; t < nt; t += 2) {
            const bool last = (t == nt - 2);
            const char* a1 = cA + (size_t)(t + 1) * kstep;
            const char* a2 = last ? nA : cA + (size_t)(t + 2) * kstep; const char* b2 = last ? nB : cB + (size_t)(t + 2) * kstep;
            const char* a3 = a2 + kstep; const char* b3 = b2 + kstep;
            if (last && has_next) S.a_ready(nxt);
            PG8_LDB(B0, 0, 0); PG8_SCHED; PG8_LDA(At, 0, 0); PG8_STAGE(PG8_SA(1, 1), a1 + hstep, voffA);
            PG8_WAIT_L(8); PG8_BAR; PG8_WAIT_L(0); PG8_MMA(0, 0, At, B0); PG8_BAR; PG8_SCHED;
            PG8_LDB(B1, 0, 1); PG8_STAGE(PG8_SB(0, 0), b2, voffB);
            PG8_BAR; PG8_WAIT_L(0); PG8_MMA(0, 1, At, B1); PG8_BAR;
            PG8_LDA(At, 0, 1); PG8_STAGE(PG8_SA(0, 0), a2, voffA);
            PG8_BAR; PG8_WAIT_L(0); PG8_MMA(1, 0, At, B0); PG8_BAR; PG8_SCHED;
            PG8_STAGE(PG8_SB(0, 1), b2 + hstep, voffB);
            PG8_WAIT_V(6); PG8_BAR; PG8_MMA(1, 1, At, B1); PG8_BAR;
            PG8_LDB(B0, 1, 0); PG8_SCHED; PG8_LDA(At, 1, 0); PG8_STAGE(PG8_SA(0, 1), a2 + hstep, voffA);
            PG8_WAIT_L(8); PG8_BAR; PG8_WAIT_L(0); PG8_MMA(0, 0, At, B0); PG8_BAR; PG8_SCHED;
            PG8_LDB(B1, 1, 1); PG8_STAGE(PG8_SB(1, 0), b3, voffB);
            PG8_BAR; PG8_WAIT_L(0); PG8_MMA(0, 1, At, B1); PG8_BAR;
            PG8_LDA(At, 1, 1); PG8_STAGE(PG8_SA(1, 0), a3, voffA);
            PG8_BAR; PG8_WAIT_L(0); PG8_MMA(1, 0, At, B0); PG8_BAR; PG8_SCHED;
            PG8_STAGE(PG8_SB(1, 1), b3 + hstep, voffB);
            PG8_WAIT_V(6); PG8_BAR; PG8_MMA(1, 1, At, B1); PG8_BAR;
        }
        PG8_STAMP();
        if constexpr (!Epi::AFTER_DRAIN) { E(acc, cur, wr, wc, fr, fq); S.done(cur); }
        PG8_STAMP();
        if (!has_next) break;
#pragma unroll
        for (int a = 0; a < 2; ++a)
#pragma unroll
            for (int b = 0; b < 2; ++b)
#pragma unroll
                for (int m = 0; m < 4; ++m)
#pragma unroll
                    for (int n = 0; n < 2; ++n) acc[a][b][m][n] = (f32x4){0.f, 0.f, 0.f, 0.f};
        cur = nxt; cA = nA; cB = nB; ++ui;
    }
    PG8_WAIT_V(0);
    if (wr == 0) PG8_BAR;
    PG8_BAR;
    if constexpr (Epi::AFTER_DRAIN) { E.fused(acc, cur, wr, wc, fr, fq, lds, wid, lane); S.done(cur); }
    PG8_STAMP();
    if (STAMP && wid == 0) { stamps[lane] = lane < nts ? (((unsigned long long)(unsigned)ts_hi << 32) | (unsigned)ts_lo) : 0ull;
        if (lane == 62) stamps[62] = rt_entry; if (lane == 63) stamps[63] = (unsigned long long)wall_clock64(); }
#undef PG8_STAMP
#undef PG8_SA
#undef PG8_SB
#undef PG8_STAGE
#undef PG8_LDA
#undef PG8_LDB
#undef PG8_MMA
#undef PG8_WAIT_V
#undef PG8_WAIT_L
#undef PG8_BAR
#undef PG8_SCHED
}
}

namespace cg = cooperative_groups;
typedef unsigned short bf16_t;
typedef short bf16x8 __attribute__((ext_vector_type(8)));
typedef float f32x4 __attribute__((ext_vector_type(4)));
typedef unsigned u32x4 __attribute__((ext_vector_type(4)));
typedef unsigned u32x2 __attribute__((ext_vector_type(2)));

constexpr int NB = 8, NT = 4096, DM = 1024, NTOK = NB * NT;
constexpr int DIN = 4744, NPAD = 4864;
constexpr int C_R = 0, C_K = 512, C_V = 1024, C_WD = 1536, C_AD = 1600, C_ZR = 1664, C_Q = 2176, C_KM = 2688, C_VM = 3200, C_O = 3712, C_I = 4224, C_F = 4228, C_ZM = 4232;
constexpr int NTHR = 512, NWV = 8;
constexpr int LDS_BYTES = 147456;
constexpr int NPHASE = 8;

constexpr size_t MiB = 1u << 20;
constexpr size_t WS_CTL = 0, CTL_BYTES = 1 * MiB;
constexpr size_t WS_ADA = 1 * MiB;
constexpr size_t WS_LORA = 1 * MiB + 512 * 1024;
constexpr size_t WS_WL = 14 * MiB, WS_BONUS = 15 * MiB;
constexpr size_t WS_WIN = 2 * MiB;
constexpr size_t WS_WOUT = 12 * MiB;
constexpr size_t WS_X = 16 * MiB;
constexpr size_t WS_PROJ = 144 * MiB;
constexpr size_t WS_Y = 448 * MiB;
constexpr size_t WS_END = 512 * MiB;

struct Params { const float* in[24]; float* out; unsigned char* ws; int ph_lo, ph_hi; };

struct Ctx {
    const Params& p;
    __device__ __forceinline__ const float* x() const { return p.in[0]; }
    __device__ __forceinline__ const float* c() const { return p.in[1]; }
    __device__ __forceinline__ const float* w_ada() const { return p.in[2]; }
    __device__ __forceinline__ const float* b_ada() const { return p.in[3]; }
    __device__ __forceinline__ const float* norm_gain() const { return p.in[4]; }
    __device__ __forceinline__ const float* w_in() const { return p.in[5]; }
    __device__ __forceinline__ const float* mu() const { return p.in[6]; }
    __device__ __forceinline__ const float* w_dup() const { return p.in[7]; }
    __device__ __forceinline__ const float* w_d0() const { return p.in[8]; }
    __device__ __forceinline__ const float* w_iup() const { return p.in[9]; }
    __device__ __forceinline__ const float* a0() const { return p.in[10]; }
    __device__ __forceinline__ const float* k_k() const { return p.in[11]; }
    __device__ __forceinline__ const float* k_a() const { return p.in[12]; }
    __device__ __forceinline__ const float* r_k() const { return p.in[13]; }
    __device__ __forceinline__ const float* gn_w() const { return p.in[14]; }
    __device__ __forceinline__ const float* gn_b() const { return p.in[15]; }
    __device__ __forceinline__ const float* conv_w() const { return p.in[16]; }
    __device__ __forceinline__ const float* conv_b() const { return p.in[17]; }
    __device__ __forceinline__ const float* b_i() const { return p.in[18]; }
    __device__ __forceinline__ const float* b_f() const { return p.in[19]; }
    __device__ __forceinline__ const float* ln_w() const { return p.in[20]; }
    __device__ __forceinline__ const float* skip() const { return p.in[21]; }
    __device__ __forceinline__ const float* w_out() const { return p.in[22]; }
    __device__ __forceinline__ const float* fgain() const { return p.in[23]; }
    __device__ __forceinline__ float* out() const { return p.out; }
    __device__ __forceinline__ float* sumsq() const { return (float*)(p.ws + (WS_Y)); }
    __device__ __forceinline__ float* ada() const { return (float*)(p.ws + (WS_ADA)); }
    __device__ __forceinline__ bf16_t* win_t() const { return (bf16_t*)(p.ws + (WS_WIN)); }
    __device__ __forceinline__ bf16_t* wout_t() const { return (bf16_t*)(p.ws + (WS_WOUT)); }
    __device__ __forceinline__ bf16_t* hn() const { return (bf16_t*)(p.ws + (WS_X)); }
    __device__ __forceinline__ bf16_t* proj() const { return (bf16_t*)(p.ws + (WS_PROJ)); }
    __device__ __forceinline__ bf16_t* y() const { return (bf16_t*)(p.ws + (WS_Y)); }
    __device__ __forceinline__ bf16_t* wdup_t() const { return (bf16_t*)(p.ws + (WS_LORA)); }
    __device__ __forceinline__ bf16_t* wiup_t() const { return (bf16_t*)(p.ws + (WS_LORA + 65536)); }
    __device__ __forceinline__ bf16_t* q1p() const { return (bf16_t*)(p.ws + (WS_X)); }
    __device__ __forceinline__ bf16_t* mp() const { return (bf16_t*)(p.ws + (WS_X + 32 * MiB)); }
    __device__ __forceinline__ bf16_t* yid() const { return (bf16_t*)(p.ws + (WS_X + 64 * MiB)); }
    __device__ __forceinline__ bf16_t* nd() const { return (bf16_t*)(p.ws + (WS_X + 96 * MiB)); }
    __device__ __forceinline__ float* wl() const { return (float*)(p.ws + (WS_WL)); }
    __device__ __forceinline__ float* bonus() const { return (float*)(p.ws + (WS_BONUS)); }
    __device__ __forceinline__ bf16_t* qc() const { return (bf16_t*)(p.ws + WS_Y); }
    __device__ __forceinline__ bf16_t* kc() const { return (bf16_t*)(p.ws + WS_Y + 32 * MiB); }
    __device__ __forceinline__ bf16_t* mixo() const { return (bf16_t*)(p.ws + WS_Y); }
    __device__ __forceinline__ bf16_t* p0s() const { return (bf16_t*)p.out; }
    __device__ __forceinline__ bf16_t* ymix() const { return (bf16_t*)(p.ws + WS_X); }
    unsigned char* lds; int tid, lane, wid, gw, ngw;
};

__device__ __forceinline__ float bf2f(bf16_t v) { return __uint_as_float(((unsigned)v) << 16); }
typedef __bf16 bf16v2_t __attribute__((ext_vector_type(2))); typedef float f32v2_t __attribute__((ext_vector_type(2)));
__device__ __forceinline__ unsigned pk2(float lo, float hi) { const f32v2_t v = {lo, hi}; const bf16v2_t b = __builtin_convertvector(v, bf16v2_t); return __builtin_bit_cast(unsigned, b); }
__device__ __forceinline__ bf16_t f2bf(float f) { return __builtin_bit_cast(bf16_t, (__bf16)f); }
__device__ __forceinline__ void unpack8(const u32x4 v, float* o) {
    o[0] = __uint_as_float(v.x << 16); o[1] = __uint_as_float(v.x & 0xffff0000u); o[2] = __uint_as_float(v.y << 16); o[3] = __uint_as_float(v.y & 0xffff0000u);
    o[4] = __uint_as_float(v.z << 16); o[5] = __uint_as_float(v.z & 0xffff0000u); o[6] = __uint_as_float(v.w << 16); o[7] = __uint_as_float(v.w & 0xffff0000u);
}
__device__ __forceinline__ u32x4 pack8(const float* v) { u32x4 o; o.x = pk2(v[0], v[1]); o.y = pk2(v[2], v[3]); o.z = pk2(v[4], v[5]); o.w = pk2(v[6], v[7]); return o; }
__device__ __forceinline__ float wave_sum(float v) {
#pragma unroll
    for (int o = 1; o < 64; o <<= 1) v += __shfl_xor(v, o);
    return v;
}
#define LDS_BARRIER() do { asm volatile("s_waitcnt lgkmcnt(0)" ::: "memory"); __builtin_amdgcn_s_barrier(); asm volatile("" ::: "memory"); } while (0)
__device__ __forceinline__ float fexp(float x) { return __builtin_amdgcn_exp2f(x * 1.4426950408889634f); }
__device__ __forceinline__ float frcp(float x) { return __builtin_amdgcn_rcpf(x); }
__device__ __forceinline__ float sigmoidf_(float z) { return frcp(1.0f + fexp(-z)); }
__device__ __forceinline__ float siluf_(float z) { return z * frcp(1.0f + fexp(-z)); }
__device__ __forceinline__ float ftanh(float x) { return 1.0f - 2.0f * frcp(1.0f + fexp(2.0f * x)); }
template <int CTRL> __device__ __forceinline__ float dppf(float v) { return __int_as_float(__builtin_amdgcn_update_dpp(0, __float_as_int(v), CTRL, 0xF, 0xF, true)); }
__device__ __forceinline__ float row16_sum(float v) {
    v += dppf<0xB1>(v); v += dppf<0x4E>(v); v += dppf<0x141>(v); v += dppf<0x140>(v); return v;
}

__device__ __forceinline__ void transpose_item(const float* W, int K, int N, bf16_t* WT, float* scr, int item, int nblk, int lane) {
    const int kb = item / nblk, nb = item % nblk, k0 = 64 * kb, n0 = 32 * nb;
#pragma unroll 8
    for (int i = 0; i < 32; ++i) { const int kk = 2 * i + (lane >> 5); const int n = n0 + (lane & 31); scr[kk * 33 + (lane & 31)] = (n < N) ? W[(size_t)(k0 + kk) * N + n] : 0.f; }
    __builtin_amdgcn_s_waitcnt(0); asm volatile("" ::: "memory");
    const int c = lane & 7;
#pragma unroll
    for (int j = 0; j < 4; ++j) { const int n = (lane >> 3) + 8 * j; const float* s = scr + (8 * c) * 33 + n;
        u32x4 o; o.x = pk2(s[0 * 33], s[1 * 33]); o.y = pk2(s[2 * 33], s[3 * 33]); o.z = pk2(s[4 * 33], s[5 * 33]); o.w = pk2(s[6 * 33], s[7 * 33]);
        *(u32x4*)(WT + (size_t)(n0 + n) * K + k0 + 8 * c) = o; }
    __builtin_amdgcn_s_waitcnt(0); asm volatile("" ::: "memory");
}
__device__ __forceinline__ void phase0(const Ctx& C) {
    if (blockIdx.x >= 48) return;
    float* Ls = (float*)C.lds;
    float* Lp = Ls + 8192;
    for (int e = C.tid; e < 8192; e += NTHR) Ls[e] = siluf_(C.c()[e]);
    __syncthreads();
    const int lane = C.lane, wid = C.wid, grp = wid >> 2, kq = wid & 3, kp = lane >> 3, c4 = 4 * (lane & 7);
    const int col0 = (2 * blockIdx.x + grp) * 32;
    f32x4 acc[8];
#pragma unroll
    for (int b = 0; b < 8; ++b) acc[b] = (f32x4){0.f, 0.f, 0.f, 0.f};
#pragma unroll 4
    for (int it = 0; it < 32; ++it) {
        const int k = kq * 256 + it * 8 + kp;
        const f32x4 w = *(const f32x4*)(C.w_ada() + (size_t)k * 3072 + col0 + c4);
#pragma unroll
        for (int b = 0; b < 8; ++b) acc[b] = acc[b] + w * Ls[b * 1024 + k];
    }
#pragma unroll
    for (int b = 0; b < 8; ++b) {
#pragma unroll
        for (int o = 8; o < 64; o <<= 1) { acc[b].x += __shfl_xor(acc[b].x, o); acc[b].y += __shfl_xor(acc[b].y, o); acc[b].z += __shfl_xor(acc[b].z, o); acc[b].w += __shfl_xor(acc[b].w, o); }
        if (kp == 0) *(f32x4*)(Lp + ((grp * 4 + kq) * 8 + b) * 32 + c4) = acc[b];
    }
    __syncthreads();
    if (C.tid < 512) { const int g2 = C.tid >> 8, b = (C.tid >> 5) & 7, c = C.tid & 31; const int col = (2 * blockIdx.x + g2) * 32 + c;
        float s = C.b_ada()[col];
#pragma unroll
        for (int q = 0; q < 4; ++q) s += Lp[((g2 * 4 + q) * 8 + b) * 32 + c];
        C.ada()[b * 3072 + col] = s; }
}
__device__ __forceinline__ void weight_copies(const Ctx& C) {
    float* scr = (float*)(C.lds + C.wid * 16384);
    constexpr int NBI = NPAD / 32, I_IN = 16 * NBI, I_OUT = 16 * 32;
    for (int it = C.gw; it < I_IN + I_OUT + 32; it += C.ngw) {
        if (it < I_IN) transpose_item(C.w_in(), 1024, DIN, C.win_t(), scr, it, NBI, C.lane);
        else if (it < I_IN + I_OUT) transpose_item(C.w_out(), 1024, 1024, C.wout_t(), scr, it - I_IN, 32, C.lane);
        else if (it < I_IN + I_OUT + 16) transpose_item(C.w_dup(), 64, 512, C.wdup_t(), scr, it - I_IN - I_OUT, 16, C.lane);
        else transpose_item(C.w_iup(), 64, 512, C.wiup_t(), scr, it - I_IN - I_OUT - 16, 16, C.lane);
    }
}

__device__ __forceinline__ void phase1(const Ctx& C) {
    f32x4 g[4];
#pragma unroll
    for (int j = 0; j < 4; ++j) g[j] = *(const f32x4*)(C.norm_gain() + 4 * C.lane + 256 * j);
    f32x4 v[4], n1[4];
    { const f32x4* xr = (const f32x4*)(C.x() + (size_t)C.gw * DM) + C.lane; const f32x4* x1 = (const f32x4*)(C.x() + (size_t)(C.gw + C.ngw) * DM) + C.lane;
#pragma unroll
      for (int j = 0; j < 4; ++j) { v[j] = __builtin_nontemporal_load(xr + 64 * j); n1[j] = __builtin_nontemporal_load(x1 + 64 * j); } }
    f32x4 shv[4], scv[4]; int bcur = -1;
    for (int m = C.gw; m < NTOK; m += C.ngw) {
        const int b = m >> 12; const int mn = (m + 2 * C.ngw < NTOK) ? m + 2 * C.ngw : m;
        if (b != bcur) { bcur = b;
#pragma unroll
            for (int j = 0; j < 4; ++j) { shv[j] = *(const f32x4*)(C.ada() + b * 3072 + 4 * C.lane + 256 * j); scv[j] = *(const f32x4*)(C.ada() + b * 3072 + 1024 + 4 * C.lane + 256 * j) + 1.0f; } }
        f32x4 nv[4];
        { const f32x4* xr = (const f32x4*)(C.x() + (size_t)mn * DM) + C.lane;
#pragma unroll
          for (int j = 0; j < 4; ++j) nv[j] = __builtin_nontemporal_load(xr + 64 * j); }
        float s = 0.f;
#pragma unroll
        for (int j = 0; j < 4; ++j) s += (v[j].x * v[j].x + v[j].y * v[j].y) + (v[j].z * v[j].z + v[j].w * v[j].w);
        const float rs = __builtin_amdgcn_rsqf(wave_sum(s) * (1.0f / DM) + 1e-6f);
        u32x2* o = (u32x2*)(C.hn() + (size_t)m * DM) + C.lane;
#pragma unroll
        for (int j = 0; j < 4; ++j) {
            const f32x4 h = v[j] * rs * g[j] * scv[j] + shv[j];
            u32x2 w; w.x = pk2(h.x, h.y); w.y = pk2(h.z, h.w); o[64 * j] = w; }
#pragma unroll
        for (int j = 0; j < 4; ++j) { v[j] = n1[j]; n1[j] = nv[j]; }
    }
}

typedef short s16x4 __attribute__((ext_vector_type(4)));
__device__ __forceinline__ bf16x8 tr_frag(const bf16_t* base, int stride, int row0, int col0, int fr, int fq) {
    const bf16_t* a0 = base + (row0 + 8 * fq + (fr >> 2)) * stride + col0 + 4 * (fr & 3);
    const s16x4 lo = __builtin_amdgcn_ds_read_tr16_b64_v4i16((__attribute__((address_space(3))) s16x4*)a0);
    const s16x4 hi = __builtin_amdgcn_ds_read_tr16_b64_v4i16((__attribute__((address_space(3))) s16x4*)(a0 + 4 * stride));
    return (bf16x8){lo[0], lo[1], lo[2], lo[3], hi[0], hi[1], hi[2], hi[3]};
}

constexpr int LS = 72;
constexpr int XS = 68;
__device__ __forceinline__ int permc(int c) { return (c & 32) | ((c & 12) << 1) | ((c & 16) >> 2) | (c & 3); }
__device__ __forceinline__ bf16x8 zero8() { return (bf16x8){0, 0, 0, 0, 0, 0, 0, 0}; }
#define MFMA16(a, b, c) __builtin_amdgcn_mfma_f32_16x16x32_bf16(a, b, c, 0, 0, 0)
#define LDFRAG(base, row, col) (*(const bf16x8*)((base) + (row) * LS + (col)))

#define FR_(base, rowoff, coloff) (*(const bf16x8*)((base) + lfo + (rowoff) * LS + (coloff)))
#define DW_(base, rowoff, coloff, r) ((base)[ldo + ((rowoff) + (r)) * LS + (coloff)])
#define OPAQ() asm volatile("" : "+v"(lfo), "+v"(ldo), "+v"(lto), "+v"(lxo))
template <int VAR> __device__ __forceinline__ void rwkv_r1_wg(const Ctx& C, int b, int h, int ck0, int nck) {
    bf16_t* B0 = (bf16_t*)C.lds;
    bf16_t* B1 = B0 + 64 * LS;
    bf16_t* B2 = B1 + 64 * LS;
    bf16_t* B3 = B2 + 64 * LS;
    bf16_t* B4 = B3 + 64 * LS;
    bf16_t* B5 = B4 + 64 * LS;
    bf16_t* B6 = B5 + 64 * LS;
    bf16_t* B7 = B6 + 64 * LS;
    bf16_t* B8 = B7 + 64 * LS;
    float* F = (float*)(B8 + 64 * LS);
    float* Xr = F; float* Xk = F + 64 * XS; float* Xv = Xk + 64 * XS;
    bf16_t* LAab = (bf16_t*)F; bf16_t* LAak = LAab + 64 * LS; bf16_t* LArb = LAak + 64 * LS; bf16_t* LArk = LArb + 64 * LS; bf16_t* LTinv = LArk + 64 * LS;
    float* G = F + 3 * 64 * XS;
    float* LAd = G;
    float* Ltot = LAd + 1024;
    float* Linv = Ltot + 256;
    float* Lbp = Linv + 64;
    bf16_t* LX = (bf16_t*)LAd;
    bf16_t* LX2 = LX + 2 * 16 * 40;
    float* Lc = Lbp + 128;
    int tid = C.tid; asm volatile("" : "+v"(tid));
    const int lane = tid & 63, wid = C.wid, fr = lane & 15, fq = lane >> 4;
    const int tt = tid >> 3, cg8 = tid & 7, ch0 = h * 64 + 8 * cg8;
    const int wt = wid >> 1, wc0 = 2 * (wid & 1);
    __syncthreads();
    if (tid < 384) { const int a = tid >> 6, c = tid & 63;
        Lc[tid] = (a == 0) ? C.mu()[C_R + h * 64 + c] : (a == 1) ? C.mu()[C_K + h * 64 + c] : (a == 2) ? C.mu()[C_V + h * 64 + c] : (a == 3) ? C.k_k()[h * 64 + c] : (a == 4) ? C.mu()[C_WD + c] : C.mu()[C_AD + c]; }
    __syncthreads();
    float d0c[2], a0c[2], kkc[2], kac[2], rkc[2];
#pragma unroll
    for (int jj = 0; jj < 2; ++jj) { const int c = h * 64 + 16 * (wc0 + jj) + fr;
        d0c[jj] = C.w_d0()[c]; a0c[jj] = C.a0()[c]; kkc[jj] = C.k_k()[c]; kac[jj] = C.k_a()[c]; rkc[jj] = C.r_k()[c]; }
    int lfo = fr * LS + 8 * fq, ldo = 4 * fq * LS + fr, lto = fr * LS + 4 * fq, lxo = 4 * fq * XS + fr;

    u32x4 raw[10];
#define R1_LOAD_RAW(mm) do { const bf16_t* pc_ = C.proj() + (size_t)(mm) * NPAD; const bf16_t* pp_ = ((mm) > 0) ? pc_ - NPAD : pc_; \
        raw[0] = *(const u32x4*)(pc_ + C_R + ch0); raw[1] = *(const u32x4*)(pc_ + C_K + ch0); raw[2] = *(const u32x4*)(pc_ + C_V + ch0); \
        raw[3] = *(const u32x4*)(pc_ + C_WD + 8 * cg8); raw[4] = *(const u32x4*)(pc_ + C_AD + 8 * cg8); \
        raw[5] = *(const u32x4*)(pp_ + C_R + ch0); raw[6] = *(const u32x4*)(pp_ + C_K + ch0); raw[7] = *(const u32x4*)(pp_ + C_V + ch0); \
        raw[8] = *(const u32x4*)(pp_ + C_WD + 8 * cg8); raw[9] = *(const u32x4*)(pp_ + C_AD + 8 * cg8); } while (0)
    R1_LOAD_RAW(b * NT + ck0 * 64 + tt);
    for (int ci = 0; ci < nck; ++ci) {
        const int ck = ck0 + ci; const int m = b * NT + ck * 64 + tt; const size_t chx = (size_t)((b * 8 + h) * 64 + ck);
        OPAQ();
        bf16x8 Bw[2][2], Bi[2][2];
        { int co = (h * 64 + 16 * wc0 + fr) * 64 + 8 * fq; asm volatile("" : "+v"(co));
#pragma unroll
          for (int jj = 0; jj < 2; ++jj)
#pragma unroll
            for (int ks = 0; ks < 2; ++ks) { Bw[jj][ks] = *(const bf16x8*)(C.wdup_t() + co + jj * 1024 + 32 * ks); Bi[jj][ks] = *(const bf16x8*)(C.wiup_t() + co + jj * 1024 + 32 * ks); } }
        if constexpr ((VAR & 2) == 0) {
        {
            const bool hp = (ck | tt) != 0;
            if (!hp) {
#pragma unroll
                for (int i = 5; i < 10; ++i) raw[i] = (u32x4){0u, 0u, 0u, 0u}; }
            const int o = tt * XS + 8 * cg8;
            {
                float v[8], pv[8], mu8[8]; unpack8(raw[2], v); unpack8(raw[7], pv);
                { const f32x4* p4 = (const f32x4*)(Lc + 128 + 8 * cg8); *(f32x4*)mu8 = p4[0]; *(f32x4*)(mu8 + 4) = p4[1]; }
#pragma unroll
                for (int i = 0; i < 8; ++i) v[i] += mu8[i] * (pv[i] - v[i]);
                *(f32x4*)(Xv + o) = (f32x4){v[0], v[1], v[2], v[3]}; *(f32x4*)(Xv + o + 4) = (f32x4){v[4], v[5], v[6], v[7]};
            }
            asm volatile("" ::: "memory");
            {
                float v[8], pv[8], mu8[8]; unpack8(raw[0], v); unpack8(raw[5], pv);
                { const f32x4* p4 = (const f32x4*)(Lc + 8 * cg8); *(f32x4*)mu8 = p4[0]; *(f32x4*)(mu8 + 4) = p4[1]; }
#pragma unroll
                for (int i = 0; i < 8; ++i) v[i] += mu8[i] * (pv[i] - v[i]);
                *(f32x4*)(Xr + o) = (f32x4){v[0], v[1], v[2], v[3]}; *(f32x4*)(Xr + o + 4) = (f32x4){v[4], v[5], v[6], v[7]};
            }
            asm volatile("" ::: "memory");
            {
                float v[8], pv[8], mu8[8], kw8[8]; unpack8(raw[1], v); unpack8(raw[6], pv);
                { const f32x4* p4 = (const f32x4*)(Lc + 64 + 8 * cg8); *(f32x4*)mu8 = p4[0]; *(f32x4*)(mu8 + 4) = p4[1]; p4 = (const f32x4*)(Lc + 192 + 8 * cg8); *(f32x4*)kw8 = p4[0]; *(f32x4*)(kw8 + 4) = p4[1]; }
                float ss = 0.f;
#pragma unroll
                for (int i = 0; i < 8; ++i) { v[i] += mu8[i] * (pv[i] - v[i]); const float q = v[i] * kw8[i]; ss += q * q; }
                ss += __shfl_xor(ss, 1); ss += __shfl_xor(ss, 2); ss += __shfl_xor(ss, 4);
                if (cg8 == 0) Linv[tt] = frcp(fmaxf(__builtin_amdgcn_sqrtf(ss), 1e-12f));
                *(f32x4*)(Xk + o) = (f32x4){v[0], v[1], v[2], v[3]}; *(f32x4*)(Xk + o + 4) = (f32x4){v[4], v[5], v[6], v[7]};
            }
            asm volatile("" ::: "memory");
            {
                float v[8], pv[8], mu8[8]; unpack8(raw[3], v); unpack8(raw[8], pv);
                { const f32x4* p4 = (const f32x4*)(Lc + 256 + 8 * cg8); *(f32x4*)mu8 = p4[0]; *(f32x4*)(mu8 + 4) = p4[1]; }
#pragma unroll
                for (int i = 0; i < 8; ++i) v[i] = ftanh(v[i] + mu8[i] * (pv[i] - v[i]));
                *(u32x4*)(B0 + tt * LS + 8 * cg8) = pack8(v);
            }
            asm volatile("" ::: "memory");
            {
                float v[8], pv[8], mu8[8]; unpack8(raw[4], v); unpack8(raw[9], pv);
                { const f32x4* p4 = (const f32x4*)(Lc + 320 + 8 * cg8); *(f32x4*)mu8 = p4[0]; *(f32x4*)(mu8 + 4) = p4[1]; }
#pragma unroll
                for (int i = 0; i < 8; ++i) v[i] += mu8[i] * (pv[i] - v[i]);
                *(u32x4*)(B1 + tt * LS + 8 * cg8) = pack8(v);
            }
        }
        }
        LDS_BARRIER();
        float lw[2][4], aa[2][4];
        {
            f32x4 zw[2], za[2];
#pragma unroll
            for (int jj = 0; jj < 2; ++jj) { zw[jj] = (f32x4){0.f, 0.f, 0.f, 0.f}; za[jj] = (f32x4){0.f, 0.f, 0.f, 0.f}; }
#pragma unroll
            for (int ks = 0; ks < 2; ++ks) { const bf16x8 aw = FR_(B0, 16 * wt, 32 * ks), ai = FR_(B1, 16 * wt, 32 * ks);
#pragma unroll
                for (int jj = 0; jj < 2; ++jj) { zw[jj] = MFMA16(aw, Bw[jj][ks], zw[jj]); za[jj] = MFMA16(ai, Bi[jj][ks], za[jj]); } }
#pragma unroll
            for (int jj = 0; jj < 2; ++jj)
#pragma unroll
                for (int r = 0; r < 4; ++r) { lw[jj][r] = -0.6065306597126334f * sigmoidf_(d0c[jj] + zw[jj][r]); aa[jj][r] = sigmoidf_(a0c[jj] + za[jj][r]); }
        }
        float clx[2][4], cin[2][4];
#pragma unroll
        for (int jj = 0; jj < 2; ++jj) {
            const float s4 = (lw[jj][0] + lw[jj][1]) + (lw[jj][2] + lw[jj][3]); float x = s4;
            float t1 = __shfl_up(x, 16); if (fq >= 1) x += t1; t1 = __shfl_up(x, 32); if (fq >= 2) x += t1;
            const float eq = x - s4;
            clx[jj][0] = eq; cin[jj][0] = eq + lw[jj][0];
#pragma unroll
            for (int r = 1; r < 4; ++r) { clx[jj][r] = cin[jj][r - 1]; cin[jj][r] = cin[jj][r - 1] + lw[jj][r]; }
            if (fq == 3) Ltot[wt * 64 + 16 * (wc0 + jj) + fr] = x;
        }
        LDS_BARRIER();
        OPAQ();
        if constexpr ((VAR & 4) == 0) {
        {
            float bsum[4] = {0.f, 0.f, 0.f, 0.f};
            const int xb = lxo + 16 * wt * XS + 16 * wc0;
            const int db = 16 * wt * LS + 16 * wc0;
            const int tb = lto + 16 * wc0 * LS + 16 * wt;
#pragma unroll
            for (int jj = 0; jj < 2; ++jj) {
                const int c = 16 * (wc0 + jj) + fr;
                float off = 0.f, clL = 0.f;
#pragma unroll
                for (int q = 0; q < 4; ++q) { const float tv = Ltot[q * 64 + c]; clL += tv; if (q < wt) off += tv; }
                const float eL = fexp(clL);
                if ((VAR & 1) == 0 && wt == 0 && fq == 0) C.wl()[chx * 64 + c] = eL;
                float at[4], rt[4], bt[4], kt[4], bh[4], kh[4], vv[4]; float eprev = 0.f;
#pragma unroll
                for (int r = 0; r < 4; ++r) {
                    const float rr = Xr[xb + r * XS + 16 * jj], kr = Xk[xb + r * XS + 16 * jj]; vv[r] = Xv[xb + r * XS + 16 * jj];
                    const float kk = kr * kkc[jj] * Linv[16 * wt + 4 * fq + r]; const float a = aa[jj][r];
                    const float be = kk * a, km = kr * (1.0f + (a - 1.0f) * kac[jj]);
                    const float ci_ = off + cin[jj][r], cx = off + clx[jj][r];
                    const float ei = fexp(ci_), en = frcp(ei), el = eL * en;
                    at[r] = -kk * ((r == 0) ? fexp(cx) : eprev); eprev = ei; rt[r] = rr * ei; bt[r] = be * en; kt[r] = km * en; bh[r] = be * el; kh[r] = km * el;
                    bsum[r] += rr * km * rkc[jj];
                    B3[ldo + db + r * LS + 16 * jj] = f2bf(rt[r]);
                }
                u32x2 w;
                w.x = pk2(at[0], at[1]); w.y = pk2(at[2], at[3]); *(u32x2*)(B4 + tb + 16 * jj * LS) = w;
                w.x = pk2(bt[0], bt[1]); w.y = pk2(bt[2], bt[3]); *(u32x2*)(B1 + tb + 16 * jj * LS) = w;
                w.x = pk2(kt[0], kt[1]); w.y = pk2(kt[2], kt[3]); *(u32x2*)(B2 + tb + 16 * jj * LS) = w;
                w.x = pk2(bh[0], bh[1]); w.y = pk2(bh[2], bh[3]); *(u32x2*)(B5 + tb + 16 * jj * LS) = w;
                w.x = pk2(kh[0], kh[1]); w.y = pk2(kh[2], kh[3]); *(u32x2*)(B6 + tb + 16 * jj * LS) = w;
                w.x = pk2(vv[0], vv[1]); w.y = pk2(vv[2], vv[3]); *(u32x2*)(B7 + tb + 16 * jj * LS) = w;
            }
#pragma unroll
            for (int r = 0; r < 4; ++r) { const float s = row16_sum(bsum[r]); if (fr == 0) Lbp[(wid & 1) * 64 + 16 * wt + 4 * fq + r] = s; }
        }
        }
        LDS_BARRIER();
        OPAQ();
        if ((VAR & 1) == 0 && tid < 64) C.bonus()[(size_t)(b * NT + ck * 64 + tid) * 8 + h] = Lbp[tid] + Lbp[64 + tid];
        if constexpr ((VAR & 8) == 0) {
        {
            int fr3 = fr, fq3 = fq; asm volatile("" : "+v"(fr3), "+v"(fq3));
#pragma unroll
            for (int jj = 0; jj < 2; ++jj) {
                const int st = wc0 + jj;
                if (st <= wt) {
                    f32x4 ab = (f32x4){0.f, 0.f, 0.f, 0.f}, ak = ab, rb = ab, rk = ab;
#pragma unroll
                    for (int ks = 0; ks < 2; ++ks) {
                        const bf16x8 fa = tr_frag(B4, LS, 32 * ks, 16 * wt, fr3, fq3), frr = FR_(B3, 16 * wt, 32 * ks);
                        const bf16x8 fb = tr_frag(B1, LS, 32 * ks, 16 * st, fr3, fq3), fk = tr_frag(B2, LS, 32 * ks, 16 * st, fr3, fq3);
                        ab = MFMA16(fa, fb, ab); ak = MFMA16(fa, fk, ak); rb = MFMA16(frr, fb, rb); rk = MFMA16(frr, fk, rk);
                    }
                    int fro = fr, fqo = 4 * fq; asm volatile("" : "+v"(fro), "+v"(fqo));
                    const int s = 16 * st + fro;
#pragma unroll
                    for (int r = 0; r < 4; ++r) { const int t = 16 * wt + fqo + r; const bool lo = s < t, le = s <= t;
                        const float vab = lo ? ab[r] : 0.f;
                        DW_(LAab, 16 * wt, 16 * st, r) = f2bf(vab); DW_(LAak, 16 * wt, 16 * st, r) = f2bf(lo ? ak[r] : 0.f); DW_(LArb, 16 * wt, 16 * st, r) = f2bf(le ? rb[r] : 0.f); DW_(LArk, 16 * wt, 16 * st, r) = f2bf(le ? rk[r] : 0.f);
                        if (st == wt) LAd[wt * 256 + (4 * fq + r) * 16 + fr] = vab; }
                } else if (st == wt + 1 && (wt & 1) == 0) {
#pragma unroll
                    for (int r = 0; r < 4; ++r) { DW_(LAak, 16 * wt, 16 * st, r) = 0; DW_(LArb, 16 * wt, 16 * st, r) = 0; DW_(LArk, 16 * wt, 16 * st, r) = 0; DW_(LTinv, 16 * wt, 16 * st, r) = 0; }
                }
            }
            if (tid < 32) *(u32x4*)(B8 + (16 + (tid >> 1)) * LS + 8 * (tid & 1)) = (u32x4){0u, 0u, 0u, 0u};
        }
        }
        LDS_BARRIER();
        OPAQ();
        if constexpr ((VAR & 16) == 0) {
        if (wid == 0) {
            const float* Ad = LAd + fq * 256; float X[16];
#pragma unroll
            for (int i = 0; i < 16; ++i) X[i] = (i == fr) ? 1.0f : 0.f;
#pragma unroll
            for (int i = 1; i < 16; ++i) { float acc = X[i];
#pragma unroll
                for (int s = 0; s < i; ++s) acc += Ad[i * 16 + s] * X[s];
                X[i] = acc; }
            const int dg = ldo + 12 * fq * LS + 16 * fq;
#pragma unroll
            for (int i = 0; i < 16; ++i) LTinv[dg + i * LS] = f2bf(X[i]);
            const int dt = lfo + 16 * fq * LS + 8 * fq;
            *(u32x4*)(B8 + dt) = pack8(X); *(u32x4*)(B8 + dt + 8) = pack8(X + 8);
        } else {
            for (int tile = wid - 1; tile < 16; tile += 7) { const int vt = tile >> 2, t2 = tile & 3; f32x4 acc = (f32x4){0.f, 0.f, 0.f, 0.f};
#pragma unroll
                for (int ks = 0; ks < 2; ++ks) if (ks == 0 || t2 >= 2) acc = MFMA16(FR_(B7, 16 * vt, 32 * ks), FR_(LAak, 16 * t2, 32 * ks), acc);
#pragma unroll
                for (int r = 0; r < 4; ++r) DW_(B0, 16 * vt, 16 * t2, r) = f2bf(acc[r]); }
        }
        }
        LDS_BARRIER();
        OPAQ();
        if (ci + 1 < nck) R1_LOAD_RAW(m + 64);
        if ((VAR & 32) == 0 && wid < 2) {
            const int o = 32 * wid;
            bf16_t* lx = LX + wid * 16 * 40;
            const bool kv = fq < 2;
            const int xf = fr * 40 + 8 * fq, xd = 4 * fq * 40 + fr;
            {
                const bf16x8 fa = kv ? FR_(B8, o, o) : zero8(), fb = kv ? FR_(LAab, o + 16, o) : zero8();
                const f32x4 acc = MFMA16(fa, fb, ((f32x4){0.f, 0.f, 0.f, 0.f}));
#pragma unroll
                for (int r = 0; r < 4; ++r) lx[xd + r * 40] = f2bf(acc[r]);
            }
            asm volatile("s_waitcnt lgkmcnt(0)" ::: "memory");
            {
                const bf16x8 ft = kv ? FR_(LTinv, o + 16, o + 16) : zero8(), fx = kv ? *(const bf16x8*)(lx + xf) : zero8();
                const f32x4 acc = MFMA16(ft, fx, ((f32x4){0.f, 0.f, 0.f, 0.f}));
#pragma unroll
                for (int r = 0; r < 4; ++r) DW_(LTinv, o + 16, o, r) = f2bf(acc[r]);
                if (wid == 0) { const f32x4 acT = MFMA16(fx, ft, ((f32x4){0.f, 0.f, 0.f, 0.f}));
#pragma unroll
                    for (int r = 0; r < 4; ++r) DW_(B8, 0, 16, r) = f2bf(acT[r]); }
            }
        }
        LDS_BARRIER();
        if ((VAR & 32) == 0 && wid < 4) {
            const int jt = wid >> 1, ut = wid & 1;
            const f32x4 acc = MFMA16(FR_(B8, 16 * jt, 0), FR_(LAab, 32 + 16 * ut, 0), ((f32x4){0.f, 0.f, 0.f, 0.f}));
#pragma unroll
            for (int r = 0; r < 4; ++r) LX2[(16 * jt + 4 * fq + r) * 40 + 16 * ut + fr] = f2bf(acc[r]);
        }
        LDS_BARRIER();
        if ((VAR & 32) == 0 && wid < 4) {
            const int t2 = wid >> 1, jt = wid & 1;
            const f32x4 acc = MFMA16(FR_(LTinv, 32 + 16 * t2, 32), *(const bf16x8*)(LX2 + (16 * jt + fr) * 40 + 8 * fq), ((f32x4){0.f, 0.f, 0.f, 0.f}));
#pragma unroll
            for (int r = 0; r < 4; ++r) DW_(LTinv, 32 + 16 * t2, 16 * jt, r) = f2bf(acc[r]);
        }
        LDS_BARRIER();
        OPAQ();
        if constexpr ((VAR & 64) == 0) {
        {
#pragma unroll
            for (int jj = 0; jj < 2; ++jj) { const int t2 = wc0 + jj; f32x4 p1 = (f32x4){0.f, 0.f, 0.f, 0.f}, p2 = p1;
#pragma unroll
                for (int ks = 0; ks < 2; ++ks) if (ks == 0 || t2 >= 2) { const bf16x8 ft = FR_(LTinv, 16 * t2, 32 * ks);
                    p1 = MFMA16(FR_(B4, 16 * wt, 32 * ks), ft, p1); p2 = MFMA16(FR_(B0, 16 * wt, 32 * ks), ft, p2); }
#pragma unroll
                for (int r = 0; r < 4; ++r) { DW_(B1, 16 * wt, 16 * t2, r) = f2bf(p1[r]); DW_(B2, 16 * wt, 16 * t2, r) = f2bf(p2[r]); } }
        }
        }
        LDS_BARRIER();
        OPAQ();
        if constexpr ((VAR & 128) == 0) {
        {
            bf16_t* gq = C.q1p() + chx * 4096; bf16_t* gm = C.mp() + chx * 4096; bf16_t* gy = C.yid() + chx * 4096; bf16_t* gn = C.nd() + chx * 4096;
#pragma unroll
            for (int jj = 0; jj < 2; ++jj) {
                const int ct2 = wc0 + jj;
                f32x4 q1 = (f32x4){0.f, 0.f, 0.f, 0.f}, mm = q1, yi = q1, nn = q1;
#pragma unroll
                for (int ks = 0; ks < 2; ++ks) {
                    const bf16x8 fp1 = FR_(B1, 16 * wt, 32 * ks);
                    if (ks == 0 || ct2 >= 2) q1 = MFMA16(fp1, FR_(LArb, 16 * ct2, 32 * ks), q1);
                    mm = MFMA16(fp1, FR_(B5, 16 * ct2, 32 * ks), mm);
                    const bf16x8 fp2 = FR_(B2, 16 * ct2, 32 * ks), fv = FR_(B7, 16 * ct2, 32 * ks);
                    if (ks == 0 || wt >= 2) { yi = MFMA16(FR_(LArb, 16 * wt, 32 * ks), fp2, yi); yi = MFMA16(FR_(LArk, 16 * wt, 32 * ks), fv, yi); }
                    nn = MFMA16(FR_(B5, 16 * wt, 32 * ks), fp2, nn); nn = MFMA16(FR_(B6, 16 * wt, 32 * ks), fv, nn);
                }
                {
                    const int t = 16 * ct2 + fr, c0 = 16 * wt + 4 * fq; const u32x2 rv = *(const u32x2*)(B3 + lto + 16 * ct2 * LS + 16 * wt);
                    u32x2 w; w.x = pk2(q1[0] + __uint_as_float(rv.x << 16), q1[1] + __uint_as_float(rv.x & 0xffff0000u)); w.y = pk2(q1[2] + __uint_as_float(rv.y << 16), q1[3] + __uint_as_float(rv.y & 0xffff0000u));
                    *(u32x2*)(B0 + t * LS + permc(c0)) = w;
                    u32x2 w2; w2.x = pk2(mm[0], mm[1]); w2.y = pk2(mm[2], mm[3]); *(u32x2*)(B4 + t * LS + permc(c0)) = w2;
                }
                { u32x2 w; w.x = pk2(yi[0], yi[1]); w.y = pk2(yi[2], yi[3]); if ((VAR & 1) == 0) *(u32x2*)(gy + ((wt * 4 + ct2) * 64 + lane) * 4) = w;
                  u32x2 w2; w2.x = pk2(nn[0], nn[1]); w2.y = pk2(nn[2], nn[3]); if ((VAR & 1) == 0) *(u32x2*)(gn + ((wt * 4 + ct2) * 64 + lane) * 4) = w2; }
            }
        }
        }
        LDS_BARRIER();
        if constexpr ((VAR & 1) == 0 && (VAR & 128) == 0) {
            const int o = (tid >> 3) * LS + (tid & 7) * 8;
            *(u32x4*)(C.q1p() + chx * 4096 + tid * 8) = *(const u32x4*)(B0 + o); *(u32x4*)(C.mp() + chx * 4096 + tid * 8) = *(const u32x4*)(B4 + o);
        }
    }
}
#undef FR_
#undef DW_
#undef OPAQ

constexpr int R2_SLOT = 2 * 64 * 72 * 2 + 2 * 8192 + 256;
struct R2Set { u32x4 q, m, y, n, w; };
__device__ __forceinline__ void r2_issue(const Ctx& C, R2Set& r, size_t chx, int tid) {
    r.q = *(const u32x4*)(C.q1p() + chx * 4096 + tid * 8); r.m = *(const u32x4*)(C.mp() + chx * 4096 + tid * 8);
    r.y = *(const u32x4*)(C.yid() + chx * 4096 + tid * 8); r.n = *(const u32x4*)(C.nd() + chx * 4096 + tid * 8);
    r.w = *(const u32x4*)(C.wl() + chx * 64 + 4 * (tid & 15));
}
__device__ __forceinline__ void r2_put(const R2Set& r, unsigned char* slot, int tid) {
    bf16_t* LQ = (bf16_t*)slot; bf16_t* LM = LQ + 64 * 72; bf16_t* LY = LM + 64 * 72; bf16_t* LN = LY + 4096; float* LW = (float*)(LN + 4096);
    const int o = (tid >> 3) * 72 + (tid & 7) * 8;
    *(u32x4*)(LQ + o) = r.q; *(u32x4*)(LM + o) = r.m; *(u32x4*)(LY + tid * 8) = r.y; *(u32x4*)(LN + tid * 8) = r.n;
    if (tid < 16) *(u32x4*)(LW + 4 * tid) = r.w;
}
__device__ __forceinline__ void r2_step(const Ctx& C, f32x4 (&S)[4], const unsigned char* slot, int b, int h, int vt, int ck, int lane, int fr, int fq) {
    const bf16_t* LQ = (const bf16_t*)slot; const bf16_t* LM = LQ + 64 * 72; const bf16_t* LY = LM + 64 * 72; const bf16_t* LN = LY + 4096; const float* LW = (const float*)(LN + 4096);
    bf16x8 Sb[2];
#pragma unroll
    for (int ks = 0; ks < 2; ++ks) { u32x4 w; w.x = pk2(S[2 * ks][0], S[2 * ks][1]); w.y = pk2(S[2 * ks][2], S[2 * ks][3]); w.z = pk2(S[2 * ks + 1][0], S[2 * ks + 1][1]); w.w = pk2(S[2 * ks + 1][2], S[2 * ks + 1][3]);
        Sb[ks] = __builtin_bit_cast(bf16x8, w); }
    f32x4 Sn[4];
#pragma unroll
    for (int c4 = 0; c4 < 4; ++c4) {
        const u32x2 nv = *(const u32x2*)(LN + ((c4 * 4 + vt) * 64 + lane) * 4); const f32x4 wl = *(const f32x4*)(LW + 16 * c4 + 4 * fq);
        f32x4 acc = (f32x4){__uint_as_float(nv.x << 16), __uint_as_float(nv.x & 0xffff0000u), __uint_as_float(nv.y << 16), __uint_as_float(nv.y & 0xffff0000u)};
        acc = acc + wl * S[c4];
#pragma unroll
        for (int ks = 0; ks < 2; ++ks) acc = MFMA16(*(const bf16x8*)(LM + (16 * c4 + fr) * 72 + 32 * ks + 8 * fq), Sb[ks], acc);
        Sn[c4] = acc;
    }
#pragma unroll
    for (int t4 = 0; t4 < 4; ++t4) {
        const u32x2 yv = *(const u32x2*)(LY + ((t4 * 4 + vt) * 64 + lane) * 4);
        f32x4 acc = (f32x4){__uint_as_float(yv.x << 16), __uint_as_float(yv.x & 0xffff0000u), __uint_as_float(yv.y << 16), __uint_as_float(yv.y & 0xffff0000u)};
#pragma unroll
        for (int ks = 0; ks < 2; ++ks) acc = MFMA16(*(const bf16x8*)(LQ + (16 * t4 + fr) * 72 + 32 * ks + 8 * fq), Sb[ks], acc);
        bf16_t* yo = C.proj() + (size_t)(b * NT + ck * 64 + 16 * t4 + 4 * fq) * NPAD + C_R + h * 64 + 16 * vt + fr;
#pragma unroll
        for (int r = 0; r < 4; ++r) yo[(size_t)r * NPAD] = f2bf(acc[r]);
    }
#pragma unroll
    for (int c4 = 0; c4 < 4; ++c4) S[c4] = Sn[c4];
}
__device__ __forceinline__ void rwkv_r2_wg(const Ctx& C, int b, int h) {
    const int tid = C.tid, lane = C.lane, wid = C.wid, fr = lane & 15, fq = lane >> 4;
    unsigned char* slot0 = C.lds; unsigned char* slot1 = C.lds + R2_SLOT;
    const size_t ch0 = (size_t)((b * 8 + h) * 64);
    f32x4 S[4];
#pragma unroll
    for (int i = 0; i < 4; ++i) S[i] = (f32x4){0.f, 0.f, 0.f, 0.f};
    R2Set r0, r1, r2, r3;
    __syncthreads();
    r2_issue(C, r0, ch0 + 0, tid); r2_issue(C, r1, ch0 + 1, tid); r2_issue(C, r2, ch0 + 2, tid); r2_issue(C, r3, ch0 + 3, tid);
    r2_put(r0, slot0, tid); r2_issue(C, r0, ch0 + 4, tid);
    LDS_BARRIER();
    for (int c = 0; c < NT / 64; c += 4) {
#define R2_ITER(i, rnext, snext, scur) do { const int cc = c + (i); const int cn = (cc + 5 < NT / 64) ? cc + 5 : NT / 64 - 1; \
        r2_put(rnext, snext, tid); r2_issue(C, rnext, ch0 + cn, tid);                  \
        if (wid < 4) r2_step(C, S, scur, b, h, wid, cc, lane, fr, fq); \
        LDS_BARRIER(); } while (0)
        R2_ITER(0, r1, slot1, slot0);
        R2_ITER(1, r2, slot0, slot1);
        R2_ITER(2, r3, slot1, slot0);
        R2_ITER(3, r0, slot0, slot1);
#undef R2_ITER
    }
}
constexpr int C_G = DIN;
__device__ __forceinline__ float* gate_ptr(bf16_t* proj, size_t m, int hm) { return (float*)(proj + m * NPAD + C_G) + 4 * hm; }

__device__ __forceinline__ void mlstm_gate_scan(const Ctx& C, int b, int hm, int ck) {
    const int lane = C.lane;
    const size_t mg = (size_t)(b * NT + ck * 64 + lane); const bf16_t* pr = C.proj() + mg * NPAD;
    const float ig = bf2f(pr[C_I + hm]) + C.b_i()[hm]; const float fp = bf2f(pr[C_F + hm]) + C.b_f()[hm];
    const float lf = (fp >= 0.f) ? -log1pf(expf(-fp)) : fp - log1pf(expf(fp));
    float bc = lf;
#pragma unroll
    for (int o = 1; o < 64; o <<= 1) { const float tv = __shfl_up(bc, o); if (lane >= o) bc += tv; }
    const float e = ig - bc; float pm = e;
#pragma unroll
    for (int o = 1; o < 64; o <<= 1) { const float tv = __shfl_up(pm, o); if (lane >= o) pm = fmaxf(pm, tv); }
    *(f32x4*)gate_ptr(C.proj(), mg, hm) = (f32x4){bc, e, pm, 0.f};
}
__device__ __forceinline__ void mlstm_m1_stream(const Ctx& C) {
    const int lane = C.lane; const bool isk = lane >= 32; const int ch = 16 * (lane & 31);
    const int col = (isk ? C_KM : C_Q) + ch; const int cw = (isk ? 512 : 0) + ch;
    float w[4][16], bias[16];
#pragma unroll
    for (int i = 0; i < 16; i += 4) { const f32x4 bv = *(const f32x4*)(C.conv_b() + cw + i); bias[i] = bv.x; bias[i + 1] = bv.y; bias[i + 2] = bv.z; bias[i + 3] = bv.w;
#pragma unroll
        for (int j = 0; j < 4; ++j) { const f32x4 wv = *(const f32x4*)(C.conv_w() + j * 1024 + cw + i); w[j][i] = wv.x; w[j][i + 1] = wv.y; w[j][i + 2] = wv.z; w[j][i + 3] = wv.w; } }
    const float osc = isk ? 0.08838834764831845f : 1.0f;
    bf16_t* dst = (isk ? C.kc() : C.qc()) + ch;
    for (int t0 = 16 * C.gw; t0 < NTOK; t0 += 16 * C.ngw) {
        const int tb = t0 & (NT - 1);
        u32x4 ring[7][2];
        const bf16_t* p0 = C.proj() + (size_t)t0 * NPAD + col;
#pragma unroll
        for (int k = 0; k < 7; ++k) {
            if (k < 3 && tb == 0) { ring[k][0] = (u32x4){0u, 0u, 0u, 0u}; ring[k][1] = ring[k][0]; }
            else { const bf16_t* p = p0 + (ptrdiff_t)(k - 3) * NPAD; ring[k][0] = *(const u32x4*)p; ring[k][1] = *(const u32x4*)(p + 8); }
        }
#pragma unroll
        for (int i = 0; i < 16; ++i) {
            const size_t m = (size_t)(t0 + i);
            float a[16], x0[16], x1[16], x2[16], x3[16];
            unpack8(ring[i % 7][0], x0); unpack8(ring[i % 7][1], x0 + 8); unpack8(ring[(i + 1) % 7][0], x1); unpack8(ring[(i + 1) % 7][1], x1 + 8);
            unpack8(ring[(i + 2) % 7][0], x2); unpack8(ring[(i + 2) % 7][1], x2 + 8); unpack8(ring[(i + 3) % 7][0], x3); unpack8(ring[(i + 3) % 7][1], x3 + 8);
            { const int rn = (i + 4 < 16) ? i + 4 : 15; const bf16_t* p = p0 + (size_t)rn * NPAD; ring[i % 7][0] = *(const u32x4*)p; ring[i % 7][1] = *(const u32x4*)(p + 8); }
#pragma unroll
            for (int c = 0; c < 16; ++c) { a[c] = bias[c] + w[0][c] * x0[c] + w[1][c] * x1[c] + w[2][c] * x2[c] + w[3][c] * x3[c]; a[c] = siluf_(a[c]) * osc; }
            *(u32x4*)(dst + m * 512) = pack8(a); *(u32x4*)(dst + m * 512 + 8) = pack8(a + 8);
        }
    }
}

__device__ __forceinline__ void mlstm_p0_item(const Ctx& C, int b, int hm, int ck) {
    const int lane = C.lane, fr = lane & 15, fq = lane >> 4;
    {
        const int it = (b << 8) | (ck << 2) | hm; const size_t m0 = (size_t)(b * NT + ck * 64);
        bf16_t* out = C.p0s() + (size_t)it * 4096;
        bf16x8 kf[4][4]; float es[4][4];
#pragma unroll
        for (int sj = 0; sj < 4; ++sj) {
#pragma unroll
            for (int ks = 0; ks < 4; ++ks) kf[sj][ks] = *(const bf16x8*)(C.kc() + (m0 + 16 * sj + fr) * 512 + hm * 128 + 32 * ks + 8 * fq);
#pragma unroll
            for (int r = 0; r < 4; ++r) es[sj][r] = gate_ptr(C.proj(), m0 + 16 * sj + 4 * fq + r, hm)[1]; }
#pragma unroll
        for (int ti = 0; ti < 4; ++ti) {
            bf16x8 qf[4];
#pragma unroll
            for (int ks = 0; ks < 4; ++ks) qf[ks] = *(const bf16x8*)(C.qc() + (m0 + 16 * ti + fr) * 512 + hm * 128 + 32 * ks + 8 * fq);
            const int t = 16 * ti + fr; const float pmt = gate_ptr(C.proj(), m0 + t, hm)[2];
#pragma unroll
            for (int sj = 0; sj < 4; ++sj) {
                f32x4 acc = (f32x4){0.f, 0.f, 0.f, 0.f};
                if (sj <= ti) {
#pragma unroll
                    for (int ks = 0; ks < 4; ++ks) acc = __builtin_amdgcn_mfma_f32_16x16x32_bf16(kf[sj][ks], qf[ks], acc, 0, 0, 0);
                }
                float o[4];
#pragma unroll
                for (int r = 0; r < 4; ++r) { const int s = 16 * sj + 4 * fq + r; o[r] = (sj <= ti && s <= t) ? acc[r] * fexp(es[sj][r] - pmt) : 0.f; }
                u32x2 w; w.x = pk2(o[0], o[1]); w.y = pk2(o[2], o[3]); *(u32x2*)(out + t * 64 + 16 * sj + 4 * fq) = w;
            }
        }
    }
}

#define LDS_WAIT_ALL() asm volatile("s_waitcnt lgkmcnt(0)" ::: "memory")
constexpr int VS = 52;
constexpr int ML_BUF = (2 * 64 * 136 + 2 * 64 * VS + 64 * 72) * 2 + 1280;
template <int VAR> __device__ __forceinline__ void mlstm_item(const Ctx& C, int b, int hm, int sl) {
    constexpr bool st_out = (VAR & 1) == 0;
    unsigned char* buf0 = C.lds; unsigned char* buf1 = C.lds + ML_BUF;
    bf16_t* LCb0 = (bf16_t*)(C.lds + 2 * ML_BUF); bf16_t* LCb1 = LCb0 + 48 * 136;
#define ML_Q(bf) ((bf16_t*)(bf))
#define ML_K(bf) (ML_Q(bf) + 64 * 136)
#define ML_V(bf) (ML_K(bf) + 64 * 136)
#define ML_WV(bf) (ML_V(bf) + 64 * VS)
#define ML_P(bf) (ML_WV(bf) + 64 * VS)
#define ML_F(bf) ((float*)(ML_P(bf) + 64 * 72))
    const int tid = C.tid, lane = C.lane, wid = C.wid;
    const int fr_ = lane & 15, fq_ = lane >> 4, tt_ = tid >> 3;
    __syncthreads();
    for (int e = tid; e < 2 * 48 * 136; e += NTHR) LCb0[e] = 0;
    for (int e = tid; e < 64 * VS; e += NTHR) { const bf16_t o = ((e % VS) == 32) ? (bf16_t)0x3f80 : (bf16_t)0; ML_V(buf0)[e] = o; ML_V(buf1)[e] = o; ML_WV(buf0)[e] = 0; ML_WV(buf1)[e] = 0; }
    for (int e = tid; e < 64 * 72; e += NTHR) { ML_P(buf0)[e] = 0; ML_P(buf1)[e] = 0; }
    const int cg8 = tid & 7, d0 = 16 * cg8;
    const int ti = wid >> 1, vtw = wid & 1;
    const int ct0_t = (wid < 4) ? ((wid == 0) ? 0 : (wid == 3 ? 2 : 1)) : ((wid == 4) ? 2 : 3), ct0_s = (wid < 4) ? ((wid == 2) ? 1 : 0) : ((wid == 4) ? 1 : wid - 5);
    const int ct1_t = (wid == 0) ? 2 : 3, ct1_s = (wid == 0) ? 2 : 3; const bool has2 = wid < 2;
    f32x4 Cst[3];
#pragma unroll
    for (int i = 0; i < 3; ++i) Cst[i] = (f32x4){0.f, 0.f, 0.f, 0.f};
    float mst = 0.f, carry_cur = 1.f, carry_nxt = 1.f;
    u32x4 pq0, pq1, pk0, pk1, pp; u32x2 pv; f32x4 pg, pgl; u32x4 pq0_b, pq1_b, pk0_b, pk1_b, pp_b; u32x2 pv_b; f32x4 pg_b, pgl_b;
    const bf16_t* p0base = C.p0s() + (size_t)(((b * 64) * 4 + hm)) * 4096 + tid * 8;
    {
        const size_t m = (size_t)(b * NT + tt_);
        const bf16_t* qs = C.qc() + m * 512 + hm * 128 + d0; const bf16_t* ks = C.kc() + m * 512 + hm * 128 + d0;
        pq0 = *(const u32x4*)qs; pq1 = *(const u32x4*)(qs + 8); pk0 = *(const u32x4*)ks; pk1 = *(const u32x4*)(ks + 8);
        pv = *(const u32x2*)(C.proj() + m * NPAD + C_VM + hm * 128 + sl * 32 + 4 * cg8);
        pg = *(const f32x4*)gate_ptr(C.proj(), m, hm); pgl = *(const f32x4*)gate_ptr(C.proj(), (size_t)(b * NT + 63), hm); pp = *(const u32x4*)p0base;
        const size_t m2 = m + 64; qs += 64 * 512; ks += 64 * 512;
        pq0_b = *(const u32x4*)qs; pq1_b = *(const u32x4*)(qs + 8); pk0_b = *(const u32x4*)ks; pk1_b = *(const u32x4*)(ks + 8);
        pv_b = *(const u32x2*)(C.proj() + m2 * NPAD + C_VM + hm * 128 + sl * 32 + 4 * cg8);
        pg_b = *(const f32x4*)gate_ptr(C.proj(), m2, hm); pgl_b = *(const f32x4*)gate_ptr(C.proj(), (size_t)(b * NT + 127), hm); pp_b = *(const u32x4*)(p0base + 4 * 4096);
    }
    __syncthreads();
    { const int kst = 0; const int fr = fr_, fq = fq_, tt = tt_;
        asm volatile("" :: "v"(pg.w), "v"(pgl.y), "v"(pgl.w));
        {
            const float mxl = fmaxf(mst, pgl.z); carry_nxt = fexp(mst - mxl);
            if constexpr ((VAR & 16) == 0) {
                const float ws = fexp(pg.y - mxl);
                *(u32x4*)(ML_Q(buf0) + tt * 136 + d0) = pq0; *(u32x4*)(ML_Q(buf0) + tt * 136 + d0 + 8) = pq1;
                *(u32x4*)(ML_K(buf0) + tt * 136 + d0) = pk0; *(u32x4*)(ML_K(buf0) + tt * 136 + d0 + 8) = pk1;
                const float v0 = __uint_as_float(pv.x << 16), v1 = __uint_as_float(pv.x & 0xffff0000u), v2 = __uint_as_float(pv.y << 16), v3 = __uint_as_float(pv.y & 0xffff0000u);
                *(u32x2*)(ML_V(buf0) + tt * VS + 4 * cg8) = pv; *(u32x4*)(ML_P(buf0) + tt * 72 + 8 * cg8) = pp;
                u32x2 wv; wv.x = pk2(v0 * ws, v1 * ws); wv.y = pk2(v2 * ws, v3 * ws); *(u32x2*)(ML_WV(buf0) + tt * VS + 4 * cg8) = wv;
                if (cg8 == 0) { ML_WV(buf0)[tt * VS + 32] = f2bf(ws); const float mx = fmaxf(mst, pg.z); float* F = ML_F(buf0); F[tt] = pg.y; F[64 + tt] = mx; F[128 + tt] = fexp(mst - mx); F[192 + tt] = fexp(-(pg.x + mx)); F[256 + tt] = fexp(pg.z - mx); }
            }
            mst = pgl.x + mxl;
            const int cn = (kst + 2 < NT / 64) ? kst + 2 : NT / 64 - 1;
            const size_t m = (size_t)(b * NT + cn * 64 + tt);
            const bf16_t* qs = C.qc() + m * 512 + hm * 128 + d0; const bf16_t* ks = C.kc() + m * 512 + hm * 128 + d0;
            pq0 = *(const u32x4*)qs; pq1 = *(const u32x4*)(qs + 8); pk0 = *(const u32x4*)ks; pk1 = *(const u32x4*)(ks + 8);
            pv = *(const u32x2*)(C.proj() + m * NPAD + C_VM + hm * 128 + sl * 32 + 4 * cg8);
            pg = *(const f32x4*)gate_ptr(C.proj(), m, hm); pgl = *(const f32x4*)gate_ptr(C.proj(), (size_t)(b * NT + cn * 64 + 63), hm); pp = *(const u32x4*)(p0base + (size_t)cn * 4 * 4096);
        }
    }
    carry_cur = carry_nxt;
    LDS_BARRIER();
    { const int kc = 0; const int fr = fr_, fq = fq_;
    }
    for (int ck2 = 0; ck2 < NT / 64; ck2 += 2) {
      { const int ck = ck2;
        int fr = fr_, fq = fq_, tt = tt_; asm volatile("" : "+v"(fr), "+v"(fq), "+v"(tt));
        { const int kst = ck + 1;
        asm volatile("" :: "v"(pg_b.w), "v"(pgl_b.y), "v"(pgl_b.w));
        {
            const float mxl = fmaxf(mst, pgl_b.z); carry_nxt = fexp(mst - mxl);
            if constexpr ((VAR & 16) == 0) {
                const float ws = fexp(pg_b.y - mxl);
                *(u32x4*)(ML_Q(buf1) + tt * 136 + d0) = pq0_b; *(u32x4*)(ML_Q(buf1) + tt * 136 + d0 + 8) = pq1_b;
                *(u32x4*)(ML_K(buf1) + tt * 136 + d0) = pk0_b; *(u32x4*)(ML_K(buf1) + tt * 136 + d0 + 8) = pk1_b;
                const float v0 = __uint_as_float(pv_b.x << 16), v1 = __uint_as_float(pv_b.x & 0xffff0000u), v2 = __uint_as_float(pv_b.y << 16), v3 = __uint_as_float(pv_b.y & 0xffff0000u);
                *(u32x2*)(ML_V(buf1) + tt * VS + 4 * cg8) = pv_b; *(u32x4*)(ML_P(buf1) + tt * 72 + 8 * cg8) = pp_b;
                u32x2 wv; wv.x = pk2(v0 * ws, v1 * ws); wv.y = pk2(v2 * ws, v3 * ws); *(u32x2*)(ML_WV(buf1) + tt * VS + 4 * cg8) = wv;
                if (cg8 == 0) { ML_WV(buf1)[tt * VS + 32] = f2bf(ws); const float mx = fmaxf(mst, pg_b.z); float* F = ML_F(buf1); F[tt] = pg_b.y; F[64 + tt] = mx; F[128 + tt] = fexp(mst - mx); F[192 + tt] = fexp(-(pg_b.x + mx)); F[256 + tt] = fexp(pg_b.z - mx); }
            }
            mst = pgl_b.x + mxl;
            const int cn = (kst + 2 < NT / 64) ? kst + 2 : NT / 64 - 1;
            const size_t m = (size_t)(b * NT + cn * 64 + tt);
            const bf16_t* qs = C.qc() + m * 512 + hm * 128 + d0; const bf16_t* ks = C.kc() + m * 512 + hm * 128 + d0;
            pq0_b = *(const u32x4*)qs; pq1_b = *(const u32x4*)(qs + 8); pk0_b = *(const u32x4*)ks; pk1_b = *(const u32x4*)(ks + 8);
            pv_b = *(const u32x2*)(C.proj() + m * NPAD + C_VM + hm * 128 + sl * 32 + 4 * cg8);
            pg_b = *(const f32x4*)gate_ptr(C.proj(), m, hm); pgl_b = *(const f32x4*)gate_ptr(C.proj(), (size_t)(b * NT + cn * 64 + 63), hm); pp_b = *(const u32x4*)(p0base + (size_t)cn * 4 * 4096);
        }
        }
        LDS_BARRIER();
        { const int kc = ck + 1;
        }
        {
            const int mbase = b * NT + ck * 64;
            const bf16_t* LQ = ML_Q(buf0); const bf16_t* LK = ML_K(buf0); const bf16_t* LV = ML_V(buf0); const bf16_t* LWV = ML_WV(buf0); const bf16_t* LP = ML_P(buf0); const float* F = ML_F(buf0);
            const bf16_t* LCr = LCb0; bf16_t* LCw = LCb1;
            bf16x8 fp[2], fvr[2], fvd[2], fqq[4], fcr[4], fcd[4], kf[2], fw[3][2]; float inr[4], clr[4], rsr[4];
#pragma unroll
            for (int ks = 0; ks < 2; ++ks) { fp[ks] = *(const bf16x8*)(LP + (16 * ti + fr) * 72 + 32 * ks + 8 * fq); fvr[ks] = tr_frag(LV, VS, 32 * ks, 16 * vtw, fr, fq); fvd[ks] = tr_frag(LV, VS, 32 * ks, 32, fr, fq); }
#pragma unroll
            for (int ks = 0; ks < 4; ++ks) { fqq[ks] = *(const bf16x8*)(LQ + (16 * ti + fr) * 136 + 32 * ks + 8 * fq); fcr[ks] = *(const bf16x8*)(LCr + (16 * vtw + fr) * 136 + 32 * ks + 8 * fq); fcd[ks] = *(const bf16x8*)(LCr + (32 + fr) * 136 + 32 * ks + 8 * fq); }
#pragma unroll
            for (int ks = 0; ks < 2; ++ks) { kf[ks] = tr_frag(LK, 136, 32 * ks, 16 * wid, fr, fq);
#pragma unroll
                for (int vt2 = 0; vt2 < 3; ++vt2) fw[vt2][ks] = tr_frag(LWV, VS, 32 * ks, 16 * vt2, fr, fq); }
#pragma unroll
            for (int r = 0; r < 4; ++r) { inr[r] = F[128 + 16 * ti + 4 * fq + r]; clr[r] = F[192 + 16 * ti + 4 * fq + r]; rsr[r] = F[256 + 16 * ti + 4 * fq + r]; }
            LDS_WAIT_ALL();
            f32x4 numr = (f32x4){0.f, 0.f, 0.f, 0.f}, numd = numr;
            if constexpr ((VAR & 4) == 0) {
                f32x4 a1r = (f32x4){0.f, 0.f, 0.f, 0.f}, a1d = a1r, a2r = a1r, a2d = a1r;
#pragma unroll
                for (int ks = 0; ks < 2; ++ks) { a1r = __builtin_amdgcn_mfma_f32_16x16x32_bf16(fp[ks], fvr[ks], a1r, 0, 0, 0); a1d = __builtin_amdgcn_mfma_f32_16x16x32_bf16(fp[ks], fvd[ks], a1d, 0, 0, 0); }
#pragma unroll
                for (int ks = 0; ks < 4; ++ks) { a2r = __builtin_amdgcn_mfma_f32_16x16x32_bf16(fqq[ks], fcr[ks], a2r, 0, 0, 0); a2d = __builtin_amdgcn_mfma_f32_16x16x32_bf16(fqq[ks], fcd[ks], a2d, 0, 0, 0); }
#pragma unroll
                for (int r = 0; r < 4; ++r) { numr[r] = rsr[r] * a1r[r] + inr[r] * a2r[r]; numd[r] = rsr[r] * a1d[r] + inr[r] * a2d[r]; }
            }
            if constexpr ((VAR & 8) == 0) {
#pragma unroll
                for (int vt2 = 0; vt2 < 3; ++vt2) {
                    f32x4 acc = Cst[vt2] * carry_cur;
#pragma unroll
                    for (int ks = 0; ks < 2; ++ks) acc = __builtin_amdgcn_mfma_f32_16x16x32_bf16(fw[vt2][ks], kf[ks], acc, 0, 0, 0);
                    Cst[vt2] = acc;
#pragma unroll
                    for (int r = 0; r < 4; ++r) LCw[(16 * vt2 + 4 * fq + r) * 136 + 16 * wid + fr] = f2bf(acc[r]);
                }
            }
#pragma unroll
            for (int r = 0; r < 4; ++r) { const int t = 16 * ti + 4 * fq + r;
                const float den = __shfl(numd[r], lane & 48);
                const float dv = fmaxf(fabsf(den), clr[r]);
                if (st_out) C.proj()[(size_t)(mbase + t) * NPAD + C_VM + hm * 128 + sl * 32 + 16 * vtw + fr] = f2bf(numr[r] * frcp(dv)); }
        }
        carry_cur = carry_nxt;
        LDS_BARRIER();
      }
      { const int ck = ck2 + 1;
        int fr = fr_, fq = fq_, tt = tt_; asm volatile("" : "+v"(fr), "+v"(fq), "+v"(tt));
        { const int kst = ck + 1;
        asm volatile("" :: "v"(pg.w), "v"(pgl.y), "v"(pgl.w));
        {
            const float mxl = fmaxf(mst, pgl.z); carry_nxt = fexp(mst - mxl);
            if constexpr ((VAR & 16) == 0) {
                const float ws = fexp(pg.y - mxl);
                *(u32x4*)(ML_Q(buf0) + tt * 136 + d0) = pq0; *(u32x4*)(ML_Q(buf0) + tt * 136 + d0 + 8) = pq1;
                *(u32x4*)(ML_K(buf0) + tt * 136 + d0) = pk0; *(u32x4*)(ML_K(buf0) + tt * 136 + d0 + 8) = pk1;
                const float v0 = __uint_as_float(pv.x << 16), v1 = __uint_as_float(pv.x & 0xffff0000u), v2 = __uint_as_float(pv.y << 16), v3 = __uint_as_float(pv.y & 0xffff0000u);
                *(u32x2*)(ML_V(buf0) + tt * VS + 4 * cg8) = pv; *(u32x4*)(ML_P(buf0) + tt * 72 + 8 * cg8) = pp;
                u32x2 wv; wv.x = pk2(v0 * ws, v1 * ws); wv.y = pk2(v2 * ws, v3 * ws); *(u32x2*)(ML_WV(buf0) + tt * VS + 4 * cg8) = wv;
                if (cg8 == 0) { ML_WV(buf0)[tt * VS + 32] = f2bf(ws); const float mx = fmaxf(mst, pg.z); float* F = ML_F(buf0); F[tt] = pg.y; F[64 + tt] = mx; F[128 + tt] = fexp(mst - mx); F[192 + tt] = fexp(-(pg.x + mx)); F[256 + tt] = fexp(pg.z - mx); }
            }
            mst = pgl.x + mxl;
            const int cn = (kst + 2 < NT / 64) ? kst + 2 : NT / 64 - 1;
            const size_t m = (size_t)(b * NT + cn * 64 + tt);
            const bf16_t* qs = C.qc() + m * 512 + hm * 128 + d0; const bf16_t* ks = C.kc() + m * 512 + hm * 128 + d0;
            pq0 = *(const u32x4*)qs; pq1 = *(const u32x4*)(qs + 8); pk0 = *(const u32x4*)ks; pk1 = *(const u32x4*)(ks + 8);
            pv = *(const u32x2*)(C.proj() + m * NPAD + C_VM + hm * 128 + sl * 32 + 4 * cg8);
            pg = *(const f32x4*)gate_ptr(C.proj(), m, hm); pgl = *(const f32x4*)gate_ptr(C.proj(), (size_t)(b * NT + cn * 64 + 63), hm); pp = *(const u32x4*)(p0base + (size_t)cn * 4 * 4096);
        }
        }
        LDS_BARRIER();
        { const int kc = ck + 1;
        }
        {
            const int mbase = b * NT + ck * 64;
            const bf16_t* LQ = ML_Q(buf1); const bf16_t* LK = ML_K(buf1); const bf16_t* LV = ML_V(buf1); const bf16_t* LWV = ML_WV(buf1); const bf16_t* LP = ML_P(buf1); const float* F = ML_F(buf1);
            const bf16_t* LCr = LCb1; bf16_t* LCw = LCb0;
            bf16x8 fp[2], fvr[2], fvd[2], fqq[4], fcr[4], fcd[4], kf[2], fw[3][2]; float inr[4], clr[4], rsr[4];
#pragma unroll
            for (int ks = 0; ks < 2; ++ks) { fp[ks] = *(const bf16x8*)(LP + (16 * ti + fr) * 72 + 32 * ks + 8 * fq); fvr[ks] = tr_frag(LV, VS, 32 * ks, 16 * vtw, fr, fq); fvd[ks] = tr_frag(LV, VS, 32 * ks, 32, fr, fq); }
#pragma unroll
            for (int ks = 0; ks < 4; ++ks) { fqq[ks] = *(const bf16x8*)(LQ + (16 * ti + fr) * 136 + 32 * ks + 8 * fq); fcr[ks] = *(const bf16x8*)(LCr + (16 * vtw + fr) * 136 + 32 * ks + 8 * fq); fcd[ks] = *(const bf16x8*)(LCr + (32 + fr) * 136 + 32 * ks + 8 * fq); }
#pragma unroll
            for (int ks = 0; ks < 2; ++ks) { kf[ks] = tr_frag(LK, 136, 32 * ks, 16 * wid, fr, fq);
#pragma unroll
                for (int vt2 = 0; vt2 < 3; ++vt2) fw[vt2][ks] = tr_frag(LWV, VS, 32 * ks, 16 * vt2, fr, fq); }
#pragma unroll
            for (int r = 0; r < 4; ++r) { inr[r] = F[128 + 16 * ti + 4 * fq + r]; clr[r] = F[192 + 16 * ti + 4 * fq + r]; rsr[r] = F[256 + 16 * ti + 4 * fq + r]; }
            LDS_WAIT_ALL();
            f32x4 numr = (f32x4){0.f, 0.f, 0.f, 0.f}, numd = numr;
            if constexpr ((VAR & 4) == 0) {
                f32x4 a1r = (f32x4){0.f, 0.f, 0.f, 0.f}, a1d = a1r, a2r = a1r, a2d = a1r;
#pragma unroll
                for (int ks = 0; ks < 2; ++ks) { a1r = __builtin_amdgcn_mfma_f32_16x16x32_bf16(fp[ks], fvr[ks], a1r, 0, 0, 0); a1d = __builtin_amdgcn_mfma_f32_16x16x32_bf16(fp[ks], fvd[ks], a1d, 0, 0, 0); }
#pragma unroll
                for (int ks = 0; ks < 4; ++ks) { a2r = __builtin_amdgcn_mfma_f32_16x16x32_bf16(fqq[ks], fcr[ks], a2r, 0, 0, 0); a2d = __builtin_amdgcn_mfma_f32_16x16x32_bf16(fqq[ks], fcd[ks], a2d, 0, 0, 0); }
#pragma unroll
                for (int r = 0; r < 4; ++r) { numr[r] = rsr[r] * a1r[r] + inr[r] * a2r[r]; numd[r] = rsr[r] * a1d[r] + inr[r] * a2d[r]; }
            }
            if constexpr ((VAR & 8) == 0) {
#pragma unroll
                for (int vt2 = 0; vt2 < 3; ++vt2) {
                    f32x4 acc = Cst[vt2] * carry_cur;
#pragma unroll
                    for (int ks = 0; ks < 2; ++ks) acc = __builtin_amdgcn_mfma_f32_16x16x32_bf16(fw[vt2][ks], kf[ks], acc, 0, 0, 0);
                    Cst[vt2] = acc;
#pragma unroll
                    for (int r = 0; r < 4; ++r) LCw[(16 * vt2 + 4 * fq + r) * 136 + 16 * wid + fr] = f2bf(acc[r]);
                }
            }
#pragma unroll
            for (int r = 0; r < 4; ++r) { const int t = 16 * ti + 4 * fq + r;
                const float den = __shfl(numd[r], lane & 48);
                const float dv = fmaxf(fabsf(den), clr[r]);
                if (st_out) C.proj()[(size_t)(mbase + t) * NPAD + C_VM + hm * 128 + sl * 32 + 16 * vtw + fr] = f2bf(numr[r] * frcp(dv)); }
        }
        carry_cur = carry_nxt;
        LDS_BARRIER();
      }
    }
#undef ML_Q
#undef ML_K
#undef ML_V
#undef ML_WV
#undef ML_P
#undef ML_F
}
__device__ __forceinline__ void phase3(const Ctx& C, int sub) {
    const int g = blockIdx.x;
    if (sub == 0 || sub == 1) {
        mlstm_m1_stream(C);
        asm volatile("s_waitcnt vmcnt(0)" ::: "memory"); __syncthreads();
        const int bb = g >> 5, ck = 2 * (g & 31) + (C.wid >> 2), hm = C.wid & 3;
        mlstm_gate_scan(C, bb, hm, ck);
        asm volatile("s_waitcnt vmcnt(0)" ::: "memory");
        mlstm_p0_item(C, bb, hm, ck);
    }
    if (sub >= 3) rwkv_r1_wg<(PROBE_SUB >= 3 ? PROBE_SUB : 0) | 1>(C, g >> 5, (g >> 2) & 7, (g & 3) * 16, 16); else if (sub != 1) rwkv_r1_wg<0>(C, g >> 5, (g >> 2) & 7, (g & 3) * 16, 16);
}
__device__ __forceinline__ void phase4(const Ctx& C, int sub) {
    for (int item = blockIdx.x; item < 256; item += gridDim.x) {
        if (item < 64) { if (sub != 2 && sub != 3) rwkv_r2_wg(C, item >> 3, item & 7); }
        else if (item < 128) { }
        else { const int i = item - 128; if (sub == 3) mlstm_item<PROBE_SUB | 1>(C, i >> 4, (i >> 2) & 3, i & 3); else if (sub != 1) mlstm_item<0>(C, i >> 4, (i >> 2) & 3, i & 3); }
        __syncthreads();
    }
}

__device__ __forceinline__ void ld8f(const float* p, float* o) { const f32x4 a = *(const f32x4*)p, b = *(const f32x4*)(p + 4); o[0] = a.x; o[1] = a.y; o[2] = a.z; o[3] = a.w; o[4] = b.x; o[5] = b.y; o[6] = b.z; o[7] = b.w; }
__device__ __forceinline__ void phase5(const Ctx& C) {
    const int lane = C.lane; const int c0 = 8 * lane;
    float muv[8], gnw[8], gnb[8], lnw[8], skp[8];
    ld8f(C.mu() + C_V + c0, muv); ld8f(C.gn_w() + c0, gnw); ld8f(C.gn_b() + c0, gnb); ld8f(C.ln_w() + c0, lnw); ld8f(C.skip() + c0, skp);
    for (int m = C.gw; m < NTOK; m += C.ngw) {
        const bool hp = (m & (NT - 1)) != 0;
        const bf16_t* pc = C.proj() + (size_t)m * NPAD; bf16_t* yo = C.ymix() + (size_t)m * DM;
        float outr[8], outm[8];
        {
            float y[8], v[8], pv[8], z[8];
            unpack8(*(const u32x4*)(pc + C_R + c0), y);
            unpack8(*(const u32x4*)(pc + C_V + c0), v); unpack8(*(const u32x4*)(pc + C_ZR + c0), z);
            unpack8(*(const u32x4*)((m > 0 ? pc - NPAD : pc) + C_V + c0), pv);
            if (!hp) {
#pragma unroll
                for (int i = 0; i < 8; ++i) { pv[i] = 0.f; } }
            float s = 0.f; const float bs = C.bonus()[(size_t)m * 8 + (lane >> 3)];
#pragma unroll
            for (int i = 0; i < 8; ++i) { v[i] += muv[i] * (pv[i] - v[i]); s += y[i]; }
            s += __shfl_xor(s, 1); s += __shfl_xor(s, 2); s += __shfl_xor(s, 4);
            const float mean = s * (1.0f / 64.0f); float q = 0.f;
#pragma unroll
            for (int i = 0; i < 8; ++i) { y[i] -= mean; q += y[i] * y[i]; }
            q += __shfl_xor(q, 1); q += __shfl_xor(q, 2); q += __shfl_xor(q, 4);
            const float rstd = __builtin_amdgcn_rsqf(q * (1.0f / 64.0f) + 64e-5f);
#pragma unroll
            for (int i = 0; i < 8; ++i) { const float yn = y[i] * rstd * gnw[i] + gnb[i]; outr[i] = (yn + bs * v[i]) * siluf_(z[i]); }
        }
        {
            float h[8], o[8], z[8], qc[8];
            unpack8(*(const u32x4*)(pc + C_VM + c0), h);
            unpack8(*(const u32x4*)(pc + C_O + c0), o); unpack8(*(const u32x4*)(pc + C_ZM + c0), z); unpack8(*(const u32x4*)(C.qc() + (size_t)m * 512 + c0), qc);
            float s = 0.f;
#pragma unroll
            for (int i = 0; i < 8; ++i) s += h[i];
            s += __shfl_xor(s, 1); s += __shfl_xor(s, 2); s += __shfl_xor(s, 4); s += __shfl_xor(s, 8);
            const float mean = s * (1.0f / 128.0f); float q = 0.f;
#pragma unroll
            for (int i = 0; i < 8; ++i) { h[i] -= mean; q += h[i] * h[i]; }
            q += __shfl_xor(q, 1); q += __shfl_xor(q, 2); q += __shfl_xor(q, 4); q += __shfl_xor(q, 8);
            const float rstd = __builtin_amdgcn_rsqf(q * (1.0f / 128.0f) + 1e-6f);
#pragma unroll
            for (int i = 0; i < 8; ++i) { const float hn = h[i] * rstd * lnw[i]; outm[i] = (sigmoidf_(o[i]) * hn + skp[i] * qc[i]) * siluf_(z[i]); }
        }
        *(u32x4*)(yo + c0) = pack8(outr);
        *(u32x4*)(yo + 512 + c0) = pack8(outm);
    }
}

struct RowIn { f32x4 x[4]; u32x4 mx[2]; };
__device__ __forceinline__ void p7_load(const Ctx& C, RowIn& r, int m) {
    const f32x4* xr = (const f32x4*)(C.x() + (size_t)m * DM) + C.lane;
#pragma unroll
    for (int j = 0; j < 4; ++j) r.x[j] = __builtin_nontemporal_load(xr + 64 * j);
    const u32x2* mr = (const u32x2*)(C.mixo() + (size_t)m * DM) + C.lane;
    const u32x2 a0 = __builtin_nontemporal_load(mr), a1 = __builtin_nontemporal_load(mr + 64), a2 = __builtin_nontemporal_load(mr + 128), a3 = __builtin_nontemporal_load(mr + 192);
    r.mx[0] = (u32x4){a0.x, a0.y, a1.x, a1.y}; r.mx[1] = (u32x4){a2.x, a2.y, a3.x, a3.y};
}
template <int VAR> __device__ __forceinline__ void phase7(const Ctx& C) {
    f32x4 g[4];
#pragma unroll
    for (int j = 0; j < 4; ++j) g[j] = *(const f32x4*)(C.fgain() + 4 * C.lane + 256 * j);
    RowIn cur, nx1; p7_load(C, cur, C.gw); p7_load(C, nx1, C.gw + C.ngw);
    if constexpr ((VAR & 2) != 0) { asm volatile("" : "+v"(cur.x[0]), "+v"(nx1.x[0])); }
    f32x4 gtv[4]; int bcur = -1;
    for (int m = C.gw; m < NTOK; m += C.ngw) {
        const int b = m >> 12; const int mn = (m + 2 * C.ngw < NTOK) ? m + 2 * C.ngw : m;
        if (b != bcur) { bcur = b;
#pragma unroll
            for (int j = 0; j < 4; ++j) gtv[j] = *(const f32x4*)(C.ada() + b * 3072 + 2048 + 4 * C.lane + 256 * j); }
        RowIn nxt; if constexpr ((VAR & 2) == 0) p7_load(C, nxt, mn); else nxt = nx1;
        f32x4 h[4]; float s = 0.f;
#pragma unroll
        for (int j = 0; j < 4; ++j) {
            const f32x4 gt = gtv[j];
            const unsigned w0 = (j & 1) ? cur.mx[j >> 1].z : cur.mx[j >> 1].x, w1 = (j & 1) ? cur.mx[j >> 1].w : cur.mx[j >> 1].y;
            const f32x4 mv = (f32x4){__uint_as_float(w0 << 16), __uint_as_float(w0 & 0xffff0000u), __uint_as_float(w1 << 16), __uint_as_float(w1 & 0xffff0000u)};
            h[j] = cur.x[j] + gt * mv; s += (h[j].x * h[j].x + h[j].y * h[j].y) + (h[j].z * h[j].z + h[j].w * h[j].w); }
        const float rs = __builtin_amdgcn_rsqf(wave_sum(s) * (1.0f / DM) + 1e-6f);
        f32x4* o = (f32x4*)(C.out() + (size_t)m * DM) + C.lane;
#pragma unroll
        for (int j = 0; j < 4; ++j) { if constexpr ((VAR & 1) == 0) __builtin_nontemporal_store(h[j] * rs * g[j], o + 64 * j); else asm volatile("" :: "v"(h[j] * rs * g[j])); }
        cur = nx1; nx1 = nxt;
    }
}

#define LAS __attribute__((address_space(3)))
#define XB_TMO      128
#define XB_XCNT(j)  (256  + 64 * (j))
#define XB_XSUB(j)  (1280 + 64 * (j))
#define XB_XGEN(j)  (2304 + 64 * (j))
#define XB_TOP      3328
#define XB_TOPGEN   3392
#define XCD_BAR_WORDS 3456
#define XB_SPIN_CAP (1u << 18)

__device__ __forceinline__ unsigned xb_ld(unsigned* p)              { return __hip_atomic_load(p, __ATOMIC_RELAXED, __HIP_MEMORY_SCOPE_AGENT); }
__device__ __forceinline__ unsigned xb_add(unsigned* p, unsigned v) { return __hip_atomic_fetch_add(p, v, __ATOMIC_RELAXED, __HIP_MEMORY_SCOPE_AGENT); }
__device__ __forceinline__ unsigned xb_xcc_id() { return (unsigned)__builtin_amdgcn_s_getreg((3 << 11) | 20) & 0xFu; }
#define XB_SPIN(cond, bar) do { unsigned _sp = 0; while (cond) { __builtin_amdgcn_s_sleep(1); \
    if ((++_sp & 255u) == 0u) { if (xb_ld(&(bar)[XB_TMO])) break; if (_sp > XB_SPIN_CAP) { atomicAdd(&(bar)[XB_TMO], 1u); break; } } } } while (0)

struct XcdBarrier {
    unsigned* bar; unsigned x;
    volatile LAS unsigned* st;
};

__device__ __forceinline__ XcdBarrier xcd_barrier_post(unsigned* bar, volatile LAS unsigned* st) {
    XcdBarrier b; b.bar = bar; b.x = xb_xcc_id(); b.st = st;
    if (threadIdx.x == 0) (void)xb_add(&bar[XB_XCNT(b.x)], 1u);
    return b;
}
__device__ __forceinline__ void xcd_barrier_complete(unsigned* bar, unsigned x, unsigned& nloc, unsigned& nx) {
    const unsigned G = gridDim.x * gridDim.y * gridDim.z;
    unsigned sum, cnt, mine, sp = 0u;
    for (;;) {
        sum = 0u; cnt = 0u; mine = 0u;
#pragma unroll
        for (unsigned j = 0; j < 16; ++j) { const unsigned c = xb_ld(&bar[XB_XCNT(j)]); sum += c; cnt += (c > 0u) ? 1u : 0u; mine = (j == x) ? c : mine; }
        if (sum == G) break;
        __builtin_amdgcn_s_sleep(1);
        if ((++sp & 255u) == 0u) { if (xb_ld(&bar[XB_TMO])) break; if (sp > XB_SPIN_CAP) { atomicAdd(&bar[XB_TMO], 1u); break; } }
    }
    nloc = mine > 0u ? mine : 1u; nx = cnt > 0u ? cnt : 1u;
}

__device__ __forceinline__ void xcd_barrier(const XcdBarrier& b) {
    asm volatile("s_waitcnt vmcnt(0)" ::: "memory");
    __syncthreads();
    if (threadIdx.x == 0) {
        unsigned* bar = b.bar;
        __builtin_amdgcn_s_waitcnt(0);
        unsigned nloc = b.st[0], nx = b.st[1];
        if (nloc == 0u) { xcd_barrier_complete(bar, b.x, nloc, nx); b.st[0] = nloc; b.st[1] = nx; }
        const unsigned old = xb_add(&bar[XB_XSUB(b.x)], 1u);
        const unsigned gen = old / nloc;
        if (old + 1u == (gen + 1u) * nloc) {
            __builtin_amdgcn_fence(__ATOMIC_RELEASE, "agent");
            asm volatile("s_waitcnt vmcnt(0)" ::: "memory");
            const unsigned og = xb_add(&bar[XB_TOP], 1u);
            const unsigned tg = og / nx;
            if (og + 1u == (tg + 1u) * nx) xb_add(&bar[XB_TOPGEN], 1u);
            else XB_SPIN(xb_ld(&bar[XB_TOPGEN]) == tg, bar);
            __builtin_amdgcn_fence(__ATOMIC_ACQUIRE, "agent");
            xb_add(&bar[XB_XGEN(b.x)], 1u);
            asm volatile("s_waitcnt vmcnt(0)" ::: "memory");
        } else {
            XB_SPIN(xb_ld(&bar[XB_XGEN(b.x)]) == gen, bar);
            __builtin_amdgcn_fence(__ATOMIC_ACQUIRE, "agent");
            asm volatile("s_waitcnt vmcnt(0)" ::: "memory");
        }
    }
    __syncthreads();
}

#ifndef PROBE_REP
#define PROBE_REP -1
#endif
#ifndef PROBE_SUB
#define PROBE_SUB 0
#endif
__global__ void __launch_bounds__(NTHR, 2) fwd_kernel(Params p) {
    extern __shared__ __attribute__((aligned(16))) unsigned char lds_raw[];
    cg::grid_group grid = cg::this_grid();
    Ctx C{p};
    C.lds = lds_raw; C.tid = threadIdx.x; C.lane = C.tid & 63; C.wid = __builtin_amdgcn_readfirstlane(C.tid >> 6);
    C.gw = blockIdx.x * NWV + C.wid; C.ngw = gridDim.x * NWV;
    const int lo = p.ph_lo, hi = p.ph_hi;
    unsigned* barw = (unsigned*)(p.ws + WS_CTL);
    volatile LAS unsigned* bst = (volatile LAS unsigned*)((LAS unsigned char*)lds_raw + LDS_BYTES - 16);
    if (threadIdx.x < 4) bst[threadIdx.x] = 0u;
    if (blockIdx.x == 0) for (int e = threadIdx.x; e < XCD_BAR_WORDS; e += NTHR) barw[e] = 0u;
    XcdBarrier xbar; xbar.bar = barw; xbar.x = 0; xbar.st = bst;
#define RUN(k) (lo <= (k) && (k) < hi)
#define GSYNC() xcd_barrier(xbar)
#define SEAM(k) do { if (RUN(k) && RUN((k) + 1)) GSYNC(); } while (0)
    if (RUN(0)) phase0(C);
    if (RUN(0) && RUN(1)) { grid.sync(); xbar = xcd_barrier_post(barw, bst); }
#if PROBE_REP == 8
    GSYNC(); GSYNC(); GSYNC(); GSYNC(); GSYNC(); GSYNC(); GSYNC(); GSYNC();
#endif
    if (RUN(1)) { phase1(C); weight_copies(C); }
#if PROBE_REP == 1
    GSYNC(); phase0(C); GSYNC(); phase1(C); weight_copies(C);
#endif
    SEAM(1);
    if (RUN(2)) {
        pg8::Gemm g{C.hn(), C.win_t(), NTOK, NPAD, DM}; pg8::StaticOrder S; S.init(NTOK, NPAD, (int)gridDim.x, (int)blockIdx.x);
        pg8::EpiBf16<0> E{C.proj(), NPAD, nullptr, 0, 0};
        pg8::gemm_phase<pg8::EpiBf16<0>, pg8::StaticOrder, false>((PG8_LAS unsigned char*)lds_raw, g, S, E, nullptr);
#if PROBE_REP == 2
        GSYNC(); pg8::gemm_phase<pg8::EpiBf16<0>, pg8::StaticOrder, false>((PG8_LAS unsigned char*)lds_raw, g, S, E, nullptr);
#endif
    }
    SEAM(2);
    if (RUN(3)) phase3(C, 0);
#if PROBE_REP == 3
    GSYNC(); phase3(C, PROBE_SUB);
#endif
    SEAM(3);
#if PROBE_REP == 6
    phase4(C, 3); GSYNC();
#endif
    if (RUN(4)) phase4(C, 0);
#if PROBE_REP == 4
    GSYNC(); phase4(C, PROBE_SUB);
#endif
    SEAM(4);
    if (RUN(5)) phase5(C);
#if PROBE_REP == 5
    GSYNC(); phase5(C);
#endif
    SEAM(5);
    if (RUN(6)) {
        pg8::Gemm g{C.ymix(), C.wout_t(), NTOK, DM, DM}; pg8::StaticOrder S; S.init(NTOK, DM, (int)gridDim.x, (int)blockIdx.x);
        pg8::EpiBf16<0> E{C.mixo(), DM, nullptr, 0, 0};
        pg8::gemm_phase<pg8::EpiBf16<0>, pg8::StaticOrder, false>((PG8_LAS unsigned char*)lds_raw, g, S, E, nullptr);
#if PROBE_REP == 7
        GSYNC(); pg8::gemm_phase<pg8::EpiBf16<0>, pg8::StaticOrder, false>((PG8_LAS unsigned char*)lds_raw, g, S, E, nullptr);
#endif
    }
    SEAM(6);
#if PROBE_REP == 9
    phase7<PROBE_SUB>(C); GSYNC();
#endif
    if (RUN(7)) phase7<0>(C);
#undef RUN
#undef SEAM
}

#ifndef N_LAUNCHES
#define N_LAUNCHES 1
#endif
extern "C" void kernel_launch(void* const* d_in, const int* in_sizes, int n_in, void* d_out, int out_size, void* d_ws, size_t ws_size, hipStream_t stream) {
    static int grid = 0;
    if (grid == 0) {
        if (n_in != 24 || out_size != NTOK * DM || ws_size < WS_END) { fprintf(stderr, "kernel_launch: unexpected shapes (n_in %d, out %d, ws %zu < %zu)\n", n_in, out_size, ws_size, (size_t)WS_END); grid = -1; return; }
        int dev = 0, cus = 0, per_cu = 0;
        hipGetDevice(&dev); hipDeviceGetAttribute(&cus, hipDeviceAttributeMultiprocessorCount, dev);
        if (hipFuncSetAttribute((const void*)fwd_kernel, hipFuncAttributeMaxDynamicSharedMemorySize, LDS_BYTES) != hipSuccess) { fprintf(stderr, "kernel_launch: hipFuncSetAttribute failed\n"); grid = -1; return; }
        if (hipOccupancyMaxActiveBlocksPerMultiprocessor(&per_cu, (const void*)fwd_kernel, NTHR, LDS_BYTES) != hipSuccess || per_cu < 1) { fprintf(stderr, "kernel_launch: occupancy query says %d\n", per_cu); per_cu = 1; }
        (void)hipGetLastError();
        if (cus < 256) { fprintf(stderr, "kernel_launch: this build needs 256 CUs (got %d)\n", cus); grid = -1; return; }
        grid = 256;
        fprintf(stderr, "kernel_launch: grid %d, per_cu %d\n", grid, per_cu);
    }
    if (grid < 0) return;
    Params p{};
    for (int i = 0; i < 24; ++i) p.in[i] = (const float*)d_in[i];
    p.out = (float*)d_out; p.ws = (unsigned char*)d_ws;
    if (N_LAUNCHES == 1) {
        p.ph_lo = 0; p.ph_hi = NPHASE; void* args[] = {&p};
        hipError_t e = hipLaunchCooperativeKernel((const void*)fwd_kernel, dim3(grid), dim3(NTHR), args, LDS_BYTES, stream);
        if (e != hipSuccess) fprintf(stderr, "cooperative launch failed: %s (grid %d)\n", hipGetErrorString(e), grid);
    } else {
        for (int ph = 0; ph < NPHASE; ++ph) { p.ph_lo = ph; p.ph_hi = ph + 1; hipLaunchKernelGGL(fwd_kernel, dim3(grid), dim3(NTHR), LDS_BYTES, stream, p); }
    }
}
```

```cpp
#include <hip/hip_runtime.h>
#include <hip/hip_cooperative_groups.h>
#include <cstdio>
#define PROBE_REP -1
#define PROBE_SUB 0
namespace pg8 {
#define PG8_LAS __attribute__((address_space(3)))
typedef unsigned short bf16_t;
typedef short bf16x8 __attribute__((ext_vector_type(8)));
typedef float f32x4 __attribute__((ext_vector_type(4)));
typedef unsigned u32x4 __attribute__((ext_vector_type(4)));
constexpr int BM = 256, BK = 64, HALF = 128, HTB = HALF * BK * 2  , STAGE_BYTES = 8 * HTB, NXCD = 8, WGM = 8;

__host__ __device__ __forceinline__ int lds_byte(int r, int c) { const int st = (r >> 4) * 2 + (c >> 5), rr = r & 15, cc = c & 31, ob = rr * 64 + cc * 2; return st * 1024 + (ob ^ (((ob >> 9) & 1) << 5)); }
__host__ __device__ __forceinline__ void stage_rc(int b, int& R, int& C) { const int st = b / 1024, sb = b % 1024, swz = sb ^ (((sb >> 9) & 1) << 5); R = (st >> 1) * 16 + swz / 64; C = (st & 1) * 32 + (swz % 64) / 2; }
__host__ __device__ __forceinline__ int perm32(int rho) { const int n = rho >> 4, i = rho & 15; return 8 * (i >> 2) + 4 * n + (i & 3); }

struct Unit { int pm, pn; };
struct Gemm { const bf16_t* A; const bf16_t* Bt; int M, N, K; };

struct StaticOrder {
    int nM, nN, nwg, G, c;
    __host__ __device__ void init(int M, int N, int G_, int c_) { nM = M / BM; nN = N / BM; nwg = nM * nN; G = G_; c = c_; }
    __host__ __device__ bool next(int i, Unit& u) const {
        const long L = (long)i * G + c; if (L >= nwg) return false;
        int wgid = (int)L; { const int q = nwg / NXCD, r = nwg % NXCD, xcd = wgid % NXCD, off = wgid / NXCD; wgid = (xcd < r ? xcd * (q + 1) : r * (q + 1) + (xcd - r) * q) + off; }
        const int nig = WGM * nN, gid = wgid / nig, fm = gid * WGM, gsz = (nM - fm) < WGM ? (nM - fm) : WGM;
        u.pm = fm + ((wgid % nig) % gsz); u.pn = (wgid % nig) / gsz; return true;
    }
    __device__ __forceinline__ void a_ready(const Unit&) const {}
    __device__ __forceinline__ void done(const Unit&) const {}
};
struct CountedOrder : StaticOrder {
    const unsigned* ready; unsigned need; unsigned* tmo;
    __device__ __forceinline__ void a_ready(const Unit& u) const {
        if (threadIdx.x < 64) {
            const unsigned long long t0 = __builtin_amdgcn_s_memrealtime(); unsigned polls = 0;
            while ((unsigned)__builtin_amdgcn_readfirstlane(__hip_atomic_load(ready + 64 * u.pm, __ATOMIC_RELAXED, __HIP_MEMORY_SCOPE_AGENT)) < need) {
                if ((++polls & 255u) == 0u && __builtin_amdgcn_readfirstlane(__hip_atomic_load(tmo, __ATOMIC_RELAXED, __HIP_MEMORY_SCOPE_AGENT)) != 0u) break;
                if (__builtin_amdgcn_s_memrealtime() - t0 > 2000000ull) {
                    if (threadIdx.x == 0) { unsigned expect = 0u; __hip_atomic_compare_exchange_strong(tmo + 1, &expect, 0x600u | (unsigned)(u.pm & 0xff), __ATOMIC_RELAXED, __ATOMIC_RELAXED, __HIP_MEMORY_SCOPE_AGENT); __hip_atomic_store(tmo, 1u, __ATOMIC_RELAXED, __HIP_MEMORY_SCOPE_AGENT); }
                    break; }
                __builtin_amdgcn_s_sleep(2); }
            __builtin_amdgcn_fence(__ATOMIC_ACQUIRE, "agent");
            asm volatile("s_waitcnt vmcnt(0)" ::: "memory");
        }
#if !defined(BROKEN_HOOK_NO_BARRIER)
        asm volatile("" ::: "memory"); __builtin_amdgcn_s_barrier(); asm volatile("" ::: "memory");
#endif
    }
};

__device__ __forceinline__ unsigned cvt_pk_bf16(float lo, float hi) { unsigned r; asm volatile("v_cvt_pk_bf16_f32 %0, %1, %2" : "=v"(r) : "v"(lo), "v"(hi)); return r; }
typedef float f32x2 __attribute__((ext_vector_type(2)));
__device__ __forceinline__ f32x2 gelu_pk(f32x2 v) {
    const f32x2 av = __builtin_elementwise_abs(v), d = av * 0.2316418882f + 1.0f;
    f32x2 t; t.x = __builtin_amdgcn_rcpf(d.x); t.y = __builtin_amdgcn_rcpf(d.y);
    f32x2 q = t * 0.5307027145f + (-0.7265760135f); q = q * t + 0.7107068705f; q = q * t + (-0.142248368f); q = q * t + 0.127414796f; q = q * t;
    const f32x2 s = (v * v) * (-0.72134752044f);
    f32x2 e; e.x = __builtin_amdgcn_exp2f(s.x); e.y = __builtin_amdgcn_exp2f(s.y);
    const f32x2 m = v * (q * e), r = v - m;
    f32x2 o; o.x = v.x < 0.f ? m.x : r.x; o.y = v.y < 0.f ? m.y : r.y; return o;
}

struct EpiF32 {
    static constexpr bool PERM = false, AFTER_DRAIN = false;
    float* C; int ldc; const float* bias;
    __device__ __forceinline__ void operator()(const f32x4 (&acc)[2][2][4][2], const Unit& u, int wr, int wc, int fr, int fq) const {
        const int row0 = u.pm * BM + wr * 64 + fr, col0 = u.pn * BM + wc * 32 + 4 * fq;
        f32x4 bv[2][2];
#pragma unroll
        for (int bj = 0; bj < 2; ++bj)
#pragma unroll
            for (int n = 0; n < 2; ++n) bv[bj][n] = bias ? *(const f32x4*)(bias + col0 + bj * HALF + n * 16) : (f32x4){0.f, 0.f, 0.f, 0.f};
#pragma unroll
        for (int ai = 0; ai < 2; ++ai)
#pragma unroll
            for (int m = 0; m < 4; ++m) { float* rowp = C + (size_t)(row0 + ai * HALF + m * 16) * ldc + col0;
#pragma unroll
                for (int bj = 0; bj < 2; ++bj)
#pragma unroll
                    for (int n = 0; n < 2; ++n) *(f32x4*)(rowp + bj * HALF + n * 16) = acc[ai][bj][m][n] + bv[bj][n]; }
    }
};
template <int ACT  > struct EpiBf16 {
    static constexpr bool PERM = true, AFTER_DRAIN = false;
    bf16_t* O; int ldc; const float* bias; int split_cols; size_t split_stride;
    __device__ __forceinline__ void operator()(const f32x4 (&acc)[2][2][4][2], const Unit& u, int wr, int wc, int fr, int fq) const {
        const int row0 = u.pm * BM + wr * 64 + fr; int colt = u.pn * BM; bf16_t* base = O;
        if (split_cols) { const int t = colt / split_cols; base += (size_t)t * split_stride; colt -= t * split_cols; }
        const int col0 = colt + wc * 32 + 8 * fq, bcol0 = u.pn * BM + wc * 32 + 8 * fq;
        f32x4 bv[2][2];
#pragma unroll
        for (int bj = 0; bj < 2; ++bj)
#pragma unroll
            for (int n = 0; n < 2; ++n) bv[bj][n] = bias ? *(const f32x4*)(bias + bcol0 + bj * HALF + 4 * n) : (f32x4){0.f, 0.f, 0.f, 0.f};
#pragma unroll
        for (int ai = 0; ai < 2; ++ai)
#pragma unroll
            for (int m = 0; m < 4; ++m) { bf16_t* rowp = base + (size_t)(row0 + ai * HALF + m * 16) * ldc + col0;
#pragma unroll
                for (int bj = 0; bj < 2; ++bj) { f32x4 v0 = acc[ai][bj][m][0] + bv[bj][0], v1 = acc[ai][bj][m][1] + bv[bj][1];
                    if (ACT == 1) { f32x2 a = gelu_pk((f32x2){v0[0], v0[1]}), b = gelu_pk((f32x2){v0[2], v0[3]}), c = gelu_pk((f32x2){v1[0], v1[1]}), d = gelu_pk((f32x2){v1[2], v1[3]});
                        v0 = (f32x4){a.x, a.y, b.x, b.y}; v1 = (f32x4){c.x, c.y, d.x, d.y}; }
                    if (ACT == 2) {
#pragma unroll
                        for (int j = 0; j < 4; ++j) { v0[j] = 0.5f * v0[j] * (1.0f + erff(v0[j] * 0.70710678f)); v1[j] = 0.5f * v1[j] * (1.0f + erff(v1[j] * 0.70710678f)); } }
                    u32x4 w; w.x = cvt_pk_bf16(v0[0], v0[1]); w.y = cvt_pk_bf16(v0[2], v0[3]); w.z = cvt_pk_bf16(v1[0], v1[1]); w.w = cvt_pk_bf16(v1[2], v1[3]);
                    *(u32x4*)(rowp + bj * HALF) = w; } }
    }
};

struct PanelStats {
    unsigned* xbuf;
    unsigned* cnt;
    unsigned* tmo;
    int ntn; float eps;
    unsigned code;
    __device__ __forceinline__ bool run(const f32x4 (&v)[2][2][4][2], const Unit& u, int wr, int wc, int fr, int fq, PG8_LAS unsigned char* lds, int wid, int lane) const {
        typedef float f32x2v __attribute__((ext_vector_type(2)));
        PG8_LAS f32x2v* P = (PG8_LAS f32x2v*)lds;
        PG8_LAS f32x2v* S = (PG8_LAS f32x2v*)(lds + 8192);
        PG8_LAS unsigned* flag = (PG8_LAS unsigned*)(lds + 8192 + 2048);
#pragma unroll
        for (int ai = 0; ai < 2; ++ai)
#pragma unroll
            for (int m = 0; m < 4; ++m) {
                float s = 0.f;
#pragma unroll
                for (int bj = 0; bj < 2; ++bj)
#pragma unroll
                    for (int n = 0; n < 2; ++n) { const f32x4 x = v[ai][bj][m][n]; s += (x[0] + x[1]) + (x[2] + x[3]); }
                s += __shfl_xor(s, 16); s += __shfl_xor(s, 32);
                const float mw = s * (1.0f / 64.0f); float q = 0.f;
#pragma unroll
                for (int bj = 0; bj < 2; ++bj)
#pragma unroll
                    for (int n = 0; n < 2; ++n) { const f32x4 d = v[ai][bj][m][n] - mw; q += (d[0] * d[0] + d[1] * d[1]) + (d[2] * d[2] + d[3] * d[3]); }
                q += __shfl_xor(q, 16); q += __shfl_xor(q, 32);
                if (fq == 0) P[(ai * HALF + wr * 64 + m * 16 + fr) * 4 + wc] = (f32x2v){mw, q};
            }
        asm volatile("s_waitcnt lgkmcnt(0)" ::: "memory"); __builtin_amdgcn_s_barrier(); asm volatile("" ::: "memory");
#if defined(BROKEN_NO_WAIT)
        if (blockIdx.x >= 64) { const long long t0 = clock64(); while (clock64() - t0 < 60000) __builtin_amdgcn_s_sleep(8); }
#endif
        const int row = wid * 32 + (lane & 31);
        if (lane < 32) {
            const f32x2v a = P[row * 4 + 0], b = P[row * 4 + 1], c = P[row * 4 + 2], d = P[row * 4 + 3];
            const float mt = (a.x + b.x + c.x + d.x) * 0.25f;
            const float da = a.x - mt, db = b.x - mt, dc = c.x - mt, dd = d.x - mt;
            const float m2 = (a.y + b.y) + (c.y + d.y) + 64.0f * ((da * da + db * db) + (dc * dc + dd * dd));
            unsigned long long* slot = (unsigned long long*)xbuf + ((size_t)(u.pm * BM + row) * 4 + u.pn);
            __hip_atomic_store(slot, ((unsigned long long)__float_as_uint(m2) << 32) | __float_as_uint(mt), __ATOMIC_RELAXED, __HIP_MEMORY_SCOPE_AGENT);
        }
        asm volatile("s_waitcnt vmcnt(0)" ::: "memory");
        if (lane == 0) __hip_atomic_fetch_add(cnt + 64 * u.pm, 1u, __ATOMIC_RELAXED, __HIP_MEMORY_SCOPE_AGENT);
        if (wid == 0) {
            bool dead = false; const unsigned long long t0 = __builtin_amdgcn_s_memrealtime(); const unsigned want = 8u * (unsigned)ntn;
            for (;;) {
#if defined(BROKEN_NO_WAIT)
                break;
#endif
                if ((unsigned)__builtin_amdgcn_readfirstlane(__hip_atomic_load(cnt + 64 * u.pm, __ATOMIC_RELAXED, __HIP_MEMORY_SCOPE_AGENT)) >= want) break;
                if (__builtin_amdgcn_s_memrealtime() - t0 > 2000000ull) {
                    if (lane == 0) { unsigned expect = 0u; __hip_atomic_compare_exchange_strong(tmo + 1, &expect, code | (unsigned)(u.pm & 0xff), __ATOMIC_RELAXED, __ATOMIC_RELAXED, __HIP_MEMORY_SCOPE_AGENT);
                                     __hip_atomic_store(tmo, 1u, __ATOMIC_RELAXED, __HIP_MEMORY_SCOPE_AGENT); }
                    dead = true; break; }
                __builtin_amdgcn_s_sleep(2);
            }
            __builtin_amdgcn_fence(__ATOMIC_ACQUIRE, "agent");
            if (lane == 0) flag[0] = dead ? 1u : 0u;
        }
        asm volatile("s_waitcnt vmcnt(0) lgkmcnt(0)" ::: "memory"); __builtin_amdgcn_s_barrier(); asm volatile("" ::: "memory");
        const bool bad = flag[0] != 0u;
        if (lane < 32) {
            const unsigned long long* slot = (const unsigned long long*)xbuf + (size_t)(u.pm * BM + row) * 4; float mt[4], m2[4]; float ms = 0.f;
#pragma unroll
            for (int t = 0; t < 4; ++t) { if (t < ntn) { const unsigned long long w = __hip_atomic_load(slot + t, __ATOMIC_RELAXED, __HIP_MEMORY_SCOPE_AGENT); mt[t] = __uint_as_float((unsigned)w); m2[t] = __uint_as_float((unsigned)(w >> 32)); } else { mt[t] = 0.f; m2[t] = 0.f; } ms += mt[t]; }
            const float mean = ms / (float)ntn; float q = 0.f;
#pragma unroll
            for (int t = 0; t < 4; ++t) if (t < ntn) { const float dm = mt[t] - mean; q += m2[t] + 256.0f * dm * dm; }
            S[row] = (f32x2v){mean, 1.0f / sqrtf(q / (256.0f * (float)ntn) + eps)};
        }
        asm volatile("s_waitcnt lgkmcnt(0)" ::: "memory"); __builtin_amdgcn_s_barrier(); asm volatile("" ::: "memory");
        return bad;
    }
};
struct EpiLnRes {
    static constexpr bool PERM = false, AFTER_DRAIN = true;
    const float* base; float* out; int ldc; const float* bias; PanelStats st; unsigned poison;
    __device__ __forceinline__ void refuse(size_t i0, size_t stride, int M, int N) const { const float q = __builtin_nanf(""); for (size_t i = i0; i < (size_t)M * N; i += stride) out[(i / N) * ldc + i % N] = q;
        if (i0 == 0) { unsigned expect = 0u; __hip_atomic_compare_exchange_strong(st.tmo + 1, &expect, 0x7f0u, __ATOMIC_RELAXED, __ATOMIC_RELAXED, __HIP_MEMORY_SCOPE_AGENT); __hip_atomic_store(st.tmo, 1u, __ATOMIC_RELAXED, __HIP_MEMORY_SCOPE_AGENT); } }
    __device__ __forceinline__ void fused(f32x4 (&acc)[2][2][4][2], const Unit& u, int wr, int wc, int fr, int fq, PG8_LAS unsigned char* lds, int wid, int lane) const {
        typedef float f32x2v __attribute__((ext_vector_type(2)));
        const PG8_LAS f32x2v* S = (const PG8_LAS f32x2v*)(lds + 8192);
        const int col0 = u.pn * BM + wc * 32 + 4 * fq;
#pragma unroll
        for (int bj = 0; bj < 2; ++bj)
#pragma unroll
            for (int n = 0; n < 2; ++n) { const f32x4 bv = bias ? *(const f32x4*)(bias + col0 + bj * HALF + n * 16) : (f32x4){0.f, 0.f, 0.f, 0.f};
#pragma unroll
                for (int ai = 0; ai < 2; ++ai)
#pragma unroll
                    for (int m = 0; m < 4; ++m) acc[ai][bj][m][n] += bv; }
        const bool bad = st.run(acc, u, wr, wc, fr, fq, lds, wid, lane) || poison != 0u;
        const float qnan = __builtin_nanf("");
#pragma unroll
        for (int ai = 0; ai < 2; ++ai)
#pragma unroll
            for (int m = 0; m < 4; ++m) { const int r = ai * HALF + wr * 64 + m * 16 + fr; const f32x2v sr = S[r]; const size_t off = (size_t)(u.pm * BM + r) * ldc + col0;
#pragma unroll
                for (int bj = 0; bj < 2; ++bj)
#pragma unroll
                    for (int n = 0; n < 2; ++n) { const f32x4 bs = *(const f32x4*)(base + off + bj * HALF + n * 16); f32x4 o = bs + (acc[ai][bj][m][n] - sr.x) * sr.y;
                        if (bad) o = (f32x4){qnan, qnan, qnan, qnan}; *(f32x4*)(out + off + bj * HALF + n * 16) = o; }
                asm volatile("" ::: "memory"); }
    }
};
struct EpiLnResLn {
    static constexpr bool PERM = false, AFTER_DRAIN = true;
    const float* base; float* out; bf16_t* xn; int ldc; const float* bias; PanelStats st1, st2; unsigned poison;
    __device__ __forceinline__ void refuse(size_t i0, size_t stride, int M, int N) const { const float q = __builtin_nanf(""); for (size_t i = i0; i < (size_t)M * N; i += stride) { const size_t o = (i / N) * ldc + i % N; out[o] = q; xn[o] = (bf16_t)0x7fc0u; }
        if (i0 == 0) { unsigned expect = 0u; __hip_atomic_compare_exchange_strong(st1.tmo + 1, &expect, 0x7f0u, __ATOMIC_RELAXED, __ATOMIC_RELAXED, __HIP_MEMORY_SCOPE_AGENT); __hip_atomic_store(st1.tmo, 1u, __ATOMIC_RELAXED, __HIP_MEMORY_SCOPE_AGENT); } }
    __device__ __forceinline__ void fused(f32x4 (&acc)[2][2][4][2], const Unit& u, int wr, int wc, int fr, int fq, PG8_LAS unsigned char* lds, int wid, int lane) const {
        typedef float f32x2v __attribute__((ext_vector_type(2))); typedef unsigned u32x2v __attribute__((ext_vector_type(2)));
        const PG8_LAS f32x2v* S = (const PG8_LAS f32x2v*)(lds + 8192);
        const int col0 = u.pn * BM + wc * 32 + 4 * fq;
#pragma unroll
        for (int bj = 0; bj < 2; ++bj)
#pragma unroll
            for (int n = 0; n < 2; ++n) { const f32x4 bv = bias ? *(const f32x4*)(bias + col0 + bj * HALF + n * 16) : (f32x4){0.f, 0.f, 0.f, 0.f};
#pragma unroll
                for (int ai = 0; ai < 2; ++ai)
#pragma unroll
                    for (int m = 0; m < 4; ++m) acc[ai][bj][m][n] += bv; }
        bool bad = st1.run(acc, u, wr, wc, fr, fq, lds, wid, lane) || poison != 0u;
        const float qnan = __builtin_nanf("");
#pragma unroll
        for (int ai = 0; ai < 2; ++ai)
#pragma unroll
            for (int m = 0; m < 4; ++m) { const int r = ai * HALF + wr * 64 + m * 16 + fr; const f32x2v sr = S[r]; const size_t off = (size_t)(u.pm * BM + r) * ldc + col0;
#pragma unroll
                for (int bj = 0; bj < 2; ++bj)
#pragma unroll
                    for (int n = 0; n < 2; ++n) { const f32x4 bs = *(const f32x4*)(base + off + bj * HALF + n * 16); acc[ai][bj][m][n] = bs + (acc[ai][bj][m][n] - sr.x) * sr.y; }
                asm volatile("" : "+v"(acc[ai][0][m][0]), "+v"(acc[ai][0][m][1]), "+v"(acc[ai][1][m][0]), "+v"(acc[ai][1][m][1]));
                if (m & 1) asm volatile("" ::: "memory"); }
        const bool bad1 = bad;
        bad = st2.run(acc, u, wr, wc, fr, fq, lds, wid, lane) || bad;
#pragma unroll
        for (int ai = 0; ai < 2; ++ai)
#pragma unroll
            for (int m = 0; m < 4; ++m) { const int r = ai * HALF + wr * 64 + m * 16 + fr; const f32x2v sr = S[r]; const size_t off = (size_t)(u.pm * BM + r) * ldc + col0;
#pragma unroll
                for (int bj = 0; bj < 2; ++bj)
#pragma unroll
                    for (int n = 0; n < 2; ++n) { const f32x4 x1 = acc[ai][bj][m][n]; *(f32x4*)(out + off + bj * HALF + n * 16) = bad1 ? (f32x4){qnan, qnan, qnan, qnan} : x1;
                        const f32x4 o = (x1 - sr.x) * sr.y; u32x2v w; w.x = cvt_pk_bf16(o[0], o[1]); w.y = cvt_pk_bf16(o[2], o[3]);
                        if (bad) { w.x = 0x7fc07fc0u; w.y = 0x7fc07fc0u; } *(u32x2v*)(xn + off + bj * HALF + n * 16) = w; }
                asm volatile("" ::: "memory"); }
    }
};

template <class Epi, class Sched, bool STAMP = false>
__device__ __forceinline__ void gemm_phase(PG8_LAS unsigned char* lds, const Gemm g, const Sched& S, const Epi& E, unsigned long long* stamps) {
    const int tid = threadIdx.x, wid = __builtin_amdgcn_readfirstlane(tid >> 6), lane = tid & 63, wr = wid >> 2, wc = wid & 3, fr = lane & 15, fq = lane >> 4;
    const int K = g.K, nt = K / BK;
    int ts_lo = 0, ts_hi = 0, nts = 0; const unsigned long long rt_entry = STAMP ? (unsigned long long)wall_clock64() : 0ull;
#define PG8_STAMP() do { if (STAMP && wid == 0 && nts < 64) { const unsigned long long _c = (unsigned long long)clock64(); \
        ts_lo = (lane == nts) ? (int)(unsigned)_c : ts_lo; ts_hi = (lane == nts) ? (int)(unsigned)(_c >> 32) : ts_hi; ++nts; } } while (0)
    PG8_STAMP();
    unsigned voffA[2], voffB[2];
#pragma unroll
    for (int i = 0; i < 2; ++i) { int R, C; stage_rc(tid * 16 + i * 8192, R, C); const int Rb = Epi::PERM ? ((R & ~31) + perm32(R & 31)) : R;
        voffA[i] = (unsigned)(R * K + C) * 2u; voffB[i] = (unsigned)(Rb * K + C) * 2u; }
    const size_t kstep = (size_t)(BK * 2);
    const size_t hstep = (size_t)HALF * K * 2;
    const size_t tstep = 2 * hstep;
    const unsigned ldsw = (unsigned)wid * 1024u;
    const int aoff = lds_byte(wr * 64 + fr, fq * 8), boff = lds_byte(wc * 32 + fr, fq * 8);
#define PG8_SA(b, h) (((b) * 2 + (h)) * HTB)
#define PG8_SB(b, h) ((4 + (b) * 2 + (h)) * HTB)
#define PG8_STAGE(bufoff, gbase, voff) do { _Pragma("unroll") for (int _i = 0; _i < 2; ++_i) \
        __builtin_amdgcn_global_load_lds((const unsigned*)((const char*)(gbase) + (voff)[_i]), (PG8_LAS unsigned*)(lds + (bufoff) + ldsw + _i * 8192), 16, 0, 0); } while (0)
#define PG8_LDA(dst, b, h) do { _Pragma("unroll") for (int m = 0; m < 4; ++m) _Pragma("unroll") for (int k = 0; k < 2; ++k) dst[m][k] = *(const PG8_LAS bf16x8*)(lds + PG8_SA(b, h) + aoff + m * 2048 + k * 1024); } while (0)
#define PG8_LDB(dst, b, h) do { _Pragma("unroll") for (int n = 0; n < 2; ++n) _Pragma("unroll") for (int k = 0; k < 2; ++k) dst[n][k] = *(const PG8_LAS bf16x8*)(lds + PG8_SB(b, h) + boff + n * 2048 + k * 1024); } while (0)
#define PG8_MMA(ai, bj, At, Bt) do { __builtin_amdgcn_s_setprio(1); _Pragma("unroll") for (int m = 0; m < 4; ++m) _Pragma("unroll") for (int n = 0; n < 2; ++n) _Pragma("unroll") for (int k = 0; k < 2; ++k) \
        acc[ai][bj][m][n] = __builtin_amdgcn_mfma_f32_16x16x32_bf16(Bt[n][k], At[m][k], acc[ai][bj][m][n], 0, 0, 0); __builtin_amdgcn_s_setprio(0); } while (0)
#define PG8_WAIT_V(n) asm volatile("s_waitcnt vmcnt(" #n ")" ::: "memory")
#define PG8_WAIT_L(n) asm volatile("s_waitcnt lgkmcnt(" #n ")" ::: "memory")
#define PG8_BAR __builtin_amdgcn_s_barrier()
#define PG8_SCHED __builtin_amdgcn_sched_barrier(0)
    Unit cur, nxt; int ui = 0;
    if (!S.next(0, cur)) return;
    f32x4 acc[2][2][4][2];
#pragma unroll
    for (int a = 0; a < 2; ++a)
#pragma unroll
        for (int b = 0; b < 2; ++b)
#pragma unroll
            for (int m = 0; m < 4; ++m)
#pragma unroll
                for (int n = 0; n < 2; ++n) acc[a][b][m][n] = (f32x4){0.f, 0.f, 0.f, 0.f};
    bf16x8 At[4][2], B0[2][2], B1[2][2];
    const char* cA = (const char*)g.A + (size_t)cur.pm * tstep; const char* cB = (const char*)g.Bt + (size_t)cur.pn * tstep;
    S.a_ready(cur);
    PG8_STAGE(PG8_SB(0, 0), cB, voffB); PG8_STAGE(PG8_SA(0, 0), cA, voffA); PG8_STAGE(PG8_SB(0, 1), cB + hstep, voffB); PG8_STAGE(PG8_SA(0, 1), cA + hstep, voffA);
    if (wr == 1) PG8_BAR;
    PG8_WAIT_V(4); PG8_BAR;
    PG8_STAGE(PG8_SB(1, 0), cB + kstep, voffB); PG8_STAGE(PG8_SA(1, 0), cA + kstep, voffA); PG8_STAGE(PG8_SB(1, 1), cB + hstep + kstep, voffB);
    PG8_WAIT_V(6); PG8_BAR;
    PG8_STAMP();
    for (;;) {
        const bool has_next = S.next(ui + 1, nxt);
        const char* nA = has_next ? (const char*)g.A + (size_t)nxt.pm * tstep : cA; const char* nB = has_next ? (const char*)g.Bt + (size_t)nxt.pn * tstep : cB;
        for (int t = 0; t < nt; t += 2) {
            const bool last = (t == nt - 2);
            const char* a1 = cA + (size_t)(t + 1) * kstep;
            const char* a2 = last ? nA : cA + (size_t)(t + 2) * kstep; const char* b2 = last ? nB : cB + (size_t)(t + 2) * kstep;
            const char* a3 = a2 + kstep; const char* b3 = b2 + kstep;
            if (last && has_next) S.a_ready(nxt);
            PG8_LDB(B0, 0, 0); PG8_SCHED; PG8_LDA(At, 0, 0); PG8_STAGE(PG8_SA(1, 1), a1 + hstep, voffA);
            PG8_WAIT_L(8); PG8_BAR; PG8_WAIT_L(0); PG8_MMA(0, 0, At, B0); PG8_BAR; PG8_SCHED;
            PG8_LDB(B1, 0, 1); PG8_STAGE(PG8_SB(0, 0), b2, voffB);
            PG8_BAR; PG8_WAIT_L(0); PG8_MMA(0, 1, At, B1); PG8_BAR;
            PG8_LDA(At, 0, 1); PG8_STAGE(PG8_SA(0, 0), a2, voffA);
            PG8_BAR; PG8_WAIT_L(0); PG8_MMA(1, 0, At, B0); PG8_BAR; PG8_SCHED;
            PG8_STAGE(PG8_SB(0, 1), b2 + hstep, voffB);
            PG8_WAIT_V(6); PG8_BAR; PG8_MMA(1, 1, At, B1); PG8_BAR;
            PG8_LDB(B0, 1, 0); PG8_SCHED; PG8_LDA(At, 1, 0); PG8_STAGE(PG8_SA(0, 1), a2 + hstep, voffA);
            PG8_WAIT_L(8); PG8_BAR; PG8_WAIT_L(0); PG8_MMA(0, 0, At, B0); PG8_BAR; PG8_SCHED;
            PG8_LDB(B1, 1, 1); PG8_STAGE(PG8_SB(1, 0), b3, voffB);
            PG8_BAR; PG8_WAIT_L(0); PG8_MMA(0, 1, At, B1); PG8_BAR;
            PG8_LDA(At, 1, 1); PG8_STAGE(PG8_SA(1, 0), a3, voffA);
            PG8_BAR; PG8_WAIT_L(0); PG8_MMA(1, 0, At, B0); PG8_BAR; PG8_SCHED;
            PG8_STAGE(PG8_SB(1, 1), b3 + hstep, voffB);
            PG8_WAIT_V(6); PG8_BAR; PG8_MMA(1, 1, At, B1); PG8_BAR;
        }
        PG8_STAMP();
        if constexpr (!Epi::AFTER_DRAIN) { E(acc, cur, wr, wc, fr, fq); S.done(cur); }
        PG8_STAMP();
        if (!has_next) break;
#pragma unroll
        for (int a = 0; a < 2; ++a)
#pragma unroll
            for (int b = 0; b < 2; ++b)
#pragma unroll
                for (int m = 0; m < 4; ++m)
#pragma unroll
                    for (int n = 0; n < 2; ++n) acc[a][b][m][n] = (f32x4){0.f, 0.f, 0.f, 0.f};
        cur = nxt; cA = nA; cB = nB; ++ui;
    }
    PG8_WAIT_V(0);
    if (wr == 0) PG8_BAR;
    PG8_BAR;
    if constexpr (Epi::AFTER_DRAIN) { E.fused(acc, cur, wr, wc, fr, fq, lds, wid, lane); S.done(cur); }
    PG8_STAMP();
    if (STAMP && wid == 0) { stamps[lane] = lane < nts ? (((unsigned long long)(unsigned)ts_hi << 32) | (unsigned)ts_lo) : 0ull;
        if (lane == 62) stamps[62] = rt_entry; if (lane == 63) stamps[63] = (unsigned long long)wall_clock64(); }
#undef PG8_STAMP
#undef PG8_SA
#undef PG8_SB
#undef PG8_STAGE
#undef PG8_LDA
#undef PG8_LDB
#undef PG8_MMA
#undef PG8_WAIT_V
#undef PG8_WAIT_L
#undef PG8_BAR
#undef PG8_SCHED
}
}

namespace cg = cooperative_groups;
typedef unsigned short bf16_t;
typedef short bf16x8 __attribute__((ext_vector_type(8)));
typedef float f32x4 __attribute__((ext_vector_type(4)));
typedef unsigned u32x4 __attribute__((ext_vector_type(4)));
typedef unsigned u32x2 __attribute__((ext_vector_type(2)));

constexpr int NB = 8, NT = 4096, DM = 1024, NTOK = NB * NT;
constexpr int DIN = 4744, NPAD = 4864;
constexpr int C_R = 0, C_K = 512, C_V = 1024, C_WD = 1536, C_AD = 1600, C_ZR = 1664, C_Q = 2176, C_KM = 2688, C_VM = 3200, C_O = 3712, C_I = 4224, C_F = 4228, C_ZM = 4232;
constexpr int NTHR = 512, NWV = 8;
constexpr int LDS_BYTES = 147456;
constexpr int NPHASE = 8;

constexpr size_t MiB = 1u << 20;
constexpr size_t WS_CTL = 0, CTL_BYTES = 1 * MiB;
constexpr size_t WS_ADA = 1 * MiB;
constexpr size_t WS_LORA = 1 * MiB + 512 * 1024;
constexpr size_t WS_WL = 14 * MiB, WS_BONUS = 15 * MiB;
constexpr size_t WS_WIN = 2 * MiB;
constexpr size_t WS_WOUT = 12 * MiB;
constexpr size_t WS_X = 16 * MiB;
constexpr size_t WS_PROJ = 144 * MiB;
constexpr size_t WS_Y = 448 * MiB;
constexpr size_t WS_END = 512 * MiB;

struct Params { const float* in[24]; float* out; unsigned char* ws; int ph_lo, ph_hi; };

struct Ctx {
    const Params& p;
    __device__ __forceinline__ const float* x() const { return p.in[0]; }
    __device__ __forceinline__ const float* c() const { return p.in[1]; }
    __device__ __forceinline__ const float* w_ada() const { return p.in[2]; }
    __device__ __forceinline__ const float* b_ada() const { return p.in[3]; }
    __device__ __forceinline__ const float* norm_gain() const { return p.in[4]; }
    __device__ __forceinline__ const float* w_in() const { return p.in[5]; }
    __device__ __forceinline__ const float* mu() const { return p.in[6]; }
    __device__ __forceinline__ const float* w_dup() const { return p.in[7]; }
    __device__ __forceinline__ const float* w_d0() const { return p.in[8]; }
    __device__ __forceinline__ const float* w_iup() const { return p.in[9]; }
    __device__ __forceinline__ const float* a0() const { return p.in[10]; }
    __device__ __forceinline__ const float* k_k() const { return p.in[11]; }
    __device__ __forceinline__ const float* k_a() const { return p.in[12]; }
    __device__ __forceinline__ const float* r_k() const { return p.in[13]; }
    __device__ __forceinline__ const float* gn_w() const { return p.in[14]; }
    __device__ __forceinline__ const float* gn_b() const { return p.in[15]; }
    __device__ __forceinline__ const float* conv_w() const { return p.in[16]; }
    __device__ __forceinline__ const float* conv_b() const { return p.in[17]; }
    __device__ __forceinline__ const float* b_i() const { return p.in[18]; }
    __device__ __forceinline__ const float* b_f() const { return p.in[19]; }
    __device__ __forceinline__ const float* ln_w() const { return p.in[20]; }
    __device__ __forceinline__ const float* skip() const { return p.in[21]; }
    __device__ __forceinline__ const float* w_out() const { return p.in[22]; }
    __device__ __forceinline__ const float* fgain() const { return p.in[23]; }
    __device__ __forceinline__ float* out() const { return p.out; }
    __device__ __forceinline__ float* sumsq() const { return (float*)(p.ws + (WS_Y)); }
    __device__ __forceinline__ float* ada() const { return (float*)(p.ws + (WS_ADA)); }
    __device__ __forceinline__ bf16_t* win_t() const { return (bf16_t*)(p.ws + (WS_WIN)); }
    __device__ __forceinline__ bf16_t* wout_t() const { return (bf16_t*)(p.ws + (WS_WOUT)); }
    __device__ __forceinline__ bf16_t* hn() const { return (bf16_t*)(p.ws + (WS_X)); }
    __device__ __forceinline__ bf16_t* proj() const { return (bf16_t*)(p.ws + (WS_PROJ)); }
    __device__ __forceinline__ bf16_t* y() const { return (bf16_t*)(p.ws + (WS_Y)); }
    __device__ __forceinline__ bf16_t* wdup_t() const { return (bf16_t*)(p.ws + (WS_LORA)); }
    __device__ __forceinline__ bf16_t* wiup_t() const { return (bf16_t*)(p.ws + (WS_LORA + 65536)); }
    __device__ __forceinline__ bf16_t* q1p() const { return (bf16_t*)(p.ws + (WS_X)); }
    __device__ __forceinline__ bf16_t* mp() const { return (bf16_t*)(p.ws + (WS_X + 32 * MiB)); }
    __device__ __forceinline__ bf16_t* yid() const { return (bf16_t*)(p.ws + (WS_X + 64 * MiB)); }
    __device__ __forceinline__ bf16_t* nd() const { return (bf16_t*)(p.ws + (WS_X + 96 * MiB)); }
    __device__ __forceinline__ float* wl() const { return (float*)(p.ws + (WS_WL)); }
    __device__ __forceinline__ float* bonus() const { return (float*)(p.ws + (WS_BONUS)); }
    __device__ __forceinline__ bf16_t* qc() const { return (bf16_t*)(p.ws + WS_Y); }
    __device__ __forceinline__ bf16_t* kc() const { return (bf16_t*)(p.ws + WS_Y + 32 * MiB); }
    __device__ __forceinline__ bf16_t* mixo() const { return (bf16_t*)(p.ws + WS_Y); }
    __device__ __forceinline__ bf16_t* p0s() const { return (bf16_t*)p.out; }
    __device__ __forceinline__ bf16_t* ymix() const { return (bf16_t*)(p.ws + WS_X); }
    unsigned char* lds; int tid, lane, wid, gw, ngw;
};

__device__ __forceinline__ float bf2f(bf16_t v) { return __uint_as_float(((unsigned)v) << 16); }
typedef __bf16 bf16v2_t __attribute__((ext_vector_type(2))); typedef float f32v2_t __attribute__((ext_vector_type(2)));
__device__ __forceinline__ unsigned pk2(float lo, float hi) { const f32v2_t v = {lo, hi}; const bf16v2_t b = __builtin_convertvector(v, bf16v2_t); return __builtin_bit_cast(unsigned, b); }
__device__ __forceinline__ bf16_t f2bf(float f) { return __builtin_bit_cast(bf16_t, (__bf16)f); }
__device__ __forceinline__ void unpack8(const u32x4 v, float* o) {
    o[0] = __uint_as_float(v.x << 16); o[1] = __uint_as_float(v.x & 0xffff0000u); o[2] = __uint_as_float(v.y << 16); o[3] = __uint_as_float(v.y & 0xffff0000u);
    o[4] = __uint_as_float(v.z << 16); o[5] = __uint_as_float(v.z & 0xffff0000u); o[6] = __uint_as_float(v.w << 16); o[7] = __uint_as_float(v.w & 0xffff0000u);
}
__device__ __forceinline__ u32x4 pack8(const float* v) { u32x4 o; o.x = pk2(v[0], v[1]); o.y = pk2(v[2], v[3]); o.z = pk2(v[4], v[5]); o.w = pk2(v[6], v[7]); return o; }
__device__ __forceinline__ float wave_sum(float v) {
#pragma unroll
    for (int o = 1; o < 64; o <<= 1) v += __shfl_xor(v, o);
    return v;
}
#define LDS_BARRIER() do { asm volatile("s_waitcnt lgkmcnt(0)" ::: "memory"); __builtin_amdgcn_s_barrier(); asm volatile("" ::: "memory"); } while (0)
__device__ __forceinline__ float fexp(float x) { return __builtin_amdgcn_exp2f(x * 1.4426950408889634f); }
__device__ __forceinline__ float frcp(float x) { return __builtin_amdgcn_rcpf(x); }
__device__ __forceinline__ float sigmoidf_(float z) { return frcp(1.0f + fexp(-z)); }
__device__ __forceinline__ float siluf_(float z) { return z * frcp(1.0f + fexp(-z)); }
__device__ __forceinline__ float ftanh(float x) { return 1.0f - 2.0f * frcp(1.0f + fexp(2.0f * x)); }
template <int CTRL> __device__ __forceinline__ float dppf(float v) { return __int_as_float(__builtin_amdgcn_update_dpp(0, __float_as_int(v), CTRL, 0xF, 0xF, true)); }
__device__ __forceinline__ float row16_sum(float v) {
    v += dppf<0xB1>(v); v += dppf<0x4E>(v); v += dppf<0x141>(v); v += dppf<0x140>(v); return v;
}

__device__ __forceinline__ void transpose_item(const float* W, int K, int N, bf16_t* WT, float* scr, int item, int nblk, int lane) {
    const int kb = item / nblk, nb = item % nblk, k0 = 64 * kb, n0 = 32 * nb;
#pragma unroll
    for (int i = 0; i < 32; ++i) { const int kk = 2 * i + (lane >> 5); const int n = n0 + (lane & 31); scr[kk * 33 + (lane & 31)] = (n < N) ? W[(size_t)(k0 + kk) * N + n] : 0.f; }
    __builtin_amdgcn_s_waitcnt(0); asm volatile("" ::: "memory");
    const int c = lane & 7;
#pragma unroll
    for (int j = 0; j < 4; ++j) { const int n = (lane >> 3) + 8 * j; const float* s = scr + (8 * c) * 33 + n;
        u32x4 o; o.x = pk2(s[0 * 33], s[1 * 33]); o.y = pk2(s[2 * 33], s[3 * 33]); o.z = pk2(s[4 * 33], s[5 * 33]); o.w = pk2(s[6 * 33], s[7 * 33]);
        *(u32x4*)(WT + (size_t)(n0 + n) * K + k0 + 8 * c) = o; }
    __builtin_amdgcn_s_waitcnt(0); asm volatile("" ::: "memory");
}
__device__ __forceinline__ void phase0(const Ctx& C) {
    if (blockIdx.x >= 48) return;
    float* Ls = (float*)C.lds;
    float* Lp = Ls + 8192;
    for (int e = C.tid; e < 8192; e += NTHR) Ls[e] = siluf_(C.c()[e]);
    __syncthreads();
    const int lane = C.lane, wid = C.wid, grp = wid >> 2, kq = wid & 3, kp = lane >> 3, c4 = 4 * (lane & 7);
    const int col0 = (2 * blockIdx.x + grp) * 32;
    f32x4 acc[8];
#pragma unroll
    for (int b = 0; b < 8; ++b) acc[b] = (f32x4){0.f, 0.f, 0.f, 0.f};
#pragma unroll 16
    for (int it = 0; it < 32; ++it) {
        const int k = kq * 256 + it * 8 + kp;
        const f32x4 w = *(const f32x4*)(C.w_ada() + (size_t)k * 3072 + col0 + c4);
#pragma unroll
        for (int b = 0; b < 8; ++b) acc[b] = acc[b] + w * Ls[b * 1024 + k];
    }
#pragma unroll
    for (int b = 0; b < 8; ++b) {
#pragma unroll
        for (int o = 8; o < 64; o <<= 1) { acc[b].x += __shfl_xor(acc[b].x, o); acc[b].y += __shfl_xor(acc[b].y, o); acc[b].z += __shfl_xor(acc[b].z, o); acc[b].w += __shfl_xor(acc[b].w, o); }
        if (kp == 0) *(f32x4*)(Lp + ((grp * 4 + kq) * 8 + b) * 32 + c4) = acc[b];
    }
    __syncthreads();
    if (C.tid < 512) { const int g2 = C.tid >> 8, b = (C.tid >> 5) & 7, c = C.tid & 31; const int col = (2 * blockIdx.x + g2) * 32 + c;
        float s = C.b_ada()[col];
#pragma unroll
        for (int q = 0; q < 4; ++q) s += Lp[((g2 * 4 + q) * 8 + b) * 32 + c];
        C.ada()[b * 3072 + col] = s; }
}
__device__ __forceinline__ void weight_copies(const Ctx& C) {
    float* scr = (float*)(C.lds + C.wid * 16384);
    constexpr int NBI = NPAD / 32, I_IN = 16 * NBI, I_OUT = 16 * 32;
    for (int it = C.gw; it < I_IN + I_OUT + 32; it += C.ngw) {
        if (it < I_IN) transpose_item(C.w_in(), 1024, DIN, C.win_t(), scr, it, NBI, C.lane);
        else if (it < I_IN + I_OUT) transpose_item(C.w_out(), 1024, 1024, C.wout_t(), scr, it - I_IN, 32, C.lane);
        else if (it < I_IN + I_OUT + 16) transpose_item(C.w_dup(), 64, 512, C.wdup_t(), scr, it - I_IN - I_OUT, 16, C.lane);
        else transpose_item(C.w_iup(), 64, 512, C.wiup_t(), scr, it - I_IN - I_OUT - 16, 16, C.lane);
    }
}

__device__ __forceinline__ void phase1(const Ctx& C) {
    f32x4 g[4];
#pragma unroll
    for (int j = 0; j < 4; ++j) g[j] = *(const f32x4*)(C.norm_gain() + 4 * C.lane + 256 * j);
    f32x4 v[4], n1[4];
    { const f32x4* xr = (const f32x4*)(C.x() + (size_t)C.gw * DM) + C.lane; const f32x4* x1 = (const f32x4*)(C.x() + (size_t)(C.gw + C.ngw) * DM) + C.lane;
#pragma unroll
      for (int j = 0; j < 4; ++j) { v[j] = __builtin_nontemporal_load(xr + 64 * j); n1[j] = __builtin_nontemporal_load(x1 + 64 * j); } }
    f32x4 shv[4], scv[4]; int bcur = -1;
    for (int m = C.gw; m < NTOK; m += C.ngw) {
        const int b = m >> 12; const int mn = (m + 2 * C.ngw < NTOK) ? m + 2 * C.ngw : m;
        if (b != bcur) { bcur = b;
#pragma unroll
            for (int j = 0; j < 4; ++j) { shv[j] = *(const f32x4*)(C.ada() + b * 3072 + 4 * C.lane + 256 * j); scv[j] = *(const f32x4*)(C.ada() + b * 3072 + 1024 + 4 * C.lane + 256 * j) + 1.0f; } }
        f32x4 nv[4];
        { const f32x4* xr = (const f32x4*)(C.x() + (size_t)mn * DM) + C.lane;
#pragma unroll
          for (int j = 0; j < 4; ++j) nv[j] = __builtin_nontemporal_load(xr + 64 * j); }
        float s = 0.f;
#pragma unroll
        for (int j = 0; j < 4; ++j) s += (v[j].x * v[j].x + v[j].y * v[j].y) + (v[j].z * v[j].z + v[j].w * v[j].w);
        const float rs = __builtin_amdgcn_rsqf(wave_sum(s) * (1.0f / DM) + 1e-6f);
        u32x2* o = (u32x2*)(C.hn() + (size_t)m * DM) + C.lane;
#pragma unroll
        for (int j = 0; j < 4; ++j) {
            const f32x4 h = v[j] * rs * g[j] * scv[j] + shv[j];
            u32x2 w; w.x = pk2(h.x, h.y); w.y = pk2(h.z, h.w); o[64 * j] = w; }
#pragma unroll
        for (int j = 0; j < 4; ++j) { v[j] = n1[j]; n1[j] = nv[j]; }
    }
}

typedef short s16x4 __attribute__((ext_vector_type(4)));
__device__ __forceinline__ bf16x8 tr_frag(const bf16_t* base, int stride, int row0, int col0, int fr, int fq) {
    const bf16_t* a0 = base + (row0 + 8 * fq + (fr >> 2)) * stride + col0 + 4 * (fr & 3);
    const s16x4 lo = __builtin_amdgcn_ds_read_tr16_b64_v4i16((__attribute__((address_space(3))) s16x4*)a0);
    const s16x4 hi = __builtin_amdgcn_ds_read_tr16_b64_v4i16((__attribute__((address_space(3))) s16x4*)(a0 + 4 * stride));
    return (bf16x8){lo[0], lo[1], lo[2], lo[3], hi[0], hi[1], hi[2], hi[3]};
}

constexpr int LS = 72;
constexpr int XS = 68;
__device__ __forceinline__ int permc(int c) { return (c & 32) | ((c & 12) << 1) | ((c & 16) >> 2) | (c & 3); }
__device__ __forceinline__ bf16x8 zero8() { return (bf16x8){0, 0, 0, 0, 0, 0, 0, 0}; }
#define MFMA16(a, b, c) __builtin_amdgcn_mfma_f32_16x16x32_bf16(a, b, c, 0, 0, 0)
#define LDFRAG(base, row, col) (*(const bf16x8*)((base) + (row) * LS + (col)))

#define FR_(base, rowoff, coloff) (*(const bf16x8*)((base) + lfo + (rowoff) * LS + (coloff)))
#define DW_(base, rowoff, coloff, r) ((base)[ldo + ((rowoff) + (r)) * LS + (coloff)])
#define OPAQ() asm volatile("" : "+v"(lfo), "+v"(ldo), "+v"(lto), "+v"(lxo))
template <int VAR> __device__ __forceinline__ void rwkv_r1_wg(const Ctx& C, int b, int h, int ck0, int nck) {
    bf16_t* B0 = (bf16_t*)C.lds;
    bf16_t* B1 = B0 + 64 * LS;
    bf16_t* B2 = B1 + 64 * LS;
    bf16_t* B3 = B2 + 64 * LS;
    bf16_t* B4 = B3 + 64 * LS;
    bf16_t* B5 = B4 + 64 * LS;
    bf16_t* B6 = B5 + 64 * LS;
    bf16_t* B7 = B6 + 64 * LS;
    bf16_t* B8 = B7 + 64 * LS;
    float* F = (float*)(B8 + 64 * LS);
    float* Xr = F; float* Xk = F + 64 * XS; float* Xv = Xk + 64 * XS;
    bf16_t* LAab = (bf16_t*)F; bf16_t* LAak = LAab + 64 * LS; bf16_t* LArb = LAak + 64 * LS; bf16_t* LArk = LArb + 64 * LS; bf16_t* LTinv = LArk + 64 * LS;
    float* G = F + 3 * 64 * XS;
    float* LAd = G;
    float* Ltot = LAd + 1024;
    float* Linv = Ltot + 256;
    float* Lbp = Linv + 64;
    bf16_t* LX = (bf16_t*)LAd;
    bf16_t* LX2 = LX + 2 * 16 * 40;
    float* Lc = Lbp + 128;
    int tid = C.tid; asm volatile("" : "+v"(tid));
    const int lane = tid & 63, wid = C.wid, fr = lane & 15, fq = lane >> 4;
    const int tt = tid >> 3, cg8 = tid & 7, ch0 = h * 64 + 8 * cg8;
    const int wt = wid >> 1, wc0 = 2 * (wid & 1);
    __syncthreads();
    if (tid < 384) { const int a = tid >> 6, c = tid & 63;
        Lc[tid] = (a == 0) ? C.mu()[C_R + h * 64 + c] : (a == 1) ? C.mu()[C_K + h * 64 + c] : (a == 2) ? C.mu()[C_V + h * 64 + c] : (a == 3) ? C.k_k()[h * 64 + c] : (a == 4) ? C.mu()[C_WD + c] : C.mu()[C_AD + c]; }
    __syncthreads();
    float d0c[2], a0c[2], kkc[2], kac[2], rkc[2];
#pragma unroll
    for (int jj = 0; jj < 2; ++jj) { const int c = h * 64 + 16 * (wc0 + jj) + fr;
        d0c[jj] = C.w_d0()[c]; a0c[jj] = C.a0()[c]; kkc[jj] = C.k_k()[c]; kac[jj] = C.k_a()[c]; rkc[jj] = C.r_k()[c]; }
    int lfo = fr * LS + 8 * fq, ldo = 4 * fq * LS + fr, lto = fr * LS + 4 * fq, lxo = 4 * fq * XS + fr;

    u32x4 raw[10];
#define R1_LOAD_RAW(mm) do { const bf16_t* pc_ = C.proj() + (size_t)(mm) * NPAD; const bf16_t* pp_ = ((mm) > 0) ? pc_ - NPAD : pc_; \
        raw[0] = *(const u32x4*)(pc_ + C_R + ch0); raw[1] = *(const u32x4*)(pc_ + C_K + ch0); raw[2] = *(const u32x4*)(pc_ + C_V + ch0); \
        raw[3] = *(const u32x4*)(pc_ + C_WD + 8 * cg8); raw[4] = *(const u32x4*)(pc_ + C_AD + 8 * cg8); \
        raw[5] = *(const u32x4*)(pp_ + C_R + ch0); raw[6] = *(const u32x4*)(pp_ + C_K + ch0); raw[7] = *(const u32x4*)(pp_ + C_V + ch0); \
        raw[8] = *(const u32x4*)(pp_ + C_WD + 8 * cg8); raw[9] = *(const u32x4*)(pp_ + C_AD + 8 * cg8); } while (0)
    R1_LOAD_RAW(b * NT + ck0 * 64 + tt);
    for (int ci = 0; ci < nck; ++ci) {
        const int ck = ck0 + ci; const int m = b * NT + ck * 64 + tt; const size_t chx = (size_t)((b * 8 + h) * 64 + ck);
        OPAQ();
        bf16x8 Bw[2][2], Bi[2][2];
        { int co = (h * 64 + 16 * wc0 + fr) * 64 + 8 * fq; asm volatile("" : "+v"(co));
#pragma unroll
          for (int jj = 0; jj < 2; ++jj)
#pragma unroll
            for (int ks = 0; ks < 2; ++ks) { Bw[jj][ks] = *(const bf16x8*)(C.wdup_t() + co + jj * 1024 + 32 * ks); Bi[jj][ks] = *(const bf16x8*)(C.wiup_t() + co + jj * 1024 + 32 * ks); } }
        if constexpr ((VAR & 2) == 0) {
        {
            const bool hp = (ck | tt) != 0;
            if (!hp) {
#pragma unroll
                for (int i = 5; i < 10; ++i) raw[i] = (u32x4){0u, 0u, 0u, 0u}; }
            const int o = tt * XS + 8 * cg8;
            {
                float v[8], pv[8], mu8[8]; unpack8(raw[2], v); unpack8(raw[7], pv);
                { const f32x4* p4 = (const f32x4*)(Lc + 128 + 8 * cg8); *(f32x4*)mu8 = p4[0]; *(f32x4*)(mu8 + 4) = p4[1]; }
#pragma unroll
                for (int i = 0; i < 8; ++i) v[i] += mu8[i] * (pv[i] - v[i]);
                *(f32x4*)(Xv + o) = (f32x4){v[0], v[1], v[2], v[3]}; *(f32x4*)(Xv + o + 4) = (f32x4){v[4], v[5], v[6], v[7]};
            }
            asm volatile("" ::: "memory");
            {
                float v[8], pv[8], mu8[8]; unpack8(raw[0], v); unpack8(raw[5], pv);
                { const f32x4* p4 = (const f32x4*)(Lc + 8 * cg8); *(f32x4*)mu8 = p4[0]; *(f32x4*)(mu8 + 4) = p4[1]; }
#pragma unroll
                for (int i = 0; i < 8; ++i) v[i] += mu8[i] * (pv[i] - v[i]);
                *(f32x4*)(Xr + o) = (f32x4){v[0], v[1], v[2], v[3]}; *(f32x4*)(Xr + o + 4) = (f32x4){v[4], v[5], v[6], v[7]};
            }
            asm volatile("" ::: "memory");
            {
                float v[8], pv[8], mu8[8], kw8[8]; unpack8(raw[1], v); unpack8(raw[6], pv);
                { const f32x4* p4 = (const f32x4*)(Lc + 64 + 8 * cg8); *(f32x4*)mu8 = p4[0]; *(f32x4*)(mu8 + 4) = p4[1]; p4 = (const f32x4*)(Lc + 192 + 8 * cg8); *(f32x4*)kw8 = p4[0]; *(f32x4*)(kw8 + 4) = p4[1]; }
                float ss = 0.f;
#pragma unroll
                for (int i = 0; i < 8; ++i) { v[i] += mu8[i] * (pv[i] - v[i]); const float q = v[i] * kw8[i]; ss += q * q; }
                ss += __shfl_xor(ss, 1); ss += __shfl_xor(ss, 2); ss += __shfl_xor(ss, 4);
                if (cg8 == 0) Linv[tt] = frcp(fmaxf(__builtin_amdgcn_sqrtf(ss), 1e-12f));
                *(f32x4*)(Xk + o) = (f32x4){v[0], v[1], v[2], v[3]}; *(f32x4*)(Xk + o + 4) = (f32x4){v[4], v[5], v[6], v[7]};
            }
            asm volatile("" ::: "memory");
            {
                float v[8], pv[8], mu8[8]; unpack8(raw[3], v); unpack8(raw[8], pv);
                { const f32x4* p4 = (const f32x4*)(Lc + 256 + 8 * cg8); *(f32x4*)mu8 = p4[0]; *(f32x4*)(mu8 + 4) = p4[1]; }
#pragma unroll
                for (int i = 0; i < 8; ++i) v[i] = ftanh(v[i] + mu8[i] * (pv[i] - v[i]));
                *(u32x4*)(B0 + tt * LS + 8 * cg8) = pack8(v);
            }
            asm volatile("" ::: "memory");
            {
                float v[8], pv[8], mu8[8]; unpack8(raw[4], v); unpack8(raw[9], pv);
                { const f32x4* p4 = (const f32x4*)(Lc + 320 + 8 * cg8); *(f32x4*)mu8 = p4[0]; *(f32x4*)(mu8 + 4) = p4[1]; }
#pragma unroll
                for (int i = 0; i < 8; ++i) v[i] += mu8[i] * (pv[i] - v[i]);
                *(u32x4*)(B1 + tt * LS + 8 * cg8) = pack8(v);
            }
        }
        }
        LDS_BARRIER();
        float lw[2][4], aa[2][4];
        {
            f32x4 zw[2], za[2];
#pragma unroll
            for (int jj = 0; jj < 2; ++jj) { zw[jj] = (f32x4){0.f, 0.f, 0.f, 0.f}; za[jj] = (f32x4){0.f, 0.f, 0.f, 0.f}; }
#pragma unroll
            for (int ks = 0; ks < 2; ++ks) { const bf16x8 aw = FR_(B0, 16 * wt, 32 * ks), ai = FR_(B1, 16 * wt, 32 * ks);
#pragma unroll
                for (int jj = 0; jj < 2; ++jj) { zw[jj] = MFMA16(aw, Bw[jj][ks], zw[jj]); za[jj] = MFMA16(ai, Bi[jj][ks], za[jj]); } }
#pragma unroll
            for (int jj = 0; jj < 2; ++jj)
#pragma unroll
                for (int r = 0; r < 4; ++r) { lw[jj][r] = -0.6065306597126334f * sigmoidf_(d0c[jj] + zw[jj][r]); aa[jj][r] = sigmoidf_(a0c[jj] + za[jj][r]); }
        }
        float clx[2][4], cin[2][4];
#pragma unroll
        for (int jj = 0; jj < 2; ++jj) {
            const float s4 = (lw[jj][0] + lw[jj][1]) + (lw[jj][2] + lw[jj][3]); float x = s4;
            float t1 = __shfl_up(x, 16); if (fq >= 1) x += t1; t1 = __shfl_up(x, 32); if (fq >= 2) x += t1;
            const float eq = x - s4;
            clx[jj][0] = eq; cin[jj][0] = eq + lw[jj][0];
#pragma unroll
            for (int r = 1; r < 4; ++r) { clx[jj][r] = cin[jj][r - 1]; cin[jj][r] = cin[jj][r - 1] + lw[jj][r]; }
            if (fq == 3) Ltot[wt * 64 + 16 * (wc0 + jj) + fr] = x;
        }
        LDS_BARRIER();
        OPAQ();
        if constexpr ((VAR & 4) == 0) {
        {
            float bsum[4] = {0.f, 0.f, 0.f, 0.f};
            const int xb = lxo + 16 * wt * XS + 16 * wc0;
            const int db = 16 * wt * LS + 16 * wc0;
            const int tb = lto + 16 * wc0 * LS + 16 * wt;
#pragma unroll
            for (int jj = 0; jj < 2; ++jj) {
                const int c = 16 * (wc0 + jj) + fr;
                float off = 0.f, clL = 0.f;
#pragma unroll
                for (int q = 0; q < 4; ++q) { const float tv = Ltot[q * 64 + c]; clL += tv; if (q < wt) off += tv; }
                const float eL = fexp(clL);
                if ((VAR & 1) == 0 && wt == 0 && fq == 0) C.wl()[chx * 64 + c] = eL;
                float at[4], rt[4], bt[4], kt[4], bh[4], kh[4], vv[4]; float eprev = 0.f;
#pragma unroll
                for (int r = 0; r < 4; ++r) {
                    const float rr = Xr[xb + r * XS + 16 * jj], kr = Xk[xb + r * XS + 16 * jj]; vv[r] = Xv[xb + r * XS + 16 * jj];
                    const float kk = kr * kkc[jj] * Linv[16 * wt + 4 * fq + r]; const float a = aa[jj][r];
                    const float be = kk * a, km = kr * (1.0f + (a - 1.0f) * kac[jj]);
                    const float ci_ = off + cin[jj][r], cx = off + clx[jj][r];
                    const float ei = fexp(ci_), en = frcp(ei), el = eL * en;
                    at[r] = -kk * ((r == 0) ? fexp(cx) : eprev); eprev = ei; rt[r] = rr * ei; bt[r] = be * en; kt[r] = km * en; bh[r] = be * el; kh[r] = km * el;
                    bsum[r] += rr * km * rkc[jj];
                    B3[ldo + db + r * LS + 16 * jj] = f2bf(rt[r]);
                }
                u32x2 w;
                w.x = pk2(at[0], at[1]); w.y = pk2(at[2], at[3]); *(u32x2*)(B4 + tb + 16 * jj * LS) = w;
                w.x = pk2(bt[0], bt[1]); w.y = pk2(bt[2], bt[3]); *(u32x2*)(B1 + tb + 16 * jj * LS) = w;
                w.x = pk2(kt[0], kt[1]); w.y = pk2(kt[2], kt[3]); *(u32x2*)(B2 + tb + 16 * jj * LS) = w;
                w.x = pk2(bh[0], bh[1]); w.y = pk2(bh[2], bh[3]); *(u32x2*)(B5 + tb + 16 * jj * LS) = w;
                w.x = pk2(kh[0], kh[1]); w.y = pk2(kh[2], kh[3]); *(u32x2*)(B6 + tb + 16 * jj * LS) = w;
                w.x = pk2(vv[0], vv[1]); w.y = pk2(vv[2], vv[3]); *(u32x2*)(B7 + tb + 16 * jj * LS) = w;
            }
#pragma unroll
            for (int r = 0; r < 4; ++r) { const float s = row16_sum(bsum[r]); if (fr == 0) Lbp[(wid & 1) * 64 + 16 * wt + 4 * fq + r] = s; }
        }
        }
        LDS_BARRIER();
        OPAQ();
        if ((VAR & 1) == 0 && tid < 64) C.bonus()[(size_t)(b * NT + ck * 64 + tid) * 8 + h] = Lbp[tid] + Lbp[64 + tid];
        if constexpr ((VAR & 8) == 0) {
        {
            int fr3 = fr, fq3 = fq; asm volatile("" : "+v"(fr3), "+v"(fq3));
#pragma unroll
            for (int jj = 0; jj < 2; ++jj) {
                const int st = wc0 + jj;
                if (st <= wt) {
                    f32x4 ab = (f32x4){0.f, 0.f, 0.f, 0.f}, ak = ab, rb = ab, rk = ab;
#pragma unroll
                    for (int ks = 0; ks < 2; ++ks) {
                        const bf16x8 fa = tr_frag(B4, LS, 32 * ks, 16 * wt, fr3, fq3), frr = FR_(B3, 16 * wt, 32 * ks);
                        const bf16x8 fb = tr_frag(B1, LS, 32 * ks, 16 * st, fr3, fq3), fk = tr_frag(B2, LS, 32 * ks, 16 * st, fr3, fq3);
                        ab = MFMA16(fa, fb, ab); ak = MFMA16(fa, fk, ak); rb = MFMA16(frr, fb, rb); rk = MFMA16(frr, fk, rk);
                    }
                    int fro = fr, fqo = 4 * fq; asm volatile("" : "+v"(fro), "+v"(fqo));
                    const int s = 16 * st + fro;
#pragma unroll
                    for (int r = 0; r < 4; ++r) { const int t = 16 * wt + fqo + r; const bool lo = s < t, le = s <= t;
                        const float vab = lo ? ab[r] : 0.f;
                        DW_(LAab, 16 * wt, 16 * st, r) = f2bf(vab); DW_(LAak, 16 * wt, 16 * st, r) = f2bf(lo ? ak[r] : 0.f); DW_(LArb, 16 * wt, 16 * st, r) = f2bf(le ? rb[r] : 0.f); DW_(LArk, 16 * wt, 16 * st, r) = f2bf(le ? rk[r] : 0.f);
                        if (st == wt) LAd[wt * 256 + (4 * fq + r) * 16 + fr] = vab; }
                } else if (st == wt + 1 && (wt & 1) == 0) {
#pragma unroll
                    for (int r = 0; r < 4; ++r) { DW_(LAak, 16 * wt, 16 * st, r) = 0; DW_(LArb, 16 * wt, 16 * st, r) = 0; DW_(LArk, 16 * wt, 16 * st, r) = 0; DW_(LTinv, 16 * wt, 16 * st, r) = 0; }
                }
            }
            if (tid < 32) *(u32x4*)(B8 + (16 + (tid >> 1)) * LS + 8 * (tid & 1)) = (u32x4){0u, 0u, 0u, 0u};
        }
        }
        LDS_BARRIER();
        OPAQ();
        if constexpr ((VAR & 16) == 0) {
        if (wid == 0) {
            const float* Ad = LAd + fq * 256; float X[16];
#pragma unroll
            for (int i = 0; i < 16; ++i) X[i] = (i == fr) ? 1.0f : 0.f;
#pragma unroll
            for (int i = 1; i < 16; ++i) { float acc = X[i];
#pragma unroll
                for (int s = 0; s < i; ++s) acc += Ad[i * 16 + s] * X[s];
                X[i] = acc; }
            const int dg = ldo + 12 * fq * LS + 16 * fq;
#pragma unroll
            for (int i = 0; i < 16; ++i) LTinv[dg + i * LS] = f2bf(X[i]);
            const int dt = lfo + 16 * fq * LS + 8 * fq;
            *(u32x4*)(B8 + dt) = pack8(X); *(u32x4*)(B8 + dt + 8) = pack8(X + 8);
        } else {
            for (int tile = wid - 1; tile < 16; tile += 7) { const int vt = tile >> 2, t2 = tile & 3; f32x4 acc = (f32x4){0.f, 0.f, 0.f, 0.f};
#pragma unroll
                for (int ks = 0; ks < 2; ++ks) if (ks == 0 || t2 >= 2) acc = MFMA16(FR_(B7, 16 * vt, 32 * ks), FR_(LAak, 16 * t2, 32 * ks), acc);
#pragma unroll
                for (int r = 0; r < 4; ++r) DW_(B0, 16 * vt, 16 * t2, r) = f2bf(acc[r]); }
        }
        }
        LDS_BARRIER();
        OPAQ();
        if (ci + 1 < nck) R1_LOAD_RAW(m + 64);
        if ((VAR & 32) == 0 && wid < 2) {
            const int o = 32 * wid;
            bf16_t* lx = LX + wid * 16 * 40;
            const bool kv = fq < 2;
            const int xf = fr * 40 + 8 * fq, xd = 4 * fq * 40 + fr;
            {
                const bf16x8 fa = kv ? FR_(B8, o, o) : zero8(), fb = kv ? FR_(LAab, o + 16, o) : zero8();
                const f32x4 acc = MFMA16(fa, fb, ((f32x4){0.f, 0.f, 0.f, 0.f}));
#pragma unroll
                for (int r = 0; r < 4; ++r) lx[xd + r * 40] = f2bf(acc[r]);
            }
            asm volatile("s_waitcnt lgkmcnt(0)" ::: "memory");
            {
                const bf16x8 ft = kv ? FR_(LTinv, o + 16, o + 16) : zero8(), fx = kv ? *(const bf16x8*)(lx + xf) : zero8();
                const f32x4 acc = MFMA16(ft, fx, ((f32x4){0.f, 0.f, 0.f, 0.f}));
#pragma unroll
                for (int r = 0; r < 4; ++r) DW_(LTinv, o + 16, o, r) = f2bf(acc[r]);
                if (wid == 0) { const f32x4 acT = MFMA16(fx, ft, ((f32x4){0.f, 0.f, 0.f, 0.f}));
#pragma unroll
                    for (int r = 0; r < 4; ++r) DW_(B8, 0, 16, r) = f2bf(acT[r]); }
            }
        }
        LDS_BARRIER();
        if ((VAR & 32) == 0 && wid < 4) {
            const int jt = wid >> 1, ut = wid & 1;
            const f32x4 acc = MFMA16(FR_(B8, 16 * jt, 0), FR_(LAab, 32 + 16 * ut, 0), ((f32x4){0.f, 0.f, 0.f, 0.f}));
#pragma unroll
            for (int r = 0; r < 4; ++r) LX2[(16 * jt + 4 * fq + r) * 40 + 16 * ut + fr] = f2bf(acc[r]);
        }
        LDS_BARRIER();
        if ((VAR & 32) == 0 && wid < 4) {
            const int t2 = wid >> 1, jt = wid & 1;
            const f32x4 acc = MFMA16(FR_(LTinv, 32 + 16 * t2, 32), *(const bf16x8*)(LX2 + (16 * jt + fr) * 40 + 8 * fq), ((f32x4){0.f, 0.f, 0.f, 0.f}));
#pragma unroll
            for (int r = 0; r < 4; ++r) DW_(LTinv, 32 + 16 * t2, 16 * jt, r) = f2bf(acc[r]);
        }
        LDS_BARRIER();
        OPAQ();
        if constexpr ((VAR & 64) == 0) {
        {
#pragma unroll
            for (int jj = 0; jj < 2; ++jj) { const int t2 = wc0 + jj; f32x4 p1 = (f32x4){0.f, 0.f, 0.f, 0.f}, p2 = p1;
#pragma unroll
                for (int ks = 0; ks < 2; ++ks) if (ks == 0 || t2 >= 2) { const bf16x8 ft = FR_(LTinv, 16 * t2, 32 * ks);
                    p1 = MFMA16(FR_(B4, 16 * wt, 32 * ks), ft, p1); p2 = MFMA16(FR_(B0, 16 * wt, 32 * ks), ft, p2); }
#pragma unroll
                for (int r = 0; r < 4; ++r) { DW_(B1, 16 * wt, 16 * t2, r) = f2bf(p1[r]); DW_(B2, 16 * wt, 16 * t2, r) = f2bf(p2[r]); } }
        }
        }
        LDS_BARRIER();
        OPAQ();
        if constexpr ((VAR & 128) == 0) {
        {
            bf16_t* gq = C.q1p() + chx * 4096; bf16_t* gm = C.mp() + chx * 4096; bf16_t* gy = C.yid() + chx * 4096; bf16_t* gn = C.nd() + chx * 4096;
#pragma unroll
            for (int jj = 0; jj < 2; ++jj) {
                const int ct2 = wc0 + jj;
                f32x4 q1 = (f32x4){0.f, 0.f, 0.f, 0.f}, mm = q1, yi = q1, nn = q1;
#pragma unroll
                for (int ks = 0; ks < 2; ++ks) {
                    const bf16x8 fp1 = FR_(B1, 16 * wt, 32 * ks);
                    if (ks == 0 || ct2 >= 2) q1 = MFMA16(fp1, FR_(LArb, 16 * ct2, 32 * ks), q1);
                    mm = MFMA16(fp1, FR_(B5, 16 * ct2, 32 * ks), mm);
                    const bf16x8 fp2 = FR_(B2, 16 * ct2, 32 * ks), fv = FR_(B7, 16 * ct2, 32 * ks);
                    if (ks == 0 || wt >= 2) { yi = MFMA16(FR_(LArb, 16 * wt, 32 * ks), fp2, yi); yi = MFMA16(FR_(LArk, 16 * wt, 32 * ks), fv, yi); }
                    nn = MFMA16(FR_(B5, 16 * wt, 32 * ks), fp2, nn); nn = MFMA16(FR_(B6, 16 * wt, 32 * ks), fv, nn);
                }
                {
                    const int t = 16 * ct2 + fr, c0 = 16 * wt + 4 * fq; const u32x2 rv = *(const u32x2*)(B3 + lto + 16 * ct2 * LS + 16 * wt);
                    u32x2 w; w.x = pk2(q1[0] + __uint_as_float(rv.x << 16), q1[1] + __uint_as_float(rv.x & 0xffff0000u)); w.y = pk2(q1[2] + __uint_as_float(rv.y << 16), q1[3] + __uint_as_float(rv.y & 0xffff0000u));
                    *(u32x2*)(B0 + t * LS + permc(c0)) = w;
                    u32x2 w2; w2.x = pk2(mm[0], mm[1]); w2.y = pk2(mm[2], mm[3]); *(u32x2*)(B4 + t * LS + permc(c0)) = w2;
                }
                { u32x2 w; w.x = pk2(yi[0], yi[1]); w.y = pk2(yi[2], yi[3]); if ((VAR & 1) == 0) *(u32x2*)(gy + ((wt * 4 + ct2) * 64 + lane) * 4) = w;
                  u32x2 w2; w2.x = pk2(nn[0], nn[1]); w2.y = pk2(nn[2], nn[3]); if ((VAR & 1) == 0) *(u32x2*)(gn + ((wt * 4 + ct2) * 64 + lane) * 4) = w2; }
            }
        }
        }
        LDS_BARRIER();
        if constexpr ((VAR & 1) == 0 && (VAR & 128) == 0) {
            const int o = (tid >> 3) * LS + (tid & 7) * 8;
            *(u32x4*)(C.q1p() + chx * 4096 + tid * 8) = *(const u32x4*)(B0 + o); *(u32x4*)(C.mp() + chx * 4096 + tid * 8) = *(const u32x4*)(B4 + o);
        }
    }
}
#undef FR_
#undef DW_
#undef OPAQ

constexpr int R2_SLOT = 2 * 64 * 72 * 2 + 2 * 8192 + 256;
struct R2Set { u32x4 q, m, y, n, w; };
__device__ __forceinline__ void r2_issue(const Ctx& C, R2Set& r, size_t chx, int tid) {
    r.q = *(const u32x4*)(C.q1p() + chx * 4096 + tid * 8); r.m = *(const u32x4*)(C.mp() + chx * 4096 + tid * 8);
    r.y = *(const u32x4*)(C.yid() + chx * 4096 + tid * 8); r.n = *(const u32x4*)(C.nd() + chx * 4096 + tid * 8);
    r.w = *(const u32x4*)(C.wl() + chx * 64 + 4 * (tid & 15));
}
__device__ __forceinline__ void r2_put(const R2Set& r, unsigned char* slot, int tid) {
    bf16_t* LQ = (bf16_t*)slot; bf16_t* LM = LQ + 64 * 72; bf16_t* LY = LM + 64 * 72; bf16_t* LN = LY + 4096; float* LW = (float*)(LN + 4096);
    const int o = (tid >> 3) * 72 + (tid & 7) * 8;
    *(u32x4*)(LQ + o) = r.q; *(u32x4*)(LM + o) = r.m; *(u32x4*)(LY + tid * 8) = r.y; *(u32x4*)(LN + tid * 8) = r.n;
    if (tid < 16) *(u32x4*)(LW + 4 * tid) = r.w;
}
__device__ __forceinline__ void r2_step(const Ctx& C, f32x4 (&S)[4], const unsigned char* slot, int b, int h, int vt, int ck, int lane, int fr, int fq) {
    const bf16_t* LQ = (const bf16_t*)slot; const bf16_t* LM = LQ + 64 * 72; const bf16_t* LY = LM + 64 * 72; const bf16_t* LN = LY + 4096; const float* LW = (const float*)(LN + 4096);
    bf16x8 Sb[2];
#pragma unroll
    for (int ks = 0; ks < 2; ++ks) { u32x4 w; w.x = pk2(S[2 * ks][0], S[2 * ks][1]); w.y = pk2(S[2 * ks][2], S[2 * ks][3]); w.z = pk2(S[2 * ks + 1][0], S[2 * ks + 1][1]); w.w = pk2(S[2 * ks + 1][2], S[2 * ks + 1][3]);
        Sb[ks] = __builtin_bit_cast(bf16x8, w); }
    f32x4 Sn[4];
#pragma unroll
    for (int c4 = 0; c4 < 4; ++c4) {
        const u32x2 nv = *(const u32x2*)(LN + ((c4 * 4 + vt) * 64 + lane) * 4); const f32x4 wl = *(const f32x4*)(LW + 16 * c4 + 4 * fq);
        f32x4 acc = (f32x4){__uint_as_float(nv.x << 16), __uint_as_float(nv.x & 0xffff0000u), __uint_as_float(nv.y << 16), __uint_as_float(nv.y & 0xffff0000u)};
        acc = acc + wl * S[c4];
#pragma unroll
        for (int ks = 0; ks < 2; ++ks) acc = MFMA16(*(const bf16x8*)(LM + (16 * c4 + fr) * 72 + 32 * ks + 8 * fq), Sb[ks], acc);
        Sn[c4] = acc;
    }
#pragma unroll
    for (int t4 = 0; t4 < 4; ++t4) {
        const u32x2 yv = *(const u32x2*)(LY + ((t4 * 4 + vt) * 64 + lane) * 4);
        f32x4 acc = (f32x4){__uint_as_float(yv.x << 16), __uint_as_float(yv.x & 0xffff0000u), __uint_as_float(yv.y << 16), __uint_as_float(yv.y & 0xffff0000u)};
#pragma unroll
        for (int ks = 0; ks < 2; ++ks) acc = MFMA16(*(const bf16x8*)(LQ + (16 * t4 + fr) * 72 + 32 * ks + 8 * fq), Sb[ks], acc);
        bf16_t* yo = C.proj() + (size_t)(b * NT + ck * 64 + 16 * t4 + 4 * fq) * NPAD + C_R + h * 64 + 16 * vt + fr;
#pragma unroll
        for (int r = 0; r < 4; ++r) yo[(size_t)r * NPAD] = f2bf(acc[r]);
    }
#pragma unroll
    for (int c4 = 0; c4 < 4; ++c4) S[c4] = Sn[c4];
}
__device__ __forceinline__ void rwkv_r2_wg(const Ctx& C, int b, int h) {
    const int tid = C.tid, lane = C.lane, wid = C.wid, fr = lane & 15, fq = lane >> 4;
    unsigned char* slot0 = C.lds; unsigned char* slot1 = C.lds + R2_SLOT;
    const size_t ch0 = (size_t)((b * 8 + h) * 64);
    f32x4 S[4];
#pragma unroll
    for (int i = 0; i < 4; ++i) S[i] = (f32x4){0.f, 0.f, 0.f, 0.f};
    R2Set r0, r1, r2, r3;
    __syncthreads();
    r2_issue(C, r0, ch0 + 0, tid); r2_issue(C, r1, ch0 + 1, tid); r2_issue(C, r2, ch0 + 2, tid); r2_issue(C, r3, ch0 + 3, tid);
    r2_put(r0, slot0, tid); r2_issue(C, r0, ch0 + 4, tid);
    LDS_BARRIER();
    for (int c = 0; c < NT / 64; c += 4) {
#define R2_ITER(i, rnext, snext, scur) do { const int cc = c + (i); const int cn = (cc + 5 < NT / 64) ? cc + 5 : NT / 64 - 1; \
        r2_put(rnext, snext, tid); r2_issue(C, rnext, ch0 + cn, tid);                  \
        if (wid < 4) r2_step(C, S, scur, b, h, wid, cc, lane, fr, fq); \
        LDS_BARRIER(); } while (0)
        R2_ITER(0, r1, slot1, slot0);
        R2_ITER(1, r2, slot0, slot1);
        R2_ITER(2, r3, slot1, slot0);
        R2_ITER(3, r0, slot0, slot1);
#undef R2_ITER
    }
}
constexpr int C_G = DIN;
__device__ __forceinline__ float* gate_ptr(bf16_t* proj, size_t m, int hm) { return (float*)(proj + m * NPAD + C_G) + 4 * hm; }

__device__ __forceinline__ void mlstm_gate_scan(const Ctx& C, int b, int hm, int ck) {
    const int lane = C.lane;
    const size_t mg = (size_t)(b * NT + ck * 64 + lane); const bf16_t* pr = C.proj() + mg * NPAD;
    const float ig = bf2f(pr[C_I + hm]) + C.b_i()[hm]; const float fp = bf2f(pr[C_F + hm]) + C.b_f()[hm];
    const float lf = (fp >= 0.f) ? -log1pf(expf(-fp)) : fp - log1pf(expf(fp));
    float bc = lf;
#pragma unroll
    for (int o = 1; o < 64; o <<= 1) { const float tv = __shfl_up(bc, o); if (lane >= o) bc += tv; }
    const float e = ig - bc; float pm = e;
#pragma unroll
    for (int o = 1; o < 64; o <<= 1) { const float tv = __shfl_up(pm, o); if (lane >= o) pm = fmaxf(pm, tv); }
    *(f32x4*)gate_ptr(C.proj(), mg, hm) = (f32x4){bc, e, pm, 0.f};
}
__device__ __forceinline__ void mlstm_m1_stream(const Ctx& C) {
    const int lane = C.lane; const bool isk = lane >= 32; const int ch = 16 * (lane & 31);
    const int col = (isk ? C_KM : C_Q) + ch; const int cw = (isk ? 512 : 0) + ch;
    float w[4][16], bias[16];
#pragma unroll
    for (int i = 0; i < 16; i += 4) { const f32x4 bv = *(const f32x4*)(C.conv_b() + cw + i); bias[i] = bv.x; bias[i + 1] = bv.y; bias[i + 2] = bv.z; bias[i + 3] = bv.w;
#pragma unroll
        for (int j = 0; j < 4; ++j) { const f32x4 wv = *(const f32x4*)(C.conv_w() + j * 1024 + cw + i); w[j][i] = wv.x; w[j][i + 1] = wv.y; w[j][i + 2] = wv.z; w[j][i + 3] = wv.w; } }
    const float osc = isk ? 0.08838834764831845f : 1.0f;
    bf16_t* dst = (isk ? C.kc() : C.qc()) + ch;
    for (int t0 = 16 * C.gw; t0 < NTOK; t0 += 16 * C.ngw) {
        const int tb = t0 & (NT - 1);
        u32x4 ring[7][2];
        const bf16_t* p0 = C.proj() + (size_t)t0 * NPAD + col;
#pragma unroll
        for (int k = 0; k < 7; ++k) {
            if (k < 3 && tb == 0) { ring[k][0] = (u32x4){0u, 0u, 0u, 0u}; ring[k][1] = ring[k][0]; }
            else { const bf16_t* p = p0 + (ptrdiff_t)(k - 3) * NPAD; ring[k][0] = *(const u32x4*)p; ring[k][1] = *(const u32x4*)(p + 8); }
        }
#pragma unroll
        for (int i = 0; i < 16; ++i) {
            const size_t m = (size_t)(t0 + i);
            float a[16], x0[16], x1[16], x2[16], x3[16];
            unpack8(ring[i % 7][0], x0); unpack8(ring[i % 7][1], x0 + 8); unpack8(ring[(i + 1) % 7][0], x1); unpack8(ring[(i + 1) % 7][1], x1 + 8);
            unpack8(ring[(i + 2) % 7][0], x2); unpack8(ring[(i + 2) % 7][1], x2 + 8); unpack8(ring[(i + 3) % 7][0], x3); unpack8(ring[(i + 3) % 7][1], x3 + 8);
            { const int rn = (i + 4 < 16) ? i + 4 : 15; const bf16_t* p = p0 + (size_t)rn * NPAD; ring[i % 7][0] = *(const u32x4*)p; ring[i % 7][1] = *(const u32x4*)(p + 8); }
#pragma unroll
            for (int c = 0; c < 16; ++c) { a[c] = bias[c] + w[0][c] * x0[c] + w[1][c] * x1[c] + w[2][c] * x2[c] + w[3][c] * x3[c]; a[c] = siluf_(a[c]) * osc; }
            *(u32x4*)(dst + m * 512) = pack8(a); *(u32x4*)(dst + m * 512 + 8) = pack8(a + 8);
        }
    }
}

__device__ __forceinline__ void mlstm_p0_item(const Ctx& C, int b, int hm, int ck) {
    const int lane = C.lane, fr = lane & 15, fq = lane >> 4;
    {
        const int it = (b << 8) | (ck << 2) | hm; const size_t m0 = (size_t)(b * NT + ck * 64);
        bf16_t* out = C.p0s() + (size_t)it * 4096;
        bf16x8 kf[4][4]; float es[4][4];
#pragma unroll
        for (int sj = 0; sj < 4; ++sj) {
#pragma unroll
            for (int ks = 0; ks < 4; ++ks) kf[sj][ks] = *(const bf16x8*)(C.kc() + (m0 + 16 * sj + fr) * 512 + hm * 128 + 32 * ks + 8 * fq);
#pragma unroll
            for (int r = 0; r < 4; ++r) es[sj][r] = gate_ptr(C.proj(), m0 + 16 * sj + 4 * fq + r, hm)[1]; }
#pragma unroll
        for (int ti = 0; ti < 4; ++ti) {
            bf16x8 qf[4];
#pragma unroll
            for (int ks = 0; ks < 4; ++ks) qf[ks] = *(const bf16x8*)(C.qc() + (m0 + 16 * ti + fr) * 512 + hm * 128 + 32 * ks + 8 * fq);
            const int t = 16 * ti + fr; const float pmt = gate_ptr(C.proj(), m0 + t, hm)[2];
#pragma unroll
            for (int sj = 0; sj < 4; ++sj) {
                f32x4 acc = (f32x4){0.f, 0.f, 0.f, 0.f};
                if (sj <= ti) {
#pragma unroll
                    for (int ks = 0; ks < 4; ++ks) acc = __builtin_amdgcn_mfma_f32_16x16x32_bf16(kf[sj][ks], qf[ks], acc, 0, 0, 0);
                }
                float o[4];
#pragma unroll
                for (int r = 0; r < 4; ++r) { const int s = 16 * sj + 4 * fq + r; o[r] = (sj <= ti && s <= t) ? acc[r] * fexp(es[sj][r] - pmt) : 0.f; }
                u32x2 w; w.x = pk2(o[0], o[1]); w.y = pk2(o[2], o[3]); *(u32x2*)(out + t * 64 + 16 * sj + 4 * fq) = w;
            }
        }
    }
}

#define LDS_WAIT_ALL() asm volatile("s_waitcnt lgkmcnt(0)" ::: "memory")
constexpr int VS = 52;
constexpr int ML_BUF = (2 * 64 * 136 + 2 * 64 * VS + 64 * 72) * 2 + 1280;
template <int VAR> __device__ __forceinline__ void mlstm_item(const Ctx& C, int b, int hm, int sl) {
    constexpr bool st_out = (VAR & 1) == 0;
    unsigned char* buf0 = C.lds; unsigned char* buf1 = C.lds + ML_BUF;
    bf16_t* LCb0 = (bf16_t*)(C.lds + 2 * ML_BUF); bf16_t* LCb1 = LCb0 + 48 * 136;
#define ML_Q(bf) ((bf16_t*)(bf))
#define ML_K(bf) (ML_Q(bf) + 64 * 136)
#define ML_V(bf) (ML_K(bf) + 64 * 136)
#define ML_WV(bf) (ML_V(bf) + 64 * VS)
#define ML_P(bf) (ML_WV(bf) + 64 * VS)
#define ML_F(bf) ((float*)(ML_P(bf) + 64 * 72))
    const int tid = C.tid, lane = C.lane, wid = C.wid;
    const int fr_ = lane & 15, fq_ = lane >> 4, tt_ = tid >> 3;
    __syncthreads();
    for (int e = tid; e < 2 * 48 * 136; e += NTHR) LCb0[e] = 0;
    for (int e = tid; e < 64 * VS; e += NTHR) { const bf16_t o = ((e % VS) == 32) ? (bf16_t)0x3f80 : (bf16_t)0; ML_V(buf0)[e] = o; ML_V(buf1)[e] = o; ML_WV(buf0)[e] = 0; ML_WV(buf1)[e] = 0; }
    for (int e = tid; e < 64 * 72; e += NTHR) { ML_P(buf0)[e] = 0; ML_P(buf1)[e] = 0; }
    const int cg8 = tid & 7, d0 = 16 * cg8;
    const int ti = wid >> 1, vtw = wid & 1;
    const int ct0_t = (wid < 4) ? ((wid == 0) ? 0 : (wid == 3 ? 2 : 1)) : ((wid == 4) ? 2 : 3), ct0_s = (wid < 4) ? ((wid == 2) ? 1 : 0) : ((wid == 4) ? 1 : wid - 5);
    const int ct1_t = (wid == 0) ? 2 : 3, ct1_s = (wid == 0) ? 2 : 3; const bool has2 = wid < 2;
    f32x4 Cst[3];
#pragma unroll
    for (int i = 0; i < 3; ++i) Cst[i] = (f32x4){0.f, 0.f, 0.f, 0.f};
    float mst = 0.f, carry_cur = 1.f, carry_nxt = 1.f;
    u32x4 pq0, pq1, pk0, pk1, pp; u32x2 pv; f32x4 pg, pgl; u32x4 pq0_b, pq1_b, pk0_b, pk1_b, pp_b; u32x2 pv_b; f32x4 pg_b, pgl_b;
    const bf16_t* p0base = C.p0s() + (size_t)(((b * 64) * 4 + hm)) * 4096 + tid * 8;
    {
        const size_t m = (size_t)(b * NT + tt_);
        const bf16_t* qs = C.qc() + m * 512 + hm * 128 + d0; const bf16_t* ks = C.kc() + m * 512 + hm * 128 + d0;
        pq0 = *(const u32x4*)qs; pq1 = *(const u32x4*)(qs + 8); pk0 = *(const u32x4*)ks; pk1 = *(const u32x4*)(ks + 8);
        pv = *(const u32x2*)(C.proj() + m * NPAD + C_VM + hm * 128 + sl * 32 + 4 * cg8);
        pg = *(const f32x4*)gate_ptr(C.proj(), m, hm); pgl = *(const f32x4*)gate_ptr(C.proj(), (size_t)(b * NT + 63), hm); pp = *(const u32x4*)p0base;
        const size_t m2 = m + 64; qs += 64 * 512; ks += 64 * 512;
        pq0_b = *(const u32x4*)qs; pq1_b = *(const u32x4*)(qs + 8); pk0_b = *(const u32x4*)ks; pk1_b = *(const u32x4*)(ks + 8);
        pv_b = *(const u32x2*)(C.proj() + m2 * NPAD + C_VM + hm * 128 + sl * 32 + 4 * cg8);
        pg_b = *(const f32x4*)gate_ptr(C.proj(), m2, hm); pgl_b = *(const f32x4*)gate_ptr(C.proj(), (size_t)(b * NT + 127), hm); pp_b = *(const u32x4*)(p0base + 4 * 4096);
    }
    __syncthreads();
    { const int kst = 0; const int fr = fr_, fq = fq_, tt = tt_;
        asm volatile("" :: "v"(pg.w), "v"(pgl.y), "v"(pgl.w));
        {
            const float mxl = fmaxf(mst, pgl.z); carry_nxt = fexp(mst - mxl);
            if constexpr ((VAR & 16) == 0) {
                const float ws = fexp(pg.y - mxl);
                *(u32x4*)(ML_Q(buf0) + tt * 136 + d0) = pq0; *(u32x4*)(ML_Q(buf0) + tt * 136 + d0 + 8) = pq1;
                *(u32x4*)(ML_K(buf0) + tt * 136 + d0) = pk0; *(u32x4*)(ML_K(buf0) + tt * 136 + d0 + 8) = pk1;
                const float v0 = __uint_as_float(pv.x << 16), v1 = __uint_as_float(pv.x & 0xffff0000u), v2 = __uint_as_float(pv.y << 16), v3 = __uint_as_float(pv.y & 0xffff0000u);
                *(u32x2*)(ML_V(buf0) + tt * VS + 4 * cg8) = pv; *(u32x4*)(ML_P(buf0) + tt * 72 + 8 * cg8) = pp;
                u32x2 wv; wv.x = pk2(v0 * ws, v1 * ws); wv.y = pk2(v2 * ws, v3 * ws); *(u32x2*)(ML_WV(buf0) + tt * VS + 4 * cg8) = wv;
                if (cg8 == 0) { ML_WV(buf0)[tt * VS + 32] = f2bf(ws); const float mx = fmaxf(mst, pg.z); float* F = ML_F(buf0); F[tt] = pg.y; F[64 + tt] = mx; F[128 + tt] = fexp(mst - mx); F[192 + tt] = fexp(-(pg.x + mx)); F[256 + tt] = fexp(pg.z - mx); }
            }
            mst = pgl.x + mxl;
            const int cn = (kst + 2 < NT / 64) ? kst + 2 : NT / 64 - 1;
            const size_t m = (size_t)(b * NT + cn * 64 + tt);
            const bf16_t* qs = C.qc() + m * 512 + hm * 128 + d0; const bf16_t* ks = C.kc() + m * 512 + hm * 128 + d0;
            pq0 = *(const u32x4*)qs; pq1 = *(const u32x4*)(qs + 8); pk0 = *(const u32x4*)ks; pk1 = *(const u32x4*)(ks + 8);
            pv = *(const u32x2*)(C.proj() + m * NPAD + C_VM + hm * 128 + sl * 32 + 4 * cg8);
            pg = *(const f32x4*)gate_ptr(C.proj(), m, hm); pgl = *(const f32x4*)gate_ptr(C.proj(), (size_t)(b * NT + cn * 64 + 63), hm); pp = *(const u32x4*)(p0base + (size_t)cn * 4 * 4096);
        }
    }
    carry_cur = carry_nxt;
    LDS_BARRIER();
    { const int kc = 0; const int fr = fr_, fq = fq_;
    }
    for (int ck2 = 0; ck2 < NT / 64; ck2 += 2) {
      { const int ck = ck2;
        int fr = fr_, fq = fq_, tt = tt_; asm volatile("" : "+v"(fr), "+v"(fq), "+v"(tt));
        { const int kst = ck + 1;
        asm volatile("" :: "v"(pg_b.w), "v"(pgl_b.y), "v"(pgl_b.w));
        {
            const float mxl = fmaxf(mst, pgl_b.z); carry_nxt = fexp(mst - mxl);
            if constexpr ((VAR & 16) == 0) {
                const float ws = fexp(pg_b.y - mxl);
                *(u32x4*)(ML_Q(buf1) + tt * 136 + d0) = pq0_b; *(u32x4*)(ML_Q(buf1) + tt * 136 + d0 + 8) = pq1_b;
                *(u32x4*)(ML_K(buf1) + tt * 136 + d0) = pk0_b; *(u32x4*)(ML_K(buf1) + tt * 136 + d0 + 8) = pk1_b;
                const float v0 = __uint_as_float(pv_b.x << 16), v1 = __uint_as_float(pv_b.x & 0xffff0000u), v2 = __uint_as_float(pv_b.y << 16), v3 = __uint_as_float(pv_b.y & 0xffff0000u);
                *(u32x2*)(ML_V(buf1) + tt * VS + 4 * cg8) = pv_b; *(u32x4*)(ML_P(buf1) + tt * 72 + 8 * cg8) = pp_b;
                u32x2 wv; wv.x = pk2(v0 * ws, v1 * ws); wv.y = pk2(v2 * ws, v3 * ws); *(u32x2*)(ML_WV(buf1) + tt * VS + 4 * cg8) = wv;
                if (cg8 == 0) { ML_WV(buf1)[tt * VS + 32] = f2bf(ws); const float mx = fmaxf(mst, pg_b.z); float* F = ML_F(buf1); F[tt] = pg_b.y; F[64 + tt] = mx; F[128 + tt] = fexp(mst - mx); F[192 + tt] = fexp(-(pg_b.x + mx)); F[256 + tt] = fexp(pg_b.z - mx); }
            }
            mst = pgl_b.x + mxl;
            const int cn = (kst + 2 < NT / 64) ? kst + 2 : NT / 64 - 1;
            const size_t m = (size_t)(b * NT + cn * 64 + tt);
            const bf16_t* qs = C.qc() + m * 512 + hm * 128 + d0; const bf16_t* ks = C.kc() + m * 512 + hm * 128 + d0;
            pq0_b = *(const u32x4*)qs; pq1_b = *(const u32x4*)(qs + 8); pk0_b = *(const u32x4*)ks; pk1_b = *(const u32x4*)(ks + 8);
            pv_b = *(const u32x2*)(C.proj() + m * NPAD + C_VM + hm * 128 + sl * 32 + 4 * cg8);
            pg_b = *(const f32x4*)gate_ptr(C.proj(), m, hm); pgl_b = *(const f32x4*)gate_ptr(C.proj(), (size_t)(b * NT + cn * 64 + 63), hm); pp_b = *(const u32x4*)(p0base + (size_t)cn * 4 * 4096);
        }
        }
        LDS_BARRIER();
        { const int kc = ck + 1;
        }
        {
            const int mbase = b * NT + ck * 64;
            const bf16_t* LQ = ML_Q(buf0); const bf16_t* LK = ML_K(buf0); const bf16_t* LV = ML_V(buf0); const bf16_t* LWV = ML_WV(buf0); const bf16_t* LP = ML_P(buf0); const float* F = ML_F(buf0);
            const bf16_t* LCr = LCb0; bf16_t* LCw = LCb1;
            bf16x8 fp[2], fvr[2], fvd[2], fqq[4], fcr[4], fcd[4], kf[2], fw[3][2]; float inr[4], clr[4], rsr[4];
#pragma unroll
            for (int ks = 0; ks < 2; ++ks) { fp[ks] = *(const bf16x8*)(LP + (16 * ti + fr) * 72 + 32 * ks + 8 * fq); fvr[ks] = tr_frag(LV, VS, 32 * ks, 16 * vtw, fr, fq); fvd[ks] = tr_frag(LV, VS, 32 * ks, 32, fr, fq); }
#pragma unroll
            for (int ks = 0; ks < 4; ++ks) { fqq[ks] = *(const bf16x8*)(LQ + (16 * ti + fr) * 136 + 32 * ks + 8 * fq); fcr[ks] = *(const bf16x8*)(LCr + (16 * vtw + fr) * 136 + 32 * ks + 8 * fq); fcd[ks] = *(const bf16x8*)(LCr + (32 + fr) * 136 + 32 * ks + 8 * fq); }
#pragma unroll
            for (int ks = 0; ks < 2; ++ks) { kf[ks] = tr_frag(LK, 136, 32 * ks, 16 * wid, fr, fq);
#pragma unroll
                for (int vt2 = 0; vt2 < 3; ++vt2) fw[vt2][ks] = tr_frag(LWV, VS, 32 * ks, 16 * vt2, fr, fq); }
#pragma unroll
            for (int r = 0; r < 4; ++r) { inr[r] = F[128 + 16 * ti + 4 * fq + r]; clr[r] = F[192 + 16 * ti + 4 * fq + r]; rsr[r] = F[256 + 16 * ti + 4 * fq + r]; }
            LDS_WAIT_ALL();
            f32x4 numr = (f32x4){0.f, 0.f, 0.f, 0.f}, numd = numr;
            if constexpr ((VAR & 4) == 0) {
                f32x4 a1r = (f32x4){0.f, 0.f, 0.f, 0.f}, a1d = a1r, a2r = a1r, a2d = a1r;
#pragma unroll
                for (int ks = 0; ks < 2; ++ks) { a1r = __builtin_amdgcn_mfma_f32_16x16x32_bf16(fp[ks], fvr[ks], a1r, 0, 0, 0); a1d = __builtin_amdgcn_mfma_f32_16x16x32_bf16(fp[ks], fvd[ks], a1d, 0, 0, 0); }
#pragma unroll
                for (int ks = 0; ks < 4; ++ks) { a2r = __builtin_amdgcn_mfma_f32_16x16x32_bf16(fqq[ks], fcr[ks], a2r, 0, 0, 0); a2d = __builtin_amdgcn_mfma_f32_16x16x32_bf16(fqq[ks], fcd[ks], a2d, 0, 0, 0); }
#pragma unroll
                for (int r = 0; r < 4; ++r) { numr[r] = rsr[r] * a1r[r] + inr[r] * a2r[r]; numd[r] = rsr[r] * a1d[r] + inr[r] * a2d[r]; }
            }
            if constexpr ((VAR & 8) == 0) {
#pragma unroll
                for (int vt2 = 0; vt2 < 3; ++vt2) {
                    f32x4 acc = Cst[vt2] * carry_cur;
#pragma unroll
                    for (int ks = 0; ks < 2; ++ks) acc = __builtin_amdgcn_mfma_f32_16x16x32_bf16(fw[vt2][ks], kf[ks], acc, 0, 0, 0);
                    Cst[vt2] = acc;
#pragma unroll
                    for (int r = 0; r < 4; ++r) LCw[(16 * vt2 + 4 * fq + r) * 136 + 16 * wid + fr] = f2bf(acc[r]);
                }
            }
#pragma unroll
            for (int r = 0; r < 4; ++r) { const int t = 16 * ti + 4 * fq + r;
                const float den = __shfl(numd[r], lane & 48);
                const float dv = fmaxf(fabsf(den), clr[r]);
                if (st_out) C.proj()[(size_t)(mbase + t) * NPAD + C_VM + hm * 128 + sl * 32 + 16 * vtw + fr] = f2bf(numr[r] * frcp(dv)); }
        }
        carry_cur = carry_nxt;
        LDS_BARRIER();
      }
      { const int ck = ck2 + 1;
        int fr = fr_, fq = fq_, tt = tt_; asm volatile("" : "+v"(fr), "+v"(fq), "+v"(tt));
        { const int kst = ck + 1;
        asm volatile("" :: "v"(pg.w), "v"(pgl.y), "v"(pgl.w));
        {
            const float mxl = fmaxf(mst, pgl.z); carry_nxt = fexp(mst - mxl);
            if constexpr ((VAR & 16) == 0) {
                const float ws = fexp(pg.y - mxl);
                *(u32x4*)(ML_Q(buf0) + tt * 136 + d0) = pq0; *(u32x4*)(ML_Q(buf0) + tt * 136 + d0 + 8) = pq1;
                *(u32x4*)(ML_K(buf0) + tt * 136 + d0) = pk0; *(u32x4*)(ML_K(buf0) + tt * 136 + d0 + 8) = pk1;
                const float v0 = __uint_as_float(pv.x << 16), v1 = __uint_as_float(pv.x & 0xffff0000u), v2 = __uint_as_float(pv.y << 16), v3 = __uint_as_float(pv.y & 0xffff0000u);
                *(u32x2*)(ML_V(buf0) + tt * VS + 4 * cg8) = pv; *(u32x4*)(ML_P(buf0) + tt * 72 + 8 * cg8) = pp;
                u32x2 wv; wv.x = pk2(v0 * ws, v1 * ws); wv.y = pk2(v2 * ws, v3 * ws); *(u32x2*)(ML_WV(buf0) + tt * VS + 4 * cg8) = wv;
                if (cg8 == 0) { ML_WV(buf0)[tt * VS + 32] = f2bf(ws); const float mx = fmaxf(mst, pg.z); float* F = ML_F(buf0); F[tt] = pg.y; F[64 + tt] = mx; F[128 + tt] = fexp(mst - mx); F[192 + tt] = fexp(-(pg.x + mx)); F[256 + tt] = fexp(pg.z - mx); }
            }
            mst = pgl.x + mxl;
            const int cn = (kst + 2 < NT / 64) ? kst + 2 : NT / 64 - 1;
            const size_t m = (size_t)(b * NT + cn * 64 + tt);
            const bf16_t* qs = C.qc() + m * 512 + hm * 128 + d0; const bf16_t* ks = C.kc() + m * 512 + hm * 128 + d0;
            pq0 = *(const u32x4*)qs; pq1 = *(const u32x4*)(qs + 8); pk0 = *(const u32x4*)ks; pk1 = *(const u32x4*)(ks + 8);
            pv = *(const u32x2*)(C.proj() + m * NPAD + C_VM + hm * 128 + sl * 32 + 4 * cg8);
            pg = *(const f32x4*)gate_ptr(C.proj(), m, hm); pgl = *(const f32x4*)gate_ptr(C.proj(), (size_t)(b * NT + cn * 64 + 63), hm); pp = *(const u32x4*)(p0base + (size_t)cn * 4 * 4096);
        }
        }
        LDS_BARRIER();
        { const int kc = ck + 1;
        }
        {
            const int mbase = b * NT + ck * 64;
            const bf16_t* LQ = ML_Q(buf1); const bf16_t* LK = ML_K(buf1); const bf16_t* LV = ML_V(buf1); const bf16_t* LWV = ML_WV(buf1); const bf16_t* LP = ML_P(buf1); const float* F = ML_F(buf1);
            const bf16_t* LCr = LCb1; bf16_t* LCw = LCb0;
            bf16x8 fp[2], fvr[2], fvd[2], fqq[4], fcr[4], fcd[4], kf[2], fw[3][2]; float inr[4], clr[4], rsr[4];
#pragma unroll
            for (int ks = 0; ks < 2; ++ks) { fp[ks] = *(const bf16x8*)(LP + (16 * ti + fr) * 72 + 32 * ks + 8 * fq); fvr[ks] = tr_frag(LV, VS, 32 * ks, 16 * vtw, fr, fq); fvd[ks] = tr_frag(LV, VS, 32 * ks, 32, fr, fq); }
#pragma unroll
            for (int ks = 0; ks < 4; ++ks) { fqq[ks] = *(const bf16x8*)(LQ + (16 * ti + fr) * 136 + 32 * ks + 8 * fq); fcr[ks] = *(const bf16x8*)(LCr + (16 * vtw + fr) * 136 + 32 * ks + 8 * fq); fcd[ks] = *(const bf16x8*)(LCr + (32 + fr) * 136 + 32 * ks + 8 * fq); }
#pragma unroll
            for (int ks = 0; ks < 2; ++ks) { kf[ks] = tr_frag(LK, 136, 32 * ks, 16 * wid, fr, fq);
#pragma unroll
                for (int vt2 = 0; vt2 < 3; ++vt2) fw[vt2][ks] = tr_frag(LWV, VS, 32 * ks, 16 * vt2, fr, fq); }
#pragma unroll
            for (int r = 0; r < 4; ++r) { inr[r] = F[128 + 16 * ti + 4 * fq + r]; clr[r] = F[192 + 16 * ti + 4 * fq + r]; rsr[r] = F[256 + 16 * ti + 4 * fq + r]; }
            LDS_WAIT_ALL();
            f32x4 numr = (f32x4){0.f, 0.f, 0.f, 0.f}, numd = numr;
            if constexpr ((VAR & 4) == 0) {
                f32x4 a1r = (f32x4){0.f, 0.f, 0.f, 0.f}, a1d = a1r, a2r = a1r, a2d = a1r;
#pragma unroll
                for (int ks = 0; ks < 2; ++ks) { a1r = __builtin_amdgcn_mfma_f32_16x16x32_bf16(fp[ks], fvr[ks], a1r, 0, 0, 0); a1d = __builtin_amdgcn_mfma_f32_16x16x32_bf16(fp[ks], fvd[ks], a1d, 0, 0, 0); }
#pragma unroll
                for (int ks = 0; ks < 4; ++ks) { a2r = __builtin_amdgcn_mfma_f32_16x16x32_bf16(fqq[ks], fcr[ks], a2r, 0, 0, 0); a2d = __builtin_amdgcn_mfma_f32_16x16x32_bf16(fqq[ks], fcd[ks], a2d, 0, 0, 0); }
#pragma unroll
                for (int r = 0; r < 4; ++r) { numr[r] = rsr[r] * a1r[r] + inr[r] * a2r[r]; numd[r] = rsr[r] * a1d[r] + inr[r] * a2d[r]; }
            }
            if constexpr ((VAR & 8) == 0) {
#pragma unroll
                for (int vt2 = 0; vt2 < 3; ++vt2) {
                    f32x4 acc = Cst[vt2] * carry_cur;
#pragma unroll
                    for (int ks = 0; ks < 2; ++ks) acc = __builtin_amdgcn_mfma_f32_16x16x32_bf16(fw[vt2][ks], kf[ks], acc, 0, 0, 0);
                    Cst[vt2] = acc;
#pragma unroll
                    for (int r = 0; r < 4; ++r) LCw[(16 * vt2 + 4 * fq + r) * 136 + 16 * wid + fr] = f2bf(acc[r]);
                }
            }
#pragma unroll
            for (int r = 0; r < 4; ++r) { const int t = 16 * ti + 4 * fq + r;
                const float den = __shfl(numd[r], lane & 48);
                const float dv = fmaxf(fabsf(den), clr[r]);
                if (st_out) C.proj()[(size_t)(mbase + t) * NPAD + C_VM + hm * 128 + sl * 32 + 16 * vtw + fr] = f2bf(numr[r] * frcp(dv)); }
        }
        carry_cur = carry_nxt;
        LDS_BARRIER();
      }
    }
#undef ML_Q
#undef ML_K
#undef ML_V
#undef ML_WV
#undef ML_P
#undef ML_F
}
__device__ __forceinline__ void phase3(const Ctx& C, int sub) {
    const int g = blockIdx.x;
    if (sub == 0 || sub == 1) {
        mlstm_m1_stream(C);
        asm volatile("s_waitcnt vmcnt(0)" ::: "memory"); __syncthreads();
        const int bb = g >> 5, ck = 2 * (g & 31) + (C.wid >> 2), hm = C.wid & 3;
        mlstm_gate_scan(C, bb, hm, ck);
        asm volatile("s_waitcnt vmcnt(0)" ::: "memory");
        mlstm_p0_item(C, bb, hm, ck);
    }
    if (sub >= 3) rwkv_r1_wg<(PROBE_SUB >= 3 ? PROBE_SUB : 0) | 1>(C, g >> 5, (g >> 2) & 7, (g & 3) * 16, 16); else if (sub != 1) rwkv_r1_wg<0>(C, g >> 5, (g >> 2) & 7, (g & 3) * 16, 16);
}
__device__ __forceinline__ void phase4(const Ctx& C, int sub) {
    for (int item = blockIdx.x; item < 256; item += gridDim.x) {
        if (item < 64) { if (sub != 2 && sub != 3) rwkv_r2_wg(C, item >> 3, item & 7); }
        else if (item < 128) { }
        else { const int i = item - 128; if (sub == 3) mlstm_item<PROBE_SUB | 1>(C, i >> 4, (i >> 2) & 3, i & 3); else if (sub != 1) mlstm_item<0>(C, i >> 4, (i >> 2) & 3, i & 3); }
        __syncthreads();
    }
}

__device__ __forceinline__ void ld8f(const float* p, float* o) { const f32x4 a = *(const f32x4*)p, b = *(const f32x4*)(p + 4); o[0] = a.x; o[1] = a.y; o[2] = a.z; o[3] = a.w; o[4] = b.x; o[5] = b.y; o[6] = b.z; o[7] = b.w; }
__device__ __forceinline__ void phase5(const Ctx& C) {
    const int lane = C.lane; const int c0 = 8 * lane;
    float muv[8], gnw[8], gnb[8], lnw[8], skp[8];
    ld8f(C.mu() + C_V + c0, muv); ld8f(C.gn_w() + c0, gnw); ld8f(C.gn_b() + c0, gnb); ld8f(C.ln_w() + c0, lnw); ld8f(C.skip() + c0, skp);
    for (int m = C.gw; m < NTOK; m += C.ngw) {
        const bool hp = (m & (NT - 1)) != 0;
        const bf16_t* pc = C.proj() + (size_t)m * NPAD; bf16_t* yo = C.ymix() + (size_t)m * DM;
        float outr[8], outm[8];
        {
            float y[8], v[8], pv[8], z[8];
            unpack8(*(const u32x4*)(pc + C_R + c0), y);
            unpack8(*(const u32x4*)(pc + C_V + c0), v); unpack8(*(const u32x4*)(pc + C_ZR + c0), z);
            unpack8(*(const u32x4*)((m > 0 ? pc - NPAD : pc) + C_V + c0), pv);
            if (!hp) {
#pragma unroll
                for (int i = 0; i < 8; ++i) { pv[i] = 0.f; } }
            float s = 0.f; const float bs = C.bonus()[(size_t)m * 8 + (lane >> 3)];
#pragma unroll
            for (int i = 0; i < 8; ++i) { v[i] += muv[i] * (pv[i] - v[i]); s += y[i]; }
            s += __shfl_xor(s, 1); s += __shfl_xor(s, 2); s += __shfl_xor(s, 4);
            const float mean = s * (1.0f / 64.0f); float q = 0.f;
#pragma unroll
            for (int i = 0; i < 8; ++i) { y[i] -= mean; q += y[i] * y[i]; }
            q += __shfl_xor(q, 1); q += __shfl_xor(q, 2); q += __shfl_xor(q, 4);
            const float rstd = __builtin_amdgcn_rsqf(q * (1.0f / 64.0f) + 64e-5f);
#pragma unroll
            for (int i = 0; i < 8; ++i) { const float yn = y[i] * rstd * gnw[i] + gnb[i]; outr[i] = (yn + bs * v[i]) * siluf_(z[i]); }
        }
        {
            float h[8], o[8], z[8], qc[8];
            unpack8(*(const u32x4*)(pc + C_VM + c0), h);
            unpack8(*(const u32x4*)(pc + C_O + c0), o); unpack8(*(const u32x4*)(pc + C_ZM + c0), z); unpack8(*(const u32x4*)(C.qc() + (size_t)m * 512 + c0), qc);
            float s = 0.f;
#pragma unroll
            for (int i = 0; i < 8; ++i) s += h[i];
            s += __shfl_xor(s, 1); s += __shfl_xor(s, 2); s += __shfl_xor(s, 4); s += __shfl_xor(s, 8);
            const float mean = s * (1.0f / 128.0f); float q = 0.f;
#pragma unroll
            for (int i = 0; i < 8; ++i) { h[i] -= mean; q += h[i] * h[i]; }
            q += __shfl_xor(q, 1); q += __shfl_xor(q, 2); q += __shfl_xor(q, 4); q += __shfl_xor(q, 8);
            const float rstd = __builtin_amdgcn_rsqf(q * (1.0f / 128.0f) + 1e-6f);
#pragma unroll
            for (int i = 0; i < 8; ++i) { const float hn = h[i] * rstd * lnw[i]; outm[i] = (sigmoidf_(o[i]) * hn + skp[i] * qc[i]) * siluf_(z[i]); }
        }
        *(u32x4*)(yo + c0) = pack8(outr);
        *(u32x4*)(yo + 512 + c0) = pack8(outm);
    }
}

struct RowIn { f32x4 x[4]; u32x4 mx[2]; };
__device__ __forceinline__ void p7_load(const Ctx& C, RowIn& r, int m) {
    const f32x4* xr = (const f32x4*)(C.x() + (size_t)m * DM) + C.lane;
#pragma unroll
    for (int j = 0; j < 4; ++j) r.x[j] = __builtin_nontemporal_load(xr + 64 * j);
    const u32x2* mr = (const u32x2*)(C.mixo() + (size_t)m * DM) + C.lane;
    const u32x2 a0 = __builtin_nontemporal_load(mr), a1 = __builtin_nontemporal_load(mr + 64), a2 = __builtin_nontemporal_load(mr + 128), a3 = __builtin_nontemporal_load(mr + 192);
    r.mx[0] = (u32x4){a0.x, a0.y, a1.x, a1.y}; r.mx[1] = (u32x4){a2.x, a2.y, a3.x, a3.y};
}
template <int VAR> __device__ __forceinline__ void phase7(const Ctx& C) {
    f32x4 g[4];
#pragma unroll
    for (int j = 0; j < 4; ++j) g[j] = *(const f32x4*)(C.fgain() + 4 * C.lane + 256 * j);
    RowIn cur, nx1; p7_load(C, cur, C.gw); p7_load(C, nx1, C.gw + C.ngw);
    if constexpr ((VAR & 2) != 0) { asm volatile("" : "+v"(cur.x[0]), "+v"(nx1.x[0])); }
    f32x4 gtv[4]; int bcur = -1;
    for (int m = C.gw; m < NTOK; m += C.ngw) {
        const int b = m >> 12; const int mn = (m + 2 * C.ngw < NTOK) ? m + 2 * C.ngw : m;
        if (b != bcur) { bcur = b;
#pragma unroll
            for (int j = 0; j < 4; ++j) gtv[j] = *(const f32x4*)(C.ada() + b * 3072 + 2048 + 4 * C.lane + 256 * j); }
        RowIn nxt; if constexpr ((VAR & 2) == 0) p7_load(C, nxt, mn); else nxt = nx1;
        f32x4 h[4]; float s = 0.f;
#pragma unroll
        for (int j = 0; j < 4; ++j) {
            const f32x4 gt = gtv[j];
            const unsigned w0 = (j & 1) ? cur.mx[j >> 1].z : cur.mx[j >> 1].x, w1 = (j & 1) ? cur.mx[j >> 1].w : cur.mx[j >> 1].y;
            const f32x4 mv = (f32x4){__uint_as_float(w0 << 16), __uint_as_float(w0 & 0xffff0000u), __uint_as_float(w1 << 16), __uint_as_float(w1 & 0xffff0000u)};
            h[j] = cur.x[j] + gt * mv; s += (h[j].x * h[j].x + h[j].y * h[j].y) + (h[j].z * h[j].z + h[j].w * h[j].w); }
        const float rs = __builtin_amdgcn_rsqf(wave_sum(s) * (1.0f / DM) + 1e-6f);
        f32x4* o = (f32x4*)(C.out() + (size_t)m * DM) + C.lane;
#pragma unroll
        for (int j = 0; j < 4; ++j) { if constexpr ((VAR & 1) == 0) __builtin_nontemporal_store(h[j] * rs * g[j], o + 64 * j); else asm volatile("" :: "v"(h[j] * rs * g[j])); }
        cur = nx1; nx1 = nxt;
    }
}

#define LAS __attribute__((address_space(3)))
#define XB_TMO      128
#define XB_XCNT(j)  (256  + 64 * (j))
#define XB_XSUB(j)  (1280 + 64 * (j))
#define XB_XGEN(j)  (2304 + 64 * (j))
#define XB_TOP      3328
#define XB_TOPGEN   3392
#define XCD_BAR_WORDS 3456
#define XB_SPIN_CAP (1u << 18)

__device__ __forceinline__ unsigned xb_ld(unsigned* p)              { return __hip_atomic_load(p, __ATOMIC_RELAXED, __HIP_MEMORY_SCOPE_AGENT); }
__device__ __forceinline__ unsigned xb_add(unsigned* p, unsigned v) { return __hip_atomic_fetch_add(p, v, __ATOMIC_RELAXED, __HIP_MEMORY_SCOPE_AGENT); }
__device__ __forceinline__ unsigned xb_xcc_id() { return (unsigned)__builtin_amdgcn_s_getreg((3 << 11) | 20) & 0xFu; }
#define XB_SPIN(cond, bar) do { unsigned _sp = 0; while (cond) { __builtin_amdgcn_s_sleep(1); \
    if ((++_sp & 255u) == 0u) { if (xb_ld(&(bar)[XB_TMO])) break; if (_sp > XB_SPIN_CAP) { atomicAdd(&(bar)[XB_TMO], 1u); break; } } } } while (0)

struct XcdBarrier {
    unsigned* bar; unsigned x;
    volatile LAS unsigned* st;
};

__device__ __forceinline__ XcdBarrier xcd_barrier_post(unsigned* bar, volatile LAS unsigned* st) {
    XcdBarrier b; b.bar = bar; b.x = xb_xcc_id(); b.st = st;
    if (threadIdx.x == 0) (void)xb_add(&bar[XB_XCNT(b.x)], 1u);
    return b;
}
__device__ __forceinline__ void xcd_barrier_complete(unsigned* bar, unsigned x, unsigned& nloc, unsigned& nx) {
    const unsigned G = gridDim.x * gridDim.y * gridDim.z;
    unsigned sum, cnt, mine, sp = 0u;
    for (;;) {
        sum = 0u; cnt = 0u; mine = 0u;
#pragma unroll
        for (unsigned j = 0; j < 16; ++j) { const unsigned c = xb_ld(&bar[XB_XCNT(j)]); sum += c; cnt += (c > 0u) ? 1u : 0u; mine = (j == x) ? c : mine; }
        if (sum == G) break;
        __builtin_amdgcn_s_sleep(1);
        if ((++sp & 255u) == 0u) { if (xb_ld(&bar[XB_TMO])) break; if (sp > XB_SPIN_CAP) { atomicAdd(&bar[XB_TMO], 1u); break; } }
    }
    nloc = mine > 0u ? mine : 1u; nx = cnt > 0u ? cnt : 1u;
}

__device__ __forceinline__ void xcd_barrier(const XcdBarrier& b) {
    asm volatile("s_waitcnt vmcnt(0)" ::: "memory");
    __syncthreads();
    if (threadIdx.x == 0) {
        unsigned* bar = b.bar;
        __builtin_amdgcn_s_waitcnt(0);
        unsigned nloc = b.st[0], nx = b.st[1];
        if (nloc == 0u) { xcd_barrier_complete(bar, b.x, nloc, nx); b.st[0] = nloc; b.st[1] = nx; }
        const unsigned old = xb_add(&bar[XB_XSUB(b.x)], 1u);
        const unsigned gen = old / nloc;
        if (old + 1u == (gen + 1u) * nloc) {
            __builtin_amdgcn_fence(__ATOMIC_RELEASE, "agent");
            asm volatile("s_waitcnt vmcnt(0)" ::: "memory");
            const unsigned og = xb_add(&bar[XB_TOP], 1u);
            const unsigned tg = og / nx;
            if (og + 1u == (tg + 1u) * nx) xb_add(&bar[XB_TOPGEN], 1u);
            else XB_SPIN(xb_ld(&bar[XB_TOPGEN]) == tg, bar);
            __builtin_amdgcn_fence(__ATOMIC_ACQUIRE, "agent");
            xb_add(&bar[XB_XGEN(b.x)], 1u);
            asm volatile("s_waitcnt vmcnt(0)" ::: "memory");
        } else {
            XB_SPIN(xb_ld(&bar[XB_XGEN(b.x)]) == gen, bar);
            __builtin_amdgcn_fence(__ATOMIC_ACQUIRE, "agent");
            asm volatile("s_waitcnt vmcnt(0)" ::: "memory");
        }
    }
    __syncthreads();
}

#ifndef PROBE_REP
#define PROBE_REP -1
#endif
#ifndef PROBE_SUB
#define PROBE_SUB 0
#endif
__global__ void __launch_bounds__(NTHR, 2) fwd_kernel(Params p) {
    extern __shared__ __attribute__((aligned(16))) unsigned char lds_raw[];
    cg::grid_group grid = cg::this_grid();
    Ctx C{p};
    C.lds = lds_raw; C.tid = threadIdx.x; C.lane = C.tid & 63; C.wid = __builtin_amdgcn_readfirstlane(C.tid >> 6);
    C.gw = blockIdx.x * NWV + C.wid; C.ngw = gridDim.x * NWV;
    const int lo = p.ph_lo, hi = p.ph_hi;
    unsigned* barw = (unsigned*)(p.ws + WS_CTL);
    volatile LAS unsigned* bst = (volatile LAS unsigned*)((LAS unsigned char*)lds_raw + LDS_BYTES - 16);
    if (threadIdx.x < 4) bst[threadIdx.x] = 0u;
    if (blockIdx.x == 0) for (int e = threadIdx.x; e < XCD_BAR_WORDS; e += NTHR) barw[e] = 0u;
    XcdBarrier xbar; xbar.bar = barw; xbar.x = 0; xbar.st = bst;
#define RUN(k) (lo <= (k) && (k) < hi)
#define GSYNC() xcd_barrier(xbar)
#define SEAM(k) do { if (RUN(k) && RUN((k) + 1)) GSYNC(); } while (0)
    if (RUN(0)) phase0(C);
    if (RUN(0) && RUN(1)) { grid.sync(); xbar = xcd_barrier_post(barw, bst); }
#if PROBE_REP == 8
    GSYNC(); GSYNC(); GSYNC(); GSYNC(); GSYNC(); GSYNC(); GSYNC(); GSYNC();
#endif
    if (RUN(1)) { phase1(C); weight_copies(C); }
#if PROBE_REP == 1
    GSYNC(); phase0(C); GSYNC(); phase1(C); weight_copies(C);
#endif
    SEAM(1);
    if (RUN(2)) {
        pg8::Gemm g{C.hn(), C.win_t(), NTOK, NPAD, DM}; pg8::StaticOrder S; S.init(NTOK, NPAD, (int)gridDim.x, (int)blockIdx.x);
        pg8::EpiBf16<0> E{C.proj(), NPAD, nullptr, 0, 0};
        pg8::gemm_phase<pg8::EpiBf16<0>, pg8::StaticOrder, false>((PG8_LAS unsigned char*)lds_raw, g, S, E, nullptr);
#if PROBE_REP == 2
        GSYNC(); pg8::gemm_phase<pg8::EpiBf16<0>, pg8::StaticOrder, false>((PG8_LAS unsigned char*)lds_raw, g, S, E, nullptr);
#endif
    }
    SEAM(2);
    if (RUN(3)) phase3(C, 0);
#if PROBE_REP == 3
    GSYNC(); phase3(C, PROBE_SUB);
#endif
    SEAM(3);
#if PROBE_REP == 6
    phase4(C, 3); GSYNC();
#endif
    if (RUN(4)) phase4(C, 0);
#if PROBE_REP == 4
    GSYNC(); phase4(C, PROBE_SUB);
#endif
    SEAM(4);
    if (RUN(5)) phase5(C);
#if PROBE_REP == 5
    GSYNC(); phase5(C);
#endif
    SEAM(5);
    if (RUN(6)) {
        pg8::Gemm g{C.ymix(), C.wout_t(), NTOK, DM, DM}; pg8::StaticOrder S; S.init(NTOK, DM, (int)gridDim.x, (int)blockIdx.x);
        pg8::EpiBf16<0> E{C.mixo(), DM, nullptr, 0, 0};
        pg8::gemm_phase<pg8::EpiBf16<0>, pg8::StaticOrder, false>((PG8_LAS unsigned char*)lds_raw, g, S, E, nullptr);
#if PROBE_REP == 7
        GSYNC(); pg8::gemm_phase<pg8::EpiBf16<0>, pg8::StaticOrder, false>((PG8_LAS unsigned char*)lds_raw, g, S, E, nullptr);
#endif
    }
    SEAM(6);
#if PROBE_REP == 9
    phase7<PROBE_SUB>(C); GSYNC();
#endif
    if (RUN(7)) phase7<0>(C);
#undef RUN
#undef SEAM
}

#ifndef N_LAUNCHES
#define N_LAUNCHES 1
#endif
extern "C" void kernel_launch(void* const* d_in, const int* in_sizes, int n_in, void* d_out, int out_size, void* d_ws, size_t ws_size, hipStream_t stream) {
    static int grid = 0;
    if (grid == 0) {
        if (n_in != 24 || out_size != NTOK * DM || ws_size < WS_END) { fprintf(stderr, "kernel_launch: unexpected shapes (n_in %d, out %d, ws %zu < %zu)\n", n_in, out_size, ws_size, (size_t)WS_END); grid = -1; return; }
        int dev = 0, cus = 0, per_cu = 0;
        hipGetDevice(&dev); hipDeviceGetAttribute(&cus, hipDeviceAttributeMultiprocessorCount, dev);
        if (hipFuncSetAttribute((const void*)fwd_kernel, hipFuncAttributeMaxDynamicSharedMemorySize, LDS_BYTES) != hipSuccess) { fprintf(stderr, "kernel_launch: hipFuncSetAttribute failed\n"); grid = -1; return; }
        if (hipOccupancyMaxActiveBlocksPerMultiprocessor(&per_cu, (const void*)fwd_kernel, NTHR, LDS_BYTES) != hipSuccess || per_cu < 1) { fprintf(stderr, "kernel_launch: occupancy query says %d\n", per_cu); per_cu = 1; }
        (void)hipGetLastError();
        if (cus < 256) { fprintf(stderr, "kernel_launch: this build needs 256 CUs (got %d)\n", cus); grid = -1; return; }
        grid = 256;
        fprintf(stderr, "kernel_launch: grid %d, per_cu %d\n", grid, per_cu);
    }
    if (grid < 0) return;
    Params p{};
    for (int i = 0; i < 24; ++i) p.in[i] = (const float*)d_in[i];
    p.out = (float*)d_out; p.ws = (unsigned char*)d_ws;
    if (N_LAUNCHES == 1) {
        p.ph_lo = 0; p.ph_hi = NPHASE; void* args[] = {&p};
        hipError_t e = hipLaunchCooperativeKernel((const void*)fwd_kernel, dim3(grid), dim3(NTHR), args, LDS_BYTES, stream);
        if (e != hipSuccess) fprintf(stderr, "cooperative launch failed: %s (grid %d)\n", hipGetErrorString(e), grid);
    } else {
        for (int ph = 0; ph < NPHASE; ++ph) { p.ph_lo = ph; p.ph_hi = ph + 1; hipLaunchKernelGGL(fwd_kernel, dim3(grid), dim3(NTHR), LDS_BYTES, stream, p); }
    }
}
```

```cpp
#include <hip/hip_runtime.h>
#include <hip/hip_cooperative_groups.h>
#include <cstdio>
#define PROBE_REP -1
#define PROBE_SUB 0
namespace pg8 {
#define PG8_LAS __attribute__((address_space(3)))
typedef unsigned short bf16_t;
typedef short bf16x8 __attribute__((ext_vector_type(8)));
typedef float f32x4 __attribute__((ext_vector_type(4)));
typedef unsigned u32x4 __attribute__((ext_vector_type(4)));
constexpr int BM = 256, BK = 64, HALF = 128, HTB = HALF * BK * 2  , STAGE_BYTES = 8 * HTB, NXCD = 8, WGM = 8;

__host__ __device__ __forceinline__ int lds_byte(int r, int c) { const int st = (r >> 4) * 2 + (c >> 5), rr = r & 15, cc = c & 31, ob = rr * 64 + cc * 2; return st * 1024 + (ob ^ (((ob >> 9) & 1) << 5)); }
__host__ __device__ __forceinline__ void stage_rc(int b, int& R, int& C) { const int st = b / 1024, sb = b % 1024, swz = sb ^ (((sb >> 9) & 1) << 5); R = (st >> 1) * 16 + swz / 64; C = (st & 1) * 32 + (swz % 64) / 2; }
__host__ __device__ __forceinline__ int perm32(int rho) { const int n = rho >> 4, i = rho & 15; return 8 * (i >> 2) + 4 * n + (i & 3); }

struct Unit { int pm, pn; };
struct Gemm { const bf16_t* A; const bf16_t* Bt; int M, N, K; };

struct StaticOrder {
    int nM, nN, nwg, G, c;
    __host__ __device__ void init(int M, int N, int G_, int c_) { nM = M / BM; nN = N / BM; nwg = nM * nN; G = G_; c = c_; }
    __host__ __device__ bool next(int i, Unit& u) const {
        const long L = (long)i * G + c; if (L >= nwg) return false;
        int wgid = (int)L; { const int q = nwg / NXCD, r = nwg % NXCD, xcd = wgid % NXCD, off = wgid / NXCD; wgid = (xcd < r ? xcd * (q + 1) : r * (q + 1) + (xcd - r) * q) + off; }
        const int nig = WGM * nN, gid = wgid / nig, fm = gid * WGM, gsz = (nM - fm) < WGM ? (nM - fm) : WGM;
        u.pm = fm + ((wgid % nig) % gsz); u.pn = (wgid % nig) / gsz; return true;
    }
    __device__ __forceinline__ void a_ready(const Unit&) const {}
    __device__ __forceinline__ void done(const Unit&) const {}
};
struct CountedOrder : StaticOrder {
    const unsigned* ready; unsigned need; unsigned* tmo;
    __device__ __forceinline__ void a_ready(const Unit& u) const {
        if (threadIdx.x < 64) {
            const unsigned long long t0 = __builtin_amdgcn_s_memrealtime(); unsigned polls = 0;
            while ((unsigned)__builtin_amdgcn_readfirstlane(__hip_atomic_load(ready + 64 * u.pm, __ATOMIC_RELAXED, __HIP_MEMORY_SCOPE_AGENT)) < need) {
                if ((++polls & 255u) == 0u && __builtin_amdgcn_readfirstlane(__hip_atomic_load(tmo, __ATOMIC_RELAXED, __HIP_MEMORY_SCOPE_AGENT)) != 0u) break;
                if (__builtin_amdgcn_s_memrealtime() - t0 > 2000000ull) {
                    if (threadIdx.x == 0) { unsigned expect = 0u; __hip_atomic_compare_exchange_strong(tmo + 1, &expect, 0x600u | (unsigned)(u.pm & 0xff), __ATOMIC_RELAXED, __ATOMIC_RELAXED, __HIP_MEMORY_SCOPE_AGENT); __hip_atomic_store(tmo, 1u, __ATOMIC_RELAXED, __HIP_MEMORY_SCOPE_AGENT); }
                    break; }
                __builtin_amdgcn_s_sleep(2); }
            __builtin_amdgcn_fence(__ATOMIC_ACQUIRE, "agent");
            asm volatile("s_waitcnt vmcnt(0)" ::: "memory");
        }
#if !defined(BROKEN_HOOK_NO_BARRIER)
        asm volatile("" ::: "memory"); __builtin_amdgcn_s_barrier(); asm volatile("" ::: "memory");
#endif
    }
};

__device__ __forceinline__ unsigned cvt_pk_bf16(float lo, float hi) { unsigned r; asm volatile("v_cvt_pk_bf16_f32 %0, %1, %2" : "=v"(r) : "v"(lo), "v"(hi)); return r; }
typedef float f32x2 __attribute__((ext_vector_type(2)));
__device__ __forceinline__ f32x2 gelu_pk(f32x2 v) {
    const f32x2 av = __builtin_elementwise_abs(v), d = av * 0.2316418882f + 1.0f;
    f32x2 t; t.x = __builtin_amdgcn_rcpf(d.x); t.y = __builtin_amdgcn_rcpf(d.y);
    f32x2 q = t * 0.5307027145f + (-0.7265760135f); q = q * t + 0.7107068705f; q = q * t + (-0.142248368f); q = q * t + 0.127414796f; q = q * t;
    const f32x2 s = (v * v) * (-0.72134752044f);
    f32x2 e; e.x = __builtin_amdgcn_exp2f(s.x); e.y = __builtin_amdgcn_exp2f(s.y);
    const f32x2 m = v * (q * e), r = v - m;
    f32x2 o; o.x = v.x < 0.f ? m.x : r.x; o.y = v.y < 0.f ? m.y : r.y; return o;
}

struct EpiF32 {
    static constexpr bool PERM = false, AFTER_DRAIN = false;
    float* C; int ldc; const float* bias;
    __device__ __forceinline__ void operator()(const f32x4 (&acc)[2][2][4][2], const Unit& u, int wr, int wc, int fr, int fq) const {
        const int row0 = u.pm * BM + wr * 64 + fr, col0 = u.pn * BM + wc * 32 + 4 * fq;
        f32x4 bv[2][2];
#pragma unroll
        for (int bj = 0; bj < 2; ++bj)
#pragma unroll
            for (int n = 0; n < 2; ++n) bv[bj][n] = bias ? *(const f32x4*)(bias + col0 + bj * HALF + n * 16) : (f32x4){0.f, 0.f, 0.f, 0.f};
#pragma unroll
        for (int ai = 0; ai < 2; ++ai)
#pragma unroll
            for (int m = 0; m < 4; ++m) { float* rowp = C + (size_t)(row0 + ai * HALF + m * 16) * ldc + col0;
#pragma unroll
                for (int bj = 0; bj < 2; ++bj)
#pragma unroll
                    for (int n = 0; n < 2; ++n) *(f32x4*)(rowp + bj * HALF + n * 16) = acc[ai][bj][m][n] + bv[bj][n]; }
    }
};
template <int ACT  > struct EpiBf16 {
    static constexpr bool PERM = true, AFTER_DRAIN = false;
    bf16_t* O; int ldc; const float* bias; int split_cols; size_t split_stride;
    __device__ __forceinline__ void operator()(const f32x4 (&acc)[2][2][4][2], const Unit& u, int wr, int wc, int fr, int fq) const {
        const int row0 = u.pm * BM + wr * 64 + fr; int colt = u.pn * BM; bf16_t* base = O;
        if (split_cols) { const int t = colt / split_cols; base += (size_t)t * split_stride; colt -= t * split_cols; }
        const int col0 = colt + wc * 32 + 8 * fq, bcol0 = u.pn * BM + wc * 32 + 8 * fq;
        f32x4 bv[2][2];
#pragma unroll
        for (int bj = 0; bj < 2; ++bj)
#pragma unroll
            for (int n = 0; n < 2; ++n) bv[bj][n] = bias ? *(const f32x4*)(bias + bcol0 + bj * HALF + 4 * n) : (f32x4){0.f, 0.f, 0.f, 0.f};
#pragma unroll
        for (int ai = 0; ai < 2; ++ai)
#pragma unroll
            for (int m = 0; m < 4; ++m) { bf16_t* rowp = base + (size_t)(row0 + ai * HALF + m * 16) * ldc + col0;
#pragma unroll
                for (int bj = 0; bj < 2; ++bj) { f32x4 v0 = acc[ai][bj][m][0] + bv[bj][0], v1 = acc[ai][bj][m][1] + bv[bj][1];
                    if (ACT == 1) { f32x2 a = gelu_pk((f32x2){v0[0], v0[1]}), b = gelu_pk((f32x2){v0[2], v0[3]}), c = gelu_pk((f32x2){v1[0], v1[1]}), d = gelu_pk((f32x2){v1[2], v1[3]});
                        v0 = (f32x4){a.x, a.y, b.x, b.y}; v1 = (f32x4){c.x, c.y, d.x, d.y}; }
                    if (ACT == 2) {
#pragma unroll
                        for (int j = 0; j < 4; ++j) { v0[j] = 0.5f * v0[j] * (1.0f + erff(v0[j] * 0.70710678f)); v1[j] = 0.5f * v1[j] * (1.0f + erff(v1[j] * 0.70710678f)); } }
                    u32x4 w; w.x = cvt_pk_bf16(v0[0], v0[1]); w.y = cvt_pk_bf16(v0[2], v0[3]); w.z = cvt_pk_bf16(v1[0], v1[1]); w.w = cvt_pk_bf16(v1[2], v1[3]);
                    *(u32x4*)(rowp + bj * HALF) = w; } }
    }
};

struct PanelStats {
    unsigned* xbuf;
    unsigned* cnt;
    unsigned* tmo;
    int ntn; float eps;
    unsigned code;
    __device__ __forceinline__ bool run(const f32x4 (&v)[2][2][4][2], const Unit& u, int wr, int wc, int fr, int fq, PG8_LAS unsigned char* lds, int wid, int lane) const {
        typedef float f32x2v __attribute__((ext_vector_type(2)));
        PG8_LAS f32x2v* P = (PG8_LAS f32x2v*)lds;
        PG8_LAS f32x2v* S = (PG8_LAS f32x2v*)(lds + 8192);
        PG8_LAS unsigned* flag = (PG8_LAS unsigned*)(lds + 8192 + 2048);
#pragma unroll
        for (int ai = 0; ai < 2; ++ai)
#pragma unroll
            for (int m = 0; m < 4; ++m) {
                float s = 0.f;
#pragma unroll
                for (int bj = 0; bj < 2; ++bj)
#pragma unroll
                    for (int n = 0; n < 2; ++n) { const f32x4 x = v[ai][bj][m][n]; s += (x[0] + x[1]) + (x[2] + x[3]); }
                s += __shfl_xor(s, 16); s += __shfl_xor(s, 32);
                const float mw = s * (1.0f / 64.0f); float q = 0.f;
#pragma unroll
                for (int bj = 0; bj < 2; ++bj)
#pragma unroll
                    for (int n = 0; n < 2; ++n) { const f32x4 d = v[ai][bj][m][n] - mw; q += (d[0] * d[0] + d[1] * d[1]) + (d[2] * d[2] + d[3] * d[3]); }
                q += __shfl_xor(q, 16); q += __shfl_xor(q, 32);
                if (fq == 0) P[(ai * HALF + wr * 64 + m * 16 + fr) * 4 + wc] = (f32x2v){mw, q};
            }
        asm volatile("s_waitcnt lgkmcnt(0)" ::: "memory"); __builtin_amdgcn_s_barrier(); asm volatile("" ::: "memory");
#if defined(BROKEN_NO_WAIT)
        if (blockIdx.x >= 64) { const long long t0 = clock64(); while (clock64() - t0 < 60000) __builtin_amdgcn_s_sleep(8); }
#endif
        const int row = wid * 32 + (lane & 31);
        if (lane < 32) {
            const f32x2v a = P[row * 4 + 0], b = P[row * 4 + 1], c = P[row * 4 + 2], d = P[row * 4 + 3];
            const float mt = (a.x + b.x + c.x + d.x) * 0.25f;
            const float da = a.x - mt, db = b.x - mt, dc = c.x - mt, dd = d.x - mt;
            const float m2 = (a.y + b.y) + (c.y + d.y) + 64.0f * ((da * da + db * db) + (dc * dc + dd * dd));
            unsigned long long* slot = (unsigned long long*)xbuf + ((size_t)(u.pm * BM + row) * 4 + u.pn);
            __hip_atomic_store(slot, ((unsigned long long)__float_as_uint(m2) << 32) | __float_as_uint(mt), __ATOMIC_RELAXED, __HIP_MEMORY_SCOPE_AGENT);
        }
        asm volatile("s_waitcnt vmcnt(0)" ::: "memory");
        if (lane == 0) __hip_atomic_fetch_add(cnt + 64 * u.pm, 1u, __ATOMIC_RELAXED, __HIP_MEMORY_SCOPE_AGENT);
        if (wid == 0) {
            bool dead = false; const unsigned long long t0 = __builtin_amdgcn_s_memrealtime(); const unsigned want = 8u * (unsigned)ntn;
            for (;;) {
#if defined(BROKEN_NO_WAIT)
                break;
#endif
                if ((unsigned)__builtin_amdgcn_readfirstlane(__hip_atomic_load(cnt + 64 * u.pm, __ATOMIC_RELAXED, __HIP_MEMORY_SCOPE_AGENT)) >= want) break;
                if (__builtin_amdgcn_s_memrealtime() - t0 > 2000000ull) {
                    if (lane == 0) { unsigned expect = 0u; __hip_atomic_compare_exchange_strong(tmo + 1, &expect, code | (unsigned)(u.pm & 0xff), __ATOMIC_RELAXED, __ATOMIC_RELAXED, __HIP_MEMORY_SCOPE_AGENT);
                                     __hip_atomic_store(tmo, 1u, __ATOMIC_RELAXED, __HIP_MEMORY_SCOPE_AGENT); }
                    dead = true; break; }
                __builtin_amdgcn_s_sleep(2);
            }
            __builtin_amdgcn_fence(__ATOMIC_ACQUIRE, "agent");
            if (lane == 0) flag[0] = dead ? 1u : 0u;
        }
        asm volatile("s_waitcnt vmcnt(0) lgkmcnt(0)" ::: "memory"); __builtin_amdgcn_s_barrier(); asm volatile("" ::: "memory");
        const bool bad = flag[0] != 0u;
        if (lane < 32) {
            const unsigned long long* slot = (const unsigned long long*)xbuf + (size_t)(u.pm * BM + row) * 4; float mt[4], m2[4]; float ms = 0.f;
#pragma unroll
            for (int t = 0; t < 4; ++t) { if (t < ntn) { const unsigned long long w = __hip_atomic_load(slot + t, __ATOMIC_RELAXED, __HIP_MEMORY_SCOPE_AGENT); mt[t] = __uint_as_float((unsigned)w); m2[t] = __uint_as_float((unsigned)(w >> 32)); } else { mt[t] = 0.f; m2[t] = 0.f; } ms += mt[t]; }
            const float mean = ms / (float)ntn; float q = 0.f;
#pragma unroll
            for (int t = 0; t < 4; ++t) if (t < ntn) { const float dm = mt[t] - mean; q += m2[t] + 256.0f * dm * dm; }
            S[row] = (f32x2v){mean, 1.0f / sqrtf(q / (256.0f * (float)ntn) + eps)};
        }
        asm volatile("s_waitcnt lgkmcnt(0)" ::: "memory"); __builtin_amdgcn_s_barrier(); asm volatile("" ::: "memory");
        return bad;
    }
};
struct EpiLnRes {
    static constexpr bool PERM = false, AFTER_DRAIN = true;
    const float* base; float* out; int ldc; const float* bias; PanelStats st; unsigned poison;
    __device__ __forceinline__ void refuse(size_t i0, size_t stride, int M, int N) const { const float q = __builtin_nanf(""); for (size_t i = i0; i < (size_t)M * N; i += stride) out[(i / N) * ldc + i % N] = q;
        if (i0 == 0) { unsigned expect = 0u; __hip_atomic_compare_exchange_strong(st.tmo + 1, &expect, 0x7f0u, __ATOMIC_RELAXED, __ATOMIC_RELAXED, __HIP_MEMORY_SCOPE_AGENT); __hip_atomic_store(st.tmo, 1u, __ATOMIC_RELAXED, __HIP_MEMORY_SCOPE_AGENT); } }
    __device__ __forceinline__ void fused(f32x4 (&acc)[2][2][4][2], const Unit& u, int wr, int wc, int fr, int fq, PG8_LAS unsigned char* lds, int wid, int lane) const {
        typedef float f32x2v __attribute__((ext_vector_type(2)));
        const PG8_LAS f32x2v* S = (const PG8_LAS f32x2v*)(lds + 8192);
        const int col0 = u.pn * BM + wc * 32 + 4 * fq;
#pragma unroll
        for (int bj = 0; bj < 2; ++bj)
#pragma unroll
            for (int n = 0; n < 2; ++n) { const f32x4 bv = bias ? *(const f32x4*)(bias + col0 + bj * HALF + n * 16) : (f32x4){0.f, 0.f, 0.f, 0.f};
#pragma unroll
                for (int ai = 0; ai < 2; ++ai)
#pragma unroll
                    for (int m = 0; m < 4; ++m) acc[ai][bj][m][n] += bv; }
        const bool bad = st.run(acc, u, wr, wc, fr, fq, lds, wid, lane) || poison != 0u;
        const float qnan = __builtin_nanf("");
#pragma unroll
        for (int ai = 0; ai < 2; ++ai)
#pragma unroll
            for (int m = 0; m < 4; ++m) { const int r = ai * HALF + wr * 64 + m * 16 + fr; const f32x2v sr = S[r]; const size_t off = (size_t)(u.pm * BM + r) * ldc + col0;
#pragma unroll
                for (int bj = 0; bj < 2; ++bj)
#pragma unroll
                    for (int n = 0; n < 2; ++n) { const f32x4 bs = *(const f32x4*)(base + off + bj * HALF + n * 16); f32x4 o = bs + (acc[ai][bj][m][n] - sr.x) * sr.y;
                        if (bad) o = (f32x4){qnan, qnan, qnan, qnan}; *(f32x4*)(out + off + bj * HALF + n * 16) = o; }
                asm volatile("" ::: "memory"); }
    }
};
struct EpiLnResLn {
    static constexpr bool PERM = false, AFTER_DRAIN = true;
    const float* base; float* out; bf16_t* xn; int ldc; const float* bias; PanelStats st1, st2; unsigned poison;
    __device__ __forceinline__ void refuse(size_t i0, size_t stride, int M, int N) const { const float q = __builtin_nanf(""); for (size_t i = i0; i < (size_t)M * N; i += stride) { const size_t o = (i / N) * ldc + i % N; out[o] = q; xn[o] = (bf16_t)0x7fc0u; }
        if (i0 == 0) { unsigned expect = 0u; __hip_atomic_compare_exchange_strong(st1.tmo + 1, &expect, 0x7f0u, __ATOMIC_RELAXED, __ATOMIC_RELAXED, __HIP_MEMORY_SCOPE_AGENT); __hip_atomic_store(st1.tmo, 1u, __ATOMIC_RELAXED, __HIP_MEMORY_SCOPE_AGENT); } }
    __device__ __forceinline__ void fused(f32x4 (&acc)[2][2][4][2], const Unit& u, int wr, int wc, int fr, int fq, PG8_LAS unsigned char* lds, int wid, int lane) const {
        typedef float f32x2v __attribute__((ext_vector_type(2))); typedef unsigned u32x2v __attribute__((ext_vector_type(2)));
        const PG8_LAS f32x2v* S = (const PG8_LAS f32x2v*)(lds + 8192);
        const int col0 = u.pn * BM + wc * 32 + 4 * fq;
#pragma unroll
        for (int bj = 0; bj < 2; ++bj)
#pragma unroll
            for (int n = 0; n < 2; ++n) { const f32x4 bv = bias ? *(const f32x4*)(bias + col0 + bj * HALF + n * 16) : (f32x4){0.f, 0.f, 0.f, 0.f};
#pragma unroll
                for (int ai = 0; ai < 2; ++ai)
#pragma unroll
                    for (int m = 0; m < 4; ++m) acc[ai][bj][m][n] += bv; }
        bool bad = st1.run(acc, u, wr, wc, fr, fq, lds, wid, lane) || poison != 0u;
        const float qnan = __builtin_nanf("");
#pragma unroll
        for (int ai = 0; ai < 2; ++ai)
#pragma unroll
            for (int m = 0; m < 4; ++m) { const int r = ai * HALF + wr * 64 + m * 16 + fr; const f32x2v sr = S[r]; const size_t off = (size_t)(u.pm * BM + r) * ldc + col0;
#pragma unroll
                for (int bj = 0; bj < 2; ++bj)
#pragma unroll
                    for (int n = 0; n < 2; ++n) { const f32x4 bs = *(const f32x4*)(base + off + bj * HALF + n * 16); acc[ai][bj][m][n] = bs + (acc[ai][bj][m][n] - sr.x) * sr.y; }
                asm volatile("" : "+v"(acc[ai][0][m][0]), "+v"(acc[ai][0][m][1]), "+v"(acc[ai][1][m][0]), "+v"(acc[ai][1][m][1]));
                if (m & 1) asm volatile("" ::: "memory"); }
        const bool bad1 = bad;
        bad = st2.run(acc, u, wr, wc, fr, fq, lds, wid, lane) || bad;
#pragma unroll
        for (int ai = 0; ai < 2; ++ai)
#pragma unroll
            for (int m = 0; m < 4; ++m) { const int r = ai * HALF + wr * 64 + m * 16 + fr; const f32x2v sr = S[r]; const size_t off = (size_t)(u.pm * BM + r) * ldc + col0;
#pragma unroll
                for (int bj = 0; bj < 2; ++bj)
#pragma unroll
                    for (int n = 0; n < 2; ++n) { const f32x4 x1 = acc[ai][bj][m][n]; *(f32x4*)(out + off + bj * HALF + n * 16) = bad1 ? (f32x4){qnan, qnan, qnan, qnan} : x1;
                        const f32x4 o = (x1 - sr.x) * sr.y; u32x2v w; w.x = cvt_pk_bf16(o[0], o[1]); w.y = cvt_pk_bf16(o[2], o[3]);
                        if (bad) { w.x = 0x7fc07fc0u; w.y = 0x7fc07fc0u; } *(u32x2v*)(xn + off + bj * HALF + n * 16) = w; }
                asm volatile("" ::: "memory"); }
    }
};

template <class Epi, class Sched, bool STAMP = false>
__device__ __forceinline__ void gemm_phase(PG8_LAS unsigned char* lds, const Gemm g, const Sched& S, const Epi& E, unsigned long long* stamps) {
    const int tid = threadIdx.x, wid = __builtin_amdgcn_readfirstlane(tid >> 6), lane = tid & 63, wr = wid >> 2, wc = wid & 3, fr = lane & 15, fq = lane >> 4;
    const int K = g.K, nt = K / BK;
    int ts_lo = 0, ts_hi = 0, nts = 0; const unsigned long long rt_entry = STAMP ? (unsigned long long)wall_clock64() : 0ull;
#define PG8_STAMP() do { if (STAMP && wid == 0 && nts < 64) { const unsigned long long _c = (unsigned long long)clock64(); \
        ts_lo = (lane == nts) ? (int)(unsigned)_c : ts_lo; ts_hi = (lane == nts) ? (int)(unsigned)(_c >> 32) : ts_hi; ++nts; } } while (0)
    PG8_STAMP();
    unsigned voffA[2], voffB[2];
#pragma unroll
    for (int i = 0; i < 2; ++i) { int R, C; stage_rc(tid * 16 + i * 8192, R, C); const int Rb = Epi::PERM ? ((R & ~31) + perm32(R & 31)) : R;
        voffA[i] = (unsigned)(R * K + C) * 2u; voffB[i] = (unsigned)(Rb * K + C) * 2u; }
    const size_t kstep = (size_t)(BK * 2);
    const size_t hstep = (size_t)HALF * K * 2;
    const size_t tstep = 2 * hstep;
    const unsigned ldsw = (unsigned)wid * 1024u;
    const int aoff = lds_byte(wr * 64 + fr, fq * 8), boff = lds_byte(wc * 32 + fr, fq * 8);
#define PG8_SA(b, h) (((b) * 2 + (h)) * HTB)
#define PG8_SB(b, h) ((4 + (b) * 2 + (h)) * HTB)
#define PG8_STAGE(bufoff, gbase, voff) do { _Pragma("unroll") for (int _i = 0; _i < 2; ++_i) \
        __builtin_amdgcn_global_load_lds((const unsigned*)((const char*)(gbase) + (voff)[_i]), (PG8_LAS unsigned*)(lds + (bufoff) + ldsw + _i * 8192), 16, 0, 0); } while (0)
#define PG8_LDA(dst, b, h) do { _Pragma("unroll") for (int m = 0; m < 4; ++m) _Pragma("unroll") for (int k = 0; k < 2; ++k) dst[m][k] = *(const PG8_LAS bf16x8*)(lds + PG8_SA(b, h) + aoff + m * 2048 + k * 1024); } while (0)
#define PG8_LDB(dst, b, h) do { _Pragma("unroll") for (int n = 0; n < 2; ++n) _Pragma("unroll") for (int k = 0; k < 2; ++k) dst[n][k] = *(const PG8_LAS bf16x8*)(lds + PG8_SB(b, h) + boff + n * 2048 + k * 1024); } while (0)
#define PG8_MMA(ai, bj, At, Bt) do { __builtin_amdgcn_s_setprio(1); _Pragma("unroll") for (int m = 0; m < 4; ++m) _Pragma("unroll") for (int n = 0; n < 2; ++n) _Pragma("unroll") for (int k = 0; k < 2; ++k) \
        acc[ai][bj][m][n] = __builtin_amdgcn_mfma_f32_16x16x32_bf16(Bt[n][k], At[m][k], acc[ai][bj][m][n], 0, 0, 0); __builtin_amdgcn_s_setprio(0); } while (0)
#define PG8_WAIT_V(n) asm volatile("s_waitcnt vmcnt(" #n ")" ::: "memory")
#define PG8_WAIT_L(n) asm volatile("s_waitcnt lgkmcnt(" #n ")" ::: "memory")
#define PG8_BAR __builtin_amdgcn_s_barrier()
#define PG8_SCHED __builtin_amdgcn_sched_barrier(0)
    Unit cur, nxt; int ui = 0;
    if (!S.next(0, cur)) return;
    f32x4 acc[2][2][4][2];
#pragma unroll
    for (int a = 0; a < 2; ++a)
#pragma unroll
        for (int b = 0; b < 2; ++b)
#pragma unroll
            for (int m = 0; m < 4; ++m)
#pragma unroll
                for (int n = 0; n < 2; ++n) acc[a][b][m][n] = (f32x4){0.f, 0.f, 0.f, 0.f};
    bf16x8 At[4][2], B0[2][2], B1[2][2];
    const char* cA = (const char*)g.A + (size_t)cur.pm * tstep; const char* cB = (const char*)g.Bt + (size_t)cur.pn * tstep;
    S.a_ready(cur);
    PG8_STAGE(PG8_SB(0, 0), cB, voffB); PG8_STAGE(PG8_SA(0, 0), cA, voffA); PG8_STAGE(PG8_SB(0, 1), cB + hstep, voffB); PG8_STAGE(PG8_SA(0, 1), cA + hstep, voffA);
    if (wr == 1) PG8_BAR;
    PG8_WAIT_V(4); PG8_BAR;
    PG8_STAGE(PG8_SB(1, 0), cB + kstep, voffB); PG8_STAGE(PG8_SA(1, 0), cA + kstep, voffA); PG8_STAGE(PG8_SB(1, 1), cB + hstep + kstep, voffB);
    PG8_WAIT_V(6); PG8_BAR;
    PG8_STAMP();
    for (;;) {
        const bool has_next = S.next(ui + 1, nxt);
        const char* nA = has_next ? (const char*)g.A + (size_t)nxt.pm * tstep : cA; const char* nB = has_next ? (const char*)g.Bt + (size_t)nxt.pn * tstep : cB;
        for (int t = 0; t < nt; t += 2) {
            const bool last = (t == nt - 2);
            const char* a1 = cA + (size_t)(t + 1) * kstep;
            const char* a2 = last ? nA : cA + (size_t)(t + 2) * kstep; const char* b2 = last ? nB : cB + (size_t)(t + 2) * kstep;
            const char* a3 = a2 + kstep; const char* b3 = b2 + kstep;
            if (last && has_next) S.a_ready(nxt);
            PG8_LDB(B0, 0, 0); PG8_SCHED; PG8_LDA(At, 0, 0); PG8_STAGE(PG8_SA(1, 1), a1 + hstep, voffA);
            PG8_WAIT_L(8); PG8_BAR; PG8_WAIT_L(0); PG8_MMA(0, 0, At, B0); PG8_BAR; PG8_SCHED;
            PG8_LDB(B1, 0, 1); PG8_STAGE(PG8_SB(0, 0), b2, voffB);
            PG8_BAR; PG8_WAIT_L(0); PG8_MMA(0, 1, At, B1); PG8_BAR;
            PG8_LDA(At, 0, 1); PG8_STAGE(PG8_SA(0, 0), a2, voffA);
            PG8_BAR; PG8_WAIT_L(0); PG8_MMA(1, 0, At, B0); PG8_BAR; PG8_SCHED;
            PG8_STAGE(PG8_SB(0, 1), b2 + hstep, voffB);
            PG8_WAIT_V(6); PG8_BAR; PG8_MMA(1, 1, At, B1); PG8_BAR;
            PG8_LDB(B0, 1, 0); PG8_SCHED; PG8_LDA(At, 1, 0); PG8_STAGE(PG8_SA(0, 1), a2 + hstep, voffA);
            PG8_WAIT_L(8); PG8_BAR; PG8_WAIT_L(0); PG8_MMA(0, 0, At, B0); PG8_BAR; PG8_SCHED;
            PG8_LDB(B1, 1, 1); PG8_STAGE(PG8_SB(1, 0), b3, voffB);
            PG8_BAR; PG8_WAIT_L(0); PG8_MMA(0, 1, At, B1); PG8_BAR;
            PG8_LDA(At, 1, 1); PG8_STAGE(PG8_SA(1, 0), a3, voffA);
            PG8_BAR; PG8_WAIT_L(0); PG8_MMA(1, 0, At, B0); PG8_BAR; PG8_SCHED;
            PG8_STAGE(PG8_SB(1, 1), b3 + hstep, voffB);
            PG8_WAIT_V(6); PG8_BAR; PG8_MMA(1, 1, At, B1); PG8_BAR;
        }
        PG8_STAMP();
        if constexpr (!Epi::AFTER_DRAIN) { E(acc, cur, wr, wc, fr, fq); S.done(cur); }
        PG8_STAMP();
        if (!has_next) break;
#pragma unroll
        for (int a = 0; a < 2; ++a)
#pragma unroll
            for (int b = 0; b < 2; ++b)
#pragma unroll
                for (int m = 0; m < 4; ++m)
#pragma unroll
                    for (int n = 0; n < 2; ++n) acc[a][b][m][n] = (f32x4){0.f, 0.f, 0.f, 0.f};
        cur = nxt; cA = nA; cB = nB; ++ui;
    }
    PG8_WAIT_V(0);
    if (wr == 0) PG8_BAR;
    PG8_BAR;
    if constexpr (Epi::AFTER_DRAIN) { E.fused(acc, cur, wr, wc, fr, fq, lds, wid, lane); S.done(cur); }
    PG8_STAMP();
    if (STAMP && wid == 0) { stamps[lane] = lane < nts ? (((unsigned long long)(unsigned)ts_hi << 32) | (unsigned)ts_lo) : 0ull;
        if (lane == 62) stamps[62] = rt_entry; if (lane == 63) stamps[63] = (unsigned long long)wall_clock64(); }
#undef PG8_STAMP
#undef PG8_SA
#undef PG8_SB
#undef PG8_STAGE
#undef PG8_LDA
#undef PG8_LDB
#undef PG8_MMA
#undef PG8_WAIT_V
#undef PG8_WAIT_L
#undef PG8_BAR
#undef PG8_SCHED
}
}

namespace cg = cooperative_groups;
typedef unsigned short bf16_t;
typedef short bf16x8 __attribute__((ext_vector_type(8)));
typedef float f32x4 __attribute__((ext_vector_type(4)));
typedef unsigned u32x4 __attribute__((ext_vector_type(4)));
typedef unsigned u32x2 __attribute__((ext_vector_type(2)));

constexpr int NB = 8, NT = 4096, DM = 1024, NTOK = NB * NT;
constexpr int DIN = 4744, NPAD = 4864;
constexpr int C_R = 0, C_K = 512, C_V = 1024, C_WD = 1536, C_AD = 1600, C_ZR = 1664, C_Q = 2176, C_KM = 2688, C_VM = 3200, C_O = 3712, C_I = 4224, C_F = 4228, C_ZM = 4232;
constexpr int NTHR = 512, NWV = 8;
constexpr int LDS_BYTES = 147456;
constexpr int NPHASE = 8;

constexpr size_t MiB = 1u << 20;
constexpr size_t WS_CTL = 0, CTL_BYTES = 1 * MiB;
constexpr size_t WS_ADA = 1 * MiB;
constexpr size_t WS_LORA = 1 * MiB + 512 * 1024;
constexpr size_t WS_WL = 14 * MiB, WS_BONUS = 15 * MiB;
constexpr size_t WS_WIN = 2 * MiB;
constexpr size_t WS_WOUT = 12 * MiB;
constexpr size_t WS_X = 16 * MiB;
constexpr size_t WS_PROJ = 144 * MiB;
constexpr size_t WS_Y = 448 * MiB;
constexpr size_t WS_END = 512 * MiB;

struct Params { const float* in[24]; float* out; unsigned char* ws; int ph_lo, ph_hi; };

struct Ctx {
    const Params& p;
    __device__ __forceinline__ const float* x() const { return p.in[0]; }
    __device__ __forceinline__ const float* c() const { return p.in[1]; }
    __device__ __forceinline__ const float* w_ada() const { return p.in[2]; }
    __device__ __forceinline__ const float* b_ada() const { return p.in[3]; }
    __device__ __forceinline__ const float* norm_gain() const { return p.in[4]; }
    __device__ __forceinline__ const float* w_in() const { return p.in[5]; }
    __device__ __forceinline__ const float* mu() const { return p.in[6]; }
    __device__ __forceinline__ const float* w_dup() const { return p.in[7]; }
    __device__ __forceinline__ const float* w_d0() const { return p.in[8]; }
    __device__ __forceinline__ const float* w_iup() const { return p.in[9]; }
    __device__ __forceinline__ const float* a0() const { return p.in[10]; }
    __device__ __forceinline__ const float* k_k() const { return p.in[11]; }
    __device__ __forceinline__ const float* k_a() const { return p.in[12]; }
    __device__ __forceinline__ const float* r_k() const { return p.in[13]; }
    __device__ __forceinline__ const float* gn_w() const { return p.in[14]; }
    __device__ __forceinline__ const float* gn_b() const { return p.in[15]; }
    __device__ __forceinline__ const float* conv_w() const { return p.in[16]; }
    __device__ __forceinline__ const float* conv_b() const { return p.in[17]; }
    __device__ __forceinline__ const float* b_i() const { return p.in[18]; }
    __device__ __forceinline__ const float* b_f() const { return p.in[19]; }
    __device__ __forceinline__ const float* ln_w() const { return p.in[20]; }
    __device__ __forceinline__ const float* skip() const { return p.in[21]; }
    __device__ __forceinline__ const float* w_out() const { return p.in[22]; }
    __device__ __forceinline__ const float* fgain() const { return p.in[23]; }
    __device__ __forceinline__ float* out() const { return p.out; }
    __device__ __forceinline__ float* sumsq() const { return (float*)(p.ws + (WS_Y)); }
    __device__ __forceinline__ float* ada() const { return (float*)(p.ws + (WS_ADA)); }
    __device__ __forceinline__ bf16_t* win_t() const { return (bf16_t*)(p.ws + (WS_WIN)); }
    __device__ __forceinline__ bf16_t* wout_t() const { return (bf16_t*)(p.ws + (WS_WOUT)); }
    __device__ __forceinline__ bf16_t* hn() const { return (bf16_t*)(p.ws + (WS_X)); }
    __device__ __forceinline__ bf16_t* proj() const { return (bf16_t*)(p.ws + (WS_PROJ)); }
    __device__ __forceinline__ bf16_t* y() const { return (bf16_t*)(p.ws + (WS_Y)); }
    __device__ __forceinline__ bf16_t* wdup_t() const { return (bf16_t*)(p.ws + (WS_LORA)); }
    __device__ __forceinline__ bf16_t* wiup_t() const { return (bf16_t*)(p.ws + (WS_LORA + 65536)); }
    __device__ __forceinline__ bf16_t* q1p() const { return (bf16_t*)(p.ws + (WS_X)); }
    __device__ __forceinline__ bf16_t* mp() const { return (bf16_t*)(p.ws + (WS_X + 32 * MiB)); }
    __device__ __forceinline__ bf16_t* yid() const { return (bf16_t*)(p.ws + (WS_X + 64 * MiB)); }
    __device__ __forceinline__ bf16_t* nd() const { return (bf16_t*)(p.ws + (WS_X + 96 * MiB)); }
    __device__ __forceinline__ float* wl() const { return (float*)(p.ws + (WS_WL)); }
    __device__ __forceinline__ float* bonus() const { return (float*)(p.ws + (WS_BONUS)); }
    __device__ __forceinline__ bf16_t* qc() const { return (bf16_t*)(p.ws + WS_Y); }
    __device__ __forceinline__ bf16_t* kc() const { return (bf16_t*)(p.ws + WS_Y + 32 * MiB); }
    __device__ __forceinline__ bf16_t* mixo() const { return (bf16_t*)(p.ws + WS_Y); }
    __device__ __forceinline__ bf16_t* p0s() const { return (bf16_t*)p.out; }
    __device__ __forceinline__ bf16_t* ymix() const { return (bf16_t*)(p.ws + WS_X); }
    unsigned char* lds; int tid, lane, wid, gw, ngw;
};

__device__ __forceinline__ float bf2f(bf16_t v) { return __uint_as_float(((unsigned)v) << 16); }
typedef __bf16 bf16v2_t __attribute__((ext_vector_type(2))); typedef float f32v2_t __attribute__((ext_vector_type(2)));
__device__ __forceinline__ unsigned pk2(float lo, float hi) { const f32v2_t v = {lo, hi}; const bf16v2_t b = __builtin_convertvector(v, bf16v2_t); return __builtin_bit_cast(unsigned, b); }
__device__ __forceinline__ bf16_t f2bf(float f) { return __builtin_bit_cast(bf16_t, (__bf16)f); }
__device__ __forceinline__ void unpack8(const u32x4 v, float* o) {
    o[0] = __uint_as_float(v.x << 16); o[1] = __uint_as_float(v.x & 0xffff0000u); o[2] = __uint_as_float(v.y << 16); o[3] = __uint_as_float(v.y & 0xffff0000u);
    o[4] = __uint_as_float(v.z << 16); o[5] = __uint_as_float(v.z & 0xffff0000u); o[6] = __uint_as_float(v.w << 16); o[7] = __uint_as_float(v.w & 0xffff0000u);
}
__device__ __forceinline__ u32x4 pack8(const float* v) { u32x4 o; o.x = pk2(v[0], v[1]); o.y = pk2(v[2], v[3]); o.z = pk2(v[4], v[5]); o.w = pk2(v[6], v[7]); return o; }
__device__ __forceinline__ float wave_sum(float v) {
#pragma unroll
    for (int o = 1; o < 64; o <<= 1) v += __shfl_xor(v, o);
    return v;
}
#define LDS_BARRIER() do { asm volatile("s_waitcnt lgkmcnt(0)" ::: "memory"); __builtin_amdgcn_s_barrier(); asm volatile("" ::: "memory"); } while (0)
__device__ __forceinline__ float fexp(float x) { return __builtin_amdgcn_exp2f(x * 1.4426950408889634f); }
__device__ __forceinline__ float frcp(float x) { return __builtin_amdgcn_rcpf(x); }
__device__ __forceinline__ float sigmoidf_(float z) { return frcp(1.0f + fexp(-z)); }
__device__ __forceinline__ float siluf_(float z) { return z * frcp(1.0f + fexp(-z)); }
__device__ __forceinline__ float ftanh(float x) { return 1.0f - 2.0f * frcp(1.0f + fexp(2.0f * x)); }
template <int CTRL> __device__ __forceinline__ float dppf(float v) { return __int_as_float(__builtin_amdgcn_update_dpp(0, __float_as_int(v), CTRL, 0xF, 0xF, true)); }
__device__ __forceinline__ float row16_sum(float v) {
    v += dppf<0xB1>(v); v += dppf<0x4E>(v); v += dppf<0x141>(v); v += dppf<0x140>(v); return v;
}

__device__ __forceinline__ void transpose_item(const float* W, int K, int N, bf16_t* WT, float* scr, int item, int nblk, int lane) {
    const int kb = item / nblk, nb = item % nblk, k0 = 64 * kb, n0 = 32 * nb;
#pragma unroll
    for (int i = 0; i < 32; ++i) { const int kk = 2 * i + (lane >> 5); const int n = n0 + (lane & 31); scr[kk * 33 + (lane & 31)] = (n < N) ? W[(size_t)(k0 + kk) * N + n] : 0.f; }
    __builtin_amdgcn_s_waitcnt(0); asm volatile("" ::: "memory");
    const int c = lane & 7;
#pragma unroll
    for (int j = 0; j < 4; ++j) { const int n = (lane >> 3) + 8 * j; const float* s = scr + (8 * c) * 33 + n;
        u32x4 o; o.x = pk2(s[0 * 33], s[1 * 33]); o.y = pk2(s[2 * 33], s[3 * 33]); o.z = pk2(s[4 * 33], s[5 * 33]); o.w = pk2(s[6 * 33], s[7 * 33]);
        *(u32x4*)(WT + (size_t)(n0 + n) * K + k0 + 8 * c) = o; }
    __builtin_amdgcn_s_waitcnt(0); asm volatile("" ::: "memory");
}
__device__ __forceinline__ void phase0(const Ctx& C) {
    if (blockIdx.x >= 48) return;
    float* Ls = (float*)C.lds;
    float* Lp = Ls + 8192;
    for (int e = C.tid; e < 8192; e += NTHR) Ls[e] = siluf_(C.c()[e]);
    __syncthreads();
    const int lane = C.lane, wid = C.wid, grp = wid >> 2, kq = wid & 3, kp = lane >> 3, c4 = 4 * (lane & 7);
    const int col0 = (2 * blockIdx.x + grp) * 32;
    f32x4 acc[8];
#pragma unroll
    for (int b = 0; b < 8; ++b) acc[b] = (f32x4){0.f, 0.f, 0.f, 0.f};
#pragma unroll 16
    for (int it = 0; it < 32; ++it) {
        const int k = kq * 256 + it * 8 + kp;
        const f32x4 w = *(const f32x4*)(C.w_ada() + (size_t)k * 3072 + col0 + c4);
#pragma unroll
        for (int b = 0; b < 8; ++b) acc[b] = acc[b] + w * Ls[b * 1024 + k];
    }
#pragma unroll
    for (int b = 0; b < 8; ++b) {
#pragma unroll
        for (int o = 8; o < 64; o <<= 1) { acc[b].x += __shfl_xor(acc[b].x, o); acc[b].y += __shfl_xor(acc[b].y, o); acc[b].z += __shfl_xor(acc[b].z, o); acc[b].w += __shfl_xor(acc[b].w, o); }
        if (kp == 0) *(f32x4*)(Lp + ((grp * 4 + kq) * 8 + b) * 32 + c4) = acc[b];
    }
    __syncthreads();
    if (C.tid < 512) { const int g2 = C.tid >> 8, b = (C.tid >> 5) & 7, c = C.tid & 31; const int col = (2 * blockIdx.x + g2) * 32 + c;
        float s = C.b_ada()[col];
#pragma unroll
        for (int q = 0; q < 4; ++q) s += Lp[((g2 * 4 + q) * 8 + b) * 32 + c];
        C.ada()[b * 3072 + col] = s; }
}
__device__ __forceinline__ void weight_copies(const Ctx& C) {
    float* scr = (float*)(C.lds + C.wid * 16384);
    constexpr int NBI = NPAD / 32, I_IN = 16 * NBI, I_OUT = 16 * 32;
    for (int it = C.gw; it < I_IN + I_OUT + 32; it += C.ngw) {
        if (it < I_IN) transpose_item(C.w_in(), 1024, DIN, C.win_t(), scr, it, NBI, C.lane);
        else if (it < I_IN + I_OUT) transpose_item(C.w_out(), 1024, 1024, C.wout_t(), scr, it - I_IN, 32, C.lane);
        else if (it < I_IN + I_OUT + 16) transpose_item(C.w_dup(), 64, 512, C.wdup_t(), scr, it - I_IN - I_OUT, 16, C.lane);
        else transpose_item(C.w_iup(), 64, 512, C.wiup_t(), scr, it - I_IN - I_OUT - 16, 16, C.lane);
    }
}

__device__ __forceinline__ void phase1(const Ctx& C) {
    f32x4 g[4];
#pragma unroll
    for (int j = 0; j < 4; ++j) g[j] = *(const f32x4*)(C.norm_gain() + 4 * C.lane + 256 * j);
    f32x4 v[4], n1[4];
    { const f32x4* xr = (const f32x4*)(C.x() + (size_t)C.gw * DM) + C.lane; const f32x4* x1 = (const f32x4*)(C.x() + (size_t)(C.gw + C.ngw) * DM) + C.lane;
#pragma unroll
      for (int j = 0; j < 4; ++j) { v[j] = __builtin_nontemporal_load(xr + 64 * j); n1[j] = __builtin_nontemporal_load(x1 + 64 * j); } }
    f32x4 shv[4], scv[4]; int bcur = -1;
    for (int m = C.gw; m < NTOK; m += C.ngw) {
        const int b = m >> 12; const int mn = (m + 2 * C.ngw < NTOK) ? m + 2 * C.ngw : m;
        if (b != bcur) { bcur = b;
#pragma unroll
            for (int j = 0; j < 4; ++j) { shv[j] = *(const f32x4*)(C.ada() + b * 3072 + 4 * C.lane + 256 * j); scv[j] = *(const f32x4*)(C.ada() + b * 3072 + 1024 + 4 * C.lane + 256 * j) + 1.0f; } }
        f32x4 nv[4];
        { const f32x4* xr = (const f32x4*)(C.x() + (size_t)mn * DM) + C.lane;
#pragma unroll
          for (int j = 0; j < 4; ++j) nv[j] = __builtin_nontemporal_load(xr + 64 * j); }
        float s = 0.f;
#pragma unroll
        for (int j = 0; j < 4; ++j) s += (v[j].x * v[j].x + v[j].y * v[j].y) + (v[j].z * v[j].z + v[j].w * v[j].w);
        const float rs = __builtin_amdgcn_rsqf(wave_sum(s) * (1.0f / DM) + 1e-6f);
        u32x2* o = (u32x2*)(C.hn() + (size_t)m * DM) + C.lane;
#pragma unroll
        for (int j = 0; j < 4; ++j) {
            const f32x4 h = v[j] * rs * g[j] * scv[j] + shv[j];
            u32x2 w; w.x = pk2(h.x, h.y); w.y = pk2(h.z, h.w); o[64 * j] = w; }
#pragma unroll
        for (int j = 0; j < 4; ++j) { v[j] = n1[j]; n1[j] = nv[j]; }
    }
}

typedef short s16x4 __attribute__((ext_vector_type(4)));
__device__ __forceinline__ bf16x8 tr_frag(const bf16_t* base, int stride, int row0, int col0, int fr, int fq) {
    const bf16_t* a0 = base + (row0 + 8 * fq + (fr >> 2)) * stride + col0 + 4 * (fr & 3);
    const s16x4 lo = __builtin_amdgcn_ds_read_tr16_b64_v4i16((__attribute__((address_space(3))) s16x4*)a0);
    const s16x4 hi = __builtin_amdgcn_ds_read_tr16_b64_v4i16((__attribute__((address_space(3))) s16x4*)(a0 + 4 * stride));
    return (bf16x8){lo[0], lo[1], lo[2], lo[3], hi[0], hi[1], hi[2], hi[3]};
}

constexpr int LS = 72;
constexpr int XS = 68;
__device__ __forceinline__ int permc(int c) { return (c & 32) | ((c & 12) << 1) | ((c & 16) >> 2) | (c & 3); }
__device__ __forceinline__ bf16x8 zero8() { return (bf16x8){0, 0, 0, 0, 0, 0, 0, 0}; }
#define MFMA16(a, b, c) __builtin_amdgcn_mfma_f32_16x16x32_bf16(a, b, c, 0, 0, 0)
#define LDFRAG(base, row, col) (*(const bf16x8*)((base) + (row) * LS + (col)))

#define FR_(base, rowoff, coloff) (*(const bf16x8*)((base) + lfo + (rowoff) * LS + (coloff)))
#define DW_(base, rowoff, coloff, r) ((base)[ldo + ((rowoff) + (r)) * LS + (coloff)])
#define OPAQ() asm volatile("" : "+v"(lfo), "+v"(ldo), "+v"(lto), "+v"(lxo))
template <int VAR> __device__ __forceinline__ void rwkv_r1_wg(const Ctx& C, int b, int h, int ck0, int nck) {
    bf16_t* B0 = (bf16_t*)C.lds;
    bf16_t* B1 = B0 + 64 * LS;
    bf16_t* B2 = B1 + 64 * LS;
    bf16_t* B3 = B2 + 64 * LS;
    bf16_t* B4 = B3 + 64 * LS;
    bf16_t* B5 = B4 + 64 * LS;
    bf16_t* B6 = B5 + 64 * LS;
    bf16_t* B7 = B6 + 64 * LS;
    bf16_t* B8 = B7 + 64 * LS;
    float* F = (float*)(B8 + 64 * LS);
    float* Xr = F; float* Xk = F + 64 * XS; float* Xv = Xk + 64 * XS;
    bf16_t* LAab = (bf16_t*)F; bf16_t* LAak = LAab + 64 * LS; bf16_t* LArb = LAak + 64 * LS; bf16_t* LArk = LArb + 64 * LS; bf16_t* LTinv = LArk + 64 * LS;
    float* G = F + 3 * 64 * XS;
    float* LAd = G;
    float* Ltot = LAd + 1024;
    float* Linv = Ltot + 256;
    float* Lbp = Linv + 64;
    bf16_t* LX = (bf16_t*)LAd;
    bf16_t* LX2 = LX + 2 * 16 * 40;
    float* Lc = Lbp + 128;
    int tid = C.tid; asm volatile("" : "+v"(tid));
    const int lane = tid & 63, wid = C.wid, fr = lane & 15, fq = lane >> 4;
    const int tt = tid >> 3, cg8 = tid & 7, ch0 = h * 64 + 8 * cg8;
    const int wt = wid >> 1, wc0 = 2 * (wid & 1);
    __syncthreads();
    if (tid < 384) { const int a = tid >> 6, c = tid & 63;
        Lc[tid] = (a == 0) ? C.mu()[C_R + h * 64 + c] : (a == 1) ? C.mu()[C_K + h * 64 + c] : (a == 2) ? C.mu()[C_V + h * 64 + c] : (a == 3) ? C.k_k()[h * 64 + c] : (a == 4) ? C.mu()[C_WD + c] : C.mu()[C_AD + c]; }
    __syncthreads();
    float d0c[2], a0c[2], kkc[2], kac[2], rkc[2];
#pragma unroll
    for (int jj = 0; jj < 2; ++jj) { const int c = h * 64 + 16 * (wc0 + jj) + fr;
        d0c[jj] = C.w_d0()[c]; a0c[jj] = C.a0()[c]; kkc[jj] = C.k_k()[c]; kac[jj] = C.k_a()[c]; rkc[jj] = C.r_k()[c]; }
    int lfo = fr * LS + 8 * fq, ldo = 4 * fq * LS + fr, lto = fr * LS + 4 * fq, lxo = 4 * fq * XS + fr;

    u32x4 raw[10];
#define R1_LOAD_RAW(mm) do { const bf16_t* pc_ = C.proj() + (size_t)(mm) * NPAD; const bf16_t* pp_ = ((mm) > 0) ? pc_ - NPAD : pc_; \
        raw[0] = *(const u32x4*)(pc_ + C_R + ch0); raw[1] = *(const u32x4*)(pc_ + C_K + ch0); raw[2] = *(const u32x4*)(pc_ + C_V + ch0); \
        raw[3] = *(const u32x4*)(pc_ + C_WD + 8 * cg8); raw[4] = *(const u32x4*)(pc_ + C_AD + 8 * cg8); \
        raw[5] = *(const u32x4*)(pp_ + C_R + ch0); raw[6] = *(const u32x4*)(pp_ + C_K + ch0); raw[7] = *(const u32x4*)(pp_ + C_V + ch0); \
        raw[8] = *(const u32x4*)(pp_ + C_WD + 8 * cg8); raw[9] = *(const u32x4*)(pp_ + C_AD + 8 * cg8); } while (0)
    R1_LOAD_RAW(b * NT + ck0 * 64 + tt);
    for (int ci = 0; ci < nck; ++ci) {
        const int ck = ck0 + ci; const int m = b * NT + ck * 64 + tt; const size_t chx = (size_t)((b * 8 + h) * 64 + ck);
        OPAQ();
        bf16x8 Bw[2][2], Bi[2][2];
        { int co = (h * 64 + 16 * wc0 + fr) * 64 + 8 * fq; asm volatile("" : "+v"(co));
#pragma unroll
          for (int jj = 0; jj < 2; ++jj)
#pragma unroll
            for (int ks = 0; ks < 2; ++ks) { Bw[jj][ks] = *(const bf16x8*)(C.wdup_t() + co + jj * 1024 + 32 * ks); Bi[jj][ks] = *(const bf16x8*)(C.wiup_t() + co + jj * 1024 + 32 * ks); } }
        if constexpr ((VAR & 2) == 0) {
        {
            const bool hp = (ck | tt) != 0;
            if (!hp) {
#pragma unroll
                for (int i = 5; i < 10; ++i) raw[i] = (u32x4){0u, 0u, 0u, 0u}; }
            const int o = tt * XS + 8 * cg8;
            {
                float v[8], pv[8], mu8[8]; unpack8(raw[2], v); unpack8(raw[7], pv);
                { const f32x4* p4 = (const f32x4*)(Lc + 128 + 8 * cg8); *(f32x4*)mu8 = p4[0]; *(f32x4*)(mu8 + 4) = p4[1]; }
#pragma unroll
                for (int i = 0; i < 8; ++i) v[i] += mu8[i] * (pv[i] - v[i]);
                *(f32x4*)(Xv + o) = (f32x4){v[0], v[1], v[2], v[3]}; *(f32x4*)(Xv + o + 4) = (f32x4){v[4], v[5], v[6], v[7]};
            }
            asm volatile("" ::: "memory");
            {
                float v[8], pv[8], mu8[8]; unpack8(raw[0], v); unpack8(raw[5], pv);
                { const f32x4* p4 = (const f32x4*)(Lc + 8 * cg8); *(f32x4*)mu8 = p4[0]; *(f32x4*)(mu8 + 4) = p4[1]; }
#pragma unroll
                for (int i = 0; i < 8; ++i) v[i] += mu8[i] * (pv[i] - v[i]);
                *(f32x4*)(Xr + o) = (f32x4){v[0], v[1], v[2], v[3]}; *(f32x4*)(Xr + o + 4) = (f32x4){v[4], v[5], v[6], v[7]};
            }
            asm volatile("" ::: "memory");
            {
                float v[8], pv[8], mu8[8], kw8[8]; unpack8(raw[1], v); unpack8(raw[6], pv);
                { const f32x4* p4 = (const f32x4*)(Lc + 64 + 8 * cg8); *(f32x4*)mu8 = p4[0]; *(f32x4*)(mu8 + 4) = p4[1]; p4 = (const f32x4*)(Lc + 192 + 8 * cg8); *(f32x4*)kw8 = p4[0]; *(f32x4*)(kw8 + 4) = p4[1]; }
                float ss = 0.f;
#pragma unroll
                for (int i = 0; i < 8; ++i) { v[i] += mu8[i] * (pv[i] - v[i]); const float q = v[i] * kw8[i]; ss += q * q; }
                ss += __shfl_xor(ss, 1); ss += __shfl_xor(ss, 2); ss += __shfl_xor(ss, 4);
                if (cg8 == 0) Linv[tt] = frcp(fmaxf(__builtin_amdgcn_sqrtf(ss), 1e-12f));
                *(f32x4*)(Xk + o) = (f32x4){v[0], v[1], v[2], v[3]}; *(f32x4*)(Xk + o + 4) = (f32x4){v[4], v[5], v[6], v[7]};
            }
            asm volatile("" ::: "memory");
            {
                float v[8], pv[8], mu8[8]; unpack8(raw[3], v); unpack8(raw[8], pv);
                { const f32x4* p4 = (const f32x4*)(Lc + 256 + 8 * cg8); *(f32x4*)mu8 = p4[0]; *(f32x4*)(mu8 + 4) = p4[1]; }
#pragma unroll
                for (int i = 0; i < 8; ++i) v[i] = ftanh(v[i] + mu8[i] * (pv[i] - v[i]));
                *(u32x4*)(B0 + tt * LS + 8 * cg8) = pack8(v);
            }
            asm volatile("" ::: "memory");
            {
                float v[8], pv[8], mu8[8]; unpack8(raw[4], v); unpack8(raw[9], pv);
                { const f32x4* p4 = (const f32x4*)(Lc + 320 + 8 * cg8); *(f32x4*)mu8 = p4[0]; *(f32x4*)(mu8 + 4) = p4[1]; }
#pragma unroll
                for (int i = 0; i < 8; ++i) v[i] += mu8[i] * (pv[i] - v[i]);
                *(u32x4*)(B1 + tt * LS + 8 * cg8) = pack8(v);
            }
        }
        }
        LDS_BARRIER();
        float lw[2][4], aa[2][4];
        {
            f32x4 zw[2], za[2];
#pragma unroll
            for (int jj = 0; jj < 2; ++jj) { zw[jj] = (f32x4){0.f, 0.f, 0.f, 0.f}; za[jj] = (f32x4){0.f, 0.f, 0.f, 0.f}; }
#pragma unroll
            for (int ks = 0; ks < 2; ++ks) { const bf16x8 aw = FR_(B0, 16 * wt, 32 * ks), ai = FR_(B1, 16 * wt, 32 * ks);
#pragma unroll
                for (int jj = 0; jj < 2; ++jj) { zw[jj] = MFMA16(aw, Bw[jj][ks], zw[jj]); za[jj] = MFMA16(ai, Bi[jj][ks], za[jj]); } }
#pragma unroll
            for (int jj = 0; jj < 2; ++jj)
#pragma unroll
                for (int r = 0; r < 4; ++r) { lw[jj][r] = -0.6065306597126334f * sigmoidf_(d0c[jj] + zw[jj][r]); aa[jj][r] = sigmoidf_(a0c[jj] + za[jj][r]); }
        }
        float clx[2][4], cin[2][4];
#pragma unroll
        for (int jj = 0; jj < 2; ++jj) {
            const float s4 = (lw[jj][0] + lw[jj][1]) + (lw[jj][2] + lw[jj][3]); float x = s4;
            float t1 = __shfl_up(x, 16); if (fq >= 1) x += t1; t1 = __shfl_up(x, 32); if (fq >= 2) x += t1;
            const float eq = x - s4;
            clx[jj][0] = eq; cin[jj][0] = eq + lw[jj][0];
#pragma unroll
            for (int r = 1; r < 4; ++r) { clx[jj][r] = cin[jj][r - 1]; cin[jj][r] = cin[jj][r - 1] + lw[jj][r]; }
            if (fq == 3) Ltot[wt * 64 + 16 * (wc0 + jj) + fr] = x;
        }
        LDS_BARRIER();
        OPAQ();
        if constexpr ((VAR & 4) == 0) {
        {
            float bsum[4] = {0.f, 0.f, 0.f, 0.f};
            const int xb = lxo + 16 * wt * XS + 16 * wc0;
            const int db = 16 * wt * LS + 16 * wc0;
            const int tb = lto + 16 * wc0 * LS + 16 * wt;
#pragma unroll
            for (int jj = 0; jj < 2; ++jj) {
                const int c = 16 * (wc0 + jj) + fr;
                float off = 0.f, clL = 0.f;
#pragma unroll
                for (int q = 0; q < 4; ++q) { const float tv = Ltot[q * 64 + c]; clL += tv; if (q < wt) off += tv; }
                const float eL = fexp(clL);
                if ((VAR & 1) == 0 && wt == 0 && fq == 0) C.wl()[chx * 64 + c] = eL;
                float at[4], rt[4], bt[4], kt[4], bh[4], kh[4], vv[4]; float eprev = 0.f;
#pragma unroll
                for (int r = 0; r < 4; ++r) {
                    const float rr = Xr[xb + r * XS + 16 * jj], kr = Xk[xb + r * XS + 16 * jj]; vv[r] = Xv[xb + r * XS + 16 * jj];
                    const float kk = kr * kkc[jj] * Linv[16 * wt + 4 * fq + r]; const float a = aa[jj][r];
                    const float be = kk * a, km = kr * (1.0f + (a - 1.0f) * kac[jj]);
                    const float ci_ = off + cin[jj][r], cx = off + clx[jj][r];
                    const float ei = fexp(ci_), en = frcp(ei), el = eL * en;
                    at[r] = -kk * ((r == 0) ? fexp(cx) : eprev); eprev = ei; rt[r] = rr * ei; bt[r] = be * en; kt[r] = km * en; bh[r] = be * el; kh[r] = km * el;
                    bsum[r] += rr * km * rkc[jj];
                    B3[ldo + db + r * LS + 16 * jj] = f2bf(rt[r]);
                }
                u32x2 w;
                w.x = pk2(at[0], at[1]); w.y = pk2(at[2], at[3]); *(u32x2*)(B4 + tb + 16 * jj * LS) = w;
                w.x = pk2(bt[0], bt[1]); w.y = pk2(bt[2], bt[3]); *(u32x2*)(B1 + tb + 16 * jj * LS) = w;
                w.x = pk2(kt[0], kt[1]); w.y = pk2(kt[2], kt[3]); *(u32x2*)(B2 + tb + 16 * jj * LS) = w;
                w.x = pk2(bh[0], bh[1]); w.y = pk2(bh[2], bh[3]); *(u32x2*)(B5 + tb + 16 * jj * LS) = w;
                w.x = pk2(kh[0], kh[1]); w.y = pk2(kh[2], kh[3]); *(u32x2*)(B6 + tb + 16 * jj * LS) = w;
                w.x = pk2(vv[0], vv[1]); w.y = pk2(vv[2], vv[3]); *(u32x2*)(B7 + tb + 16 * jj * LS) = w;
            }
#pragma unroll
            for (int r = 0; r < 4; ++r) { const float s = row16_sum(bsum[r]); if (fr == 0) Lbp[(wid & 1) * 64 + 16 * wt + 4 * fq + r] = s; }
        }
        }
        LDS_BARRIER();
        OPAQ();
        if ((VAR & 1) == 0 && tid < 64) C.bonus()[(size_t)(b * NT + ck * 64 + tid) * 8 + h] = Lbp[tid] + Lbp[64 + tid];
        if constexpr ((VAR & 8) == 0) {
        {
            int fr3 = fr, fq3 = fq; asm volatile("" : "+v"(fr3), "+v"(fq3));
#pragma unroll
            for (int jj = 0; jj < 2; ++jj) {
                const int st = wc0 + jj;
                if (st <= wt) {
                    f32x4 ab = (f32x4){0.f, 0.f, 0.f, 0.f}, ak = ab, rb = ab, rk = ab;
#pragma unroll
                    for (int ks = 0; ks < 2; ++ks) {
                        const bf16x8 fa = tr_frag(B4, LS, 32 * ks, 16 * wt, fr3, fq3), frr = FR_(B3, 16 * wt, 32 * ks);
                        const bf16x8 fb = tr_frag(B1, LS, 32 * ks, 16 * st, fr3, fq3), fk = tr_frag(B2, LS, 32 * ks, 16 * st, fr3, fq3);
                        ab = MFMA16(fa, fb, ab); ak = MFMA16(fa, fk, ak); rb = MFMA16(frr, fb, rb); rk = MFMA16(frr, fk, rk);
                    }
                    int fro = fr, fqo = 4 * fq; asm volatile("" : "+v"(fro), "+v"(fqo));
                    const int s = 16 * st + fro;
#pragma unroll
                    for (int r = 0; r < 4; ++r) { const int t = 16 * wt + fqo + r; const bool lo = s < t, le = s <= t;
                        const float vab = lo ? ab[r] : 0.f;
                        DW_(LAab, 16 * wt, 16 * st, r) = f2bf(vab); DW_(LAak, 16 * wt, 16 * st, r) = f2bf(lo ? ak[r] : 0.f); DW_(LArb, 16 * wt, 16 * st, r) = f2bf(le ? rb[r] : 0.f); DW_(LArk, 16 * wt, 16 * st, r) = f2bf(le ? rk[r] : 0.f);
                        if (st == wt) LAd[wt * 256 + (4 * fq + r) * 16 + fr] = vab; }
                } else if (st == wt + 1 && (wt & 1) == 0) {
#pragma unroll
                    for (int r = 0; r < 4; ++r) { DW_(LAak, 16 * wt, 16 * st, r) = 0; DW_(LArb, 16 * wt, 16 * st, r) = 0; DW_(LArk, 16 * wt, 16 * st, r) = 0; DW_(LTinv, 16 * wt, 16 * st, r) = 0; }
                }
            }
            if (tid < 32) *(u32x4*)(B8 + (16 + (tid >> 1)) * LS + 8 * (tid & 1)) = (u32x4){0u, 0u, 0u, 0u};
        }
        }
        LDS_BARRIER();
        OPAQ();
        if constexpr ((VAR & 16) == 0) {
        if (wid == 0) {
            const float* Ad = LAd + fq * 256; float X[16];
#pragma unroll
            for (int i = 0; i < 16; ++i) X[i] = (i == fr) ? 1.0f : 0.f;
#pragma unroll
            for (int i = 1; i < 16; ++i) { float acc = X[i];
#pragma unroll
                for (int s = 0; s < i; ++s) acc += Ad[i * 16 + s] * X[s];
                X[i] = acc; }
            const int dg = ldo + 12 * fq * LS + 16 * fq;
#pragma unroll
            for (int i = 0; i < 16; ++i) LTinv[dg + i * LS] = f2bf(X[i]);
            const int dt = lfo + 16 * fq * LS + 8 * fq;
            *(u32x4*)(B8 + dt) = pack8(X); *(u32x4*)(B8 + dt + 8) = pack8(X + 8);
        } else {
            for (int tile = wid - 1; tile < 16; tile += 7) { const int vt = tile >> 2, t2 = tile & 3; f32x4 acc = (f32x4){0.f, 0.f, 0.f, 0.f};
#pragma unroll
                for (int ks = 0; ks < 2; ++ks) if (ks == 0 || t2 >= 2) acc = MFMA16(FR_(B7, 16 * vt, 32 * ks), FR_(LAak, 16 * t2, 32 * ks), acc);
#pragma unroll
                for (int r = 0; r < 4; ++r) DW_(B0, 16 * vt, 16 * t2, r) = f2bf(acc[r]); }
        }
        }
        LDS_BARRIER();
        OPAQ();
        if (ci + 1 < nck) R1_LOAD_RAW(m + 64);
        if ((VAR & 32) == 0 && wid < 2) {
            const int o = 32 * wid;
            bf16_t* lx = LX + wid * 16 * 40;
            const bool kv = fq < 2;
            const int xf = fr * 40 + 8 * fq, xd = 4 * fq * 40 + fr;
            {
                const bf16x8 fa = kv ? FR_(B8, o, o) : zero8(), fb = kv ? FR_(LAab, o + 16, o) : zero8();
                const f32x4 acc = MFMA16(fa, fb, ((f32x4){0.f, 0.f, 0.f, 0.f}));
#pragma unroll
                for (int r = 0; r < 4; ++r) lx[xd + r * 40] = f2bf(acc[r]);
            }
            asm volatile("s_waitcnt lgkmcnt(0)" ::: "memory");
            {
                const bf16x8 ft = kv ? FR_(LTinv, o + 16, o + 16) : zero8(), fx = kv ? *(const bf16x8*)(lx + xf) : zero8();
                const f32x4 acc = MFMA16(ft, fx, ((f32x4){0.f, 0.f, 0.f, 0.f}));
#pragma unroll
                for (int r = 0; r < 4; ++r) DW_(LTinv, o + 16, o, r) = f2bf(acc[r]);
                if (wid == 0) { const f32x4 acT = MFMA16(fx, ft, ((f32x4){0.f, 0.f, 0.f, 0.f}));
#pragma unroll
                    for (int r = 0; r < 4; ++r) DW_(B8, 0, 16, r) = f2bf(acT[r]); }
            }
        }
        LDS_BARRIER();
        if ((VAR & 32) == 0 && wid < 4) {
            const int jt = wid >> 1, ut = wid & 1;
            const f32x4 acc = MFMA16(FR_(B8, 16 * jt, 0), FR_(LAab, 32 + 16 * ut, 0), ((f32x4){0.f, 0.f, 0.f, 0.f}));
#pragma unroll
            for (int r = 0; r < 4; ++r) LX2[(16 * jt + 4 * fq + r) * 40 + 16 * ut + fr] = f2bf(acc[r]);
        }
        LDS_BARRIER();
        if ((VAR & 32) == 0 && wid < 4) {
            const int t2 = wid >> 1, jt = wid & 1;
            const f32x4 acc = MFMA16(FR_(LTinv, 32 + 16 * t2, 32), *(const bf16x8*)(LX2 + (16 * jt + fr) * 40 + 8 * fq), ((f32x4){0.f, 0.f, 0.f, 0.f}));
#pragma unroll
            for (int r = 0; r < 4; ++r) DW_(LTinv, 32 + 16 * t2, 16 * jt, r) = f2bf(acc[r]);
        }
        LDS_BARRIER();
        OPAQ();
        if constexpr ((VAR & 64) == 0) {
        {
#pragma unroll
            for (int jj = 0; jj < 2; ++jj) { const int t2 = wc0 + jj; f32x4 p1 = (f32x4){0.f, 0.f, 0.f, 0.f}, p2 = p1;
#pragma unroll
                for (int ks = 0; ks < 2; ++ks) if (ks == 0 || t2 >= 2) { const bf16x8 ft = FR_(LTinv, 16 * t2, 32 * ks);
                    p1 = MFMA16(FR_(B4, 16 * wt, 32 * ks), ft, p1); p2 = MFMA16(FR_(B0, 16 * wt, 32 * ks), ft, p2); }
#pragma unroll
                for (int r = 0; r < 4; ++r) { DW_(B1, 16 * wt, 16 * t2, r) = f2bf(p1[r]); DW_(B2, 16 * wt, 16 * t2, r) = f2bf(p2[r]); } }
        }
        }
        LDS_BARRIER();
        OPAQ();
        if constexpr ((VAR & 128) == 0) {
        {
            bf16_t* gq = C.q1p() + chx * 4096; bf16_t* gm = C.mp() + chx * 4096; bf16_t* gy = C.yid() + chx * 4096; bf16_t* gn = C.nd() + chx * 4096;
#pragma unroll
            for (int jj = 0; jj < 2; ++jj) {
                const int ct2 = wc0 + jj;
                f32x4 q1 = (f32x4){0.f, 0.f, 0.f, 0.f}, mm = q1, yi = q1, nn = q1;
#pragma unroll
                for (int ks = 0; ks < 2; ++ks) {
                    const bf16x8 fp1 = FR_(B1, 16 * wt, 32 * ks);
                    if (ks == 0 || ct2 >= 2) q1 = MFMA16(fp1, FR_(LArb, 16 * ct2, 32 * ks), q1);
                    mm = MFMA16(fp1, FR_(B5, 16 * ct2, 32 * ks), mm);
                    const bf16x8 fp2 = FR_(B2, 16 * ct2, 32 * ks), fv = FR_(B7, 16 * ct2, 32 * ks);
                    if (ks == 0 || wt >= 2) { yi = MFMA16(FR_(LArb, 16 * wt, 32 * ks), fp2, yi); yi = MFMA16(FR_(LArk, 16 * wt, 32 * ks), fv, yi); }
                    nn = MFMA16(FR_(B5, 16 * wt, 32 * ks), fp2, nn); nn = MFMA16(FR_(B6, 16 * wt, 32 * ks), fv, nn);
                }
                {
                    const int t = 16 * ct2 + fr, c0 = 16 * wt + 4 * fq; const u32x2 rv = *(const u32x2*)(B3 + lto + 16 * ct2 * LS + 16 * wt);
                    u32x2 w; w.x = pk2(q1[0] + __uint_as_float(rv.x << 16), q1[1] + __uint_as_float(rv.x & 0xffff0000u)); w.y = pk2(q1[2] + __uint_as_float(rv.y << 16), q1[3] + __uint_as_float(rv.y & 0xffff0000u));
                    *(u32x2*)(B0 + t * LS + permc(c0)) = w;
                    u32x2 w2; w2.x = pk2(mm[0], mm[1]); w2.y = pk2(mm[2], mm[3]); *(u32x2*)(B4 + t * LS + permc(c0)) = w2;
                }
                { u32x2 w; w.x = pk2(yi[0], yi[1]); w.y = pk2(yi[2], yi[3]); if ((VAR & 1) == 0) *(u32x2*)(gy + ((wt * 4 + ct2) * 64 + lane) * 4) = w;
                  u32x2 w2; w2.x = pk2(nn[0], nn[1]); w2.y = pk2(nn[2], nn[3]); if ((VAR & 1) == 0) *(u32x2*)(gn + ((wt * 4 + ct2) * 64 + lane) * 4) = w2; }
            }
        }
        }
        LDS_BARRIER();
        if constexpr ((VAR & 1) == 0 && (VAR & 128) == 0) {
            const int o = (tid >> 3) * LS + (tid & 7) * 8;
            *(u32x4*)(C.q1p() + chx * 4096 + tid * 8) = *(const u32x4*)(B0 + o); *(u32x4*)(C.mp() + chx * 4096 + tid * 8) = *(const u32x4*)(B4 + o);
        }
    }
}
#undef FR_
#undef DW_
#undef OPAQ

constexpr int R2_SLOT = 2 * 64 * 72 * 2 + 2 * 8192 + 256;
struct R2Set { u32x4 q, m, y, n, w; };
__device__ __forceinline__ void r2_issue(const Ctx& C, R2Set& r, size_t chx, int tid) {
    r.q = *(const u32x4*)(C.q1p() + chx * 4096 + tid * 8); r.m = *(const u32x4*)(C.mp() + chx * 4096 + tid * 8);
    r.y = *(const u32x4*)(C.yid() + chx * 4096 + tid * 8); r.n = *(const u32x4*)(C.nd() + chx * 4096 + tid * 8);
    r.w = *(const u32x4*)(C.wl() + chx * 64 + 4 * (tid & 15));
}
__device__ __forceinline__ void r2_put(const R2Set& r, unsigned char* slot, int tid) {
    bf16_t* LQ = (bf16_t*)slot; bf16_t* LM = LQ + 64 * 72; bf16_t* LY = LM + 64 * 72; bf16_t* LN = LY + 4096; float* LW = (float*)(LN + 4096);
    const int o = (tid >> 3) * 72 + (tid & 7) * 8;
    *(u32x4*)(LQ + o) = r.q; *(u32x4*)(LM + o) = r.m; *(u32x4*)(LY + tid * 8) = r.y; *(u32x4*)(LN + tid * 8) = r.n;
    if (tid < 16) *(u32x4*)(LW + 4 * tid) = r.w;
}
__device__ __forceinline__ void r2_step(const Ctx& C, f32x4 (&S)[4], const unsigned char* slot, int b, int h, int vt, int ck, int lane, int fr, int fq) {
    const bf16_t* LQ = (const bf16_t*)slot; const bf16_t* LM = LQ + 64 * 72; const bf16_t* LY = LM + 64 * 72; const bf16_t* LN = LY + 4096; const float* LW = (const float*)(LN + 4096);
    bf16x8 Sb[2];
#pragma unroll
    for (int ks = 0; ks < 2; ++ks) { u32x4 w; w.x = pk2(S[2 * ks][0], S[2 * ks][1]); w.y = pk2(S[2 * ks][2], S[2 * ks][3]); w.z = pk2(S[2 * ks + 1][0], S[2 * ks + 1][1]); w.w = pk2(S[2 * ks + 1][2], S[2 * ks + 1][3]);
        Sb[ks] = __builtin_bit_cast(bf16x8, w); }
    f32x4 Sn[4];
#pragma unroll
    for (int c4 = 0; c4 < 4; ++c4) {
        const u32x2 nv = *(const u32x2*)(LN + ((c4 * 4 + vt) * 64 + lane) * 4); const f32x4 wl = *(const f32x4*)(LW + 16 * c4 + 4 * fq);
        f32x4 acc = (f32x4){__uint_as_float(nv.x << 16), __uint_as_float(nv.x & 0xffff0000u), __uint_as_float(nv.y << 16), __uint_as_float(nv.y & 0xffff0000u)};
        acc = acc + wl * S[c4];
#pragma unroll
        for (int ks = 0; ks < 2; ++ks) acc = MFMA16(*(const bf16x8*)(LM + (16 * c4 + fr) * 72 + 32 * ks + 8 * fq), Sb[ks], acc);
        Sn[c4] = acc;
    }
#pragma unroll
    for (int t4 = 0; t4 < 4; ++t4) {
        const u32x2 yv = *(const u32x2*)(LY + ((t4 * 4 + vt) * 64 + lane) * 4);
        f32x4 acc = (f32x4){__uint_as_float(yv.x << 16), __uint_as_float(yv.x & 0xffff0000u), __uint_as_float(yv.y << 16), __uint_as_float(yv.y & 0xffff0000u)};
#pragma unroll
        for (int ks = 0; ks < 2; ++ks) acc = MFMA16(*(const bf16x8*)(LQ + (16 * t4 + fr) * 72 + 32 * ks + 8 * fq), Sb[ks], acc);
        bf16_t* yo = C.proj() + (size_t)(b * NT + ck * 64 + 16 * t4 + 4 * fq) * NPAD + C_R + h * 64 + 16 * vt + fr;
#pragma unroll
        for (int r = 0; r < 4; ++r) yo[(size_t)r * NPAD] = f2bf(acc[r]);
    }
#pragma unroll
    for (int c4 = 0; c4 < 4; ++c4) S[c4] = Sn[c4];
}
__device__ __forceinline__ void rwkv_r2_wg(const Ctx& C, int b, int h) {
    const int tid = C.tid, lane = C.lane, wid = C.wid, fr = lane & 15, fq = lane >> 4;
    unsigned char* slot0 = C.lds; unsigned char* slot1 = C.lds + R2_SLOT;
    const size_t ch0 = (size_t)((b * 8 + h) * 64);
    f32x4 S[4];
#pragma unroll
    for (int i = 0; i < 4; ++i) S[i] = (f32x4){0.f, 0.f, 0.f, 0.f};
    R2Set r0, r1, r2, r3;
    __syncthreads();
    r2_issue(C, r0, ch0 + 0, tid); r2_issue(C, r1, ch0 + 1, tid); r2_issue(C, r2, ch0 + 2, tid); r2_issue(C, r3, ch0 + 3, tid);
    r2_put(r0, slot0, tid); r2_issue(C, r0, ch0 + 4, tid);
    LDS_BARRIER();
    for (int c = 0; c < NT / 64; c += 4) {
#define R2_ITER(i, rnext, snext, scur) do { const int cc = c + (i); const int cn = (cc + 5 < NT / 64) ? cc + 5 : NT / 64 - 1; \
        r2_put(rnext, snext, tid); r2_issue(C, rnext, ch0 + cn, tid);                  \
        if (wid < 4) r2_step(C, S, scur, b, h, wid, cc, lane, fr, fq); \
        LDS_BARRIER(); } while (0)
        R2_ITER(0, r1, slot1, slot0);
        R2_ITER(1, r2, slot0, slot1);
        R2_ITER(2, r3, slot1, slot0);
        R2_ITER(3, r0, slot0, slot1);
#undef R2_ITER
    }
}
constexpr int C_G = DIN;
__device__ __forceinline__ float* gate_ptr(bf16_t* proj, size_t m, int hm) { return (float*)(proj + m * NPAD + C_G) + 4 * hm; }

__device__ __forceinline__ void mlstm_gate_scan(const Ctx& C, int b, int hm, int ck) {
    const int lane = C.lane;
    const size_t mg = (size_t)(b * NT + ck * 64 + lane); const bf16_t* pr = C.proj() + mg * NPAD;
    const float ig = bf2f(pr[C_I + hm]) + C.b_i()[hm]; const float fp = bf2f(pr[C_F + hm]) + C.b_f()[hm];
    const float lf = (fp >= 0.f) ? -log1pf(expf(-fp)) : fp - log1pf(expf(fp));
    float bc = lf;
#pragma unroll
    for (int o = 1; o < 64; o <<= 1) { const float tv = __shfl_up(bc, o); if (lane >= o) bc += tv; }
    const float e = ig - bc; float pm = e;
#pragma unroll
    for (int o = 1; o < 64; o <<= 1) { const float tv = __shfl_up(pm, o); if (lane >= o) pm = fmaxf(pm, tv); }
    *(f32x4*)gate_ptr(C.proj(), mg, hm) = (f32x4){bc, e, pm, 0.f};
}
__device__ __forceinline__ void mlstm_m1_stream(const Ctx& C) {
    const int lane = C.lane; const bool isk = lane >= 32; const int ch = 16 * (lane & 31);
    const int col = (isk ? C_KM : C_Q) + ch; const int cw = (isk ? 512 : 0) + ch;
    float w[4][16], bias[16];
#pragma unroll
    for (int i = 0; i < 16; i += 4) { const f32x4 bv = *(const f32x4*)(C.conv_b() + cw + i); bias[i] = bv.x; bias[i + 1] = bv.y; bias[i + 2] = bv.z; bias[i + 3] = bv.w;
#pragma unroll
        for (int j = 0; j < 4; ++j) { const f32x4 wv = *(const f32x4*)(C.conv_w() + j * 1024 + cw + i); w[j][i] = wv.x; w[j][i + 1] = wv.y; w[j][i + 2] = wv.z; w[j][i + 3] = wv.w; } }
    const float osc = isk ? 0.08838834764831845f : 1.0f;
    bf16_t* dst = (isk ? C.kc() : C.qc()) + ch;
    for (int t0 = 16 * C.gw; t0 < NTOK; t0 += 16 * C.ngw) {
        const int tb = t0 & (NT - 1);
        u32x4 ring[7][2];
        const bf16_t* p0 = C.proj() + (size_t)t0 * NPAD + col;
#pragma unroll
        for (int k = 0; k < 7; ++k) {
            if (k < 3 && tb == 0) { ring[k][0] = (u32x4){0u, 0u, 0u, 0u}; ring[k][1] = ring[k][0]; }
            else { const bf16_t* p = p0 + (ptrdiff_t)(k - 3) * NPAD; ring[k][0] = *(const u32x4*)p; ring[k][1] = *(const u32x4*)(p + 8); }
        }
#pragma unroll
        for (int i = 0; i < 16; ++i) {
            const size_t m = (size_t)(t0 + i);
            float a[16], x0[16], x1[16], x2[16], x3[16];
            unpack8(ring[i % 7][0], x0); unpack8(ring[i % 7][1], x0 + 8); unpack8(ring[(i + 1) % 7][0], x1); unpack8(ring[(i + 1) % 7][1], x1 + 8);
            unpack8(ring[(i + 2) % 7][0], x2); unpack8(ring[(i + 2) % 7][1], x2 + 8); unpack8(ring[(i + 3) % 7][0], x3); unpack8(ring[(i + 3) % 7][1], x3 + 8);
            { const int rn = (i + 4 < 16) ? i + 4 : 15; const bf16_t* p = p0 + (size_t)rn * NPAD; ring[i % 7][0] = *(const u32x4*)p; ring[i % 7][1] = *(const u32x4*)(p + 8); }
#pragma unroll
            for (int c = 0; c < 16; ++c) { a[c] = bias[c] + w[0][c] * x0[c] + w[1][c] * x1[c] + w[2][c] * x2[c] + w[3][c] * x3[c]; a[c] = siluf_(a[c]) * osc; }
            *(u32x4*)(dst + m * 512) = pack8(a); *(u32x4*)(dst + m * 512 + 8) = pack8(a + 8);
        }
    }
}

__device__ __forceinline__ void mlstm_p0_item(const Ctx& C, int b, int hm, int ck) {
    const int lane = C.lane, fr = lane & 15, fq = lane >> 4;
    {
        const int it = (b << 8) | (ck << 2) | hm; const size_t m0 = (size_t)(b * NT + ck * 64);
        bf16_t* out = C.p0s() + (size_t)it * 4096;
        bf16x8 kf[4][4]; float es[4][4];
#pragma unroll
        for (int sj = 0; sj < 4; ++sj) {
#pragma unroll
            for (int ks = 0; ks < 4; ++ks) kf[sj][ks] = *(const bf16x8*)(C.kc() + (m0 + 16 * sj + fr) * 512 + hm * 128 + 32 * ks + 8 * fq);
#pragma unroll
            for (int r = 0; r < 4; ++r) es[sj][r] = gate_ptr(C.proj(), m0 + 16 * sj + 4 * fq + r, hm)[1]; }
#pragma unroll
        for (int ti = 0; ti < 4; ++ti) {
            bf16x8 qf[4];
#pragma unroll
            for (int ks = 0; ks < 4; ++ks) qf[ks] = *(const bf16x8*)(C.qc() + (m0 + 16 * ti + fr) * 512 + hm * 128 + 32 * ks + 8 * fq);
            const int t = 16 * ti + fr; const float pmt = gate_ptr(C.proj(), m0 + t, hm)[2];
#pragma unroll
            for (int sj = 0; sj < 4; ++sj) {
                f32x4 acc = (f32x4){0.f, 0.f, 0.f, 0.f};
                if (sj <= ti) {
#pragma unroll
                    for (int ks = 0; ks < 4; ++ks) acc = __builtin_amdgcn_mfma_f32_16x16x32_bf16(kf[sj][ks], qf[ks], acc, 0, 0, 0);
                }
                float o[4];
#pragma unroll
                for (int r = 0; r < 4; ++r) { const int s = 16 * sj + 4 * fq + r; o[r] = (sj <= ti && s <= t) ? acc[r] * fexp(es[sj][r] - pmt) : 0.f; }
                u32x2 w; w.x = pk2(o[0], o[1]); w.y = pk2(o[2], o[3]); *(u32x2*)(out + t * 64 + 16 * sj + 4 * fq) = w;
            }
        }
    }
}

#define LDS_WAIT_ALL() asm volatile("s_waitcnt lgkmcnt(0)" ::: "memory")
constexpr int VS = 52;
constexpr int ML_BUF = (2 * 64 * 136 + 2 * 64 * VS + 64 * 72) * 2 + 1280;
template <int VAR> __device__ __forceinline__ void mlstm_item(const Ctx& C, int b, int hm, int sl) {
    constexpr bool st_out = (VAR & 1) == 0;
    unsigned char* buf0 = C.lds; unsigned char* buf1 = C.lds + ML_BUF;
    bf16_t* LCb0 = (bf16_t*)(C.lds + 2 * ML_BUF); bf16_t* LCb1 = LCb0 + 48 * 136;
#define ML_Q(bf) ((bf16_t*)(bf))
#define ML_K(bf) (ML_Q(bf) + 64 * 136)
#define ML_V(bf) (ML_K(bf) + 64 * 136)
#define ML_WV(bf) (ML_V(bf) + 64 * VS)
#define ML_P(bf) (ML_WV(bf) + 64 * VS)
#define ML_F(bf) ((float*)(ML_P(bf) + 64 * 72))
    const int tid = C.tid, lane = C.lane, wid = C.wid;
    const int fr_ = lane & 15, fq_ = lane >> 4, tt_ = tid >> 3;
    __syncthreads();
    for (int e = tid; e < 2 * 48 * 136; e += NTHR) LCb0[e] = 0;
    for (int e = tid; e < 64 * VS; e += NTHR) { const bf16_t o = ((e % VS) == 32) ? (bf16_t)0x3f80 : (bf16_t)0; ML_V(buf0)[e] = o; ML_V(buf1)[e] = o; ML_WV(buf0)[e] = 0; ML_WV(buf1)[e] = 0; }
    for (int e = tid; e < 64 * 72; e += NTHR) { ML_P(buf0)[e] = 0; ML_P(buf1)[e] = 0; }
    const int cg8 = tid & 7, d0 = 16 * cg8;
    const int ti = wid >> 1, vtw = wid & 1;
    const int ct0_t = (wid < 4) ? ((wid == 0) ? 0 : (wid == 3 ? 2 : 1)) : ((wid == 4) ? 2 : 3), ct0_s = (wid < 4) ? ((wid == 2) ? 1 : 0) : ((wid == 4) ? 1 : wid - 5);
    const int ct1_t = (wid == 0) ? 2 : 3, ct1_s = (wid == 0) ? 2 : 3; const bool has2 = wid < 2;
    f32x4 Cst[3];
#pragma unroll
    for (int i = 0; i < 3; ++i) Cst[i] = (f32x4){0.f, 0.f, 0.f, 0.f};
    float mst = 0.f, carry_cur = 1.f, carry_nxt = 1.f;
    u32x4 pq0, pq1, pk0, pk1, pp; u32x2 pv; f32x4 pg, pgl; u32x4 pq0_b, pq1_b, pk0_b, pk1_b, pp_b; u32x2 pv_b; f32x4 pg_b, pgl_b;
    const bf16_t* p0base = C.p0s() + (size_t)(((b * 64) * 4 + hm)) * 4096 + tid * 8;
    {
        const size_t m = (size_t)(b * NT + tt_);
        const bf16_t* qs = C.qc() + m * 512 + hm * 128 + d0; const bf16_t* ks = C.kc() + m * 512 + hm * 128 + d0;
        pq0 = *(const u32x4*)qs; pq1 = *(const u32x4*)(qs + 8); pk0 = *(const u32x4*)ks; pk1 = *(const u32x4*)(ks + 8);
        pv = *(const u32x2*)(C.proj() + m * NPAD + C_VM + hm * 128 + sl * 32 + 4 * cg8);
        pg = *(const f32x4*)gate_ptr(C.proj(), m, hm); pgl = *(const f32x4*)gate_ptr(C.proj(), (size_t)(b * NT + 63), hm); pp = *(const u32x4*)p0base;
        const size_t m2 = m + 64; qs += 64 * 512; ks += 64 * 512;
        pq0_b = *(const u32x4*)qs; pq1_b = *(const u32x4*)(qs + 8); pk0_b = *(const u32x4*)ks; pk1_b = *(const u32x4*)(ks + 8);
        pv_b = *(const u32x2*)(C.proj() + m2 * NPAD + C_VM + hm * 128 + sl * 32 + 4 * cg8);
        pg_b = *(const f32x4*)gate_ptr(C.proj(), m2, hm); pgl_b = *(const f32x4*)gate_ptr(C.proj(), (size_t)(b * NT + 127), hm); pp_b = *(const u32x4*)(p0base + 4 * 4096);
    }
    __syncthreads();
    { const int kst = 0; const int fr = fr_, fq = fq_, tt = tt_;
        asm volatile("" :: "v"(pg.w), "v"(pgl.y), "v"(pgl.w));
        {
            const float mxl = fmaxf(mst, pgl.z); carry_nxt = fexp(mst - mxl);
            if constexpr ((VAR & 16) == 0) {
                const float ws = fexp(pg.y - mxl);
                *(u32x4*)(ML_Q(buf0) + tt * 136 + d0) = pq0; *(u32x4*)(ML_Q(buf0) + tt * 136 + d0 + 8) = pq1;
                *(u32x4*)(ML_K(buf0) + tt * 136 + d0) = pk0; *(u32x4*)(ML_K(buf0) + tt * 136 + d0 + 8) = pk1;
                const float v0 = __uint_as_float(pv.x << 16), v1 = __uint_as_float(pv.x & 0xffff0000u), v2 = __uint_as_float(pv.y << 16), v3 = __uint_as_float(pv.y & 0xffff0000u);
                *(u32x2*)(ML_V(buf0) + tt * VS + 4 * cg8) = pv; *(u32x4*)(ML_P(buf0) + tt * 72 + 8 * cg8) = pp;
                u32x2 wv; wv.x = pk2(v0 * ws, v1 * ws); wv.y = pk2(v2 * ws, v3 * ws); *(u32x2*)(ML_WV(buf0) + tt * VS + 4 * cg8) = wv;
                if (cg8 == 0) { ML_WV(buf0)[tt * VS + 32] = f2bf(ws); const float mx = fmaxf(mst, pg.z); float* F = ML_F(buf0); F[tt] = pg.y; F[64 + tt] = mx; F[128 + tt] = fexp(mst - mx); F[192 + tt] = fexp(-(pg.x + mx)); F[256 + tt] = fexp(pg.z - mx); }
            }
            mst = pgl.x + mxl;
            const int cn = (kst + 2 < NT / 64) ? kst + 2 : NT / 64 - 1;
            const size_t m = (size_t)(b * NT + cn * 64 + tt);
            const bf16_t* qs = C.qc() + m * 512 + hm * 128 + d0; const bf16_t* ks = C.kc() + m * 512 + hm * 128 + d0;
            pq0 = *(const u32x4*)qs; pq1 = *(const u32x4*)(qs + 8); pk0 = *(const u32x4*)ks; pk1 = *(const u32x4*)(ks + 8);
            pv = *(const u32x2*)(C.proj() + m * NPAD + C_VM + hm * 128 + sl * 32 + 4 * cg8);
            pg = *(const f32x4*)gate_ptr(C.proj(), m, hm); pgl = *(const f32x4*)gate_ptr(C.proj(), (size_t)(b * NT + cn * 64 + 63), hm); pp = *(const u32x4*)(p0base + (size_t)cn * 4 * 4096);
        }
    }
    carry_cur = carry_nxt;
    LDS_BARRIER();
    { const int kc = 0; const int fr = fr_, fq = fq_;
    }
    for (int ck2 = 0; ck2 < NT / 64; ck2 += 2) {
      { const int ck = ck2;
        int fr = fr_, fq = fq_, tt = tt_; asm volatile("" : "+v"(fr), "+v"(fq), "+v"(tt));
        { const int kst = ck + 1;
        asm volatile("" :: "v"(pg_b.w), "v"(pgl_b.y), "v"(pgl_b.w));
        {
            const float mxl = fmaxf(mst, pgl_b.z); carry_nxt = fexp(mst - mxl);
            if constexpr ((VAR & 16) == 0) {
                const float ws = fexp(pg_b.y - mxl);
                *(u32x4*)(ML_Q(buf1) + tt * 136 + d0) = pq0_b; *(u32x4*)(ML_Q(buf1) + tt * 136 + d0 + 8) = pq1_b;
                *(u32x4*)(ML_K(buf1) + tt * 136 + d0) = pk0_b; *(u32x4*)(ML_K(buf1) + tt * 136 + d0 + 8) = pk1_b;
                const float v0 = __uint_as_float(pv_b.x << 16), v1 = __uint_as_float(pv_b.x & 0xffff0000u), v2 = __uint_as_float(pv_b.y << 16), v3 = __uint_as_float(pv_b.y & 0xffff0000u);
                *(u32x2*)(ML_V(buf1) + tt * VS + 4 * cg8) = pv_b; *(u32x4*)(ML_P(buf1) + tt * 72 + 8 * cg8) = pp_b;
                u32x2 wv; wv.x = pk2(v0 * ws, v1 * ws); wv.y = pk2(v2 * ws, v3 * ws); *(u32x2*)(ML_WV(buf1) + tt * VS + 4 * cg8) = wv;
                if (cg8 == 0) { ML_WV(buf1)[tt * VS + 32] = f2bf(ws); const float mx = fmaxf(mst, pg_b.z); float* F = ML_F(buf1); F[tt] = pg_b.y; F[64 + tt] = mx; F[128 + tt] = fexp(mst - mx); F[192 + tt] = fexp(-(pg_b.x + mx)); F[256 + tt] = fexp(pg_b.z - mx); }
            }
            mst = pgl_b.x + mxl;
            const int cn = (kst + 2 < NT / 64) ? kst + 2 : NT / 64 - 1;
            const size_t m = (size_t)(b * NT + cn * 64 + tt);
            const bf16_t* qs = C.qc() + m * 512 + hm * 128 + d0; const bf16_t* ks = C.kc() + m * 512 + hm * 128 + d0;
            pq0_b = *(const u32x4*)qs; pq1_b = *(const u32x4*)(qs + 8); pk0_b = *(const u32x4*)ks; pk1_b = *(const u32x4*)(ks + 8);
            pv_b = *(const u32x2*)(C.proj() + m * NPAD + C_VM + hm * 128 + sl * 32 + 4 * cg8);
            pg_b = *(const f32x4*)gate_ptr(C.proj(), m, hm); pgl_b = *(const f32x4*)gate_ptr(C.proj(), (size_t)(b * NT + cn * 64 + 63), hm); pp_b = *(const u32x4*)(p0base + (size_t)cn * 4 * 4096);
        }
        }
        { const int kc = ck + 1;
        }
        {
            const int mbase = b * NT + ck * 64;
            const bf16_t* LQ = ML_Q(buf0); const bf16_t* LK = ML_K(buf0); const bf16_t* LV = ML_V(buf0); const bf16_t* LWV = ML_WV(buf0); const bf16_t* LP = ML_P(buf0); const float* F = ML_F(buf0);
            const bf16_t* LCr = LCb0; bf16_t* LCw = LCb1;
            bf16x8 fp[2], fvr[2], fvd[2], fqq[4], fcr[4], fcd[4], kf[2], fw[3][2]; float inr[4], clr[4], rsr[4];
#pragma unroll
            for (int ks = 0; ks < 2; ++ks) { fp[ks] = *(const bf16x8*)(LP + (16 * ti + fr) * 72 + 32 * ks + 8 * fq); fvr[ks] = tr_frag(LV, VS, 32 * ks, 16 * vtw, fr, fq); fvd[ks] = tr_frag(LV, VS, 32 * ks, 32, fr, fq); }
#pragma unroll
            for (int ks = 0; ks < 4; ++ks) { fqq[ks] = *(const bf16x8*)(LQ + (16 * ti + fr) * 136 + 32 * ks + 8 * fq); fcr[ks] = *(const bf16x8*)(LCr + (16 * vtw + fr) * 136 + 32 * ks + 8 * fq); fcd[ks] = *(const bf16x8*)(LCr + (32 + fr) * 136 + 32 * ks + 8 * fq); }
#pragma unroll
            for (int ks = 0; ks < 2; ++ks) { kf[ks] = tr_frag(LK, 136, 32 * ks, 16 * wid, fr, fq);
#pragma unroll
                for (int vt2 = 0; vt2 < 3; ++vt2) fw[vt2][ks] = tr_frag(LWV, VS, 32 * ks, 16 * vt2, fr, fq); }
#pragma unroll
            for (int r = 0; r < 4; ++r) { inr[r] = F[128 + 16 * ti + 4 * fq + r]; clr[r] = F[192 + 16 * ti + 4 * fq + r]; rsr[r] = F[256 + 16 * ti + 4 * fq + r]; }
            LDS_WAIT_ALL();
            f32x4 numr = (f32x4){0.f, 0.f, 0.f, 0.f}, numd = numr;
            if constexpr ((VAR & 4) == 0) {
                f32x4 a1r = (f32x4){0.f, 0.f, 0.f, 0.f}, a1d = a1r, a2r = a1r, a2d = a1r;
#pragma unroll
                for (int ks = 0; ks < 2; ++ks) { a1r = __builtin_amdgcn_mfma_f32_16x16x32_bf16(fp[ks], fvr[ks], a1r, 0, 0, 0); a1d = __builtin_amdgcn_mfma_f32_16x16x32_bf16(fp[ks], fvd[ks], a1d, 0, 0, 0); }
#pragma unroll
                for (int ks = 0; ks < 4; ++ks) { a2r = __builtin_amdgcn_mfma_f32_16x16x32_bf16(fqq[ks], fcr[ks], a2r, 0, 0, 0); a2d = __builtin_amdgcn_mfma_f32_16x16x32_bf16(fqq[ks], fcd[ks], a2d, 0, 0, 0); }
#pragma unroll
                for (int r = 0; r < 4; ++r) { numr[r] = rsr[r] * a1r[r] + inr[r] * a2r[r]; numd[r] = rsr[r] * a1d[r] + inr[r] * a2d[r]; }
            }
            if constexpr ((VAR & 8) == 0) {
#pragma unroll
                for (int vt2 = 0; vt2 < 3; ++vt2) {
                    f32x4 acc = Cst[vt2] * carry_cur;
#pragma unroll
                    for (int ks = 0; ks < 2; ++ks) acc = __builtin_amdgcn_mfma_f32_16x16x32_bf16(fw[vt2][ks], kf[ks], acc, 0, 0, 0);
                    Cst[vt2] = acc;
#pragma unroll
                    for (int r = 0; r < 4; ++r) LCw[(16 * vt2 + 4 * fq + r) * 136 + 16 * wid + fr] = f2bf(acc[r]);
                }
            }
#pragma unroll
            for (int r = 0; r < 4; ++r) { const int t = 16 * ti + 4 * fq + r;
                const float den = __shfl(numd[r], lane & 48);
                const float dv = fmaxf(fabsf(den), clr[r]);
                if (st_out) C.proj()[(size_t)(mbase + t) * NPAD + C_VM + hm * 128 + sl * 32 + 16 * vtw + fr] = f2bf(numr[r] * frcp(dv)); }
        }
        carry_cur = carry_nxt;
        LDS_BARRIER();
      }
      { const int ck = ck2 + 1;
        int fr = fr_, fq = fq_, tt = tt_; asm volatile("" : "+v"(fr), "+v"(fq), "+v"(tt));
        { const int kst = ck + 1;
        asm volatile("" :: "v"(pg.w), "v"(pgl.y), "v"(pgl.w));
        {
            const float mxl = fmaxf(mst, pgl.z); carry_nxt = fexp(mst - mxl);
            if constexpr ((VAR & 16) == 0) {
                const float ws = fexp(pg.y - mxl);
                *(u32x4*)(ML_Q(buf0) + tt * 136 + d0) = pq0; *(u32x4*)(ML_Q(buf0) + tt * 136 + d0 + 8) = pq1;
                *(u32x4*)(ML_K(buf0) + tt * 136 + d0) = pk0; *(u32x4*)(ML_K(buf0) + tt * 136 + d0 + 8) = pk1;
                const float v0 = __uint_as_float(pv.x << 16), v1 = __uint_as_float(pv.x & 0xffff0000u), v2 = __uint_as_float(pv.y << 16), v3 = __uint_as_float(pv.y & 0xffff0000u);
                *(u32x2*)(ML_V(buf0) + tt * VS + 4 * cg8) = pv; *(u32x4*)(ML_P(buf0) + tt * 72 + 8 * cg8) = pp;
                u32x2 wv; wv.x = pk2(v0 * ws, v1 * ws); wv.y = pk2(v2 * ws, v3 * ws); *(u32x2*)(ML_WV(buf0) + tt * VS + 4 * cg8) = wv;
                if (cg8 == 0) { ML_WV(buf0)[tt * VS + 32] = f2bf(ws); const float mx = fmaxf(mst, pg.z); float* F = ML_F(buf0); F[tt] = pg.y; F[64 + tt] = mx; F[128 + tt] = fexp(mst - mx); F[192 + tt] = fexp(-(pg.x + mx)); F[256 + tt] = fexp(pg.z - mx); }
            }
            mst = pgl.x + mxl;
            const int cn = (kst + 2 < NT / 64) ? kst + 2 : NT / 64 - 1;
            const size_t m = (size_t)(b * NT + cn * 64 + tt);
            const bf16_t* qs = C.qc() + m * 512 + hm * 128 + d0; const bf16_t* ks = C.kc() + m * 512 + hm * 128 + d0;
            pq0 = *(const u32x4*)qs; pq1 = *(const u32x4*)(qs + 8); pk0 = *(const u32x4*)ks; pk1 = *(const u32x4*)(ks + 8);
            pv = *(const u32x2*)(C.proj() + m * NPAD + C_VM + hm * 128 + sl * 32 + 4 * cg8);
            pg = *(const f32x4*)gate_ptr(C.proj(), m, hm); pgl = *(const f32x4*)gate_ptr(C.proj(), (size_t)(b * NT + cn * 64 + 63), hm); pp = *(const u32x4*)(p0base + (size_t)cn * 4 * 4096);
        }
        }
        { const int kc = ck + 1;
        }
        {
            const int mbase = b * NT + ck * 64;
            const bf16_t* LQ = ML_Q(buf1); const bf16_t* LK = ML_K(buf1); const bf16_t* LV = ML_V(buf1); const bf16_t* LWV = ML_WV(buf1); const bf16_t* LP = ML_P(buf1); const float* F = ML_F(buf1);
            const bf16_t* LCr = LCb1; bf16_t* LCw = LCb0;
            bf16x8 fp[2], fvr[2], fvd[2], fqq[4], fcr[4], fcd[4], kf[2], fw[3][2]; float inr[4], clr[4], rsr[4];
#pragma unroll
            for (int ks = 0; ks < 2; ++ks) { fp[ks] = *(const bf16x8*)(LP + (16 * ti + fr) * 72 + 32 * ks + 8 * fq); fvr[ks] = tr_frag(LV, VS, 32 * ks, 16 * vtw, fr, fq); fvd[ks] = tr_frag(LV, VS, 32 * ks, 32, fr, fq); }
#pragma unroll
            for (int ks = 0; ks < 4; ++ks) { fqq[ks] = *(const bf16x8*)(LQ + (16 * ti + fr) * 136 + 32 * ks + 8 * fq); fcr[ks] = *(const bf16x8*)(LCr + (16 * vtw + fr) * 136 + 32 * ks + 8 * fq); fcd[ks] = *(const bf16x8*)(LCr + (32 + fr) * 136 + 32 * ks + 8 * fq); }
#pragma unroll
            for (int ks = 0; ks < 2; ++ks) { kf[ks] = tr_frag(LK, 136, 32 * ks, 16 * wid, fr, fq);
#pragma unroll
                for (int vt2 = 0; vt2 < 3; ++vt2) fw[vt2][ks] = tr_frag(LWV, VS, 32 * ks, 16 * vt2, fr, fq); }
#pragma unroll
            for (int r = 0; r < 4; ++r) { inr[r] = F[128 + 16 * ti + 4 * fq + r]; clr[r] = F[192 + 16 * ti + 4 * fq + r]; rsr[r] = F[256 + 16 * ti + 4 * fq + r]; }
            LDS_WAIT_ALL();
            f32x4 numr = (f32x4){0.f, 0.f, 0.f, 0.f}, numd = numr;
            if constexpr ((VAR & 4) == 0) {
                f32x4 a1r = (f32x4){0.f, 0.f, 0.f, 0.f}, a1d = a1r, a2r = a1r, a2d = a1r;
#pragma unroll
                for (int ks = 0; ks < 2; ++ks) { a1r = __builtin_amdgcn_mfma_f32_16x16x32_bf16(fp[ks], fvr[ks], a1r, 0, 0, 0); a1d = __builtin_amdgcn_mfma_f32_16x16x32_bf16(fp[ks], fvd[ks], a1d, 0, 0, 0); }
#pragma unroll
                for (int ks = 0; ks < 4; ++ks) { a2r = __builtin_amdgcn_mfma_f32_16x16x32_bf16(fqq[ks], fcr[ks], a2r, 0, 0, 0); a2d = __builtin_amdgcn_mfma_f32_16x16x32_bf16(fqq[ks], fcd[ks], a2d, 0, 0, 0); }
#pragma unroll
                for (int r = 0; r < 4; ++r) { numr[r] = rsr[r] * a1r[r] + inr[r] * a2r[r]; numd[r] = rsr[r] * a1d[r] + inr[r] * a2d[r]; }
            }
            if constexpr ((VAR & 8) == 0) {
#pragma unroll
                for (int vt2 = 0; vt2 < 3; ++vt2) {
                    f32x4 acc = Cst[vt2] * carry_cur;
#pragma unroll
                    for (int ks = 0; ks < 2; ++ks) acc = __builtin_amdgcn_mfma_f32_16x16x32_bf16(fw[vt2][ks], kf[ks], acc, 0, 0, 0);
                    Cst[vt2] = acc;
#pragma unroll
                    for (int r = 0; r < 4; ++r) LCw[(16 * vt2 + 4 * fq + r) * 136 + 16 * wid + fr] = f2bf(acc[r]);
                }
            }
#pragma unroll
            for (int r = 0; r < 4; ++r) { const int t = 16 * ti + 4 * fq + r;
                const float den = __shfl(numd[r], lane & 48);
                const float dv = fmaxf(fabsf(den), clr[r]);
                if (st_out) C.proj()[(size_t)(mbase + t) * NPAD + C_VM + hm * 128 + sl * 32 + 16 * vtw + fr] = f2bf(numr[r] * frcp(dv)); }
        }
        carry_cur = carry_nxt;
        LDS_BARRIER();
      }
    }
#undef ML_Q
#undef ML_K
#undef ML_V
#undef ML_WV
#undef ML_P
#undef ML_F
}
__device__ __forceinline__ void phase3(const Ctx& C, int sub) {
    const int g = blockIdx.x;
    if (sub == 0 || sub == 1) {
        mlstm_m1_stream(C);
        asm volatile("s_waitcnt vmcnt(0)" ::: "memory"); __syncthreads();
        const int bb = g >> 5, ck = 2 * (g & 31) + (C.wid >> 2), hm = C.wid & 3;
        mlstm_gate_scan(C, bb, hm, ck);
        asm volatile("s_waitcnt vmcnt(0)" ::: "memory");
        mlstm_p0_item(C, bb, hm, ck);
    }
    if (sub >= 3) rwkv_r1_wg<(PROBE_SUB >= 3 ? PROBE_SUB : 0) | 1>(C, g >> 5, (g >> 2) & 7, (g & 3) * 16, 16); else if (sub != 1) rwkv_r1_wg<0>(C, g >> 5, (g >> 2) & 7, (g & 3) * 16, 16);
}
__device__ __forceinline__ void phase4(const Ctx& C, int sub) {
    for (int item = blockIdx.x; item < 256; item += gridDim.x) {
        if (item < 64) { if (sub != 2 && sub != 3) rwkv_r2_wg(C, item >> 3, item & 7); }
        else if (item < 128) { }
        else { const int i = item - 128; if (sub == 3) mlstm_item<PROBE_SUB | 1>(C, i >> 4, (i >> 2) & 3, i & 3); else if (sub != 1) mlstm_item<0>(C, i >> 4, (i >> 2) & 3, i & 3); }
        __syncthreads();
    }
}

__device__ __forceinline__ void ld8f(const float* p, float* o) { const f32x4 a = *(const f32x4*)p, b = *(const f32x4*)(p + 4); o[0] = a.x; o[1] = a.y; o[2] = a.z; o[3] = a.w; o[4] = b.x; o[5] = b.y; o[6] = b.z; o[7] = b.w; }
__device__ __forceinline__ void phase5(const Ctx& C) {
    const int lane = C.lane; const int c0 = 8 * lane;
    float muv[8], gnw[8], gnb[8], lnw[8], skp[8];
    ld8f(C.mu() + C_V + c0, muv); ld8f(C.gn_w() + c0, gnw); ld8f(C.gn_b() + c0, gnb); ld8f(C.ln_w() + c0, lnw); ld8f(C.skip() + c0, skp);
    for (int m = C.gw; m < NTOK; m += C.ngw) {
        const bool hp = (m & (NT - 1)) != 0;
        const bf16_t* pc = C.proj() + (size_t)m * NPAD; bf16_t* yo = C.ymix() + (size_t)m * DM;
        float outr[8], outm[8];
        {
            float y[8], v[8], pv[8], z[8];
            unpack8(*(const u32x4*)(pc + C_R + c0), y);
            unpack8(*(const u32x4*)(pc + C_V + c0), v); unpack8(*(const u32x4*)(pc + C_ZR + c0), z);
            unpack8(*(const u32x4*)((m > 0 ? pc - NPAD : pc) + C_V + c0), pv);
            if (!hp) {
#pragma unroll
                for (int i = 0; i < 8; ++i) { pv[i] = 0.f; } }
            float s = 0.f; const float bs = C.bonus()[(size_t)m * 8 + (lane >> 3)];
#pragma unroll
            for (int i = 0; i < 8; ++i) { v[i] += muv[i] * (pv[i] - v[i]); s += y[i]; }
            s += __shfl_xor(s, 1); s += __shfl_xor(s, 2); s += __shfl_xor(s, 4);
            const float mean = s * (1.0f / 64.0f); float q = 0.f;
#pragma unroll
            for (int i = 0; i < 8; ++i) { y[i] -= mean; q += y[i] * y[i]; }
            q += __shfl_xor(q, 1); q += __shfl_xor(q, 2); q += __shfl_xor(q, 4);
            const float rstd = __builtin_amdgcn_rsqf(q * (1.0f / 64.0f) + 64e-5f);
#pragma unroll
            for (int i = 0; i < 8; ++i) { const float yn = y[i] * rstd * gnw[i] + gnb[i]; outr[i] = (yn + bs * v[i]) * siluf_(z[i]); }
        }
        {
            float h[8], o[8], z[8], qc[8];
            unpack8(*(const u32x4*)(pc + C_VM + c0), h);
            unpack8(*(const u32x4*)(pc + C_O + c0), o); unpack8(*(const u32x4*)(pc + C_ZM + c0), z); unpack8(*(const u32x4*)(C.qc() + (size_t)m * 512 + c0), qc);
            float s = 0.f;
#pragma unroll
            for (int i = 0; i < 8; ++i) s += h[i];
            s += __shfl_xor(s, 1); s += __shfl_xor(s, 2); s += __shfl_xor(s, 4); s += __shfl_xor(s, 8);
            const float mean = s * (1.0f / 128.0f); float q = 0.f;
#pragma unroll
            for (int i = 0; i < 8; ++i) { h[i] -= mean; q += h[i] * h[i]; }
            q += __shfl_xor(q, 1); q += __shfl_xor(q, 2); q += __shfl_xor(q, 4); q += __shfl_xor(q, 8);
            const float rstd = __builtin_amdgcn_rsqf(q * (1.0f / 128.0f) + 1e-6f);
#pragma unroll
            for (int i = 0; i < 8; ++i) { const float hn = h[i] * rstd * lnw[i]; outm[i] = (sigmoidf_(o[i]) * hn + skp[i] * qc[i]) * siluf_(z[i]); }
        }
        *(u32x4*)(yo + c0) = pack8(outr);
        *(u32x4*)(yo + 512 + c0) = pack8(outm);
    }
}

struct RowIn { f32x4 x[4]; u32x4 mx[2]; };
__device__ __forceinline__ void p7_load(const Ctx& C, RowIn& r, int m) {
    const f32x4* xr = (const f32x4*)(C.x() + (size_t)m * DM) + C.lane;
#pragma unroll
    for (int j = 0; j < 4; ++j) r.x[j] = __builtin_nontemporal_load(xr + 64 * j);
    const u32x2* mr = (const u32x2*)(C.mixo() + (size_t)m * DM) + C.lane;
    const u32x2 a0 = __builtin_nontemporal_load(mr), a1 = __builtin_nontemporal_load(mr + 64), a2 = __builtin_nontemporal_load(mr + 128), a3 = __builtin_nontemporal_load(mr + 192);
    r.mx[0] = (u32x4){a0.x, a0.y, a1.x, a1.y}; r.mx[1] = (u32x4){a2.x, a2.y, a3.x, a3.y};
}
template <int VAR> __device__ __forceinline__ void phase7(const Ctx& C) {
    f32x4 g[4];
#pragma unroll
    for (int j = 0; j < 4; ++j) g[j] = *(const f32x4*)(C.fgain() + 4 * C.lane + 256 * j);
    RowIn cur, nx1; p7_load(C, cur, C.gw); p7_load(C, nx1, C.gw + C.ngw);
    if constexpr ((VAR & 2) != 0) { asm volatile("" : "+v"(cur.x[0]), "+v"(nx1.x[0])); }
    f32x4 gtv[4]; int bcur = -1;
    for (int m = C.gw; m < NTOK; m += C.ngw) {
        const int b = m >> 12; const int mn = (m + 2 * C.ngw < NTOK) ? m + 2 * C.ngw : m;
        if (b != bcur) { bcur = b;
#pragma unroll
            for (int j = 0; j < 4; ++j) gtv[j] = *(const f32x4*)(C.ada() + b * 3072 + 2048 + 4 * C.lane + 256 * j); }
        RowIn nxt; if constexpr ((VAR & 2) == 0) p7_load(C, nxt, mn); else nxt = nx1;
        f32x4 h[4]; float s = 0.f;
#pragma unroll
        for (int j = 0; j < 4; ++j) {
            const f32x4 gt = gtv[j];
            const unsigned w0 = (j & 1) ? cur.mx[j >> 1].z : cur.mx[j >> 1].x, w1 = (j & 1) ? cur.mx[j >> 1].w : cur.mx[j >> 1].y;
            const f32x4 mv = (f32x4){__uint_as_float(w0 << 16), __uint_as_float(w0 & 0xffff0000u), __uint_as_float(w1 << 16), __uint_as_float(w1 & 0xffff0000u)};
            h[j] = cur.x[j] + gt * mv; s += (h[j].x * h[j].x + h[j].y * h[j].y) + (h[j].z * h[j].z + h[j].w * h[j].w); }
        const float rs = __builtin_amdgcn_rsqf(wave_sum(s) * (1.0f / DM) + 1e-6f);
        f32x4* o = (f32x4*)(C.out() + (size_t)m * DM) + C.lane;
#pragma unroll
        for (int j = 0; j < 4; ++j) { if constexpr ((VAR & 1) == 0) __builtin_nontemporal_store(h[j] * rs * g[j], o + 64 * j); else asm volatile("" :: "v"(h[j] * rs * g[j])); }
        cur = nx1; nx1 = nxt;
    }
}

#define LAS __attribute__((address_space(3)))
#define XB_TMO      128
#define XB_XCNT(j)  (256  + 64 * (j))
#define XB_XSUB(j)  (1280 + 64 * (j))
#define XB_XGEN(j)  (2304 + 64 * (j))
#define XB_TOP      3328
#define XB_TOPGEN   3392
#define XCD_BAR_WORDS 3456
#define XB_SPIN_CAP (1u << 18)

__device__ __forceinline__ unsigned xb_ld(unsigned* p)              { return __hip_atomic_load(p, __ATOMIC_RELAXED, __HIP_MEMORY_SCOPE_AGENT); }
__device__ __forceinline__ unsigned xb_add(unsigned* p, unsigned v) { return __hip_atomic_fetch_add(p, v, __ATOMIC_RELAXED, __HIP_MEMORY_SCOPE_AGENT); }
__device__ __forceinline__ unsigned xb_xcc_id() { return (unsigned)__builtin_amdgcn_s_getreg((3 << 11) | 20) & 0xFu; }
#define XB_SPIN(cond, bar) do { unsigned _sp = 0; while (cond) { __builtin_amdgcn_s_sleep(1); \
    if ((++_sp & 255u) == 0u) { if (xb_ld(&(bar)[XB_TMO])) break; if (_sp > XB_SPIN_CAP) { atomicAdd(&(bar)[XB_TMO], 1u); break; } } } } while (0)

struct XcdBarrier {
    unsigned* bar; unsigned x;
    volatile LAS unsigned* st;
};

__device__ __forceinline__ XcdBarrier xcd_barrier_post(unsigned* bar, volatile LAS unsigned* st) {
    XcdBarrier b; b.bar = bar; b.x = xb_xcc_id(); b.st = st;
    if (threadIdx.x == 0) (void)xb_add(&bar[XB_XCNT(b.x)], 1u);
    return b;
}
__device__ __forceinline__ void xcd_barrier_complete(unsigned* bar, unsigned x, unsigned& nloc, unsigned& nx) {
    const unsigned G = gridDim.x * gridDim.y * gridDim.z;
    unsigned sum, cnt, mine, sp = 0u;
    for (;;) {
        sum = 0u; cnt = 0u; mine = 0u;
#pragma unroll
        for (unsigned j = 0; j < 16; ++j) { const unsigned c = xb_ld(&bar[XB_XCNT(j)]); sum += c; cnt += (c > 0u) ? 1u : 0u; mine = (j == x) ? c : mine; }
        if (sum == G) break;
        __builtin_amdgcn_s_sleep(1);
        if ((++sp & 255u) == 0u) { if (xb_ld(&bar[XB_TMO])) break; if (sp > XB_SPIN_CAP) { atomicAdd(&bar[XB_TMO], 1u); break; } }
    }
    nloc = mine > 0u ? mine : 1u; nx = cnt > 0u ? cnt : 1u;
}

__device__ __forceinline__ void xcd_barrier(const XcdBarrier& b) {
    asm volatile("s_waitcnt vmcnt(0)" ::: "memory");
    __syncthreads();
    if (threadIdx.x == 0) {
        unsigned* bar = b.bar;
        __builtin_amdgcn_s_waitcnt(0);
        unsigned nloc = b.st[0], nx = b.st[1];
        if (nloc == 0u) { xcd_barrier_complete(bar, b.x, nloc, nx); b.st[0] = nloc; b.st[1] = nx; }
        const unsigned old = xb_add(&bar[XB_XSUB(b.x)], 1u);
        const unsigned gen = old / nloc;
        if (old + 1u == (gen + 1u) * nloc) {
            __builtin_amdgcn_fence(__ATOMIC_RELEASE, "agent");
            asm volatile("s_waitcnt vmcnt(0)" ::: "memory");
            const unsigned og = xb_add(&bar[XB_TOP], 1u);
            const unsigned tg = og / nx;
            if (og + 1u == (tg + 1u) * nx) xb_add(&bar[XB_TOPGEN], 1u);
            else XB_SPIN(xb_ld(&bar[XB_TOPGEN]) == tg, bar);
            __builtin_amdgcn_fence(__ATOMIC_ACQUIRE, "agent");
            xb_add(&bar[XB_XGEN(b.x)], 1u);
            asm volatile("s_waitcnt vmcnt(0)" ::: "memory");
        } else {
            XB_SPIN(xb_ld(&bar[XB_XGEN(b.x)]) == gen, bar);
            __builtin_amdgcn_fence(__ATOMIC_ACQUIRE, "agent");
            asm volatile("s_waitcnt vmcnt(0)" ::: "memory");
        }
    }
    __syncthreads();
}

#ifndef PROBE_REP
#define PROBE_REP -1
#endif
#ifndef PROBE_SUB
#define PROBE_SUB 0
#endif
__global__ void __launch_bounds__(NTHR, 2) fwd_kernel(Params p) {
    extern __shared__ __attribute__((aligned(16))) unsigned char lds_raw[];
    cg::grid_group grid = cg::this_grid();
    Ctx C{p};
    C.lds = lds_raw; C.tid = threadIdx.x; C.lane = C.tid & 63; C.wid = __builtin_amdgcn_readfirstlane(C.tid >> 6);
    C.gw = blockIdx.x * NWV + C.wid; C.ngw = gridDim.x * NWV;
    const int lo = p.ph_lo, hi = p.ph_hi;
    unsigned* barw = (unsigned*)(p.ws + WS_CTL);
    volatile LAS unsigned* bst = (volatile LAS unsigned*)((LAS unsigned char*)lds_raw + LDS_BYTES - 16);
    if (threadIdx.x < 4) bst[threadIdx.x] = 0u;
    if (blockIdx.x == 0) for (int e = threadIdx.x; e < XCD_BAR_WORDS; e += NTHR) barw[e] = 0u;
    XcdBarrier xbar; xbar.bar = barw; xbar.x = 0; xbar.st = bst;
#define RUN(k) (lo <= (k) && (k) < hi)
#define GSYNC() xcd_barrier(xbar)
#define SEAM(k) do { if (RUN(k) && RUN((k) + 1)) GSYNC(); } while (0)
    if (RUN(0)) phase0(C);
    if (RUN(0) && RUN(1)) { grid.sync(); xbar = xcd_barrier_post(barw, bst); }
#if PROBE_REP == 8
    GSYNC(); GSYNC(); GSYNC(); GSYNC(); GSYNC(); GSYNC(); GSYNC(); GSYNC();
#endif
    if (RUN(1)) { phase1(C); weight_copies(C); }
#if PROBE_REP == 1
    GSYNC(); phase0(C); GSYNC(); phase1(C); weight_copies(C);
#endif
    SEAM(1);
    if (RUN(2)) {
        pg8::Gemm g{C.hn(), C.win_t(), NTOK, NPAD, DM}; pg8::StaticOrder S; S.init(NTOK, NPAD, (int)gridDim.x, (int)blockIdx.x);
        pg8::EpiBf16<0> E{C.proj(), NPAD, nullptr, 0, 0};
        pg8::gemm_phase<pg8::EpiBf16<0>, pg8::StaticOrder, false>((PG8_LAS unsigned char*)lds_raw, g, S, E, nullptr);
#if PROBE_REP == 2
        GSYNC(); pg8::gemm_phase<pg8::EpiBf16<0>, pg8::StaticOrder, false>((PG8_LAS unsigned char*)lds_raw, g, S, E, nullptr);
#endif
    }
    SEAM(2);
    if (RUN(3)) phase3(C, 0);
#if PROBE_REP == 3
    GSYNC(); phase3(C, PROBE_SUB);
#endif
    SEAM(3);
#if PROBE_REP == 6
    phase4(C, 3); GSYNC();
#endif
    if (RUN(4)) phase4(C, 0);
#if PROBE_REP == 4
    GSYNC(); phase4(C, PROBE_SUB);
#endif
    SEAM(4);
    if (RUN(5)) phase5(C);
#if PROBE_REP == 5
    GSYNC(); phase5(C);
#endif
    SEAM(5);
    if (RUN(6)) {
        pg8::Gemm g{C.ymix(), C.wout_t(), NTOK, DM, DM}; pg8::StaticOrder S; S.init(NTOK, DM, (int)gridDim.x, (int)blockIdx.x);
        pg8::EpiBf16<0> E{C.mixo(), DM, nullptr, 0, 0};
        pg8::gemm_phase<pg8::EpiBf16<0>, pg8::StaticOrder, false>((PG8_LAS unsigned char*)lds_raw, g, S, E, nullptr);
#if PROBE_REP == 7
        GSYNC(); pg8::gemm_phase<pg8::EpiBf16<0>, pg8::StaticOrder, false>((PG8_LAS unsigned char*)lds_raw, g, S, E, nullptr);
#endif
    }
    SEAM(6);
#if PROBE_REP == 9
    phase7<PROBE_SUB>(C); GSYNC();
#endif
    if (RUN(7)) phase7<0>(C);
#undef RUN
#undef SEAM
}

#ifndef N_LAUNCHES
#define N_LAUNCHES 1
#endif
extern "C" void kernel_launch(void* const* d_in, const int* in_sizes, int n_in, void* d_out, int out_size, void* d_ws, size_t ws_size, hipStream_t stream) {
    static int grid = 0;
    if (grid == 0) {
        if (n_in != 24 || out_size != NTOK * DM || ws_size < WS_END) { fprintf(stderr, "kernel_launch: unexpected shapes (n_in %d, out %d, ws %zu < %zu)\n", n_in, out_size, ws_size, (size_t)WS_END); grid = -1; return; }
        int dev = 0, cus = 0, per_cu = 0;
        hipGetDevice(&dev); hipDeviceGetAttribute(&cus, hipDeviceAttributeMultiprocessorCount, dev);
        if (hipFuncSetAttribute((const void*)fwd_kernel, hipFuncAttributeMaxDynamicSharedMemorySize, LDS_BYTES) != hipSuccess) { fprintf(stderr, "kernel_launch: hipFuncSetAttribute failed\n"); grid = -1; return; }
        if (hipOccupancyMaxActiveBlocksPerMultiprocessor(&per_cu, (const void*)fwd_kernel, NTHR, LDS_BYTES) != hipSuccess || per_cu < 1) { fprintf(stderr, "kernel_launch: occupancy query says %d\n", per_cu); per_cu = 1; }
        (void)hipGetLastError();
        if (cus < 256) { fprintf(stderr, "kernel_launch: this build needs 256 CUs (got %d)\n", cus); grid = -1; return; }
        grid = 256;
        fprintf(stderr, "kernel_launch: grid %d, per_cu %d\n", grid, per_cu);
    }
    if (grid < 0) return;
    Params p{};
    for (int i = 0; i < 24; ++i) p.in[i] = (const float*)d_in[i];
    p.out = (float*)d_out; p.ws = (unsigned char*)d_ws;
    if (N_LAUNCHES == 1) {
        p.ph_lo = 0; p.ph_hi = NPHASE; void* args[] = {&p};
        hipError_t e = hipLaunchCooperativeKernel((const void*)fwd_kernel, dim3(grid), dim3(NTHR), args, LDS_BYTES, stream);
        if (e != hipSuccess) fprintf(stderr, "cooperative launch failed: %s (grid %d)\n", hipGetErrorString(e), grid);
    } else {
        for (int ph = 0; ph < NPHASE; ++ph) { p.ph_lo = ph; p.ph_hi = ph + 1; hipLaunchKernelGGL(fwd_kernel, dim3(grid), dim3(NTHR), LDS_BYTES, stream, p); }
    }
}
```

```cpp
#include <hip/hip_runtime.h>
#include <hip/hip_cooperative_groups.h>
#include <cstdio>
#define PROBE_REP -1
#define PROBE_SUB 0
namespace pg8 {
#define PG8_LAS __attribute__((address_space(3)))
typedef unsigned short bf16_t;
typedef short bf16x8 __attribute__((ext_vector_type(8)));
typedef float f32x4 __attribute__((ext_vector_type(4)));
typedef unsigned u32x4 __attribute__((ext_vector_type(4)));
constexpr int BM = 256, BK = 64, HALF = 128, HTB = HALF * BK * 2  , STAGE_BYTES = 8 * HTB, NXCD = 8, WGM = 8;

__host__ __device__ __forceinline__ int lds_byte(int r, int c) { const int st = (r >> 4) * 2 + (c >> 5), rr = r & 15, cc = c & 31, ob = rr * 64 + cc * 2; return st * 1024 + (ob ^ (((ob >> 9) & 1) << 5)); }
__host__ __device__ __forceinline__ void stage_rc(int b, int& R, int& C) { const int st = b / 1024, sb = b % 1024, swz = sb ^ (((sb >> 9) & 1) << 5); R = (st >> 1) * 16 + swz / 64; C = (st & 1) * 32 + (swz % 64) / 2; }
__host__ __device__ __forceinline__ int perm32(int rho) { const int n = rho >> 4, i = rho & 15; return 8 * (i >> 2) + 4 * n + (i & 3); }

struct Unit { int pm, pn; };
struct Gemm { const bf16_t* A; const bf16_t* Bt; int M, N, K; };

struct StaticOrder {
    int nM, nN, nwg, G, c;
    __host__ __device__ void init(int M, int N, int G_, int c_) { nM = M / BM; nN = N / BM; nwg = nM * nN; G = G_; c = c_; }
    __host__ __device__ bool next(int i, Unit& u) const {
        const long L = (long)i * G + c; if (L >= nwg) return false;
        int wgid = (int)L; { const int q = nwg / NXCD, r = nwg % NXCD, xcd = wgid % NXCD, off = wgid / NXCD; wgid = (xcd < r ? xcd * (q + 1) : r * (q + 1) + (xcd - r) * q) + off; }
        const int nig = WGM * nN, gid = wgid / nig, fm = gid * WGM, gsz = (nM - fm) < WGM ? (nM - fm) : WGM;
        u.pm = fm + ((wgid % nig) % gsz); u.pn = (wgid % nig) / gsz; return true;
    }
    __device__ __forceinline__ void a_ready(const Unit&) const {}
    __device__ __forceinline__ void done(const Unit&) const {}
};
struct CountedOrder : StaticOrder {
    const unsigned* ready; unsigned need; unsigned* tmo;
    __device__ __forceinline__ void a_ready(const Unit& u) const {
        if (threadIdx.x < 64) {
            const unsigned long long t0 = __builtin_amdgcn_s_memrealtime(); unsigned polls = 0;
            while ((unsigned)__builtin_amdgcn_readfirstlane(__hip_atomic_load(ready + 64 * u.pm, __ATOMIC_RELAXED, __HIP_MEMORY_SCOPE_AGENT)) < need) {
                if ((++polls & 255u) == 0u && __builtin_amdgcn_readfirstlane(__hip_atomic_load(tmo, __ATOMIC_RELAXED, __HIP_MEMORY_SCOPE_AGENT)) != 0u) break;
                if (__builtin_amdgcn_s_memrealtime() - t0 > 2000000ull) {
                    if (threadIdx.x == 0) { unsigned expect = 0u; __hip_atomic_compare_exchange_strong(tmo + 1, &expect, 0x600u | (unsigned)(u.pm & 0xff), __ATOMIC_RELAXED, __ATOMIC_RELAXED, __HIP_MEMORY_SCOPE_AGENT); __hip_atomic_store(tmo, 1u, __ATOMIC_RELAXED, __HIP_MEMORY_SCOPE_AGENT); }
                    break; }
                __builtin_amdgcn_s_sleep(2); }
            __builtin_amdgcn_fence(__ATOMIC_ACQUIRE, "agent");
            asm volatile("s_waitcnt vmcnt(0)" ::: "memory");
        }
#if !defined(BROKEN_HOOK_NO_BARRIER)
        asm volatile("" ::: "memory"); __builtin_amdgcn_s_barrier(); asm volatile("" ::: "memory");
#endif
    }
};

__device__ __forceinline__ unsigned cvt_pk_bf16(float lo, float hi) { unsigned r; asm volatile("v_cvt_pk_bf16_f32 %0, %1, %2" : "=v"(r) : "v"(lo), "v"(hi)); return r; }
typedef float f32x2 __attribute__((ext_vector_type(2)));
__device__ __forceinline__ f32x2 gelu_pk(f32x2 v) {
    const f32x2 av = __builtin_elementwise_abs(v), d = av * 0.2316418882f + 1.0f;
    f32x2 t; t.x = __builtin_amdgcn_rcpf(d.x); t.y = __builtin_amdgcn_rcpf(d.y);
    f32x2 q = t * 0.5307027145f + (-0.7265760135f); q = q * t + 0.7107068705f; q = q * t + (-0.142248368f); q = q * t + 0.127414796f; q = q * t;
    const f32x2 s = (v * v) * (-0.72134752044f);
    f32x2 e; e.x = __builtin_amdgcn_exp2f(s.x); e.y = __builtin_amdgcn_exp2f(s.y);
    const f32x2 m = v * (q * e), r = v - m;
    f32x2 o; o.x = v.x < 0.f ? m.x : r.x; o.y = v.y < 0.f ? m.y : r.y; return o;
}

struct EpiF32 {
    static constexpr bool PERM = false, AFTER_DRAIN = false;
    float* C; int ldc; const float* bias;
    __device__ __forceinline__ void operator()(const f32x4 (&acc)[2][2][4][2], const Unit& u, int wr, int wc, int fr, int fq) const {
        const int row0 = u.pm * BM + wr * 64 + fr, col0 = u.pn * BM + wc * 32 + 4 * fq;
        f32x4 bv[2][2];
#pragma unroll
        for (int bj = 0; bj < 2; ++bj)
#pragma unroll
            for (int n = 0; n < 2; ++n) bv[bj][n] = bias ? *(const f32x4*)(bias + col0 + bj * HALF + n * 16) : (f32x4){0.f, 0.f, 0.f, 0.f};
#pragma unroll
        for (int ai = 0; ai < 2; ++ai)
#pragma unroll
            for (int m = 0; m < 4; ++m) { float* rowp = C + (size_t)(row0 + ai * HALF + m * 16) * ldc + col0;
#pragma unroll
                for (int bj = 0; bj < 2; ++bj)
#pragma unroll
                    for (int n = 0; n < 2; ++n) *(f32x4*)(rowp + bj * HALF + n * 16) = acc[ai][bj][m][n] + bv[bj][n]; }
    }
};
template <int ACT  > struct EpiBf16 {
    static constexpr bool PERM = true, AFTER_DRAIN = false;
    bf16_t* O; int ldc; const float* bias; int split_cols; size_t split_stride;
    __device__ __forceinline__ void operator()(const f32x4 (&acc)[2][2][4][2], const Unit& u, int wr, int wc, int fr, int fq) const {
        const int row0 = u.pm * BM + wr * 64 + fr; int colt = u.pn * BM; bf16_t* base = O;
        if (split_cols) { const int t = colt / split_cols; base += (size_t)t * split_stride; colt -= t * split_cols; }
        const int col0 = colt + wc * 32 + 8 * fq, bcol0 = u.pn * BM + wc * 32 + 8 * fq;
        f32x4 bv[2][2];
#pragma unroll
        for (int bj = 0; bj < 2; ++bj)
#pragma unroll
            for (int n = 0; n < 2; ++n) bv[bj][n] = bias ? *(const f32x4*)(bias + bcol0 + bj * HALF + 4 * n) : (f32x4){0.f, 0.f, 0.f, 0.f};
#pragma unroll
        for (int ai = 0; ai < 2; ++ai)
#pragma unroll
            for (int m = 0; m < 4; ++m) { bf16_t* rowp = base + (size_t)(row0 + ai * HALF + m * 16) * ldc + col0;
#pragma unroll
                for (int bj = 0; bj < 2; ++bj) { f32x4 v0 = acc[ai][bj][m][0] + bv[bj][0], v1 = acc[ai][bj][m][1] + bv[bj][1];
                    if (ACT == 1) { f32x2 a = gelu_pk((f32x2){v0[0], v0[1]}), b = gelu_pk((f32x2){v0[2], v0[3]}), c = gelu_pk((f32x2){v1[0], v1[1]}), d = gelu_pk((f32x2){v1[2], v1[3]});
                        v0 = (f32x4){a.x, a.y, b.x, b.y}; v1 = (f32x4){c.x, c.y, d.x, d.y}; }
                    if (ACT == 2) {
#pragma unroll
                        for (int j = 0; j < 4; ++j) { v0[j] = 0.5f * v0[j] * (1.0f + erff(v0[j] * 0.70710678f)); v1[j] = 0.5f * v1[j] * (1.0f + erff(v1[j] * 0.70710678f)); } }
                    u32x4 w; w.x = cvt_pk_bf16(v0[0], v0[1]); w.y = cvt_pk_bf16(v0[2], v0[3]); w.z = cvt_pk_bf16(v1[0], v1[1]); w.w = cvt_pk_bf16(v1[2], v1[3]);
                    *(u32x4*)(rowp + bj * HALF) = w; } }
    }
};

struct PanelStats {
    unsigned* xbuf;
    unsigned* cnt;
    unsigned* tmo;
    int ntn; float eps;
    unsigned code;
    __device__ __forceinline__ bool run(const f32x4 (&v)[2][2][4][2], const Unit& u, int wr, int wc, int fr, int fq, PG8_LAS unsigned char* lds, int wid, int lane) const {
        typedef float f32x2v __attribute__((ext_vector_type(2)));
        PG8_LAS f32x2v* P = (PG8_LAS f32x2v*)lds;
        PG8_LAS f32x2v* S = (PG8_LAS f32x2v*)(lds + 8192);
        PG8_LAS unsigned* flag = (PG8_LAS unsigned*)(lds + 8192 + 2048);
#pragma unroll
        for (int ai = 0; ai < 2; ++ai)
#pragma unroll
            for (int m = 0; m < 4; ++m) {
                float s = 0.f;
#pragma unroll
                for (int bj = 0; bj < 2; ++bj)
#pragma unroll
                    for (int n = 0; n < 2; ++n) { const f32x4 x = v[ai][bj][m][n]; s += (x[0] + x[1]) + (x[2] + x[3]); }
                s += __shfl_xor(s, 16); s += __shfl_xor(s, 32);
                const float mw = s * (1.0f / 64.0f); float q = 0.f;
#pragma unroll
                for (int bj = 0; bj < 2; ++bj)
#pragma unroll
                    for (int n = 0; n < 2; ++n) { const f32x4 d = v[ai][bj][m][n] - mw; q += (d[0] * d[0] + d[1] * d[1]) + (d[2] * d[2] + d[3] * d[3]); }
                q += __shfl_xor(q, 16); q += __shfl_xor(q, 32);
                if (fq == 0) P[(ai * HALF + wr * 64 + m * 16 + fr) * 4 + wc] = (f32x2v){mw, q};
            }
        asm volatile("s_waitcnt lgkmcnt(0)" ::: "memory"); __builtin_amdgcn_s_barrier(); asm volatile("" ::: "memory");
#if defined(BROKEN_NO_WAIT)
        if (blockIdx.x >= 64) { const long long t0 = clock64(); while (clock64() - t0 < 60000) __builtin_amdgcn_s_sleep(8); }
#endif
        const int row = wid * 32 + (lane & 31);
        if (lane < 32) {
            const f32x2v a = P[row * 4 + 0], b = P[row * 4 + 1], c = P[row * 4 + 2], d = P[row * 4 + 3];
            const float mt = (a.x + b.x + c.x + d.x) * 0.25f;
            const float da = a.x - mt, db = b.x - mt, dc = c.x - mt, dd = d.x - mt;
            const float m2 = (a.y + b.y) + (c.y + d.y) + 64.0f * ((da * da + db * db) + (dc * dc + dd * dd));
            unsigned long long* slot = (unsigned long long*)xbuf + ((size_t)(u.pm * BM + row) * 4 + u.pn);
            __hip_atomic_store(slot, ((unsigned long long)__float_as_uint(m2) << 32) | __float_as_uint(mt), __ATOMIC_RELAXED, __HIP_MEMORY_SCOPE_AGENT);
        }
        asm volatile("s_waitcnt vmcnt(0)" ::: "memory");
        if (lane == 0) __hip_atomic_fetch_add(cnt + 64 * u.pm, 1u, __ATOMIC_RELAXED, __HIP_MEMORY_SCOPE_AGENT);
        if (wid == 0) {
            bool dead = false; const unsigned long long t0 = __builtin_amdgcn_s_memrealtime(); const unsigned want = 8u * (unsigned)ntn;
            for (;;) {
#if defined(BROKEN_NO_WAIT)
                break;
#endif
                if ((unsigned)__builtin_amdgcn_readfirstlane(__hip_atomic_load(cnt + 64 * u.pm, __ATOMIC_RELAXED, __HIP_MEMORY_SCOPE_AGENT)) >= want) break;
                if (__builtin_amdgcn_s_memrealtime() - t0 > 2000000ull) {
                    if (lane == 0) { unsigned expect = 0u; __hip_atomic_compare_exchange_strong(tmo + 1, &expect, code | (unsigned)(u.pm & 0xff), __ATOMIC_RELAXED, __ATOMIC_RELAXED, __HIP_MEMORY_SCOPE_AGENT);
                                     __hip_atomic_store(tmo, 1u, __ATOMIC_RELAXED, __HIP_MEMORY_SCOPE_AGENT); }
                    dead = true; break; }
                __builtin_amdgcn_s_sleep(2);
            }
            __builtin_amdgcn_fence(__ATOMIC_ACQUIRE, "agent");
            if (lane == 0) flag[0] = dead ? 1u : 0u;
        }
        asm volatile("s_waitcnt vmcnt(0) lgkmcnt(0)" ::: "memory"); __builtin_amdgcn_s_barrier(); asm volatile("" ::: "memory");
        const bool bad = flag[0] != 0u;
        if (lane < 32) {
            const unsigned long long* slot = (const unsigned long long*)xbuf + (size_t)(u.pm * BM + row) * 4; float mt[4], m2[4]; float ms = 0.f;
#pragma unroll
            for (int t = 0; t < 4; ++t) { if (t < ntn) { const unsigned long long w = __hip_atomic_load(slot + t, __ATOMIC_RELAXED, __HIP_MEMORY_SCOPE_AGENT); mt[t] = __uint_as_float((unsigned)w); m2[t] = __uint_as_float((unsigned)(w >> 32)); } else { mt[t] = 0.f; m2[t] = 0.f; } ms += mt[t]; }
            const float mean = ms / (float)ntn; float q = 0.f;
#pragma unroll
            for (int t = 0; t < 4; ++t) if (t < ntn) { const float dm = mt[t] - mean; q += m2[t] + 256.0f * dm * dm; }
            S[row] = (f32x2v){mean, 1.0f / sqrtf(q / (256.0f * (float)ntn) + eps)};
        }
        asm volatile("s_waitcnt lgkmcnt(0)" ::: "memory"); __builtin_amdgcn_s_barrier(); asm volatile("" ::: "memory");
        return bad;
    }
};
struct EpiLnRes {
    static constexpr bool PERM = false, AFTER_DRAIN = true;
    const float* base; float* out; int ldc; const float* bias; PanelStats st; unsigned poison;
    __device__ __forceinline__ void refuse(size_t i0, size_t stride, int M, int N) const { const float q = __builtin_nanf(""); for (size_t i = i0; i < (size_t)M * N; i += stride) out[(i / N) * ldc + i % N] = q;
        if (i0 == 0) { unsigned expect = 0u; __hip_atomic_compare_exchange_strong(st.tmo + 1, &expect, 0x7f0u, __ATOMIC_RELAXED, __ATOMIC_RELAXED, __HIP_MEMORY_SCOPE_AGENT); __hip_atomic_store(st.tmo, 1u, __ATOMIC_RELAXED, __HIP_MEMORY_SCOPE_AGENT); } }
    __device__ __forceinline__ void fused(f32x4 (&acc)[2][2][4][2], const Unit& u, int wr, int wc, int fr, int fq, PG8_LAS unsigned char* lds, int wid, int lane) const {
        typedef float f32x2v __attribute__((ext_vector_type(2)));
        const PG8_LAS f32x2v* S = (const PG8_LAS f32x2v*)(lds + 8192);
        const int col0 = u.pn * BM + wc * 32 + 4 * fq;
#pragma unroll
        for (int bj = 0; bj < 2; ++bj)
#pragma unroll
            for (int n = 0; n < 2; ++n) { const f32x4 bv = bias ? *(const f32x4*)(bias + col0 + bj * HALF + n * 16) : (f32x4){0.f, 0.f, 0.f, 0.f};
#pragma unroll
                for (int ai = 0; ai < 2; ++ai)
#pragma unroll
                    for (int m = 0; m < 4; ++m) acc[ai][bj][m][n] += bv; }
        const bool bad = st.run(acc, u, wr, wc, fr, fq, lds, wid, lane) || poison != 0u;
        const float qnan = __builtin_nanf("");
#pragma unroll
        for (int ai = 0; ai < 2; ++ai)
#pragma unroll
            for (int m = 0; m < 4; ++m) { const int r = ai * HALF + wr * 64 + m * 16 + fr; const f32x2v sr = S[r]; const size_t off = (size_t)(u.pm * BM + r) * ldc + col0;
#pragma unroll
                for (int bj = 0; bj < 2; ++bj)
#pragma unroll
                    for (int n = 0; n < 2; ++n) { const f32x4 bs = *(const f32x4*)(base + off + bj * HALF + n * 16); f32x4 o = bs + (acc[ai][bj][m][n] - sr.x) * sr.y;
                        if (bad) o = (f32x4){qnan, qnan, qnan, qnan}; *(f32x4*)(out + off + bj * HALF + n * 16) = o; }
                asm volatile("" ::: "memory"); }
    }
};
struct EpiLnResLn {
    static constexpr bool PERM = false, AFTER_DRAIN = true;
    const float* base; float* out; bf16_t* xn; int ldc; const float* bias; PanelStats st1, st2; unsigned poison;
    __device__ __forceinline__ void refuse(size_t i0, size_t stride, int M, int N) const { const float q = __builtin_nanf(""); for (size_t i = i0; i < (size_t)M * N; i += stride) { const size_t o = (i / N) * ldc + i % N; out[o] = q; xn[o] = (bf16_t)0x7fc0u; }
        if (i0 == 0) { unsigned expect = 0u; __hip_atomic_compare_exchange_strong(st1.tmo + 1, &expect, 0x7f0u, __ATOMIC_RELAXED, __ATOMIC_RELAXED, __HIP_MEMORY_SCOPE_AGENT); __hip_atomic_store(st1.tmo, 1u, __ATOMIC_RELAXED, __HIP_MEMORY_SCOPE_AGENT); } }
    __device__ __forceinline__ void fused(f32x4 (&acc)[2][2][4][2], const Unit& u, int wr, int wc, int fr, int fq, PG8_LAS unsigned char* lds, int wid, int lane) const {
        typedef float f32x2v __attribute__((ext_vector_type(2))); typedef unsigned u32x2v __attribute__((ext_vector_type(2)));
        const PG8_LAS f32x2v* S = (const PG8_LAS f32x2v*)(lds + 8192);
        const int col0 = u.pn * BM + wc * 32 + 4 * fq;
#pragma unroll
        for (int bj = 0; bj < 2; ++bj)
#pragma unroll
            for (int n = 0; n < 2; ++n) { const f32x4 bv = bias ? *(const f32x4*)(bias + col0 + bj * HALF + n * 16) : (f32x4){0.f, 0.f, 0.f, 0.f};
#pragma unroll
                for (int ai = 0; ai < 2; ++ai)
#pragma unroll
                    for (int m = 0; m < 4; ++m) acc[ai][bj][m][n] += bv; }
        bool bad = st1.run(acc, u, wr, wc, fr, fq, lds, wid, lane) || poison != 0u;
        const float qnan = __builtin_nanf("");
#pragma unroll
        for (int ai = 0; ai < 2; ++ai)
#pragma unroll
            for (int m = 0; m < 4; ++m) { const int r = ai * HALF + wr * 64 + m * 16 + fr; const f32x2v sr = S[r]; const size_t off = (size_t)(u.pm * BM + r) * ldc + col0;
#pragma unroll
                for (int bj = 0; bj < 2; ++bj)
#pragma unroll
                    for (int n = 0; n < 2; ++n) { const f32x4 bs = *(const f32x4*)(base + off + bj * HALF + n * 16); acc[ai][bj][m][n] = bs + (acc[ai][bj][m][n] - sr.x) * sr.y; }
                asm volatile("" : "+v"(acc[ai][0][m][0]), "+v"(acc[ai][0][m][1]), "+v"(acc[ai][1][m][0]), "+v"(acc[ai][1][m][1]));
                if (m & 1) asm volatile("" ::: "memory"); }
        const bool bad1 = bad;
        bad = st2.run(acc, u, wr, wc, fr, fq, lds, wid, lane) || bad;
#pragma unroll
        for (int ai = 0; ai < 2; ++ai)
#pragma unroll
            for (int m = 0; m < 4; ++m) { const int r = ai * HALF + wr * 64 + m * 16 + fr; const f32x2v sr = S[r]; const size_t off = (size_t)(u.pm * BM + r) * ldc + col0;
#pragma unroll
                for (int bj = 0; bj < 2; ++bj)
#pragma unroll
                    for (int n = 0; n < 2; ++n) { const f32x4 x1 = acc[ai][bj][m][n]; *(f32x4*)(out + off + bj * HALF + n * 16) = bad1 ? (f32x4){qnan, qnan, qnan, qnan} : x1;
                        const f32x4 o = (x1 - sr.x) * sr.y; u32x2v w; w.x = cvt_pk_bf16(o[0], o[1]); w.y = cvt_pk_bf16(o[2], o[3]);
                        if (bad) { w.x = 0x7fc07fc0u; w.y = 0x7fc07fc0u; } *(u32x2v*)(xn + off + bj * HALF + n * 16) = w; }
                asm volatile("" ::: "memory"); }
    }
};

template <class Epi, class Sched, bool STAMP = false>
__device__ __forceinline__ void gemm_phase(PG8_LAS unsigned char* lds, const Gemm g, const Sched& S, const Epi& E, unsigned long long* stamps) {
    const int tid = threadIdx.x, wid = __builtin_amdgcn_readfirstlane(tid >> 6), lane = tid & 63, wr = wid >> 2, wc = wid & 3, fr = lane & 15, fq = lane >> 4;
    const int K = g.K, nt = K / BK;
    int ts_lo = 0, ts_hi = 0, nts = 0; const unsigned long long rt_entry = STAMP ? (unsigned long long)wall_clock64() : 0ull;
#define PG8_STAMP() do { if (STAMP && wid == 0 && nts < 64) { const unsigned long long _c = (unsigned long long)clock64(); \
        ts_lo = (lane == nts) ? (int)(unsigned)_c : ts_lo; ts_hi = (lane == nts) ? (int)(unsigned)(_c >> 32) : ts_hi; ++nts; } } while (0)
    PG8_STAMP();
    unsigned voffA[2], voffB[2];
#pragma unroll
    for (int i = 0; i < 2; ++i) { int R, C; stage_rc(tid * 16 + i * 8192, R, C); const int Rb = Epi::PERM ? ((R & ~31) + perm32(R & 31)) : R;
        voffA[i] = (unsigned)(R * K + C) * 2u; voffB[i] = (unsigned)(Rb * K + C) * 2u; }
    const size_t kstep = (size_t)(BK * 2);
    const size_t hstep = (size_t)HALF * K * 2;
    const size_t tstep = 2 * hstep;
    const unsigned ldsw = (unsigned)wid * 1024u;
    const int aoff = lds_byte(wr * 64 + fr, fq * 8), boff = lds_byte(wc * 32 + fr, fq * 8);
#define PG8_SA(b, h) (((b) * 2 + (h)) * HTB)
#define PG8_SB(b, h) ((4 + (b) * 2 + (h)) * HTB)
#define PG8_STAGE(bufoff, gbase, voff) do { _Pragma("unroll") for (int _i = 0; _i < 2; ++_i) \
        __builtin_amdgcn_global_load_lds((const unsigned*)((const char*)(gbase) + (voff)[_i]), (PG8_LAS unsigned*)(lds + (bufoff) + ldsw + _i * 8192), 16, 0, 0); } while (0)
#define PG8_LDA(dst, b, h) do { _Pragma("unroll") for (int m = 0; m < 4; ++m) _Pragma("unroll") for (int k = 0; k < 2; ++k) dst[m][k] = *(const PG8_LAS bf16x8*)(lds + PG8_SA(b, h) + aoff + m * 2048 + k * 1024); } while (0)
#define PG8_LDB(dst, b, h) do { _Pragma("unroll") for (int n = 0; n < 2; ++n) _Pragma("unroll") for (int k = 0; k < 2; ++k) dst[n][k] = *(const PG8_LAS bf16x8*)(lds + PG8_SB(b, h) + boff + n * 2048 + k * 1024); } while (0)
#define PG8_MMA(ai, bj, At, Bt) do { __builtin_amdgcn_s_setprio(1); _Pragma("unroll") for (int m = 0; m < 4; ++m) _Pragma("unroll") for (int n = 0; n < 2; ++n) _Pragma("unroll") for (int k = 0; k < 2; ++k) \
        acc[ai][bj][m][n] = __builtin_amdgcn_mfma_f32_16x16x32_bf16(Bt[n][k], At[m][k], acc[ai][bj][m][n], 0, 0, 0); __builtin_amdgcn_s_setprio(0); } while (0)
#define PG8_WAIT_V(n) asm volatile("s_waitcnt vmcnt(" #n ")" ::: "memory")
#define PG8_WAIT_L(n) asm volatile("s_waitcnt lgkmcnt(" #n ")" ::: "memory")
#define PG8_BAR __builtin_amdgcn_s_barrier()
#define PG8_SCHED __builtin_amdgcn_sched_barrier(0)
    Unit cur, nxt; int ui = 0;
    if (!S.next(0, cur)) return;
    f32x4 acc[2][2][4][2];
#pragma unroll
    for (int a = 0; a < 2; ++a)
#pragma unroll
        for (int b = 0; b < 2; ++b)
#pragma unroll
            for (int m = 0; m < 4; ++m)
#pragma unroll
                for (int n = 0; n < 2; ++n) acc[a][b][m][n] = (f32x4){0.f, 0.f, 0.f, 0.f};
    bf16x8 At[4][2], B0[2][2], B1[2][2];
    const char* cA = (const char*)g.A + (size_t)cur.pm * tstep; const char* cB = (const char*)g.Bt + (size_t)cur.pn * tstep;
    S.a_ready(cur);
    PG8_STAGE(PG8_SB(0, 0), cB, voffB); PG8_STAGE(PG8_SA(0, 0), cA, voffA); PG8_STAGE(PG8_SB(0, 1), cB + hstep, voffB); PG8_STAGE(PG8_SA(0, 1), cA + hstep, voffA);
    if (wr == 1) PG8_BAR;
    PG8_WAIT_V(4); PG8_BAR;
    PG8_STAGE(PG8_SB(1, 0), cB + kstep, voffB); PG8_STAGE(PG8_SA(1, 0), cA + kstep, voffA); PG8_STAGE(PG8_SB(1, 1), cB + hstep + kstep, voffB);
    PG8_WAIT_V(6); PG8_BAR;
    PG8_STAMP();
    for (;;) {
        const bool has_next = S.next(ui + 1, nxt);
        const char* nA = has_next ? (const char*)g.A + (size_t)nxt.pm * tstep : cA; const char* nB = has_next ? (const char*)g.Bt + (size_t)nxt.pn * tstep : cB;
        for (int t = 0; t < nt; t += 2) {
            const bool last = (t == nt - 2);
            const char* a1 = cA + (size_t)(t + 1) * kstep;
            const char* a2 = last ? nA : cA + (size_t)(t + 2) * kstep; const char* b2 = last ? nB : cB + (size_t)(t + 2) * kstep;
            const char* a3 = a2 + kstep; const char* b3 = b2 + kstep;
            if (last && has_next) S.a_ready(nxt);
            PG8_LDB(B0, 0, 0); PG8_SCHED; PG8_LDA(At, 0, 0); PG8_STAGE(PG8_SA(1, 1), a1 + hstep, voffA);
            PG8_WAIT_L(8); PG8_BAR; PG8_WAIT_L(0); PG8_MMA(0, 0, At, B0); PG8_BAR; PG8_SCHED;
            PG8_LDB(B1, 0, 1); PG8_STAGE(PG8_SB(0, 0), b2, voffB);
            PG8_BAR; PG8_WAIT_L(0); PG8_MMA(0, 1, At, B1); PG8_BAR;
            PG8_LDA(At, 0, 1); PG8_STAGE(PG8_SA(0, 0), a2, voffA);
            PG8_BAR; PG8_WAIT_L(0); PG8_MMA(1, 0, At, B0); PG8_BAR; PG8_SCHED;
            PG8_STAGE(PG8_SB(0, 1), b2 + hstep, voffB);
            PG8_WAIT_V(6); PG8_BAR; PG8_MMA(1, 1, At, B1); PG8_BAR;
            PG8_LDB(B0, 1, 0); PG8_SCHED; PG8_LDA(At, 1, 0); PG8_STAGE(PG8_SA(0, 1), a2 + hstep, voffA);
            PG8_WAIT_L(8); PG8_BAR; PG8_WAIT_L(0); PG8_MMA(0, 0, At, B0); PG8_BAR; PG8_SCHED;
            PG8_LDB(B1, 1, 1); PG8_STAGE(PG8_SB(1, 0), b3, voffB);
            PG8_BAR; PG8_WAIT_L(0); PG8_MMA(0, 1, At, B1); PG8_BAR;
            PG8_LDA(At, 1, 1); PG8_STAGE(PG8_SA(1, 0), a3, voffA);
            PG8_BAR; PG8_WAIT_L(0); PG8_MMA(1, 0, At, B0); PG8_BAR; PG8_SCHED;
            PG8_STAGE(PG8_SB(1, 1), b3 + hstep, voffB);
            PG8_WAIT_V(6); PG8_BAR; PG8_MMA(1, 1, At, B1); PG8_BAR;
        }
        PG8_STAMP();
        if constexpr (!Epi::AFTER_DRAIN) { E(acc, cur, wr, wc, fr, fq); S.done(cur); }
        PG8_STAMP();
        if (!has_next) break;
#pragma unroll
        for (int a = 0; a < 2; ++a)
#pragma unroll
            for (int b = 0; b < 2; ++b)
#pragma unroll
                for (int m = 0; m < 4; ++m)
#pragma unroll
                    for (int n = 0; n < 2; ++n) acc[a][b][m][n] = (f32x4){0.f, 0.f, 0.f, 0.f};
        cur = nxt; cA = nA; cB = nB; ++ui;
    }
    PG8_WAIT_V(0);
    if (wr == 0) PG8_BAR;
    PG8_BAR;
    if constexpr (Epi::AFTER_DRAIN) { E.fused(acc, cur, wr, wc, fr, fq, lds, wid, lane); S.done(cur); }
    PG8_STAMP();
    if (STAMP && wid == 0) { stamps[lane] = lane < nts ? (((unsigned long long)(unsigned)ts_hi << 32) | (unsigned)ts_lo) : 0ull;
        if (lane == 62) stamps[62] = rt_entry; if (lane == 63) stamps[63] = (unsigned long long)wall_clock64(); }
#undef PG8_STAMP
#undef PG8_SA
#undef PG8_SB
#undef PG8_STAGE
#undef PG8_LDA
#undef PG8_LDB
#undef PG8_MMA
#undef PG8_WAIT_V
#undef PG8_WAIT_L
#undef PG8_BAR
#undef PG8_SCHED
}
}

namespace cg = cooperative_groups;
typedef unsigned short bf16_t;
typedef short bf16x8 __attribute__((ext_vector_type(8)));
typedef float f32x4 __attribute__((ext_vector_type(4)));
typedef unsigned u32x4 __attribute__((ext_vector_type(4)));
typedef unsigned u32x2 __attribute__((ext_vector_type(2)));

constexpr int NB = 8, NT = 4096, DM = 1024, NTOK = NB * NT;
constexpr int DIN = 4744, NPAD = 4864;
constexpr int C_R = 0, C_K = 512, C_V = 1024, C_WD = 1536, C_AD = 1600, C_ZR = 1664, C_Q = 2176, C_KM = 2688, C_VM = 3200, C_O = 3712, C_I = 4224, C_F = 4228, C_ZM = 4232;
constexpr int NTHR = 512, NWV = 8;
constexpr int LDS_BYTES = 147456;
constexpr int NPHASE = 8;

constexpr size_t MiB = 1u << 20;
constexpr size_t WS_CTL = 0, CTL_BYTES = 1 * MiB;
constexpr size_t WS_ADA = 1 * MiB;
constexpr size_t WS_LORA = 1 * MiB + 512 * 1024;
constexpr size_t WS_WL = 14 * MiB, WS_BONUS = 15 * MiB;
constexpr size_t WS_WIN = 2 * MiB;
constexpr size_t WS_WOUT = 12 * MiB;
constexpr size_t WS_X = 16 * MiB;
constexpr size_t WS_PROJ = 144 * MiB;
constexpr size_t WS_Y = 448 * MiB;
constexpr size_t WS_END = 512 * MiB;

__device__ __forceinline__ size_t pjo(size_t m, int col) { return (size_t)(col >> 8) * ((size_t)NTOK * 256) + m * 256 + (size_t)(col & 255); }
struct Params { const float* in[24]; float* out; unsigned char* ws; int ph_lo, ph_hi; };

struct Ctx {
    const Params& p;
    __device__ __forceinline__ const float* x() const { return p.in[0]; }
    __device__ __forceinline__ const float* c() const { return p.in[1]; }
    __device__ __forceinline__ const float* w_ada() const { return p.in[2]; }
    __device__ __forceinline__ const float* b_ada() const { return p.in[3]; }
    __device__ __forceinline__ const float* norm_gain() const { return p.in[4]; }
    __device__ __forceinline__ const float* w_in() const { return p.in[5]; }
    __device__ __forceinline__ const float* mu() const { return p.in[6]; }
    __device__ __forceinline__ const float* w_dup() const { return p.in[7]; }
    __device__ __forceinline__ const float* w_d0() const { return p.in[8]; }
    __device__ __forceinline__ const float* w_iup() const { return p.in[9]; }
    __device__ __forceinline__ const float* a0() const { return p.in[10]; }
    __device__ __forceinline__ const float* k_k() const { return p.in[11]; }
    __device__ __forceinline__ const float* k_a() const { return p.in[12]; }
    __device__ __forceinline__ const float* r_k() const { return p.in[13]; }
    __device__ __forceinline__ const float* gn_w() const { return p.in[14]; }
    __device__ __forceinline__ const float* gn_b() const { return p.in[15]; }
    __device__ __forceinline__ const float* conv_w() const { return p.in[16]; }
    __device__ __forceinline__ const float* conv_b() const { return p.in[17]; }
    __device__ __forceinline__ const float* b_i() const { return p.in[18]; }
    __device__ __forceinline__ const float* b_f() const { return p.in[19]; }
    __device__ __forceinline__ const float* ln_w() const { return p.in[20]; }
    __device__ __forceinline__ const float* skip() const { return p.in[21]; }
    __device__ __forceinline__ const float* w_out() const { return p.in[22]; }
    __device__ __forceinline__ const float* fgain() const { return p.in[23]; }
    __device__ __forceinline__ float* out() const { return p.out; }
    __device__ __forceinline__ float* sumsq() const { return (float*)(p.ws + (WS_Y)); }
    __device__ __forceinline__ float* ada() const { return (float*)(p.ws + (WS_ADA)); }
    __device__ __forceinline__ bf16_t* win_t() const { return (bf16_t*)(p.ws + (WS_WIN)); }
    __device__ __forceinline__ bf16_t* wout_t() const { return (bf16_t*)(p.ws + (WS_WOUT)); }
    __device__ __forceinline__ bf16_t* hn() const { return (bf16_t*)(p.ws + (WS_X)); }
    __device__ __forceinline__ bf16_t* proj() const { return (bf16_t*)(p.ws + (WS_PROJ)); }
    __device__ __forceinline__ bf16_t* y() const { return (bf16_t*)(p.ws + (WS_Y)); }
    __device__ __forceinline__ bf16_t* wdup_t() const { return (bf16_t*)(p.ws + (WS_LORA)); }
    __device__ __forceinline__ bf16_t* wiup_t() const { return (bf16_t*)(p.ws + (WS_LORA + 65536)); }
    __device__ __forceinline__ bf16_t* q1p() const { return (bf16_t*)(p.ws + (WS_X)); }
    __device__ __forceinline__ bf16_t* mp() const { return (bf16_t*)(p.ws + (WS_X + 32 * MiB)); }
    __device__ __forceinline__ bf16_t* yid() const { return (bf16_t*)(p.ws + (WS_X + 64 * MiB)); }
    __device__ __forceinline__ bf16_t* nd() const { return (bf16_t*)(p.ws + (WS_X + 96 * MiB)); }
    __device__ __forceinline__ float* wl() const { return (float*)(p.ws + (WS_WL)); }
    __device__ __forceinline__ float* bonus() const { return (float*)(p.ws + (WS_BONUS)); }
    __device__ __forceinline__ bf16_t* qc() const { return (bf16_t*)(p.ws + WS_Y); }
    __device__ __forceinline__ bf16_t* kc() const { return (bf16_t*)(p.ws + WS_Y + 32 * MiB); }
    __device__ __forceinline__ bf16_t* mixo() const { return (bf16_t*)(p.ws + WS_Y); }
    __device__ __forceinline__ bf16_t* p0s() const { return (bf16_t*)p.out; }
    __device__ __forceinline__ bf16_t* ymix() const { return (bf16_t*)(p.ws + WS_X); }
    unsigned char* lds; int tid, lane, wid, gw, ngw;
};

__device__ __forceinline__ float bf2f(bf16_t v) { return __uint_as_float(((unsigned)v) << 16); }
typedef __bf16 bf16v2_t __attribute__((ext_vector_type(2))); typedef float f32v2_t __attribute__((ext_vector_type(2)));
__device__ __forceinline__ unsigned pk2(float lo, float hi) { const f32v2_t v = {lo, hi}; const bf16v2_t b = __builtin_convertvector(v, bf16v2_t); return __builtin_bit_cast(unsigned, b); }
__device__ __forceinline__ bf16_t f2bf(float f) { return __builtin_bit_cast(bf16_t, (__bf16)f); }
__device__ __forceinline__ void unpack8(const u32x4 v, float* o) {
    o[0] = __uint_as_float(v.x << 16); o[1] = __uint_as_float(v.x & 0xffff0000u); o[2] = __uint_as_float(v.y << 16); o[3] = __uint_as_float(v.y & 0xffff0000u);
    o[4] = __uint_as_float(v.z << 16); o[5] = __uint_as_float(v.z & 0xffff0000u); o[6] = __uint_as_float(v.w << 16); o[7] = __uint_as_float(v.w & 0xffff0000u);
}
__device__ __forceinline__ u32x4 pack8(const float* v) { u32x4 o; o.x = pk2(v[0], v[1]); o.y = pk2(v[2], v[3]); o.z = pk2(v[4], v[5]); o.w = pk2(v[6], v[7]); return o; }
__device__ __forceinline__ float wave_sum(float v) {
#pragma unroll
    for (int o = 1; o < 64; o <<= 1) v += __shfl_xor(v, o);
    return v;
}
#define LDS_BARRIER() do { asm volatile("s_waitcnt lgkmcnt(0)" ::: "memory"); __builtin_amdgcn_s_barrier(); asm volatile("" ::: "memory"); } while (0)
__device__ __forceinline__ float fexp(float x) { return __builtin_amdgcn_exp2f(x * 1.4426950408889634f); }
__device__ __forceinline__ float frcp(float x) { return __builtin_amdgcn_rcpf(x); }
__device__ __forceinline__ float sigmoidf_(float z) { return frcp(1.0f + fexp(-z)); }
__device__ __forceinline__ float siluf_(float z) { return z * frcp(1.0f + fexp(-z)); }
__device__ __forceinline__ float ftanh(float x) { return 1.0f - 2.0f * frcp(1.0f + fexp(2.0f * x)); }
template <int CTRL> __device__ __forceinline__ float dppf(float v) { return __int_as_float(__builtin_amdgcn_update_dpp(0, __float_as_int(v), CTRL, 0xF, 0xF, true)); }
__device__ __forceinline__ float row16_sum(float v) {
    v += dppf<0xB1>(v); v += dppf<0x4E>(v); v += dppf<0x141>(v); v += dppf<0x140>(v); return v;
}

__device__ __forceinline__ void transpose_item(const float* W, int K, int N, bf16_t* WT, float* scr, int item, int nblk, int lane) {
    const int kb = item / nblk, nb = item % nblk, k0 = 64 * kb, n0 = 32 * nb;
#pragma unroll
    for (int i = 0; i < 32; ++i) { const int kk = 2 * i + (lane >> 5); const int n = n0 + (lane & 31); scr[kk * 33 + (lane & 31)] = (n < N) ? W[(size_t)(k0 + kk) * N + n] : 0.f; }
    __builtin_amdgcn_s_waitcnt(0); asm volatile("" ::: "memory");
    const int c = lane & 7;
#pragma unroll
    for (int j = 0; j < 4; ++j) { const int n = (lane >> 3) + 8 * j; const float* s = scr + (8 * c) * 33 + n;
        u32x4 o; o.x = pk2(s[0 * 33], s[1 * 33]); o.y = pk2(s[2 * 33], s[3 * 33]); o.z = pk2(s[4 * 33], s[5 * 33]); o.w = pk2(s[6 * 33], s[7 * 33]);
        *(u32x4*)(WT + (size_t)(n0 + n) * K + k0 + 8 * c) = o; }
    __builtin_amdgcn_s_waitcnt(0); asm volatile("" ::: "memory");
}
__device__ __forceinline__ void phase0(const Ctx& C) {
    if (blockIdx.x >= 48) return;
    float* Ls = (float*)C.lds;
    float* Lp = Ls + 8192;
    for (int e = C.tid; e < 8192; e += NTHR) Ls[e] = siluf_(C.c()[e]);
    __syncthreads();
    const int lane = C.lane, wid = C.wid, grp = wid >> 2, kq = wid & 3, kp = lane >> 3, c4 = 4 * (lane & 7);
    const int col0 = (2 * blockIdx.x + grp) * 32;
    f32x4 acc[8];
#pragma unroll
    for (int b = 0; b < 8; ++b) acc[b] = (f32x4){0.f, 0.f, 0.f, 0.f};
#pragma unroll 16
    for (int it = 0; it < 32; ++it) {
        const int k = kq * 256 + it * 8 + kp;
        const f32x4 w = *(const f32x4*)(C.w_ada() + (size_t)k * 3072 + col0 + c4);
#pragma unroll
        for (int b = 0; b < 8; ++b) acc[b] = acc[b] + w * Ls[b * 1024 + k];
    }
#pragma unroll
    for (int b = 0; b < 8; ++b) {
#pragma unroll
        for (int o = 8; o < 64; o <<= 1) { acc[b].x += __shfl_xor(acc[b].x, o); acc[b].y += __shfl_xor(acc[b].y, o); acc[b].z += __shfl_xor(acc[b].z, o); acc[b].w += __shfl_xor(acc[b].w, o); }
        if (kp == 0) *(f32x4*)(Lp + ((grp * 4 + kq) * 8 + b) * 32 + c4) = acc[b];
    }
    __syncthreads();
    if (C.tid < 512) { const int g2 = C.tid >> 8, b = (C.tid >> 5) & 7, c = C.tid & 31; const int col = (2 * blockIdx.x + g2) * 32 + c;
        float s = C.b_ada()[col];
#pragma unroll
        for (int q = 0; q < 4; ++q) s += Lp[((g2 * 4 + q) * 8 + b) * 32 + c];
        C.ada()[b * 3072 + col] = s; }
}
__device__ __forceinline__ void weight_copies(const Ctx& C) {
    float* scr = (float*)(C.lds + C.wid * 16384);
    constexpr int NBI = NPAD / 32, I_IN = 16 * NBI, I_OUT = 16 * 32;
    for (int it = C.gw; it < I_IN + I_OUT + 32; it += C.ngw) {
        if (it < I_IN) transpose_item(C.w_in(), 1024, DIN, C.win_t(), scr, it, NBI, C.lane);
        else if (it < I_IN + I_OUT) transpose_item(C.w_out(), 1024, 1024, C.wout_t(), scr, it - I_IN, 32, C.lane);
        else if (it < I_IN + I_OUT + 16) transpose_item(C.w_dup(), 64, 512, C.wdup_t(), scr, it - I_IN - I_OUT, 16, C.lane);
        else transpose_item(C.w_iup(), 64, 512, C.wiup_t(), scr, it - I_IN - I_OUT - 16, 16, C.lane);
    }
}

__device__ __forceinline__ void phase1(const Ctx& C) {
    f32x4 g[4];
#pragma unroll
    for (int j = 0; j < 4; ++j) g[j] = *(const f32x4*)(C.norm_gain() + 4 * C.lane + 256 * j);
    f32x4 v[4], n1[4];
    { const f32x4* xr = (const f32x4*)(C.x() + (size_t)C.gw * DM) + C.lane; const f32x4* x1 = (const f32x4*)(C.x() + (size_t)(C.gw + C.ngw) * DM) + C.lane;
#pragma unroll
      for (int j = 0; j < 4; ++j) { v[j] = __builtin_nontemporal_load(xr + 64 * j); n1[j] = __builtin_nontemporal_load(x1 + 64 * j); } }
    f32x4 shv[4], scv[4]; int bcur = -1;
    for (int m = C.gw; m < NTOK; m += C.ngw) {
        const int b = m >> 12; const int mn = (m + 2 * C.ngw < NTOK) ? m + 2 * C.ngw : m;
        if (b != bcur) { bcur = b;
#pragma unroll
            for (int j = 0; j < 4; ++j) { shv[j] = *(const f32x4*)(C.ada() + b * 3072 + 4 * C.lane + 256 * j); scv[j] = *(const f32x4*)(C.ada() + b * 3072 + 1024 + 4 * C.lane + 256 * j) + 1.0f; } }
        f32x4 nv[4];
        { const f32x4* xr = (const f32x4*)(C.x() + (size_t)mn * DM) + C.lane;
#pragma unroll
          for (int j = 0; j < 4; ++j) nv[j] = __builtin_nontemporal_load(xr + 64 * j); }
        float s = 0.f;
#pragma unroll
        for (int j = 0; j < 4; ++j) s += (v[j].x * v[j].x + v[j].y * v[j].y) + (v[j].z * v[j].z + v[j].w * v[j].w);
        const float rs = __builtin_amdgcn_rsqf(wave_sum(s) * (1.0f / DM) + 1e-6f);
        u32x2* o = (u32x2*)(C.hn() + (size_t)m * DM) + C.lane;
#pragma unroll
        for (int j = 0; j < 4; ++j) {
            const f32x4 h = v[j] * rs * g[j] * scv[j] + shv[j];
            u32x2 w; w.x = pk2(h.x, h.y); w.y = pk2(h.z, h.w); o[64 * j] = w; }
#pragma unroll
        for (int j = 0; j < 4; ++j) { v[j] = n1[j]; n1[j] = nv[j]; }
    }
}

typedef short s16x4 __attribute__((ext_vector_type(4)));
__device__ __forceinline__ bf16x8 tr_frag(const bf16_t* base, int stride, int row0, int col0, int fr, int fq) {
    const bf16_t* a0 = base + (row0 + 8 * fq + (fr >> 2)) * stride + col0 + 4 * (fr & 3);
    const s16x4 lo = __builtin_amdgcn_ds_read_tr16_b64_v4i16((__attribute__((address_space(3))) s16x4*)a0);
    const s16x4 hi = __builtin_amdgcn_ds_read_tr16_b64_v4i16((__attribute__((address_space(3))) s16x4*)(a0 + 4 * stride));
    return (bf16x8){lo[0], lo[1], lo[2], lo[3], hi[0], hi[1], hi[2], hi[3]};
}

constexpr int LS = 72;
constexpr int XS = 68;
__device__ __forceinline__ int permc(int c) { return (c & 32) | ((c & 12) << 1) | ((c & 16) >> 2) | (c & 3); }
__device__ __forceinline__ bf16x8 zero8() { return (bf16x8){0, 0, 0, 0, 0, 0, 0, 0}; }
#define MFMA16(a, b, c) __builtin_amdgcn_mfma_f32_16x16x32_bf16(a, b, c, 0, 0, 0)
#define LDFRAG(base, row, col) (*(const bf16x8*)((base) + (row) * LS + (col)))

#define FR_(base, rowoff, coloff) (*(const bf16x8*)((base) + lfo + (rowoff) * LS + (coloff)))
#define DW_(base, rowoff, coloff, r) ((base)[ldo + ((rowoff) + (r)) * LS + (coloff)])
#define OPAQ() asm volatile("" : "+v"(lfo), "+v"(ldo), "+v"(lto), "+v"(lxo))
template <int VAR> __device__ __forceinline__ void rwkv_r1_wg(const Ctx& C, int b, int h, int ck0, int nck) {
    bf16_t* B0 = (bf16_t*)C.lds;
    bf16_t* B1 = B0 + 64 * LS;
    bf16_t* B2 = B1 + 64 * LS;
    bf16_t* B3 = B2 + 64 * LS;
    bf16_t* B4 = B3 + 64 * LS;
    bf16_t* B5 = B4 + 64 * LS;
    bf16_t* B6 = B5 + 64 * LS;
    bf16_t* B7 = B6 + 64 * LS;
    bf16_t* B8 = B7 + 64 * LS;
    float* F = (float*)(B8 + 64 * LS);
    float* Xr = F; float* Xk = F + 64 * XS; float* Xv = Xk + 64 * XS;
    bf16_t* LAab = (bf16_t*)F; bf16_t* LAak = LAab + 64 * LS; bf16_t* LArb = LAak + 64 * LS; bf16_t* LArk = LArb + 64 * LS; bf16_t* LTinv = LArk + 64 * LS;
    float* G = F + 3 * 64 * XS;
    float* LAd = G;
    float* Ltot = LAd + 1024;
    float* Linv = Ltot + 256;
    float* Lbp = Linv + 64;
    bf16_t* LX = (bf16_t*)LAd;
    bf16_t* LX2 = LX + 2 * 16 * 40;
    float* Lc = Lbp + 128;
    int tid = C.tid; asm volatile("" : "+v"(tid));
    const int lane = tid & 63, wid = C.wid, fr = lane & 15, fq = lane >> 4;
    const int tt = tid >> 3, cg8 = tid & 7, ch0 = h * 64 + 8 * cg8;
    const int wt = wid >> 1, wc0 = 2 * (wid & 1);
    __syncthreads();
    if (tid < 384) { const int a = tid >> 6, c = tid & 63;
        Lc[tid] = (a == 0) ? C.mu()[C_R + h * 64 + c] : (a == 1) ? C.mu()[C_K + h * 64 + c] : (a == 2) ? C.mu()[C_V + h * 64 + c] : (a == 3) ? C.k_k()[h * 64 + c] : (a == 4) ? C.mu()[C_WD + c] : C.mu()[C_AD + c]; }
    __syncthreads();
    float d0c[2], a0c[2], kkc[2], kac[2], rkc[2];
#pragma unroll
    for (int jj = 0; jj < 2; ++jj) { const int c = h * 64 + 16 * (wc0 + jj) + fr;
        d0c[jj] = C.w_d0()[c]; a0c[jj] = C.a0()[c]; kkc[jj] = C.k_k()[c]; kac[jj] = C.k_a()[c]; rkc[jj] = C.r_k()[c]; }
    int lfo = fr * LS + 8 * fq, ldo = 4 * fq * LS + fr, lto = fr * LS + 4 * fq, lxo = 4 * fq * XS + fr;

    u32x4 raw[10];
#define R1_LOAD_RAW(mm) do { const bf16_t* pj_ = C.proj(); const size_t mc_ = (size_t)(mm), mp_ = (size_t)(((mm) > 0) ? (mm) - 1 : (mm)); \
        raw[0] = *(const u32x4*)(pj_ + pjo(mc_, C_R + ch0)); raw[1] = *(const u32x4*)(pj_ + pjo(mc_, C_K + ch0)); raw[2] = *(const u32x4*)(pj_ + pjo(mc_, C_V + ch0)); \
        raw[3] = *(const u32x4*)(pj_ + pjo(mc_, C_WD + 8 * cg8)); raw[4] = *(const u32x4*)(pj_ + pjo(mc_, C_AD + 8 * cg8)); \
        raw[5] = *(const u32x4*)(pj_ + pjo(mp_, C_R + ch0)); raw[6] = *(const u32x4*)(pj_ + pjo(mp_, C_K + ch0)); raw[7] = *(const u32x4*)(pj_ + pjo(mp_, C_V + ch0)); \
        raw[8] = *(const u32x4*)(pj_ + pjo(mp_, C_WD + 8 * cg8)); raw[9] = *(const u32x4*)(pj_ + pjo(mp_, C_AD + 8 * cg8)); } while (0)
    R1_LOAD_RAW(b * NT + ck0 * 64 + tt);
    for (int ci = 0; ci < nck; ++ci) {
        const int ck = ck0 + ci; const int m = b * NT + ck * 64 + tt; const size_t chx = (size_t)((b * 8 + h) * 64 + ck);
        OPAQ();
        bf16x8 Bw[2][2], Bi[2][2];
        { int co = (h * 64 + 16 * wc0 + fr) * 64 + 8 * fq; asm volatile("" : "+v"(co));
#pragma unroll
          for (int jj = 0; jj < 2; ++jj)
#pragma unroll
            for (int ks = 0; ks < 2; ++ks) { Bw[jj][ks] = *(const bf16x8*)(C.wdup_t() + co + jj * 1024 + 32 * ks); Bi[jj][ks] = *(const bf16x8*)(C.wiup_t() + co + jj * 1024 + 32 * ks); } }
        if constexpr ((VAR & 2) == 0) {
        {
            const bool hp = (ck | tt) != 0;
            if (!hp) {
#pragma unroll
                for (int i = 5; i < 10; ++i) raw[i] = (u32x4){0u, 0u, 0u, 0u}; }
            const int o = tt * XS + 8 * cg8;
            {
                float v[8], pv[8], mu8[8]; unpack8(raw[2], v); unpack8(raw[7], pv);
                { const f32x4* p4 = (const f32x4*)(Lc + 128 + 8 * cg8); *(f32x4*)mu8 = p4[0]; *(f32x4*)(mu8 + 4) = p4[1]; }
#pragma unroll
                for (int i = 0; i < 8; ++i) v[i] += mu8[i] * (pv[i] - v[i]);
                *(f32x4*)(Xv + o) = (f32x4){v[0], v[1], v[2], v[3]}; *(f32x4*)(Xv + o + 4) = (f32x4){v[4], v[5], v[6], v[7]};
            }
            asm volatile("" ::: "memory");
            {
                float v[8], pv[8], mu8[8]; unpack8(raw[0], v); unpack8(raw[5], pv);
                { const f32x4* p4 = (const f32x4*)(Lc + 8 * cg8); *(f32x4*)mu8 = p4[0]; *(f32x4*)(mu8 + 4) = p4[1]; }
#pragma unroll
                for (int i = 0; i < 8; ++i) v[i] += mu8[i] * (pv[i] - v[i]);
                *(f32x4*)(Xr + o) = (f32x4){v[0], v[1], v[2], v[3]}; *(f32x4*)(Xr + o + 4) = (f32x4){v[4], v[5], v[6], v[7]};
            }
            asm volatile("" ::: "memory");
            {
                float v[8], pv[8], mu8[8], kw8[8]; unpack8(raw[1], v); unpack8(raw[6], pv);
                { const f32x4* p4 = (const f32x4*)(Lc + 64 + 8 * cg8); *(f32x4*)mu8 = p4[0]; *(f32x4*)(mu8 + 4) = p4[1]; p4 = (const f32x4*)(Lc + 192 + 8 * cg8); *(f32x4*)kw8 = p4[0]; *(f32x4*)(kw8 + 4) = p4[1]; }
                float ss = 0.f;
#pragma unroll
                for (int i = 0; i < 8; ++i) { v[i] += mu8[i] * (pv[i] - v[i]); const float q = v[i] * kw8[i]; ss += q * q; }
                ss += __shfl_xor(ss, 1); ss += __shfl_xor(ss, 2); ss += __shfl_xor(ss, 4);
                if (cg8 == 0) Linv[tt] = frcp(fmaxf(__builtin_amdgcn_sqrtf(ss), 1e-12f));
                *(f32x4*)(Xk + o) = (f32x4){v[0], v[1], v[2], v[3]}; *(f32x4*)(Xk + o + 4) = (f32x4){v[4], v[5], v[6], v[7]};
            }
            asm volatile("" ::: "memory");
            {
                float v[8], pv[8], mu8[8]; unpack8(raw[3], v); unpack8(raw[8], pv);
                { const f32x4* p4 = (const f32x4*)(Lc + 256 + 8 * cg8); *(f32x4*)mu8 = p4[0]; *(f32x4*)(mu8 + 4) = p4[1]; }
#pragma unroll
                for (int i = 0; i < 8; ++i) v[i] = ftanh(v[i] + mu8[i] * (pv[i] - v[i]));
                *(u32x4*)(B0 + tt * LS + 8 * cg8) = pack8(v);
            }
            asm volatile("" ::: "memory");
            {
                float v[8], pv[8], mu8[8]; unpack8(raw[4], v); unpack8(raw[9], pv);
                { const f32x4* p4 = (const f32x4*)(Lc + 320 + 8 * cg8); *(f32x4*)mu8 = p4[0]; *(f32x4*)(mu8 + 4) = p4[1]; }
#pragma unroll
                for (int i = 0; i < 8; ++i) v[i] += mu8[i] * (pv[i] - v[i]);
                *(u32x4*)(B1 + tt * LS + 8 * cg8) = pack8(v);
            }
        }
        }
        LDS_BARRIER();
        float lw[2][4], aa[2][4];
        {
            f32x4 zw[2], za[2];
#pragma unroll
            for (int jj = 0; jj < 2; ++jj) { zw[jj] = (f32x4){0.f, 0.f, 0.f, 0.f}; za[jj] = (f32x4){0.f, 0.f, 0.f, 0.f}; }
#pragma unroll
            for (int ks = 0; ks < 2; ++ks) { const bf16x8 aw = FR_(B0, 16 * wt, 32 * ks), ai = FR_(B1, 16 * wt, 32 * ks);
#pragma unroll
                for (int jj = 0; jj < 2; ++jj) { zw[jj] = MFMA16(aw, Bw[jj][ks], zw[jj]); za[jj] = MFMA16(ai, Bi[jj][ks], za[jj]); } }
#pragma unroll
            for (int jj = 0; jj < 2; ++jj)
#pragma unroll
                for (int r = 0; r < 4; ++r) { lw[jj][r] = -0.6065306597126334f * sigmoidf_(d0c[jj] + zw[jj][r]); aa[jj][r] = sigmoidf_(a0c[jj] + za[jj][r]); }
        }
        float clx[2][4], cin[2][4];
#pragma unroll
        for (int jj = 0; jj < 2; ++jj) {
            const float s4 = (lw[jj][0] + lw[jj][1]) + (lw[jj][2] + lw[jj][3]); float x = s4;
            float t1 = __shfl_up(x, 16); if (fq >= 1) x += t1; t1 = __shfl_up(x, 32); if (fq >= 2) x += t1;
            const float eq = x - s4;
            clx[jj][0] = eq; cin[jj][0] = eq + lw[jj][0];
#pragma unroll
            for (int r = 1; r < 4; ++r) { clx[jj][r] = cin[jj][r - 1]; cin[jj][r] = cin[jj][r - 1] + lw[jj][r]; }
            if (fq == 3) Ltot[wt * 64 + 16 * (wc0 + jj) + fr] = x;
        }
        LDS_BARRIER();
        OPAQ();
        if constexpr ((VAR & 4) == 0) {
        {
            float bsum[4] = {0.f, 0.f, 0.f, 0.f};
            const int xb = lxo + 16 * wt * XS + 16 * wc0;
            const int db = 16 * wt * LS + 16 * wc0;
            const int tb = lto + 16 * wc0 * LS + 16 * wt;
#pragma unroll
            for (int jj = 0; jj < 2; ++jj) {
                const int c = 16 * (wc0 + jj) + fr;
                float off = 0.f, clL = 0.f;
#pragma unroll
                for (int q = 0; q < 4; ++q) { const float tv = Ltot[q * 64 + c]; clL += tv; if (q < wt) off += tv; }
                const float eL = fexp(clL);
                if ((VAR & 1) == 0 && wt == 0 && fq == 0) C.wl()[chx * 64 + c] = eL;
                float at[4], rt[4], bt[4], kt[4], bh[4], kh[4], vv[4]; float eprev = 0.f;
#pragma unroll
                for (int r = 0; r < 4; ++r) {
                    const float rr = Xr[xb + r * XS + 16 * jj], kr = Xk[xb + r * XS + 16 * jj]; vv[r] = Xv[xb + r * XS + 16 * jj];
                    const float kk = kr * kkc[jj] * Linv[16 * wt + 4 * fq + r]; const float a = aa[jj][r];
                    const float be = kk * a, km = kr * (1.0f + (a - 1.0f) * kac[jj]);
                    const float ci_ = off + cin[jj][r], cx = off + clx[jj][r];
                    const float ei = fexp(ci_), en = frcp(ei), el = eL * en;
                    at[r] = -kk * ((r == 0) ? fexp(cx) : eprev); eprev = ei; rt[r] = rr * ei; bt[r] = be * en; kt[r] = km * en; bh[r] = be * el; kh[r] = km * el;
                    bsum[r] += rr * km * rkc[jj];
                    B3[ldo + db + r * LS + 16 * jj] = f2bf(rt[r]);
                }
                u32x2 w;
                w.x = pk2(at[0], at[1]); w.y = pk2(at[2], at[3]); *(u32x2*)(B4 + tb + 16 * jj * LS) = w;
                w.x = pk2(bt[0], bt[1]); w.y = pk2(bt[2], bt[3]); *(u32x2*)(B1 + tb + 16 * jj * LS) = w;
                w.x = pk2(kt[0], kt[1]); w.y = pk2(kt[2], kt[3]); *(u32x2*)(B2 + tb + 16 * jj * LS) = w;
                w.x = pk2(bh[0], bh[1]); w.y = pk2(bh[2], bh[3]); *(u32x2*)(B5 + tb + 16 * jj * LS) = w;
                w.x = pk2(kh[0], kh[1]); w.y = pk2(kh[2], kh[3]); *(u32x2*)(B6 + tb + 16 * jj * LS) = w;
                w.x = pk2(vv[0], vv[1]); w.y = pk2(vv[2], vv[3]); *(u32x2*)(B7 + tb + 16 * jj * LS) = w;
            }
#pragma unroll
            for (int r = 0; r < 4; ++r) { const float s = row16_sum(bsum[r]); if (fr == 0) Lbp[(wid & 1) * 64 + 16 * wt + 4 * fq + r] = s; }
        }
        }
        LDS_BARRIER();
        OPAQ();
        if ((VAR & 1) == 0 && tid < 64) C.bonus()[(size_t)(b * NT + ck * 64 + tid) * 8 + h] = Lbp[tid] + Lbp[64 + tid];
        if constexpr ((VAR & 8) == 0) {
        {
            int fr3 = fr, fq3 = fq; asm volatile("" : "+v"(fr3), "+v"(fq3));
#pragma unroll
            for (int jj = 0; jj < 2; ++jj) {
                const int st = wc0 + jj;
                if (st <= wt) {
                    f32x4 ab = (f32x4){0.f, 0.f, 0.f, 0.f}, ak = ab, rb = ab, rk = ab;
#pragma unroll
                    for (int ks = 0; ks < 2; ++ks) {
                        const bf16x8 fa = tr_frag(B4, LS, 32 * ks, 16 * wt, fr3, fq3), frr = FR_(B3, 16 * wt, 32 * ks);
                        const bf16x8 fb = tr_frag(B1, LS, 32 * ks, 16 * st, fr3, fq3), fk = tr_frag(B2, LS, 32 * ks, 16 * st, fr3, fq3);
                        ab = MFMA16(fa, fb, ab); ak = MFMA16(fa, fk, ak); rb = MFMA16(frr, fb, rb); rk = MFMA16(frr, fk, rk);
                    }
                    int fro = fr, fqo = 4 * fq; asm volatile("" : "+v"(fro), "+v"(fqo));
                    const int s = 16 * st + fro;
#pragma unroll
                    for (int r = 0; r < 4; ++r) { const int t = 16 * wt + fqo + r; const bool lo = s < t, le = s <= t;
                        const float vab = lo ? ab[r] : 0.f;
                        DW_(LAab, 16 * wt, 16 * st, r) = f2bf(vab); DW_(LAak, 16 * wt, 16 * st, r) = f2bf(lo ? ak[r] : 0.f); DW_(LArb, 16 * wt, 16 * st, r) = f2bf(le ? rb[r] : 0.f); DW_(LArk, 16 * wt, 16 * st, r) = f2bf(le ? rk[r] : 0.f);
                        if (st == wt) LAd[wt * 256 + (4 * fq + r) * 16 + fr] = vab; }
                } else if (st == wt + 1 && (wt & 1) == 0) {
#pragma unroll
                    for (int r = 0; r < 4; ++r) { DW_(LAak, 16 * wt, 16 * st, r) = 0; DW_(LArb, 16 * wt, 16 * st, r) = 0; DW_(LArk, 16 * wt, 16 * st, r) = 0; DW_(LTinv, 16 * wt, 16 * st, r) = 0; }
                }
            }
            if (tid < 32) *(u32x4*)(B8 + (16 + (tid >> 1)) * LS + 8 * (tid & 1)) = (u32x4){0u, 0u, 0u, 0u};
        }
        }
        LDS_BARRIER();
        OPAQ();
        if constexpr ((VAR & 16) == 0) {
        if (wid == 0) {
            const float* Ad = LAd + fq * 256; float X[16];
#pragma unroll
            for (int i = 0; i < 16; ++i) X[i] = (i == fr) ? 1.0f : 0.f;
#pragma unroll
            for (int i = 1; i < 16; ++i) { float acc = X[i];
#pragma unroll
                for (int s = 0; s < i; ++s) acc += Ad[i * 16 + s] * X[s];
                X[i] = acc; }
            const int dg = ldo + 12 * fq * LS + 16 * fq;
#pragma unroll
            for (int i = 0; i < 16; ++i) LTinv[dg + i * LS] = f2bf(X[i]);
            const int dt = lfo + 16 * fq * LS + 8 * fq;
            *(u32x4*)(B8 + dt) = pack8(X); *(u32x4*)(B8 + dt + 8) = pack8(X + 8);
        } else {
            for (int tile = wid - 1; tile < 16; tile += 7) { const int vt = tile >> 2, t2 = tile & 3; f32x4 acc = (f32x4){0.f, 0.f, 0.f, 0.f};
#pragma unroll
                for (int ks = 0; ks < 2; ++ks) if (ks == 0 || t2 >= 2) acc = MFMA16(FR_(B7, 16 * vt, 32 * ks), FR_(LAak, 16 * t2, 32 * ks), acc);
#pragma unroll
                for (int r = 0; r < 4; ++r) DW_(B0, 16 * vt, 16 * t2, r) = f2bf(acc[r]); }
        }
        }
        LDS_BARRIER();
        OPAQ();
        if (ci + 1 < nck) R1_LOAD_RAW(m + 64);
        if ((VAR & 32) == 0 && wid < 2) {
            const int o = 32 * wid;
            bf16_t* lx = LX + wid * 16 * 40;
            const bool kv = fq < 2;
            const int xf = fr * 40 + 8 * fq, xd = 4 * fq * 40 + fr;
            {
                const bf16x8 fa = kv ? FR_(B8, o, o) : zero8(), fb = kv ? FR_(LAab, o + 16, o) : zero8();
                const f32x4 acc = MFMA16(fa, fb, ((f32x4){0.f, 0.f, 0.f, 0.f}));
#pragma unroll
                for (int r = 0; r < 4; ++r) lx[xd + r * 40] = f2bf(acc[r]);
            }
            asm volatile("s_waitcnt lgkmcnt(0)" ::: "memory");
            {
                const bf16x8 ft = kv ? FR_(LTinv, o + 16, o + 16) : zero8(), fx = kv ? *(const bf16x8*)(lx + xf) : zero8();
                const f32x4 acc = MFMA16(ft, fx, ((f32x4){0.f, 0.f, 0.f, 0.f}));
#pragma unroll
                for (int r = 0; r < 4; ++r) DW_(LTinv, o + 16, o, r) = f2bf(acc[r]);
                if (wid == 0) { const f32x4 acT = MFMA16(fx, ft, ((f32x4){0.f, 0.f, 0.f, 0.f}));
#pragma unroll
                    for (int r = 0; r < 4; ++r) DW_(B8, 0, 16, r) = f2bf(acT[r]); }
            }
        }
        LDS_BARRIER();
        if ((VAR & 32) == 0 && wid < 4) {
            const int jt = wid >> 1, ut = wid & 1;
            const f32x4 acc = MFMA16(FR_(B8, 16 * jt, 0), FR_(LAab, 32 + 16 * ut, 0), ((f32x4){0.f, 0.f, 0.f, 0.f}));
#pragma unroll
            for (int r = 0; r < 4; ++r) LX2[(16 * jt + 4 * fq + r) * 40 + 16 * ut + fr] = f2bf(acc[r]);
        }
        LDS_BARRIER();
        if ((VAR & 32) == 0 && wid < 4) {
            const int t2 = wid >> 1, jt = wid & 1;
            const f32x4 acc = MFMA16(FR_(LTinv, 32 + 16 * t2, 32), *(const bf16x8*)(LX2 + (16 * jt + fr) * 40 + 8 * fq), ((f32x4){0.f, 0.f, 0.f, 0.f}));
#pragma unroll
            for (int r = 0; r < 4; ++r) DW_(LTinv, 32 + 16 * t2, 16 * jt, r) = f2bf(acc[r]);
        }
        LDS_BARRIER();
        OPAQ();
        if constexpr ((VAR & 64) == 0) {
        {
#pragma unroll
            for (int jj = 0; jj < 2; ++jj) { const int t2 = wc0 + jj; f32x4 p1 = (f32x4){0.f, 0.f, 0.f, 0.f}, p2 = p1;
#pragma unroll
                for (int ks = 0; ks < 2; ++ks) if (ks == 0 || t2 >= 2) { const bf16x8 ft = FR_(LTinv, 16 * t2, 32 * ks);
                    p1 = MFMA16(FR_(B4, 16 * wt, 32 * ks), ft, p1); p2 = MFMA16(FR_(B0, 16 * wt, 32 * ks), ft, p2); }
#pragma unroll
                for (int r = 0; r < 4; ++r) { DW_(B1, 16 * wt, 16 * t2, r) = f2bf(p1[r]); DW_(B2, 16 * wt, 16 * t2, r) = f2bf(p2[r]); } }
        }
        }
        LDS_BARRIER();
        OPAQ();
        if constexpr ((VAR & 128) == 0) {
        {
            bf16_t* gq = C.q1p() + chx * 4096; bf16_t* gm = C.mp() + chx * 4096; bf16_t* gy = C.yid() + chx * 4096; bf16_t* gn = C.nd() + chx * 4096;
#pragma unroll
            for (int jj = 0; jj < 2; ++jj) {
                const int ct2 = wc0 + jj;
                f32x4 q1 = (f32x4){0.f, 0.f, 0.f, 0.f}, mm = q1, yi = q1, nn = q1;
#pragma unroll
                for (int ks = 0; ks < 2; ++ks) {
                    const bf16x8 fp1 = FR_(B1, 16 * wt, 32 * ks);
                    if (ks == 0 || ct2 >= 2) q1 = MFMA16(fp1, FR_(LArb, 16 * ct2, 32 * ks), q1);
                    mm = MFMA16(fp1, FR_(B5, 16 * ct2, 32 * ks), mm);
                    const bf16x8 fp2 = FR_(B2, 16 * ct2, 32 * ks), fv = FR_(B7, 16 * ct2, 32 * ks);
                    if (ks == 0 || wt >= 2) { yi = MFMA16(FR_(LArb, 16 * wt, 32 * ks), fp2, yi); yi = MFMA16(FR_(LArk, 16 * wt, 32 * ks), fv, yi); }
                    nn = MFMA16(FR_(B5, 16 * wt, 32 * ks), fp2, nn); nn = MFMA16(FR_(B6, 16 * wt, 32 * ks), fv, nn);
                }
                {
                    const int t = 16 * ct2 + fr, c0 = 16 * wt + 4 * fq; const u32x2 rv = *(const u32x2*)(B3 + lto + 16 * ct2 * LS + 16 * wt);
                    u32x2 w; w.x = pk2(q1[0] + __uint_as_float(rv.x << 16), q1[1] + __uint_as_float(rv.x & 0xffff0000u)); w.y = pk2(q1[2] + __uint_as_float(rv.y << 16), q1[3] + __uint_as_float(rv.y & 0xffff0000u));
                    *(u32x2*)(B0 + t * LS + permc(c0)) = w;
                    u32x2 w2; w2.x = pk2(mm[0], mm[1]); w2.y = pk2(mm[2], mm[3]); *(u32x2*)(B4 + t * LS + permc(c0)) = w2;
                }
                { u32x2 w; w.x = pk2(yi[0], yi[1]); w.y = pk2(yi[2], yi[3]); if ((VAR & 1) == 0) *(u32x2*)(gy + ((wt * 4 + ct2) * 64 + lane) * 4) = w;
                  u32x2 w2; w2.x = pk2(nn[0], nn[1]); w2.y = pk2(nn[2], nn[3]); if ((VAR & 1) == 0) *(u32x2*)(gn + ((wt * 4 + ct2) * 64 + lane) * 4) = w2; }
            }
        }
        }
        LDS_BARRIER();
        if constexpr ((VAR & 1) == 0 && (VAR & 128) == 0) {
            const int o = (tid >> 3) * LS + (tid & 7) * 8;
            *(u32x4*)(C.q1p() + chx * 4096 + tid * 8) = *(const u32x4*)(B0 + o); *(u32x4*)(C.mp() + chx * 4096 + tid * 8) = *(const u32x4*)(B4 + o);
        }
    }
}
#undef FR_
#undef DW_
#undef OPAQ

constexpr int R2_SLOT = 2 * 64 * 72 * 2 + 2 * 8192 + 256;
struct R2Set { u32x4 q, m, y, n, w; };
__device__ __forceinline__ void r2_issue(const Ctx& C, R2Set& r, size_t chx, int tid) {
    r.q = *(const u32x4*)(C.q1p() + chx * 4096 + tid * 8); r.m = *(const u32x4*)(C.mp() + chx * 4096 + tid * 8);
    r.y = *(const u32x4*)(C.yid() + chx * 4096 + tid * 8); r.n = *(const u32x4*)(C.nd() + chx * 4096 + tid * 8);
    r.w = *(const u32x4*)(C.wl() + chx * 64 + 4 * (tid & 15));
}
__device__ __forceinline__ void r2_put(const R2Set& r, unsigned char* slot, int tid) {
    bf16_t* LQ = (bf16_t*)slot; bf16_t* LM = LQ + 64 * 72; bf16_t* LY = LM + 64 * 72; bf16_t* LN = LY + 4096; float* LW = (float*)(LN + 4096);
    const int o = (tid >> 3) * 72 + (tid & 7) * 8;
    *(u32x4*)(LQ + o) = r.q; *(u32x4*)(LM + o) = r.m; *(u32x4*)(LY + tid * 8) = r.y; *(u32x4*)(LN + tid * 8) = r.n;
    if (tid < 16) *(u32x4*)(LW + 4 * tid) = r.w;
}
__device__ __forceinline__ void r2_step(const Ctx& C, f32x4 (&S)[4], const unsigned char* slot, int b, int h, int vt, int ck, int lane, int fr, int fq) {
    const bf16_t* LQ = (const bf16_t*)slot; const bf16_t* LM = LQ + 64 * 72; const bf16_t* LY = LM + 64 * 72; const bf16_t* LN = LY + 4096; const float* LW = (const float*)(LN + 4096);
    bf16x8 Sb[2];
#pragma unroll
    for (int ks = 0; ks < 2; ++ks) { u32x4 w; w.x = pk2(S[2 * ks][0], S[2 * ks][1]); w.y = pk2(S[2 * ks][2], S[2 * ks][3]); w.z = pk2(S[2 * ks + 1][0], S[2 * ks + 1][1]); w.w = pk2(S[2 * ks + 1][2], S[2 * ks + 1][3]);
        Sb[ks] = __builtin_bit_cast(bf16x8, w); }
    f32x4 Sn[4];
#pragma unroll
    for (int c4 = 0; c4 < 4; ++c4) {
        const u32x2 nv = *(const u32x2*)(LN + ((c4 * 4 + vt) * 64 + lane) * 4); const f32x4 wl = *(const f32x4*)(LW + 16 * c4 + 4 * fq);
        f32x4 acc = (f32x4){__uint_as_float(nv.x << 16), __uint_as_float(nv.x & 0xffff0000u), __uint_as_float(nv.y << 16), __uint_as_float(nv.y & 0xffff0000u)};
        acc = acc + wl * S[c4];
#pragma unroll
        for (int ks = 0; ks < 2; ++ks) acc = MFMA16(*(const bf16x8*)(LM + (16 * c4 + fr) * 72 + 32 * ks + 8 * fq), Sb[ks], acc);
        Sn[c4] = acc;
    }
#pragma unroll
    for (int t4 = 0; t4 < 4; ++t4) {
        const u32x2 yv = *(const u32x2*)(LY + ((t4 * 4 + vt) * 64 + lane) * 4);
        f32x4 acc = (f32x4){__uint_as_float(yv.x << 16), __uint_as_float(yv.x & 0xffff0000u), __uint_as_float(yv.y << 16), __uint_as_float(yv.y & 0xffff0000u)};
#pragma unroll
        for (int ks = 0; ks < 2; ++ks) acc = MFMA16(*(const bf16x8*)(LQ + (16 * t4 + fr) * 72 + 32 * ks + 8 * fq), Sb[ks], acc);
        bf16_t* yo = C.proj() + pjo((size_t)(b * NT + ck * 64 + 16 * t4 + 4 * fq), C_R + h * 64 + 16 * vt + fr);
#pragma unroll
        for (int r = 0; r < 4; ++r) yo[(size_t)r * 256] = f2bf(acc[r]);
    }
#pragma unroll
    for (int c4 = 0; c4 < 4; ++c4) S[c4] = Sn[c4];
}
__device__ __forceinline__ void rwkv_r2_wg(const Ctx& C, int b, int h) {
    const int tid = C.tid, lane = C.lane, wid = C.wid, fr = lane & 15, fq = lane >> 4;
    unsigned char* slot0 = C.lds; unsigned char* slot1 = C.lds + R2_SLOT;
    const size_t ch0 = (size_t)((b * 8 + h) * 64);
    f32x4 S[4];
#pragma unroll
    for (int i = 0; i < 4; ++i) S[i] = (f32x4){0.f, 0.f, 0.f, 0.f};
    R2Set r0, r1, r2, r3;
    __syncthreads();
    r2_issue(C, r0, ch0 + 0, tid); r2_issue(C, r1, ch0 + 1, tid); r2_issue(C, r2, ch0 + 2, tid); r2_issue(C, r3, ch0 + 3, tid);
    r2_put(r0, slot0, tid); r2_issue(C, r0, ch0 + 4, tid);
    LDS_BARRIER();
    for (int c = 0; c < NT / 64; c += 4) {
#define R2_ITER(i, rnext, snext, scur) do { const int cc = c + (i); const int cn = (cc + 5 < NT / 64) ? cc + 5 : NT / 64 - 1; \
        r2_put(rnext, snext, tid); r2_issue(C, rnext, ch0 + cn, tid);                  \
        if (wid < 4) r2_step(C, S, scur, b, h, wid, cc, lane, fr, fq); \
        LDS_BARRIER(); } while (0)
        R2_ITER(0, r1, slot1, slot0);
        R2_ITER(1, r2, slot0, slot1);
        R2_ITER(2, r3, slot1, slot0);
        R2_ITER(3, r0, slot0, slot1);
#undef R2_ITER
    }
}
constexpr int C_G = DIN;
__device__ __forceinline__ float* gate_ptr(bf16_t* proj, size_t m, int hm) { return (float*)(proj + pjo(m, C_G)) + 4 * hm; }

__device__ __forceinline__ void mlstm_gate_scan(const Ctx& C, int b, int hm, int ck) {
    const int lane = C.lane;
    const size_t mg = (size_t)(b * NT + ck * 64 + lane); const bf16_t* pr = C.proj();
    const float ig = bf2f(pr[pjo(mg, C_I + hm)]) + C.b_i()[hm]; const float fp = bf2f(pr[pjo(mg, C_F + hm)]) + C.b_f()[hm];
    const float lf = (fp >= 0.f) ? -log1pf(expf(-fp)) : fp - log1pf(expf(fp));
    float bc = lf;
#pragma unroll
    for (int o = 1; o < 64; o <<= 1) { const float tv = __shfl_up(bc, o); if (lane >= o) bc += tv; }
    const float e = ig - bc; float pm = e;
#pragma unroll
    for (int o = 1; o < 64; o <<= 1) { const float tv = __shfl_up(pm, o); if (lane >= o) pm = fmaxf(pm, tv); }
    *(f32x4*)gate_ptr(C.proj(), mg, hm) = (f32x4){bc, e, pm, 0.f};
}
__device__ __forceinline__ void mlstm_m1_stream(const Ctx& C) {
    const int lane = C.lane; const bool isk = lane >= 32; const int ch = 16 * (lane & 31);
    const int col = (isk ? C_KM : C_Q) + ch; const int cw = (isk ? 512 : 0) + ch;
    float w[4][16], bias[16];
#pragma unroll
    for (int i = 0; i < 16; i += 4) { const f32x4 bv = *(const f32x4*)(C.conv_b() + cw + i); bias[i] = bv.x; bias[i + 1] = bv.y; bias[i + 2] = bv.z; bias[i + 3] = bv.w;
#pragma unroll
        for (int j = 0; j < 4; ++j) { const f32x4 wv = *(const f32x4*)(C.conv_w() + j * 1024 + cw + i); w[j][i] = wv.x; w[j][i + 1] = wv.y; w[j][i + 2] = wv.z; w[j][i + 3] = wv.w; } }
    const float osc = isk ? 0.08838834764831845f : 1.0f;
    bf16_t* dst = (isk ? C.kc() : C.qc()) + ch;
    for (int t0 = 16 * C.gw; t0 < NTOK; t0 += 16 * C.ngw) {
        const int tb = t0 & (NT - 1);
        u32x4 ring[7][2];
        const bf16_t* p0 = C.proj() + pjo((size_t)t0, col);
#pragma unroll
        for (int k = 0; k < 7; ++k) {
            if (k < 3 && tb == 0) { ring[k][0] = (u32x4){0u, 0u, 0u, 0u}; ring[k][1] = ring[k][0]; }
            else { const bf16_t* p = p0 + (ptrdiff_t)(k - 3) * 256; ring[k][0] = *(const u32x4*)p; ring[k][1] = *(const u32x4*)(p + 8); }
        }
#pragma unroll
        for (int i = 0; i < 16; ++i) {
            const size_t m = (size_t)(t0 + i);
            float a[16], x0[16], x1[16], x2[16], x3[16];
            unpack8(ring[i % 7][0], x0); unpack8(ring[i % 7][1], x0 + 8); unpack8(ring[(i + 1) % 7][0], x1); unpack8(ring[(i + 1) % 7][1], x1 + 8);
            unpack8(ring[(i + 2) % 7][0], x2); unpack8(ring[(i + 2) % 7][1], x2 + 8); unpack8(ring[(i + 3) % 7][0], x3); unpack8(ring[(i + 3) % 7][1], x3 + 8);
            { const int rn = (i + 4 < 16) ? i + 4 : 15; const bf16_t* p = p0 + (size_t)rn * 256; ring[i % 7][0] = *(const u32x4*)p; ring[i % 7][1] = *(const u32x4*)(p + 8); }
#pragma unroll
            for (int c = 0; c < 16; ++c) { a[c] = bias[c] + w[0][c] * x0[c] + w[1][c] * x1[c] + w[2][c] * x2[c] + w[3][c] * x3[c]; a[c] = siluf_(a[c]) * osc; }
            *(u32x4*)(dst + m * 512) = pack8(a); *(u32x4*)(dst + m * 512 + 8) = pack8(a + 8);
        }
    }
}

__device__ __forceinline__ void mlstm_p0_item(const Ctx& C, int b, int hm, int ck) {
    const int lane = C.lane, fr = lane & 15, fq = lane >> 4;
    {
        const int it = (b << 8) | (ck << 2) | hm; const size_t m0 = (size_t)(b * NT + ck * 64);
        bf16_t* out = C.p0s() + (size_t)it * 4096;
        bf16x8 kf[4][4]; float es[4][4];
#pragma unroll
        for (int sj = 0; sj < 4; ++sj) {
#pragma unroll
            for (int ks = 0; ks < 4; ++ks) kf[sj][ks] = *(const bf16x8*)(C.kc() + (m0 + 16 * sj + fr) * 512 + hm * 128 + 32 * ks + 8 * fq);
#pragma unroll
            for (int r = 0; r < 4; ++r) es[sj][r] = gate_ptr(C.proj(), m0 + 16 * sj + 4 * fq + r, hm)[1]; }
#pragma unroll
        for (int ti = 0; ti < 4; ++ti) {
            bf16x8 qf[4];
#pragma unroll
            for (int ks = 0; ks < 4; ++ks) qf[ks] = *(const bf16x8*)(C.qc() + (m0 + 16 * ti + fr) * 512 + hm * 128 + 32 * ks + 8 * fq);
            const int t = 16 * ti + fr; const float pmt = gate_ptr(C.proj(), m0 + t, hm)[2];
#pragma unroll
            for (int sj = 0; sj < 4; ++sj) {
                f32x4 acc = (f32x4){0.f, 0.f, 0.f, 0.f};
                if (sj <= ti) {
#pragma unroll
                    for (int ks = 0; ks < 4; ++ks) acc = __builtin_amdgcn_mfma_f32_16x16x32_bf16(kf[sj][ks], qf[ks], acc, 0, 0, 0);
                }
                float o[4];
#pragma unroll
                for (int r = 0; r < 4; ++r) { const int s = 16 * sj + 4 * fq + r; o[r] = (sj <= ti && s <= t) ? acc[r] * fexp(es[sj][r] - pmt) : 0.f; }
                u32x2 w; w.x = pk2(o[0], o[1]); w.y = pk2(o[2], o[3]); *(u32x2*)(out + t * 64 + 16 * sj + 4 * fq) = w;
            }
        }
    }
}

#define LDS_WAIT_ALL() asm volatile("s_waitcnt lgkmcnt(0)" ::: "memory")
constexpr int VS = 52;
constexpr int ML_BUF = (2 * 64 * 136 + 2 * 64 * VS + 64 * 72) * 2 + 1280;
template <int VAR> __device__ __forceinline__ void mlstm_item(const Ctx& C, int b, int hm, int sl) {
    constexpr bool st_out = (VAR & 1) == 0;
    unsigned char* buf0 = C.lds; unsigned char* buf1 = C.lds + ML_BUF;
    bf16_t* LCb0 = (bf16_t*)(C.lds + 2 * ML_BUF); bf16_t* LCb1 = LCb0 + 48 * 136;
#define ML_Q(bf) ((bf16_t*)(bf))
#define ML_K(bf) (ML_Q(bf) + 64 * 136)
#define ML_V(bf) (ML_K(bf) + 64 * 136)
#define ML_WV(bf) (ML_V(bf) + 64 * VS)
#define ML_P(bf) (ML_WV(bf) + 64 * VS)
#define ML_F(bf) ((float*)(ML_P(bf) + 64 * 72))
    const int tid = C.tid, lane = C.lane, wid = C.wid;
    const int fr_ = lane & 15, fq_ = lane >> 4, tt_ = tid >> 3;
    __syncthreads();
    for (int e = tid; e < 2 * 48 * 136; e += NTHR) LCb0[e] = 0;
    for (int e = tid; e < 64 * VS; e += NTHR) { const bf16_t o = ((e % VS) == 32) ? (bf16_t)0x3f80 : (bf16_t)0; ML_V(buf0)[e] = o; ML_V(buf1)[e] = o; ML_WV(buf0)[e] = 0; ML_WV(buf1)[e] = 0; }
    for (int e = tid; e < 64 * 72; e += NTHR) { ML_P(buf0)[e] = 0; ML_P(buf1)[e] = 0; }
    const int cg8 = tid & 7, d0 = 16 * cg8;
    const int ti = wid >> 1, vtw = wid & 1;
    const int ct0_t = (wid < 4) ? ((wid == 0) ? 0 : (wid == 3 ? 2 : 1)) : ((wid == 4) ? 2 : 3), ct0_s = (wid < 4) ? ((wid == 2) ? 1 : 0) : ((wid == 4) ? 1 : wid - 5);
    const int ct1_t = (wid == 0) ? 2 : 3, ct1_s = (wid == 0) ? 2 : 3; const bool has2 = wid < 2;
    f32x4 Cst[3];
#pragma unroll
    for (int i = 0; i < 3; ++i) Cst[i] = (f32x4){0.f, 0.f, 0.f, 0.f};
    float mst = 0.f, carry_cur = 1.f, carry_nxt = 1.f;
    u32x4 pq0, pq1, pk0, pk1, pp; u32x2 pv; f32x4 pg, pgl; u32x4 pq0_b, pq1_b, pk0_b, pk1_b, pp_b; u32x2 pv_b; f32x4 pg_b, pgl_b;
    const bf16_t* p0base = C.p0s() + (size_t)(((b * 64) * 4 + hm)) * 4096 + tid * 8;
    {
        const size_t m = (size_t)(b * NT + tt_);
        const bf16_t* qs = C.qc() + m * 512 + hm * 128 + d0; const bf16_t* ks = C.kc() + m * 512 + hm * 128 + d0;
        pq0 = *(const u32x4*)qs; pq1 = *(const u32x4*)(qs + 8); pk0 = *(const u32x4*)ks; pk1 = *(const u32x4*)(ks + 8);
        pv = *(const u32x2*)(C.proj() + pjo(m, C_VM + hm * 128 + sl * 32 + 4 * cg8));
        pg = *(const f32x4*)gate_ptr(C.proj(), m, hm); pgl = *(const f32x4*)gate_ptr(C.proj(), (size_t)(b * NT + 63), hm); pp = *(const u32x4*)p0base;
        const size_t m2 = m + 64; qs += 64 * 512; ks += 64 * 512;
        pq0_b = *(const u32x4*)qs; pq1_b = *(const u32x4*)(qs + 8); pk0_b = *(const u32x4*)ks; pk1_b = *(const u32x4*)(ks + 8);
        pv_b = *(const u32x2*)(C.proj() + pjo(m2, C_VM + hm * 128 + sl * 32 + 4 * cg8));
        pg_b = *(const f32x4*)gate_ptr(C.proj(), m2, hm); pgl_b = *(const f32x4*)gate_ptr(C.proj(), (size_t)(b * NT + 127), hm); pp_b = *(const u32x4*)(p0base + 4 * 4096);
    }
    __syncthreads();
    { const int kst = 0; const int fr = fr_, fq = fq_, tt = tt_;
        asm volatile("" :: "v"(pg.w), "v"(pgl.y), "v"(pgl.w));
        {
            const float mxl = fmaxf(mst, pgl.z); carry_nxt = fexp(mst - mxl);
            if constexpr ((VAR & 16) == 0) {
                const float ws = fexp(pg.y - mxl);
                *(u32x4*)(ML_Q(buf0) + tt * 136 + d0) = pq0; *(u32x4*)(ML_Q(buf0) + tt * 136 + d0 + 8) = pq1;
                *(u32x4*)(ML_K(buf0) + tt * 136 + d0) = pk0; *(u32x4*)(ML_K(buf0) + tt * 136 + d0 + 8) = pk1;
                const float v0 = __uint_as_float(pv.x << 16), v1 = __uint_as_float(pv.x & 0xffff0000u), v2 = __uint_as_float(pv.y << 16), v3 = __uint_as_float(pv.y & 0xffff0000u);
                *(u32x2*)(ML_V(buf0) + tt * VS + 4 * cg8) = pv; *(u32x4*)(ML_P(buf0) + tt * 72 + 8 * cg8) = pp;
                u32x2 wv; wv.x = pk2(v0 * ws, v1 * ws); wv.y = pk2(v2 * ws, v3 * ws); *(u32x2*)(ML_WV(buf0) + tt * VS + 4 * cg8) = wv;
                if (cg8 == 0) { ML_WV(buf0)[tt * VS + 32] = f2bf(ws); const float mx = fmaxf(mst, pg.z); float* F = ML_F(buf0); F[tt] = pg.y; F[64 + tt] = mx; F[128 + tt] = fexp(mst - mx); F[192 + tt] = fexp(-(pg.x + mx)); F[256 + tt] = fexp(pg.z - mx); }
            }
            mst = pgl.x + mxl;
            const int cn = (kst + 2 < NT / 64) ? kst + 2 : NT / 64 - 1;
            const size_t m = (size_t)(b * NT + cn * 64 + tt);
            const bf16_t* qs = C.qc() + m * 512 + hm * 128 + d0; const bf16_t* ks = C.kc() + m * 512 + hm * 128 + d0;
            pq0 = *(const u32x4*)qs; pq1 = *(const u32x4*)(qs + 8); pk0 = *(const u32x4*)ks; pk1 = *(const u32x4*)(ks + 8);
            pv = *(const u32x2*)(C.proj() + pjo(m, C_VM + hm * 128 + sl * 32 + 4 * cg8));
            pg = *(const f32x4*)gate_ptr(C.proj(), m, hm); pgl = *(const f32x4*)gate_ptr(C.proj(), (size_t)(b * NT + cn * 64 + 63), hm); pp = *(const u32x4*)(p0base + (size_t)cn * 4 * 4096);
        }
    }
    carry_cur = carry_nxt;
    LDS_BARRIER();
    { const int kc = 0; const int fr = fr_, fq = fq_;
    }
    for (int ck2 = 0; ck2 < NT / 64; ck2 += 2) {
      { const int ck = ck2;
        int fr = fr_, fq = fq_, tt = tt_; asm volatile("" : "+v"(fr), "+v"(fq), "+v"(tt));
        { const int kst = ck + 1;
        asm volatile("" :: "v"(pg_b.w), "v"(pgl_b.y), "v"(pgl_b.w));
        {
            const float mxl = fmaxf(mst, pgl_b.z); carry_nxt = fexp(mst - mxl);
            if constexpr ((VAR & 16) == 0) {
                const float ws = fexp(pg_b.y - mxl);
                *(u32x4*)(ML_Q(buf1) + tt * 136 + d0) = pq0_b; *(u32x4*)(ML_Q(buf1) + tt * 136 + d0 + 8) = pq1_b;
                *(u32x4*)(ML_K(buf1) + tt * 136 + d0) = pk0_b; *(u32x4*)(ML_K(buf1) + tt * 136 + d0 + 8) = pk1_b;
                const float v0 = __uint_as_float(pv_b.x << 16), v1 = __uint_as_float(pv_b.x & 0xffff0000u), v2 = __uint_as_float(pv_b.y << 16), v3 = __uint_as_float(pv_b.y & 0xffff0000u);
                *(u32x2*)(ML_V(buf1) + tt * VS + 4 * cg8) = pv_b; *(u32x4*)(ML_P(buf1) + tt * 72 + 8 * cg8) = pp_b;
                u32x2 wv; wv.x = pk2(v0 * ws, v1 * ws); wv.y = pk2(v2 * ws, v3 * ws); *(u32x2*)(ML_WV(buf1) + tt * VS + 4 * cg8) = wv;
                if (cg8 == 0) { ML_WV(buf1)[tt * VS + 32] = f2bf(ws); const float mx = fmaxf(mst, pg_b.z); float* F = ML_F(buf1); F[tt] = pg_b.y; F[64 + tt] = mx; F[128 + tt] = fexp(mst - mx); F[192 + tt] = fexp(-(pg_b.x + mx)); F[256 + tt] = fexp(pg_b.z - mx); }
            }
            mst = pgl_b.x + mxl;
            const int cn = (kst + 2 < NT / 64) ? kst + 2 : NT / 64 - 1;
            const size_t m = (size_t)(b * NT + cn * 64 + tt);
            const bf16_t* qs = C.qc() + m * 512 + hm * 128 + d0; const bf16_t* ks = C.kc() + m * 512 + hm * 128 + d0;
            pq0_b = *(const u32x4*)qs; pq1_b = *(const u32x4*)(qs + 8); pk0_b = *(const u32x4*)ks; pk1_b = *(const u32x4*)(ks + 8);
            pv_b = *(const u32x2*)(C.proj() + pjo(m, C_VM + hm * 128 + sl * 32 + 4 * cg8));
            pg_b = *(const f32x4*)gate_ptr(C.proj(), m, hm); pgl_b = *(const f32x4*)gate_ptr(C.proj(), (size_t)(b * NT + cn * 64 + 63), hm); pp_b = *(const u32x4*)(p0base + (size_t)cn * 4 * 4096);
        }
        }
        { const int kc = ck + 1;
        }
        {
            const int mbase = b * NT + ck * 64;
            const bf16_t* LQ = ML_Q(buf0); const bf16_t* LK = ML_K(buf0); const bf16_t* LV = ML_V(buf0); const bf16_t* LWV = ML_WV(buf0); const bf16_t* LP = ML_P(buf0); const float* F = ML_F(buf0);
            const bf16_t* LCr = LCb0; bf16_t* LCw = LCb1;
            bf16x8 fp[2], fvr[2], fvd[2], fqq[4], fcr[4], fcd[4], kf[2], fw[3][2]; float inr[4], clr[4], rsr[4];
#pragma unroll
            for (int ks = 0; ks < 2; ++ks) { fp[ks] = *(const bf16x8*)(LP + (16 * ti + fr) * 72 + 32 * ks + 8 * fq); fvr[ks] = tr_frag(LV, VS, 32 * ks, 16 * vtw, fr, fq); fvd[ks] = tr_frag(LV, VS, 32 * ks, 32, fr, fq); }
#pragma unroll
            for (int ks = 0; ks < 4; ++ks) { fqq[ks] = *(const bf16x8*)(LQ + (16 * ti + fr) * 136 + 32 * ks + 8 * fq); fcr[ks] = *(const bf16x8*)(LCr + (16 * vtw + fr) * 136 + 32 * ks + 8 * fq); fcd[ks] = *(const bf16x8*)(LCr + (32 + fr) * 136 + 32 * ks + 8 * fq); }
#pragma unroll
            for (int ks = 0; ks < 2; ++ks) { kf[ks] = tr_frag(LK, 136, 32 * ks, 16 * wid, fr, fq);
#pragma unroll
                for (int vt2 = 0; vt2 < 3; ++vt2) fw[vt2][ks] = tr_frag(LWV, VS, 32 * ks, 16 * vt2, fr, fq); }
#pragma unroll
            for (int r = 0; r < 4; ++r) { inr[r] = F[128 + 16 * ti + 4 * fq + r]; clr[r] = F[192 + 16 * ti + 4 * fq + r]; rsr[r] = F[256 + 16 * ti + 4 * fq + r]; }
            LDS_WAIT_ALL();
            f32x4 numr = (f32x4){0.f, 0.f, 0.f, 0.f}, numd = numr;
            if constexpr ((VAR & 4) == 0) {
                f32x4 a1r = (f32x4){0.f, 0.f, 0.f, 0.f}, a1d = a1r, a2r = a1r, a2d = a1r;
#pragma unroll
                for (int ks = 0; ks < 2; ++ks) { a1r = __builtin_amdgcn_mfma_f32_16x16x32_bf16(fp[ks], fvr[ks], a1r, 0, 0, 0); a1d = __builtin_amdgcn_mfma_f32_16x16x32_bf16(fp[ks], fvd[ks], a1d, 0, 0, 0); }
#pragma unroll
                for (int ks = 0; ks < 4; ++ks) { a2r = __builtin_amdgcn_mfma_f32_16x16x32_bf16(fqq[ks], fcr[ks], a2r, 0, 0, 0); a2d = __builtin_amdgcn_mfma_f32_16x16x32_bf16(fqq[ks], fcd[ks], a2d, 0, 0, 0); }
#pragma unroll
                for (int r = 0; r < 4; ++r) { numr[r] = rsr[r] * a1r[r] + inr[r] * a2r[r]; numd[r] = rsr[r] * a1d[r] + inr[r] * a2d[r]; }
            }
            if constexpr ((VAR & 8) == 0) {
#pragma unroll
                for (int vt2 = 0; vt2 < 3; ++vt2) {
                    f32x4 acc = Cst[vt2] * carry_cur;
#pragma unroll
                    for (int ks = 0; ks < 2; ++ks) acc = __builtin_amdgcn_mfma_f32_16x16x32_bf16(fw[vt2][ks], kf[ks], acc, 0, 0, 0);
                    Cst[vt2] = acc;
#pragma unroll
                    for (int r = 0; r < 4; ++r) LCw[(16 * vt2 + 4 * fq + r) * 136 + 16 * wid + fr] = f2bf(acc[r]);
                }
            }
#pragma unroll
            for (int r = 0; r < 4; ++r) { const int t = 16 * ti + 4 * fq + r;
                const float den = __shfl(numd[r], lane & 48);
                const float dv = fmaxf(fabsf(den), clr[r]);
                if (st_out) C.proj()[pjo((size_t)(mbase + t), C_VM + hm * 128 + sl * 32 + 16 * vtw + fr)] = f2bf(numr[r] * frcp(dv)); }
        }
        carry_cur = carry_nxt;
        LDS_BARRIER();
      }
      { const int ck = ck2 + 1;
        int fr = fr_, fq = fq_, tt = tt_; asm volatile("" : "+v"(fr), "+v"(fq), "+v"(tt));
        { const int kst = ck + 1;
        asm volatile("" :: "v"(pg.w), "v"(pgl.y), "v"(pgl.w));
        {
            const float mxl = fmaxf(mst, pgl.z); carry_nxt = fexp(mst - mxl);
            if constexpr ((VAR & 16) == 0) {
                const float ws = fexp(pg.y - mxl);
                *(u32x4*)(ML_Q(buf0) + tt * 136 + d0) = pq0; *(u32x4*)(ML_Q(buf0) + tt * 136 + d0 + 8) = pq1;
                *(u32x4*)(ML_K(buf0) + tt * 136 + d0) = pk0; *(u32x4*)(ML_K(buf0) + tt * 136 + d0 + 8) = pk1;
                const float v0 = __uint_as_float(pv.x << 16), v1 = __uint_as_float(pv.x & 0xffff0000u), v2 = __uint_as_float(pv.y << 16), v3 = __uint_as_float(pv.y & 0xffff0000u);
                *(u32x2*)(ML_V(buf0) + tt * VS + 4 * cg8) = pv; *(u32x4*)(ML_P(buf0) + tt * 72 + 8 * cg8) = pp;
                u32x2 wv; wv.x = pk2(v0 * ws, v1 * ws); wv.y = pk2(v2 * ws, v3 * ws); *(u32x2*)(ML_WV(buf0) + tt * VS + 4 * cg8) = wv;
                if (cg8 == 0) { ML_WV(buf0)[tt * VS + 32] = f2bf(ws); const float mx = fmaxf(mst, pg.z); float* F = ML_F(buf0); F[tt] = pg.y; F[64 + tt] = mx; F[128 + tt] = fexp(mst - mx); F[192 + tt] = fexp(-(pg.x + mx)); F[256 + tt] = fexp(pg.z - mx); }
            }
            mst = pgl.x + mxl;
            const int cn = (kst + 2 < NT / 64) ? kst + 2 : NT / 64 - 1;
            const size_t m = (size_t)(b * NT + cn * 64 + tt);
            const bf16_t* qs = C.qc() + m * 512 + hm * 128 + d0; const bf16_t* ks = C.kc() + m * 512 + hm * 128 + d0;
            pq0 = *(const u32x4*)qs; pq1 = *(const u32x4*)(qs + 8); pk0 = *(const u32x4*)ks; pk1 = *(const u32x4*)(ks + 8);
            pv = *(const u32x2*)(C.proj() + pjo(m, C_VM + hm * 128 + sl * 32 + 4 * cg8));
            pg = *(const f32x4*)gate_ptr(C.proj(), m, hm); pgl = *(const f32x4*)gate_ptr(C.proj(), (size_t)(b * NT + cn * 64 + 63), hm); pp = *(const u32x4*)(p0base + (size_t)cn * 4 * 4096);
        }
        }
        { const int kc = ck + 1;
        }
        {
            const int mbase = b * NT + ck * 64;
            const bf16_t* LQ = ML_Q(buf1); const bf16_t* LK = ML_K(buf1); const bf16_t* LV = ML_V(buf1); const bf16_t* LWV = ML_WV(buf1); const bf16_t* LP = ML_P(buf1); const float* F = ML_F(buf1);
            const bf16_t* LCr = LCb1; bf16_t* LCw = LCb0;
            bf16x8 fp[2], fvr[2], fvd[2], fqq[4], fcr[4], fcd[4], kf[2], fw[3][2]; float inr[4], clr[4], rsr[4];
#pragma unroll
            for (int ks = 0; ks < 2; ++ks) { fp[ks] = *(const bf16x8*)(LP + (16 * ti + fr) * 72 + 32 * ks + 8 * fq); fvr[ks] = tr_frag(LV, VS, 32 * ks, 16 * vtw, fr, fq); fvd[ks] = tr_frag(LV, VS, 32 * ks, 32, fr, fq); }
#pragma unroll
            for (int ks = 0; ks < 4; ++ks) { fqq[ks] = *(const bf16x8*)(LQ + (16 * ti + fr) * 136 + 32 * ks + 8 * fq); fcr[ks] = *(const bf16x8*)(LCr + (16 * vtw + fr) * 136 + 32 * ks + 8 * fq); fcd[ks] = *(const bf16x8*)(LCr + (32 + fr) * 136 + 32 * ks + 8 * fq); }
#pragma unroll
            for (int ks = 0; ks < 2; ++ks) { kf[ks] = tr_frag(LK, 136, 32 * ks, 16 * wid, fr, fq);
#pragma unroll
                for (int vt2 = 0; vt2 < 3; ++vt2) fw[vt2][ks] = tr_frag(LWV, VS, 32 * ks, 16 * vt2, fr, fq); }
#pragma unroll
            for (int r = 0; r < 4; ++r) { inr[r] = F[128 + 16 * ti + 4 * fq + r]; clr[r] = F[192 + 16 * ti + 4 * fq + r]; rsr[r] = F[256 + 16 * ti + 4 * fq + r]; }
            LDS_WAIT_ALL();
            f32x4 numr = (f32x4){0.f, 0.f, 0.f, 0.f}, numd = numr;
            if constexpr ((VAR & 4) == 0) {
                f32x4 a1r = (f32x4){0.f, 0.f, 0.f, 0.f}, a1d = a1r, a2r = a1r, a2d = a1r;
#pragma unroll
                for (int ks = 0; ks < 2; ++ks) { a1r = __builtin_amdgcn_mfma_f32_16x16x32_bf16(fp[ks], fvr[ks], a1r, 0, 0, 0); a1d = __builtin_amdgcn_mfma_f32_16x16x32_bf16(fp[ks], fvd[ks], a1d, 0, 0, 0); }
#pragma unroll
                for (int ks = 0; ks < 4; ++ks) { a2r = __builtin_amdgcn_mfma_f32_16x16x32_bf16(fqq[ks], fcr[ks], a2r, 0, 0, 0); a2d = __builtin_amdgcn_mfma_f32_16x16x32_bf16(fqq[ks], fcd[ks], a2d, 0, 0, 0); }
#pragma unroll
                for (int r = 0; r < 4; ++r) { numr[r] = rsr[r] * a1r[r] + inr[r] * a2r[r]; numd[r] = rsr[r] * a1d[r] + inr[r] * a2d[r]; }
            }
            if constexpr ((VAR & 8) == 0) {
#pragma unroll
                for (int vt2 = 0; vt2 < 3; ++vt2) {
                    f32x4 acc = Cst[vt2] * carry_cur;
#pragma unroll
                    for (int ks = 0; ks < 2; ++ks) acc = __builtin_amdgcn_mfma_f32_16x16x32_bf16(fw[vt2][ks], kf[ks], acc, 0, 0, 0);
                    Cst[vt2] = acc;
#pragma unroll
                    for (int r = 0; r < 4; ++r) LCw[(16 * vt2 + 4 * fq + r) * 136 + 16 * wid + fr] = f2bf(acc[r]);
                }
            }
#pragma unroll
            for (int r = 0; r < 4; ++r) { const int t = 16 * ti + 4 * fq + r;
                const float den = __shfl(numd[r], lane & 48);
                const float dv = fmaxf(fabsf(den), clr[r]);
                if (st_out) C.proj()[pjo((size_t)(mbase + t), C_VM + hm * 128 + sl * 32 + 16 * vtw + fr)] = f2bf(numr[r] * frcp(dv)); }
        }
        carry_cur = carry_nxt;
        LDS_BARRIER();
      }
    }
#undef ML_Q
#undef ML_K
#undef ML_V
#undef ML_WV
#undef ML_P
#undef ML_F
}
__device__ __forceinline__ void phase3(const Ctx& C, int sub) {
    const int g = blockIdx.x;
    if (sub == 0 || sub == 1) {
        mlstm_m1_stream(C);
        asm volatile("s_waitcnt vmcnt(0)" ::: "memory"); __syncthreads();
        const int bb = g >> 5, ck = 2 * (g & 31) + (C.wid >> 2), hm = C.wid & 3;
        mlstm_gate_scan(C, bb, hm, ck);
        asm volatile("s_waitcnt vmcnt(0)" ::: "memory");
        mlstm_p0_item(C, bb, hm, ck);
    }
    if (sub >= 3) rwkv_r1_wg<(PROBE_SUB >= 3 ? PROBE_SUB : 0) | 1>(C, g >> 5, (g >> 2) & 7, (g & 3) * 16, 16); else if (sub != 1) rwkv_r1_wg<0>(C, g >> 5, (g >> 2) & 7, (g & 3) * 16, 16);
}
__device__ __forceinline__ void phase4(const Ctx& C, int sub) {
    for (int item = blockIdx.x; item < 256; item += gridDim.x) {
        if (item < 64) { if (sub != 2 && sub != 3) rwkv_r2_wg(C, item >> 3, item & 7); }
        else if (item < 128) { }
        else { const int i = item - 128; if (sub == 3) mlstm_item<PROBE_SUB | 1>(C, i >> 4, (i >> 2) & 3, i & 3); else if (sub != 1) mlstm_item<0>(C, i >> 4, (i >> 2) & 3, i & 3); }
        __syncthreads();
    }
}

__device__ __forceinline__ void ld8f(const float* p, float* o) { const f32x4 a = *(const f32x4*)p, b = *(const f32x4*)(p + 4); o[0] = a.x; o[1] = a.y; o[2] = a.z; o[3] = a.w; o[4] = b.x; o[5] = b.y; o[6] = b.z; o[7] = b.w; }
__device__ __forceinline__ void phase5(const Ctx& C) {
    const int lane = C.lane; const int c0 = 8 * lane;
    float muv[8], gnw[8], gnb[8], lnw[8], skp[8];
    ld8f(C.mu() + C_V + c0, muv); ld8f(C.gn_w() + c0, gnw); ld8f(C.gn_b() + c0, gnb); ld8f(C.ln_w() + c0, lnw); ld8f(C.skip() + c0, skp);
    for (int m = C.gw; m < NTOK; m += C.ngw) {
        const bool hp = (m & (NT - 1)) != 0;
        const bf16_t* pj = C.proj(); const size_t mm = (size_t)m, mp = (size_t)(m > 0 ? m - 1 : m); bf16_t* yo = C.ymix() + (size_t)m * DM;
        float outr[8], outm[8];
        {
            float y[8], v[8], pv[8], z[8];
            unpack8(*(const u32x4*)(pj + pjo(mm, C_R + c0)), y);
            unpack8(*(const u32x4*)(pj + pjo(mm, C_V + c0)), v); unpack8(*(const u32x4*)(pj + pjo(mm, C_ZR + c0)), z);
            unpack8(*(const u32x4*)(pj + pjo(mp, C_V + c0)), pv);
            if (!hp) {
#pragma unroll
                for (int i = 0; i < 8; ++i) { pv[i] = 0.f; } }
            float s = 0.f; const float bs = C.bonus()[(size_t)m * 8 + (lane >> 3)];
#pragma unroll
            for (int i = 0; i < 8; ++i) { v[i] += muv[i] * (pv[i] - v[i]); s += y[i]; }
            s += __shfl_xor(s, 1); s += __shfl_xor(s, 2); s += __shfl_xor(s, 4);
            const float mean = s * (1.0f / 64.0f); float q = 0.f;
#pragma unroll
            for (int i = 0; i < 8; ++i) { y[i] -= mean; q += y[i] * y[i]; }
            q += __shfl_xor(q, 1); q += __shfl_xor(q, 2); q += __shfl_xor(q, 4);
            const float rstd = __builtin_amdgcn_rsqf(q * (1.0f / 64.0f) + 64e-5f);
#pragma unroll
            for (int i = 0; i < 8; ++i) { const float yn = y[i] * rstd * gnw[i] + gnb[i]; outr[i] = (yn + bs * v[i]) * siluf_(z[i]); }
        }
        {
            float h[8], o[8], z[8], qc[8];
            unpack8(*(const u32x4*)(pj + pjo(mm, C_VM + c0)), h);
            unpack8(*(const u32x4*)(pj + pjo(mm, C_O + c0)), o); unpack8(*(const u32x4*)(pj + pjo(mm, C_ZM + c0)), z); unpack8(*(const u32x4*)(C.qc() + (size_t)m * 512 + c0), qc);
            float s = 0.f;
#pragma unroll
            for (int i = 0; i < 8; ++i) s += h[i];
            s += __shfl_xor(s, 1); s += __shfl_xor(s, 2); s += __shfl_xor(s, 4); s += __shfl_xor(s, 8);
            const float mean = s * (1.0f / 128.0f); float q = 0.f;
#pragma unroll
            for (int i = 0; i < 8; ++i) { h[i] -= mean; q += h[i] * h[i]; }
            q += __shfl_xor(q, 1); q += __shfl_xor(q, 2); q += __shfl_xor(q, 4); q += __shfl_xor(q, 8);
            const float rstd = __builtin_amdgcn_rsqf(q * (1.0f / 128.0f) + 1e-6f);
#pragma unroll
            for (int i = 0; i < 8; ++i) { const float hn = h[i] * rstd * lnw[i]; outm[i] = (sigmoidf_(o[i]) * hn + skp[i] * qc[i]) * siluf_(z[i]); }
        }
        *(u32x4*)(yo + c0) = pack8(outr);
        *(u32x4*)(yo + 512 + c0) = pack8(outm);
    }
}

struct RowIn { f32x4 x[4]; u32x4 mx[2]; };
__device__ __forceinline__ void p7_load(const Ctx& C, RowIn& r, int m) {
    const f32x4* xr = (const f32x4*)(C.x() + (size_t)m * DM) + C.lane;
#pragma unroll
    for (int j = 0; j < 4; ++j) r.x[j] = __builtin_nontemporal_load(xr + 64 * j);
    const u32x2* mr = (const u32x2*)(C.mixo() + (size_t)m * DM) + C.lane;
    const u32x2 a0 = __builtin_nontemporal_load(mr), a1 = __builtin_nontemporal_load(mr + 64), a2 = __builtin_nontemporal_load(mr + 128), a3 = __builtin_nontemporal_load(mr + 192);
    r.mx[0] = (u32x4){a0.x, a0.y, a1.x, a1.y}; r.mx[1] = (u32x4){a2.x, a2.y, a3.x, a3.y};
}
template <int VAR> __device__ __forceinline__ void phase7(const Ctx& C) {
    f32x4 g[4];
#pragma unroll
    for (int j = 0; j < 4; ++j) g[j] = *(const f32x4*)(C.fgain() + 4 * C.lane + 256 * j);
    RowIn cur, nx1; p7_load(C, cur, C.gw); p7_load(C, nx1, C.gw + C.ngw);
    if constexpr ((VAR & 2) != 0) { asm volatile("" : "+v"(cur.x[0]), "+v"(nx1.x[0])); }
    f32x4 gtv[4]; int bcur = -1;
    for (int m = C.gw; m < NTOK; m += C.ngw) {
        const int b = m >> 12; const int mn = (m + 2 * C.ngw < NTOK) ? m + 2 * C.ngw : m;
        if (b != bcur) { bcur = b;
#pragma unroll
            for (int j = 0; j < 4; ++j) gtv[j] = *(const f32x4*)(C.ada() + b * 3072 + 2048 + 4 * C.lane + 256 * j); }
        RowIn nxt; if constexpr ((VAR & 2) == 0) p7_load(C, nxt, mn); else nxt = nx1;
        f32x4 h[4]; float s = 0.f;
#pragma unroll
        for (int j = 0; j < 4; ++j) {
            const f32x4 gt = gtv[j];
            const unsigned w0 = (j & 1) ? cur.mx[j >> 1].z : cur.mx[j >> 1].x, w1 = (j & 1) ? cur.mx[j >> 1].w : cur.mx[j >> 1].y;
            const f32x4 mv = (f32x4){__uint_as_float(w0 << 16), __uint_as_float(w0 & 0xffff0000u), __uint_as_float(w1 << 16), __uint_as_float(w1 & 0xffff0000u)};
            h[j] = cur.x[j] + gt * mv; s += (h[j].x * h[j].x + h[j].y * h[j].y) + (h[j].z * h[j].z + h[j].w * h[j].w); }
        const float rs = __builtin_amdgcn_rsqf(wave_sum(s) * (1.0f / DM) + 1e-6f);
        f32x4* o = (f32x4*)(C.out() + (size_t)m * DM) + C.lane;
#pragma unroll
        for (int j = 0; j < 4; ++j) { if constexpr ((VAR & 1) == 0) __builtin_nontemporal_store(h[j] * rs * g[j], o + 64 * j); else asm volatile("" :: "v"(h[j] * rs * g[j])); }
        cur = nx1; nx1 = nxt;
    }
}

#define LAS __attribute__((address_space(3)))
#define XB_TMO      128
#define XB_XCNT(j)  (256  + 64 * (j))
#define XB_XSUB(j)  (1280 + 64 * (j))
#define XB_XGEN(j)  (2304 + 64 * (j))
#define XB_TOP      3328
#define XB_TOPGEN   3392
#define XCD_BAR_WORDS 3456
#define XB_SPIN_CAP (1u << 18)

__device__ __forceinline__ unsigned xb_ld(unsigned* p)              { return __hip_atomic_load(p, __ATOMIC_RELAXED, __HIP_MEMORY_SCOPE_AGENT); }
__device__ __forceinline__ unsigned xb_add(unsigned* p, unsigned v) { return __hip_atomic_fetch_add(p, v, __ATOMIC_RELAXED, __HIP_MEMORY_SCOPE_AGENT); }
__device__ __forceinline__ unsigned xb_xcc_id() { return (unsigned)__builtin_amdgcn_s_getreg((3 << 11) | 20) & 0xFu; }
#define XB_SPIN(cond, bar) do { unsigned _sp = 0; while (cond) { __builtin_amdgcn_s_sleep(1); \
    if ((++_sp & 255u) == 0u) { if (xb_ld(&(bar)[XB_TMO])) break; if (_sp > XB_SPIN_CAP) { atomicAdd(&(bar)[XB_TMO], 1u); break; } } } } while (0)

struct XcdBarrier {
    unsigned* bar; unsigned x;
    volatile LAS unsigned* st;
};

__device__ __forceinline__ XcdBarrier xcd_barrier_post(unsigned* bar, volatile LAS unsigned* st) {
    XcdBarrier b; b.bar = bar; b.x = xb_xcc_id(); b.st = st;
    if (threadIdx.x == 0) (void)xb_add(&bar[XB_XCNT(b.x)], 1u);
    return b;
}
__device__ __forceinline__ void xcd_barrier_complete(unsigned* bar, unsigned x, unsigned& nloc, unsigned& nx) {
    const unsigned G = gridDim.x * gridDim.y * gridDim.z;
    unsigned sum, cnt, mine, sp = 0u;
    for (;;) {
        sum = 0u; cnt = 0u; mine = 0u;
#pragma unroll
        for (unsigned j = 0; j < 16; ++j) { const unsigned c = xb_ld(&bar[XB_XCNT(j)]); sum += c; cnt += (c > 0u) ? 1u : 0u; mine = (j == x) ? c : mine; }
        if (sum == G) break;
        __builtin_amdgcn_s_sleep(1);
        if ((++sp & 255u) == 0u) { if (xb_ld(&bar[XB_TMO])) break; if (sp > XB_SPIN_CAP) { atomicAdd(&bar[XB_TMO], 1u); break; } }
    }
    nloc = mine > 0u ? mine : 1u; nx = cnt > 0u ? cnt : 1u;
}

__device__ __forceinline__ void xcd_barrier(const XcdBarrier& b) {
    asm volatile("s_waitcnt vmcnt(0)" ::: "memory");
    __syncthreads();
    if (threadIdx.x == 0) {
        unsigned* bar = b.bar;
        __builtin_amdgcn_s_waitcnt(0);
        unsigned nloc = b.st[0], nx = b.st[1];
        if (nloc == 0u) { xcd_barrier_complete(bar, b.x, nloc, nx); b.st[0] = nloc; b.st[1] = nx; }
        const unsigned old = xb_add(&bar[XB_XSUB(b.x)], 1u);
        const unsigned gen = old / nloc;
        if (old + 1u == (gen + 1u) * nloc) {
            __builtin_amdgcn_fence(__ATOMIC_RELEASE, "agent");
            asm volatile("s_waitcnt vmcnt(0)" ::: "memory");
            const unsigned og = xb_add(&bar[XB_TOP], 1u);
            const unsigned tg = og / nx;
            if (og + 1u == (tg + 1u) * nx) xb_add(&bar[XB_TOPGEN], 1u);
            else XB_SPIN(xb_ld(&bar[XB_TOPGEN]) == tg, bar);
            __builtin_amdgcn_fence(__ATOMIC_ACQUIRE, "agent");
            xb_add(&bar[XB_XGEN(b.x)], 1u);
            asm volatile("s_waitcnt vmcnt(0)" ::: "memory");
        } else {
            XB_SPIN(xb_ld(&bar[XB_XGEN(b.x)]) == gen, bar);
            __builtin_amdgcn_fence(__ATOMIC_ACQUIRE, "agent");
            asm volatile("s_waitcnt vmcnt(0)" ::: "memory");
        }
    }
    __syncthreads();
}

#ifndef PROBE_REP
#define PROBE_REP -1
#endif
#ifndef PROBE_SUB
#define PROBE_SUB 0
#endif
__global__ void __launch_bounds__(NTHR, 2) fwd_kernel(Params p) {
    extern __shared__ __attribute__((aligned(16))) unsigned char lds_raw[];
    cg::grid_group grid = cg::this_grid();
    Ctx C{p};
    C.lds = lds_raw; C.tid = threadIdx.x; C.lane = C.tid & 63; C.wid = __builtin_amdgcn_readfirstlane(C.tid >> 6);
    C.gw = blockIdx.x * NWV + C.wid; C.ngw = gridDim.x * NWV;
    const int lo = p.ph_lo, hi = p.ph_hi;
    unsigned* barw = (unsigned*)(p.ws + WS_CTL);
    volatile LAS unsigned* bst = (volatile LAS unsigned*)((LAS unsigned char*)lds_raw + LDS_BYTES - 16);
    if (threadIdx.x < 4) bst[threadIdx.x] = 0u;
    if (blockIdx.x == 0) for (int e = threadIdx.x; e < XCD_BAR_WORDS; e += NTHR) barw[e] = 0u;
    XcdBarrier xbar; xbar.bar = barw; xbar.x = 0; xbar.st = bst;
#define RUN(k) (lo <= (k) && (k) < hi)
#define GSYNC() xcd_barrier(xbar)
#define SEAM(k) do { if (RUN(k) && RUN((k) + 1)) GSYNC(); } while (0)
    if (RUN(0)) phase0(C);
    if (RUN(0) && RUN(1)) { grid.sync(); xbar = xcd_barrier_post(barw, bst); }
#if PROBE_REP == 8
    GSYNC(); GSYNC(); GSYNC(); GSYNC(); GSYNC(); GSYNC(); GSYNC(); GSYNC();
#endif
    if (RUN(1)) { phase1(C); weight_copies(C); }
#if PROBE_REP == 1
    GSYNC(); phase0(C); GSYNC(); phase1(C); weight_copies(C);
#endif
    SEAM(1);
    if (RUN(2)) {
        pg8::Gemm g{C.hn(), C.win_t(), NTOK, NPAD, DM}; pg8::StaticOrder S; S.init(NTOK, NPAD, (int)gridDim.x, (int)blockIdx.x);
        pg8::EpiBf16<0> E{C.proj(), 256, nullptr, 256, (size_t)NTOK * 256};
        pg8::gemm_phase<pg8::EpiBf16<0>, pg8::StaticOrder, false>((PG8_LAS unsigned char*)lds_raw, g, S, E, nullptr);
#if PROBE_REP == 2
        GSYNC(); pg8::gemm_phase<pg8::EpiBf16<0>, pg8::StaticOrder, false>((PG8_LAS unsigned char*)lds_raw, g, S, E, nullptr);
#endif
    }
    SEAM(2);
    if (RUN(3)) phase3(C, 0);
#if PROBE_REP == 3
    GSYNC(); phase3(C, PROBE_SUB);
#endif
    SEAM(3);
#if PROBE_REP == 6
    phase4(C, 3); GSYNC();
#endif
    if (RUN(4)) phase4(C, 0);
#if PROBE_REP == 4
    GSYNC(); phase4(C, PROBE_SUB);
#endif
    SEAM(4);
    if (RUN(5)) phase5(C);
#if PROBE_REP == 5
    GSYNC(); phase5(C);
#endif
    SEAM(5);
    if (RUN(6)) {
        pg8::Gemm g{C.ymix(), C.wout_t(), NTOK, DM, DM}; pg8::StaticOrder S; S.init(NTOK, DM, (int)gridDim.x, (int)blockIdx.x);
        pg8::EpiBf16<0> E{C.mixo(), DM, nullptr, 0, 0};
        pg8::gemm_phase<pg8::EpiBf16<0>, pg8::StaticOrder, false>((PG8_LAS unsigned char*)lds_raw, g, S, E, nullptr);
#if PROBE_REP == 7
        GSYNC(); pg8::gemm_phase<pg8::EpiBf16<0>, pg8::StaticOrder, false>((PG8_LAS unsigned char*)lds_raw, g, S, E, nullptr);
#endif
    }
    SEAM(6);
#if PROBE_REP == 9
    phase7<PROBE_SUB>(C); GSYNC();
#endif
    if (RUN(7)) phase7<0>(C);
#undef RUN
#undef SEAM
}

#ifndef N_LAUNCHES
#define N_LAUNCHES 1
#endif
extern "C" void kernel_launch(void* const* d_in, const int* in_sizes, int n_in, void* d_out, int out_size, void* d_ws, size_t ws_size, hipStream_t stream) {
    static int grid = 0;
    if (grid == 0) {
        if (n_in != 24 || out_size != NTOK * DM || ws_size < WS_END) { fprintf(stderr, "kernel_launch: unexpected shapes (n_in %d, out %d, ws %zu < %zu)\n", n_in, out_size, ws_size, (size_t)WS_END); grid = -1; return; }
        int dev = 0, cus = 0, per_cu = 0;
        hipGetDevice(&dev); hipDeviceGetAttribute(&cus, hipDeviceAttributeMultiprocessorCount, dev);
        if (hipFuncSetAttribute((const void*)fwd_kernel, hipFuncAttributeMaxDynamicSharedMemorySize, LDS_BYTES) != hipSuccess) { fprintf(stderr, "kernel_launch: hipFuncSetAttribute failed\n"); grid = -1; return; }
        if (hipOccupancyMaxActiveBlocksPerMultiprocessor(&per_cu, (const void*)fwd_kernel, NTHR, LDS_BYTES) != hipSuccess || per_cu < 1) { fprintf(stderr, "kernel_launch: occupancy query says %d\n", per_cu); per_cu = 1; }
        (void)hipGetLastError();
        if (cus < 256) { fprintf(stderr, "kernel_launch: this build needs 256 CUs (got %d)\n", cus); grid = -1; return; }
        grid = 256;
        fprintf(stderr, "kernel_launch: grid %d, per_cu %d\n", grid, per_cu);
    }
    if (grid < 0) return;
    Params p{};
    for (int i = 0; i < 24; ++i) p.in[i] = (const float*)d_in[i];
    p.out = (float*)d_out; p.ws = (unsigned char*)d_ws;
    if (N_LAUNCHES == 1) {
        p.ph_lo = 0; p.ph_hi = NPHASE; void* args[] = {&p};
        hipError_t e = hipLaunchCooperativeKernel((const void*)fwd_kernel, dim3(grid), dim3(NTHR), args, LDS_BYTES, stream);
        if (e != hipSuccess) fprintf(stderr, "cooperative launch failed: %s (grid %d)\n", hipGetErrorString(e), grid);
    } else {
        for (int ph = 0; ph < NPHASE; ++ph) { p.ph_lo = ph; p.ph_hi = ph + 1; hipLaunchKernelGGL(fwd_kernel, dim3(grid), dim3(NTHR), LDS_BYTES, stream, p); }
    }
}
```

```cpp
#include <hip/hip_runtime.h>
#include <hip/hip_cooperative_groups.h>
#include <cstdio>
#define PROBE_REP -1
#define PROBE_SUB 0
namespace pg8 {
#define PG8_LAS __attribute__((address_space(3)))
typedef unsigned short bf16_t;
typedef short bf16x8 __attribute__((ext_vector_type(8)));
typedef float f32x4 __attribute__((ext_vector_type(4)));
typedef unsigned u32x4 __attribute__((ext_vector_type(4)));
constexpr int BM = 256, BK = 64, HALF = 128, HTB = HALF * BK * 2  , STAGE_BYTES = 8 * HTB, NXCD = 8, WGM = 8;

__host__ __device__ __forceinline__ int lds_byte(int r, int c) { const int st = (r >> 4) * 2 + (c >> 5), rr = r & 15, cc = c & 31, ob = rr * 64 + cc * 2; return st * 1024 + (ob ^ (((ob >> 9) & 1) << 5)); }
__host__ __device__ __forceinline__ void stage_rc(int b, int& R, int& C) { const int st = b / 1024, sb = b % 1024, swz = sb ^ (((sb >> 9) & 1) << 5); R = (st >> 1) * 16 + swz / 64; C = (st & 1) * 32 + (swz % 64) / 2; }
__host__ __device__ __forceinline__ int perm32(int rho) { const int n = rho >> 4, i = rho & 15; return 8 * (i >> 2) + 4 * n + (i & 3); }

struct Unit { int pm, pn; };
struct Gemm { const bf16_t* A; const bf16_t* Bt; int M, N, K; };

struct StaticOrder {
    int nM, nN, nwg, G, c;
    __host__ __device__ void init(int M, int N, int G_, int c_) { nM = M / BM; nN = N / BM; nwg = nM * nN; G = G_; c = c_; }
    __host__ __device__ bool next(int i, Unit& u) const {
        const long L = (long)i * G + c; if (L >= nwg) return false;
        int wgid = (int)L; { const int q = nwg / NXCD, r = nwg % NXCD, xcd = wgid % NXCD, off = wgid / NXCD; wgid = (xcd < r ? xcd * (q + 1) : r * (q + 1) + (xcd - r) * q) + off; }
        const int nig = WGM * nN, gid = wgid / nig, fm = gid * WGM, gsz = (nM - fm) < WGM ? (nM - fm) : WGM;
        u.pm = fm + ((wgid % nig) % gsz); u.pn = (wgid % nig) / gsz; return true;
    }
    __device__ __forceinline__ void a_ready(const Unit&) const {}
    __device__ __forceinline__ void done(const Unit&) const {}
};
struct CountedOrder : StaticOrder {
    const unsigned* ready; unsigned need; unsigned* tmo;
    __device__ __forceinline__ void a_ready(const Unit& u) const {
        if (threadIdx.x < 64) {
            const unsigned long long t0 = __builtin_amdgcn_s_memrealtime(); unsigned polls = 0;
            while ((unsigned)__builtin_amdgcn_readfirstlane(__hip_atomic_load(ready + 64 * u.pm, __ATOMIC_RELAXED, __HIP_MEMORY_SCOPE_AGENT)) < need) {
                if ((++polls & 255u) == 0u && __builtin_amdgcn_readfirstlane(__hip_atomic_load(tmo, __ATOMIC_RELAXED, __HIP_MEMORY_SCOPE_AGENT)) != 0u) break;
                if (__builtin_amdgcn_s_memrealtime() - t0 > 2000000ull) {
                    if (threadIdx.x == 0) { unsigned expect = 0u; __hip_atomic_compare_exchange_strong(tmo + 1, &expect, 0x600u | (unsigned)(u.pm & 0xff), __ATOMIC_RELAXED, __ATOMIC_RELAXED, __HIP_MEMORY_SCOPE_AGENT); __hip_atomic_store(tmo, 1u, __ATOMIC_RELAXED, __HIP_MEMORY_SCOPE_AGENT); }
                    break; }
                __builtin_amdgcn_s_sleep(2); }
            __builtin_amdgcn_fence(__ATOMIC_ACQUIRE, "agent");
            asm volatile("s_waitcnt vmcnt(0)" ::: "memory");
        }
#if !defined(BROKEN_HOOK_NO_BARRIER)
        asm volatile("" ::: "memory"); __builtin_amdgcn_s_barrier(); asm volatile("" ::: "memory");
#endif
    }
};

__device__ __forceinline__ unsigned cvt_pk_bf16(float lo, float hi) { unsigned r; asm volatile("v_cvt_pk_bf16_f32 %0, %1, %2" : "=v"(r) : "v"(lo), "v"(hi)); return r; }
typedef float f32x2 __attribute__((ext_vector_type(2)));
__device__ __forceinline__ f32x2 gelu_pk(f32x2 v) {
    const f32x2 av = __builtin_elementwise_abs(v), d = av * 0.2316418882f + 1.0f;
    f32x2 t; t.x = __builtin_amdgcn_rcpf(d.x); t.y = __builtin_amdgcn_rcpf(d.y);
    f32x2 q = t * 0.5307027145f + (-0.7265760135f); q = q * t + 0.7107068705f; q = q * t + (-0.142248368f); q = q * t + 0.127414796f; q = q * t;
    const f32x2 s = (v * v) * (-0.72134752044f);
    f32x2 e; e.x = __builtin_amdgcn_exp2f(s.x); e.y = __builtin_amdgcn_exp2f(s.y);
    const f32x2 m = v * (q * e), r = v - m;
    f32x2 o; o.x = v.x < 0.f ? m.x : r.x; o.y = v.y < 0.f ? m.y : r.y; return o;
}

struct EpiF32 {
    static constexpr bool PERM = false, AFTER_DRAIN = false;
    float* C; int ldc; const float* bias;
    __device__ __forceinline__ void operator()(const f32x4 (&acc)[2][2][4][2], const Unit& u, int wr, int wc, int fr, int fq) const {
        const int row0 = u.pm * BM + wr * 64 + fr, col0 = u.pn * BM + wc * 32 + 4 * fq;
        f32x4 bv[2][2];
#pragma unroll
        for (int bj = 0; bj < 2; ++bj)
#pragma unroll
            for (int n = 0; n < 2; ++n) bv[bj][n] = bias ? *(const f32x4*)(bias + col0 + bj * HALF + n * 16) : (f32x4){0.f, 0.f, 0.f, 0.f};
#pragma unroll
        for (int ai = 0; ai < 2; ++ai)
#pragma unroll
            for (int m = 0; m < 4; ++m) { float* rowp = C + (size_t)(row0 + ai * HALF + m * 16) * ldc + col0;
#pragma unroll
                for (int bj = 0; bj < 2; ++bj)
#pragma unroll
                    for (int n = 0; n < 2; ++n) *(f32x4*)(rowp + bj * HALF + n * 16) = acc[ai][bj][m][n] + bv[bj][n]; }
    }
};
template <int ACT  > struct EpiBf16 {
    static constexpr bool PERM = true, AFTER_DRAIN = false;
    bf16_t* O; int ldc; const float* bias; int split_cols; size_t split_stride;
    __device__ __forceinline__ void operator()(const f32x4 (&acc)[2][2][4][2], const Unit& u, int wr, int wc, int fr, int fq) const {
        const int row0 = u.pm * BM + wr * 64 + fr; int colt = u.pn * BM; bf16_t* base = O;
        if (split_cols) { const int t = colt / split_cols; base += (size_t)t * split_stride; colt -= t * split_cols; }
        const int col0 = colt + wc * 32 + 8 * fq, bcol0 = u.pn * BM + wc * 32 + 8 * fq;
        f32x4 bv[2][2];
#pragma unroll
        for (int bj = 0; bj < 2; ++bj)
#pragma unroll
            for (int n = 0; n < 2; ++n) bv[bj][n] = bias ? *(const f32x4*)(bias + bcol0 + bj * HALF + 4 * n) : (f32x4){0.f, 0.f, 0.f, 0.f};
#pragma unroll
        for (int ai = 0; ai < 2; ++ai)
#pragma unroll
            for (int m = 0; m < 4; ++m) { bf16_t* rowp = base + (size_t)(row0 + ai * HALF + m * 16) * ldc + col0;
#pragma unroll
                for (int bj = 0; bj < 2; ++bj) { f32x4 v0 = acc[ai][bj][m][0] + bv[bj][0], v1 = acc[ai][bj][m][1] + bv[bj][1];
                    if (ACT == 1) { f32x2 a = gelu_pk((f32x2){v0[0], v0[1]}), b = gelu_pk((f32x2){v0[2], v0[3]}), c = gelu_pk((f32x2){v1[0], v1[1]}), d = gelu_pk((f32x2){v1[2], v1[3]});
                        v0 = (f32x4){a.x, a.y, b.x, b.y}; v1 = (f32x4){c.x, c.y, d.x, d.y}; }
                    if (ACT == 2) {
#pragma unroll
                        for (int j = 0; j < 4; ++j) { v0[j] = 0.5f * v0[j] * (1.0f + erff(v0[j] * 0.70710678f)); v1[j] = 0.5f * v1[j] * (1.0f + erff(v1[j] * 0.70710678f)); } }
                    u32x4 w; w.x = cvt_pk_bf16(v0[0], v0[1]); w.y = cvt_pk_bf16(v0[2], v0[3]); w.z = cvt_pk_bf16(v1[0], v1[1]); w.w = cvt_pk_bf16(v1[2], v1[3]);
                    *(u32x4*)(rowp + bj * HALF) = w; } }
    }
};

struct PanelStats {
    unsigned* xbuf;
    unsigned* cnt;
    unsigned* tmo;
    int ntn; float eps;
    unsigned code;
    __device__ __forceinline__ bool run(const f32x4 (&v)[2][2][4][2], const Unit& u, int wr, int wc, int fr, int fq, PG8_LAS unsigned char* lds, int wid, int lane) const {
        typedef float f32x2v __attribute__((ext_vector_type(2)));
        PG8_LAS f32x2v* P = (PG8_LAS f32x2v*)lds;
        PG8_LAS f32x2v* S = (PG8_LAS f32x2v*)(lds + 8192);
        PG8_LAS unsigned* flag = (PG8_LAS unsigned*)(lds + 8192 + 2048);
#pragma unroll
        for (int ai = 0; ai < 2; ++ai)
#pragma unroll
            for (int m = 0; m < 4; ++m) {
                float s = 0.f;
#pragma unroll
                for (int bj = 0; bj < 2; ++bj)
#pragma unroll
                    for (int n = 0; n < 2; ++n) { const f32x4 x = v[ai][bj][m][n]; s += (x[0] + x[1]) + (x[2] + x[3]); }
                s += __shfl_xor(s, 16); s += __shfl_xor(s, 32);
                const float mw = s * (1.0f / 64.0f); float q = 0.f;
#pragma unroll
                for (int bj = 0; bj < 2; ++bj)
#pragma unroll
                    for (int n = 0; n < 2; ++n) { const f32x4 d = v[ai][bj][m][n] - mw; q += (d[0] * d[0] + d[1] * d[1]) + (d[2] * d[2] + d[3] * d[3]); }
                q += __shfl_xor(q, 16); q += __shfl_xor(q, 32);
                if (fq == 0) P[(ai * HALF + wr * 64 + m * 16 + fr) * 4 + wc] = (f32x2v){mw, q};
            }
        asm volatile("s_waitcnt lgkmcnt(0)" ::: "memory"); __builtin_amdgcn_s_barrier(); asm volatile("" ::: "memory");
#if defined(BROKEN_NO_WAIT)
        if (blockIdx.x >= 64) { const long long t0 = clock64(); while (clock64() - t0 < 60000) __builtin_amdgcn_s_sleep(8); }
#endif
        const int row = wid * 32 + (lane & 31);
        if (lane < 32) {
            const f32x2v a = P[row * 4 + 0], b = P[row * 4 + 1], c = P[row * 4 + 2], d = P[row * 4 + 3];
            const float mt = (a.x + b.x + c.x + d.x) * 0.25f;
            const float da = a.x - mt, db = b.x - mt, dc = c.x - mt, dd = d.x - mt;
            const float m2 = (a.y + b.y) + (c.y + d.y) + 64.0f * ((da * da + db * db) + (dc * dc + dd * dd));
            unsigned long long* slot = (unsigned long long*)xbuf + ((size_t)(u.pm * BM + row) * 4 + u.pn);
            __hip_atomic_store(slot, ((unsigned long long)__float_as_uint(m2) << 32) | __float_as_uint(mt), __ATOMIC_RELAXED, __HIP_MEMORY_SCOPE_AGENT);
        }
        asm volatile("s_waitcnt vmcnt(0)" ::: "memory");
        if (lane == 0) __hip_atomic_fetch_add(cnt + 64 * u.pm, 1u, __ATOMIC_RELAXED, __HIP_MEMORY_SCOPE_AGENT);
        if (wid == 0) {
            bool dead = false; const unsigned long long t0 = __builtin_amdgcn_s_memrealtime(); const unsigned want = 8u * (unsigned)ntn;
            for (;;) {
#if defined(BROKEN_NO_WAIT)
                break;
#endif
                if ((unsigned)__builtin_amdgcn_readfirstlane(__hip_atomic_load(cnt + 64 * u.pm, __ATOMIC_RELAXED, __HIP_MEMORY_SCOPE_AGENT)) >= want) break;
                if (__builtin_amdgcn_s_memrealtime() - t0 > 2000000ull) {
                    if (lane == 0) { unsigned expect = 0u; __hip_atomic_compare_exchange_strong(tmo + 1, &expect, code | (unsigned)(u.pm & 0xff), __ATOMIC_RELAXED, __ATOMIC_RELAXED, __HIP_MEMORY_SCOPE_AGENT);
                                     __hip_atomic_store(tmo, 1u, __ATOMIC_RELAXED, __HIP_MEMORY_SCOPE_AGENT); }
                    dead = true; break; }
                __builtin_amdgcn_s_sleep(2);
            }
            __builtin_amdgcn_fence(__ATOMIC_ACQUIRE, "agent");
            if (lane == 0) flag[0] = dead ? 1u : 0u;
        }
        asm volatile("s_waitcnt vmcnt(0) lgkmcnt(0)" ::: "memory"); __builtin_amdgcn_s_barrier(); asm volatile("" ::: "memory");
        const bool bad = flag[0] != 0u;
        if (lane < 32) {
            const unsigned long long* slot = (const unsigned long long*)xbuf + (size_t)(u.pm * BM + row) * 4; float mt[4], m2[4]; float ms = 0.f;
#pragma unroll
            for (int t = 0; t < 4; ++t) { if (t < ntn) { const unsigned long long w = __hip_atomic_load(slot + t, __ATOMIC_RELAXED, __HIP_MEMORY_SCOPE_AGENT); mt[t] = __uint_as_float((unsigned)w); m2[t] = __uint_as_float((unsigned)(w >> 32)); } else { mt[t] = 0.f; m2[t] = 0.f; } ms += mt[t]; }
            const float mean = ms / (float)ntn; float q = 0.f;
#pragma unroll
            for (int t = 0; t < 4; ++t) if (t < ntn) { const float dm = mt[t] - mean; q += m2[t] + 256.0f * dm * dm; }
            S[row] = (f32x2v){mean, 1.0f / sqrtf(q / (256.0f * (float)ntn) + eps)};
        }
        asm volatile("s_waitcnt lgkmcnt(0)" ::: "memory"); __builtin_amdgcn_s_barrier(); asm volatile("" ::: "memory");
        return bad;
    }
};
struct EpiLnRes {
    static constexpr bool PERM = false, AFTER_DRAIN = true;
    const float* base; float* out; int ldc; const float* bias; PanelStats st; unsigned poison;
    __device__ __forceinline__ void refuse(size_t i0, size_t stride, int M, int N) const { const float q = __builtin_nanf(""); for (size_t i = i0; i < (size_t)M * N; i += stride) out[(i / N) * ldc + i % N] = q;
        if (i0 == 0) { unsigned expect = 0u; __hip_atomic_compare_exchange_strong(st.tmo + 1, &expect, 0x7f0u, __ATOMIC_RELAXED, __ATOMIC_RELAXED, __HIP_MEMORY_SCOPE_AGENT); __hip_atomic_store(st.tmo, 1u, __ATOMIC_RELAXED, __HIP_MEMORY_SCOPE_AGENT); } }
    __device__ __forceinline__ void fused(f32x4 (&acc)[2][2][4][2], const Unit& u, int wr, int wc, int fr, int fq, PG8_LAS unsigned char* lds, int wid, int lane) const {
        typedef float f32x2v __attribute__((ext_vector_type(2)));
        const PG8_LAS f32x2v* S = (const PG8_LAS f32x2v*)(lds + 8192);
        const int col0 = u.pn * BM + wc * 32 + 4 * fq;
#pragma unroll
        for (int bj = 0; bj < 2; ++bj)
#pragma unroll
            for (int n = 0; n < 2; ++n) { const f32x4 bv = bias ? *(const f32x4*)(bias + col0 + bj * HALF + n * 16) : (f32x4){0.f, 0.f, 0.f, 0.f};
#pragma unroll
                for (int ai = 0; ai < 2; ++ai)
#pragma unroll
                    for (int m = 0; m < 4; ++m) acc[ai][bj][m][n] += bv; }
        const bool bad = st.run(acc, u, wr, wc, fr, fq, lds, wid, lane) || poison != 0u;
        const float qnan = __builtin_nanf("");
#pragma unroll
        for (int ai = 0; ai < 2; ++ai)
#pragma unroll
            for (int m = 0; m < 4; ++m) { const int r = ai * HALF + wr * 64 + m * 16 + fr; const f32x2v sr = S[r]; const size_t off = (size_t)(u.pm * BM + r) * ldc + col0;
#pragma unroll
                for (int bj = 0; bj < 2; ++bj)
#pragma unroll
                    for (int n = 0; n < 2; ++n) { const f32x4 bs = *(const f32x4*)(base + off + bj * HALF + n * 16); f32x4 o = bs + (acc[ai][bj][m][n] - sr.x) * sr.y;
                        if (bad) o = (f32x4){qnan, qnan, qnan, qnan}; *(f32x4*)(out + off + bj * HALF + n * 16) = o; }
                asm volatile("" ::: "memory"); }
    }
};
struct EpiLnResLn {
    static constexpr bool PERM = false, AFTER_DRAIN = true;
    const float* base; float* out; bf16_t* xn; int ldc; const float* bias; PanelStats st1, st2; unsigned poison;
    __device__ __forceinline__ void refuse(size_t i0, size_t stride, int M, int N) const { const float q = __builtin_nanf(""); for (size_t i = i0; i < (size_t)M * N; i += stride) { const size_t o = (i / N) * ldc + i % N; out[o] = q; xn[o] = (bf16_t)0x7fc0u; }
        if (i0 == 0) { unsigned expect = 0u; __hip_atomic_compare_exchange_strong(st1.tmo + 1, &expect, 0x7f0u, __ATOMIC_RELAXED, __ATOMIC_RELAXED, __HIP_MEMORY_SCOPE_AGENT); __hip_atomic_store(st1.tmo, 1u, __ATOMIC_RELAXED, __HIP_MEMORY_SCOPE_AGENT); } }
    __device__ __forceinline__ void fused(f32x4 (&acc)[2][2][4][2], const Unit& u, int wr, int wc, int fr, int fq, PG8_LAS unsigned char* lds, int wid, int lane) const {
        typedef float f32x2v __attribute__((ext_vector_type(2))); typedef unsigned u32x2v __attribute__((ext_vector_type(2)));
        const PG8_LAS f32x2v* S = (const PG8_LAS f32x2v*)(lds + 8192);
        const int col0 = u.pn * BM + wc * 32 + 4 * fq;
#pragma unroll
        for (int bj = 0; bj < 2; ++bj)
#pragma unroll
            for (int n = 0; n < 2; ++n) { const f32x4 bv = bias ? *(const f32x4*)(bias + col0 + bj * HALF + n * 16) : (f32x4){0.f, 0.f, 0.f, 0.f};
#pragma unroll
                for (int ai = 0; ai < 2; ++ai)
#pragma unroll
                    for (int m = 0; m < 4; ++m) acc[ai][bj][m][n] += bv; }
        bool bad = st1.run(acc, u, wr, wc, fr, fq, lds, wid, lane) || poison != 0u;
        const float qnan = __builtin_nanf("");
#pragma unroll
        for (int ai = 0; ai < 2; ++ai)
#pragma unroll
            for (int m = 0; m < 4; ++m) { const int r = ai * HALF + wr * 64 + m * 16 + fr; const f32x2v sr = S[r]; const size_t off = (size_t)(u.pm * BM + r) * ldc + col0;
#pragma unroll
                for (int bj = 0; bj < 2; ++bj)
#pragma unroll
                    for (int n = 0; n < 2; ++n) { const f32x4 bs = *(const f32x4*)(base + off + bj * HALF + n * 16); acc[ai][bj][m][n] = bs + (acc[ai][bj][m][n] - sr.x) * sr.y; }
                asm volatile("" : "+v"(acc[ai][0][m][0]), "+v"(acc[ai][0][m][1]), "+v"(acc[ai][1][m][0]), "+v"(acc[ai][1][m][1]));
                if (m & 1) asm volatile("" ::: "memory"); }
        const bool bad1 = bad;
        bad = st2.run(acc, u, wr, wc, fr, fq, lds, wid, lane) || bad;
#pragma unroll
        for (int ai = 0; ai < 2; ++ai)
#pragma unroll
            for (int m = 0; m < 4; ++m) { const int r = ai * HALF + wr * 64 + m * 16 + fr; const f32x2v sr = S[r]; const size_t off = (size_t)(u.pm * BM + r) * ldc + col0;
#pragma unroll
                for (int bj = 0; bj < 2; ++bj)
#pragma unroll
                    for (int n = 0; n < 2; ++n) { const f32x4 x1 = acc[ai][bj][m][n]; *(f32x4*)(out + off + bj * HALF + n * 16) = bad1 ? (f32x4){qnan, qnan, qnan, qnan} : x1;
                        const f32x4 o = (x1 - sr.x) * sr.y; u32x2v w; w.x = cvt_pk_bf16(o[0], o[1]); w.y = cvt_pk_bf16(o[2], o[3]);
                        if (bad) { w.x = 0x7fc07fc0u; w.y = 0x7fc07fc0u; } *(u32x2v*)(xn + off + bj * HALF + n * 16) = w; }
                asm volatile("" ::: "memory"); }
    }
};

template <class Epi, class Sched, bool STAMP = false>
__device__ __forceinline__ void gemm_phase(PG8_LAS unsigned char* lds, const Gemm g, const Sched& S, const Epi& E, unsigned long long* stamps) {
    const int tid = threadIdx.x, wid = __builtin_amdgcn_readfirstlane(tid >> 6), lane = tid & 63, wr = wid >> 2, wc = wid & 3, fr = lane & 15, fq = lane >> 4;
    const int K = g.K, nt = K / BK;
    int ts_lo = 0, ts_hi = 0, nts = 0; const unsigned long long rt_entry = STAMP ? (unsigned long long)wall_clock64() : 0ull;
#define PG8_STAMP() do { if (STAMP && wid == 0 && nts < 64) { const unsigned long long _c = (unsigned long long)clock64(); \
        ts_lo = (lane == nts) ? (int)(unsigned)_c : ts_lo; ts_hi = (lane == nts) ? (int)(unsigned)(_c >> 32) : ts_hi; ++nts; } } while (0)
    PG8_STAMP();
    unsigned voffA[2], voffB[2];
#pragma unroll
    for (int i = 0; i < 2; ++i) { int R, C; stage_rc(tid * 16 + i * 8192, R, C); const int Rb = Epi::PERM ? ((R & ~31) + perm32(R & 31)) : R;
        voffA[i] = (unsigned)(R * K + C) * 2u; voffB[i] = (unsigned)(Rb * K + C) * 2u; }
    const size_t kstep = (size_t)(BK * 2);
    const size_t hstep = (size_t)HALF * K * 2;
    const size_t tstep = 2 * hstep;
    const unsigned ldsw = (unsigned)wid * 1024u;
    const int aoff = lds_byte(wr * 64 + fr, fq * 8), boff = lds_byte(wc * 32 + fr, fq * 8);
#define PG8_SA(b, h) (((b) * 2 + (h)) * HTB)
#define PG8_SB(b, h) ((4 + (b) * 2 + (h)) * HTB)
#define PG8_STAGE(bufoff, gbase, voff) do { _Pragma("unroll") for (int _i = 0; _i < 2; ++_i) \
        __builtin_amdgcn_global_load_lds((const unsigned*)((const char*)(gbase) + (voff)[_i]), (PG8_LAS unsigned*)(lds + (bufoff) + ldsw + _i * 8192), 16, 0, 0); } while (0)
#define PG8_LDA(dst, b, h) do { _Pragma("unroll") for (int m = 0; m < 4; ++m) _Pragma("unroll") for (int k = 0; k < 2; ++k) dst[m][k] = *(const PG8_LAS bf16x8*)(lds + PG8_SA(b, h) + aoff + m * 2048 + k * 1024); } while (0)
#define PG8_LDB(dst, b, h) do { _Pragma("unroll") for (int n = 0; n < 2; ++n) _Pragma("unroll") for (int k = 0; k < 2; ++k) dst[n][k] = *(const PG8_LAS bf16x8*)(lds + PG8_SB(b, h) + boff + n * 2048 + k * 1024); } while (0)
#define PG8_MMA(ai, bj, At, Bt) do { __builtin_amdgcn_s_setprio(1); _Pragma("unroll") for (int m = 0; m < 4; ++m) _Pragma("unroll") for (int n = 0; n < 2; ++n) _Pragma("unroll") for (int k = 0; k < 2; ++k) \
        acc[ai][bj][m][n] = __builtin_amdgcn_mfma_f32_16x16x32_bf16(Bt[n][k], At[m][k], acc[ai][bj][m][n], 0, 0, 0); __builtin_amdgcn_s_setprio(0); } while (0)
#define PG8_WAIT_V(n) asm volatile("s_waitcnt vmcnt(" #n ")" ::: "memory")
#define PG8_WAIT_L(n) asm volatile("s_waitcnt lgkmcnt(" #n ")" ::: "memory")
#define PG8_BAR __builtin_amdgcn_s_barrier()
#define PG8_SCHED __builtin_amdgcn_sched_barrier(0)
    Unit cur, nxt; int ui = 0;
    if (!S.next(0, cur)) return;
    f32x4 acc[2][2][4][2];
#pragma unroll
    for (int a = 0; a < 2; ++a)
#pragma unroll
        for (int b = 0; b < 2; ++b)
#pragma unroll
            for (int m = 0; m < 4; ++m)
#pragma unroll
                for (int n = 0; n < 2; ++n) acc[a][b][m][n] = (f32x4){0.f, 0.f, 0.f, 0.f};
    bf16x8 At[4][2], B0[2][2], B1[2][2];
    const char* cA = (const char*)g.A + (size_t)cur.pm * tstep; const char* cB = (const char*)g.Bt + (size_t)cur.pn * tstep;
    S.a_ready(cur);
    PG8_STAGE(PG8_SB(0, 0), cB, voffB); PG8_STAGE(PG8_SA(0, 0), cA, voffA); PG8_STAGE(PG8_SB(0, 1), cB + hstep, voffB); PG8_STAGE(PG8_SA(0, 1), cA + hstep, voffA);
    if (wr == 1) PG8_BAR;
    PG8_WAIT_V(4); PG8_BAR;
    PG8_STAGE(PG8_SB(1, 0), cB + kstep, voffB); PG8_STAGE(PG8_SA(1, 0), cA + kstep, voffA); PG8_STAGE(PG8_SB(1, 1), cB + hstep + kstep, voffB);
    PG8_WAIT_V(6); PG8_BAR;
    PG8_STAMP();
    for (;;) {
        const bool has_next = S.next(ui + 1, nxt);
        const char* nA = has_next ? (const char*)g.A + (size_t)nxt.pm * tstep : cA; const char* nB = has_next ? (const char*)g.Bt + (size_t)nxt.pn * tstep : cB;
        for (int t = 0; t < nt; t += 2) {
            const bool last = (t == nt - 2);
            const char* a1 = cA + (size_t)(t + 1) * kstep;
            const char* a2 = last ? nA : cA + (size_t)(t + 2) * kstep; const char* b2 = last ? nB : cB + (size_t)(t + 2) * kstep;
            const char* a3 = a2 + kstep; const char* b3 = b2 + kstep;
            if (last && has_next) S.a_ready(nxt);
            PG8_LDB(B0, 0, 0); PG8_SCHED; PG8_LDA(At, 0, 0); PG8_STAGE(PG8_SA(1, 1), a1 + hstep, voffA);
            PG8_WAIT_L(8); PG8_BAR; PG8_WAIT_L(0); PG8_MMA(0, 0, At, B0); PG8_BAR; PG8_SCHED;
            PG8_LDB(B1, 0, 1); PG8_STAGE(PG8_SB(0, 0), b2, voffB);
            PG8_BAR; PG8_WAIT_L(0); PG8_MMA(0, 1, At, B1); PG8_BAR;
            PG8_LDA(At, 0, 1); PG8_STAGE(PG8_SA(0, 0), a2, voffA);
            PG8_BAR; PG8_WAIT_L(0); PG8_MMA(1, 0, At, B0); PG8_BAR; PG8_SCHED;
            PG8_STAGE(PG8_SB(0, 1), b2 + hstep, voffB);
            PG8_WAIT_V(6); PG8_BAR; PG8_MMA(1, 1, At, B1); PG8_BAR;
            PG8_LDB(B0, 1, 0); PG8_SCHED; PG8_LDA(At, 1, 0); PG8_STAGE(PG8_SA(0, 1), a2 + hstep, voffA);
            PG8_WAIT_L(8); PG8_BAR; PG8_WAIT_L(0); PG8_MMA(0, 0, At, B0); PG8_BAR; PG8_SCHED;
            PG8_LDB(B1, 1, 1); PG8_STAGE(PG8_SB(1, 0), b3, voffB);
            PG8_BAR; PG8_WAIT_L(0); PG8_MMA(0, 1, At, B1); PG8_BAR;
            PG8_LDA(At, 1, 1); PG8_STAGE(PG8_SA(1, 0), a3, voffA);
            PG8_BAR; PG8_WAIT_L(0); PG8_MMA(1, 0, At, B0); PG8_BAR; PG8_SCHED;
            PG8_STAGE(PG8_SB(1, 1), b3 + hstep, voffB);
            PG8_WAIT_V(6); PG8_BAR; PG8_MMA(1, 1, At, B1); PG8_BAR;
        }
        PG8_STAMP();
        if constexpr (!Epi::AFTER_DRAIN) { E(acc, cur, wr, wc, fr, fq); S.done(cur); }
        PG8_STAMP();
        if (!has_next) break;
#pragma unroll
        for (int a = 0; a < 2; ++a)
#pragma unroll
            for (int b = 0; b < 2; ++b)
#pragma unroll
                for (int m = 0; m < 4; ++m)
#pragma unroll
                    for (int n = 0; n < 2; ++n) acc[a][b][m][n] = (f32x4){0.f, 0.f, 0.f, 0.f};
        cur = nxt; cA = nA; cB = nB; ++ui;
    }
    PG8_WAIT_V(0);
    if (wr == 0) PG8_BAR;
    PG8_BAR;
    if constexpr (Epi::AFTER_DRAIN) { E.fused(acc, cur, wr, wc, fr, fq, lds, wid, lane); S.done(cur); }
    PG8_STAMP();
    if (STAMP && wid == 0) { stamps[lane] = lane < nts ? (((unsigned long long)(unsigned)ts_hi << 32) | (unsigned)ts_lo) : 0ull;
        if (lane == 62) stamps[62] = rt_entry; if (lane == 63) stamps[63] = (unsigned long long)wall_clock64(); }
#undef PG8_STAMP
#undef PG8_SA
#undef PG8_SB
#undef PG8_STAGE
#undef PG8_LDA
#undef PG8_LDB
#undef PG8_MMA
#undef PG8_WAIT_V
#undef PG8_WAIT_L
#undef PG8_BAR
#undef PG8_SCHED
}
}

namespace cg = cooperative_groups;
typedef unsigned short bf16_t;
typedef short bf16x8 __attribute__((ext_vector_type(8)));
typedef float f32x4 __attribute__((ext_vector_type(4)));
typedef unsigned u32x4 __attribute__((ext_vector_type(4)));
typedef unsigned u32x2 __attribute__((ext_vector_type(2)));

constexpr int NB = 8, NT = 4096, DM = 1024, NTOK = NB * NT;
constexpr int DIN = 4744, NPAD = 4864;
constexpr int C_R = 0, C_K = 512, C_V = 1024, C_WD = 1536, C_AD = 1600, C_ZR = 1664, C_Q = 2176, C_KM = 2688, C_VM = 3200, C_O = 3712, C_I = 4224, C_F = 4228, C_ZM = 4232;
constexpr int NTHR = 512, NWV = 8;
constexpr int LDS_BYTES = 147456;
constexpr int NPHASE = 8;

constexpr size_t MiB = 1u << 20;
constexpr size_t WS_CTL = 0, CTL_BYTES = 1 * MiB;
constexpr size_t WS_ADA = 1 * MiB;
constexpr size_t WS_LORA = 1 * MiB + 512 * 1024;
constexpr size_t WS_WL = 14 * MiB, WS_BONUS = 15 * MiB;
constexpr size_t WS_WIN = 2 * MiB;
constexpr size_t WS_WOUT = 12 * MiB;
constexpr size_t WS_X = 16 * MiB;
constexpr size_t WS_PROJ = 144 * MiB;
constexpr size_t WS_Y = 448 * MiB;
constexpr size_t WS_END = 512 * MiB;

__device__ __forceinline__ size_t pjo(size_t m, int col) { return (size_t)(col >> 8) * ((size_t)NTOK * 256) + m * 256 + (size_t)(col & 255); }
struct Params { const float* in[24]; float* out; unsigned char* ws; int ph_lo, ph_hi; };

struct Ctx {
    const Params& p;
    __device__ __forceinline__ const float* x() const { return p.in[0]; }
    __device__ __forceinline__ const float* c() const { return p.in[1]; }
    __device__ __forceinline__ const float* w_ada() const { return p.in[2]; }
    __device__ __forceinline__ const float* b_ada() const { return p.in[3]; }
    __device__ __forceinline__ const float* norm_gain() const { return p.in[4]; }
    __device__ __forceinline__ const float* w_in() const { return p.in[5]; }
    __device__ __forceinline__ const float* mu() const { return p.in[6]; }
    __device__ __forceinline__ const float* w_dup() const { return p.in[7]; }
    __device__ __forceinline__ const float* w_d0() const { return p.in[8]; }
    __device__ __forceinline__ const float* w_iup() const { return p.in[9]; }
    __device__ __forceinline__ const float* a0() const { return p.in[10]; }
    __device__ __forceinline__ const float* k_k() const { return p.in[11]; }
    __device__ __forceinline__ const float* k_a() const { return p.in[12]; }
    __device__ __forceinline__ const float* r_k() const { return p.in[13]; }
    __device__ __forceinline__ const float* gn_w() const { return p.in[14]; }
    __device__ __forceinline__ const float* gn_b() const { return p.in[15]; }
    __device__ __forceinline__ const float* conv_w() const { return p.in[16]; }
    __device__ __forceinline__ const float* conv_b() const { return p.in[17]; }
    __device__ __forceinline__ const float* b_i() const { return p.in[18]; }
    __device__ __forceinline__ const float* b_f() const { return p.in[19]; }
    __device__ __forceinline__ const float* ln_w() const { return p.in[20]; }
    __device__ __forceinline__ const float* skip() const { return p.in[21]; }
    __device__ __forceinline__ const float* w_out() const { return p.in[22]; }
    __device__ __forceinline__ const float* fgain() const { return p.in[23]; }
    __device__ __forceinline__ float* out() const { return p.out; }
    __device__ __forceinline__ float* sumsq() const { return (float*)(p.ws + (WS_Y)); }
    __device__ __forceinline__ float* ada() const { return (float*)(p.ws + (WS_ADA)); }
    __device__ __forceinline__ bf16_t* win_t() const { return (bf16_t*)(p.ws + (WS_WIN)); }
    __device__ __forceinline__ bf16_t* wout_t() const { return (bf16_t*)(p.ws + (WS_WOUT)); }
    __device__ __forceinline__ bf16_t* hn() const { return (bf16_t*)(p.ws + (WS_X)); }
    __device__ __forceinline__ bf16_t* proj() const { return (bf16_t*)(p.ws + (WS_PROJ)); }
    __device__ __forceinline__ bf16_t* y() const { return (bf16_t*)(p.ws + (WS_Y)); }
    __device__ __forceinline__ bf16_t* wdup_t() const { return (bf16_t*)(p.ws + (WS_LORA)); }
    __device__ __forceinline__ bf16_t* wiup_t() const { return (bf16_t*)(p.ws + (WS_LORA + 65536)); }
    __device__ __forceinline__ bf16_t* q1p() const { return (bf16_t*)(p.ws + (WS_X)); }
    __device__ __forceinline__ bf16_t* mp() const { return (bf16_t*)(p.ws + (WS_X + 32 * MiB)); }
    __device__ __forceinline__ bf16_t* yid() const { return (bf16_t*)(p.ws + (WS_X + 64 * MiB)); }
    __device__ __forceinline__ bf16_t* nd() const { return (bf16_t*)(p.ws + (WS_X + 96 * MiB)); }
    __device__ __forceinline__ float* wl() const { return (float*)(p.ws + (WS_WL)); }
    __device__ __forceinline__ float* bonus() const { return (float*)(p.ws + (WS_BONUS)); }
    __device__ __forceinline__ bf16_t* qc() const { return (bf16_t*)(p.ws + WS_Y); }
    __device__ __forceinline__ bf16_t* kc() const { return (bf16_t*)(p.ws + WS_Y + 32 * MiB); }
    __device__ __forceinline__ bf16_t* mixo() const { return (bf16_t*)(p.ws + WS_Y); }
    __device__ __forceinline__ bf16_t* p0s() const { return (bf16_t*)p.out; }
    __device__ __forceinline__ bf16_t* ymix() const { return (bf16_t*)(p.ws + WS_X); }
    unsigned char* lds; int tid, lane, wid, gw, ngw;
};

__device__ __forceinline__ float bf2f(bf16_t v) { return __uint_as_float(((unsigned)v) << 16); }
typedef __bf16 bf16v2_t __attribute__((ext_vector_type(2))); typedef float f32v2_t __attribute__((ext_vector_type(2)));
__device__ __forceinline__ unsigned pk2(float lo, float hi) { const f32v2_t v = {lo, hi}; const bf16v2_t b = __builtin_convertvector(v, bf16v2_t); return __builtin_bit_cast(unsigned, b); }
__device__ __forceinline__ bf16_t f2bf(float f) { return __builtin_bit_cast(bf16_t, (__bf16)f); }
__device__ __forceinline__ void unpack8(const u32x4 v, float* o) {
    o[0] = __uint_as_float(v.x << 16); o[1] = __uint_as_float(v.x & 0xffff0000u); o[2] = __uint_as_float(v.y << 16); o[3] = __uint_as_float(v.y & 0xffff0000u);
    o[4] = __uint_as_float(v.z << 16); o[5] = __uint_as_float(v.z & 0xffff0000u); o[6] = __uint_as_float(v.w << 16); o[7] = __uint_as_float(v.w & 0xffff0000u);
}
__device__ __forceinline__ u32x4 pack8(const float* v) { u32x4 o; o.x = pk2(v[0], v[1]); o.y = pk2(v[2], v[3]); o.z = pk2(v[4], v[5]); o.w = pk2(v[6], v[7]); return o; }
__device__ __forceinline__ float wave_sum(float v) {
#pragma unroll
    for (int o = 1; o < 64; o <<= 1) v += __shfl_xor(v, o);
    return v;
}
#define LDS_BARRIER() do { asm volatile("s_waitcnt lgkmcnt(0)" ::: "memory"); __builtin_amdgcn_s_barrier(); asm volatile("" ::: "memory"); } while (0)
__device__ __forceinline__ float fexp(float x) { return __builtin_amdgcn_exp2f(x * 1.4426950408889634f); }
__device__ __forceinline__ float frcp(float x) { return __builtin_amdgcn_rcpf(x); }
__device__ __forceinline__ float sigmoidf_(float z) { return frcp(1.0f + fexp(-z)); }
__device__ __forceinline__ float siluf_(float z) { return z * frcp(1.0f + fexp(-z)); }
__device__ __forceinline__ float ftanh(float x) { return 1.0f - 2.0f * frcp(1.0f + fexp(2.0f * x)); }
template <int CTRL> __device__ __forceinline__ float dppf(float v) { return __int_as_float(__builtin_amdgcn_update_dpp(0, __float_as_int(v), CTRL, 0xF, 0xF, true)); }
__device__ __forceinline__ float row16_sum(float v) {
    v += dppf<0xB1>(v); v += dppf<0x4E>(v); v += dppf<0x141>(v); v += dppf<0x140>(v); return v;
}
__device__ __forceinline__ float half8_sum(float v) {
    v += dppf<0xB1>(v); v += dppf<0x4E>(v); v += dppf<0x141>(v); return v;
}
__device__ __forceinline__ float wave_sum_dpp(float v) {
    v = row16_sum(v);
    const int iv = __float_as_int(v);
    const float r0 = __int_as_float(__builtin_amdgcn_readlane(iv, 0)), r1 = __int_as_float(__builtin_amdgcn_readlane(iv, 16)), r2 = __int_as_float(__builtin_amdgcn_readlane(iv, 32)), r3 = __int_as_float(__builtin_amdgcn_readlane(iv, 48));
    return (r0 + r1) + (r2 + r3);
}

__device__ __forceinline__ void transpose_item(const float* W, int K, int N, bf16_t* WT, float* scr, int item, int nblk, int lane) {
    const int kb = item / nblk, nb = item % nblk, k0 = 64 * kb, n0 = 32 * nb;
#pragma unroll
    for (int i = 0; i < 32; ++i) { const int kk = 2 * i + (lane >> 5); const int n = n0 + (lane & 31); scr[kk * 33 + (lane & 31)] = (n < N) ? W[(size_t)(k0 + kk) * N + n] : 0.f; }
    __builtin_amdgcn_s_waitcnt(0); asm volatile("" ::: "memory");
    const int c = lane & 7;
#pragma unroll
    for (int j = 0; j < 4; ++j) { const int n = (lane >> 3) + 8 * j; const float* s = scr + (8 * c) * 33 + n;
        u32x4 o; o.x = pk2(s[0 * 33], s[1 * 33]); o.y = pk2(s[2 * 33], s[3 * 33]); o.z = pk2(s[4 * 33], s[5 * 33]); o.w = pk2(s[6 * 33], s[7 * 33]);
        *(u32x4*)(WT + (size_t)(n0 + n) * K + k0 + 8 * c) = o; }
    __builtin_amdgcn_s_waitcnt(0); asm volatile("" ::: "memory");
}
__device__ __forceinline__ void phase0(const Ctx& C) {
    if (blockIdx.x >= 48) return;
    float* Ls = (float*)C.lds;
    float* Lp = Ls + 8192;
    for (int e = C.tid; e < 8192; e += NTHR) Ls[e] = siluf_(C.c()[e]);
    __syncthreads();
    const int lane = C.lane, wid = C.wid, grp = wid >> 2, kq = wid & 3, kp = lane >> 3, c4 = 4 * (lane & 7);
    const int col0 = (2 * blockIdx.x + grp) * 32;
    f32x4 acc[8];
#pragma unroll
    for (int b = 0; b < 8; ++b) acc[b] = (f32x4){0.f, 0.f, 0.f, 0.f};
#pragma unroll 16
    for (int it = 0; it < 32; ++it) {
        const int k = kq * 256 + it * 8 + kp;
        const f32x4 w = *(const f32x4*)(C.w_ada() + (size_t)k * 3072 + col0 + c4);
#pragma unroll
        for (int b = 0; b < 8; ++b) acc[b] = acc[b] + w * Ls[b * 1024 + k];
    }
#pragma unroll
    for (int b = 0; b < 8; ++b) {
#pragma unroll
        for (int o = 8; o < 64; o <<= 1) { acc[b].x += __shfl_xor(acc[b].x, o); acc[b].y += __shfl_xor(acc[b].y, o); acc[b].z += __shfl_xor(acc[b].z, o); acc[b].w += __shfl_xor(acc[b].w, o); }
        if (kp == 0) *(f32x4*)(Lp + ((grp * 4 + kq) * 8 + b) * 32 + c4) = acc[b];
    }
    __syncthreads();
    if (C.tid < 512) { const int g2 = C.tid >> 8, b = (C.tid >> 5) & 7, c = C.tid & 31; const int col = (2 * blockIdx.x + g2) * 32 + c;
        float s = C.b_ada()[col];
#pragma unroll
        for (int q = 0; q < 4; ++q) s += Lp[((g2 * 4 + q) * 8 + b) * 32 + c];
        C.ada()[b * 3072 + col] = s; }
}
__device__ __forceinline__ void weight_copies(const Ctx& C) {
    float* scr = (float*)(C.lds + C.wid * 16384);
    constexpr int NBI = NPAD / 32, I_IN = 16 * NBI, I_OUT = 16 * 32;
    for (int it = C.gw; it < I_IN + I_OUT + 32; it += C.ngw) {
        if (it < I_IN) transpose_item(C.w_in(), 1024, DIN, C.win_t(), scr, it, NBI, C.lane);
        else if (it < I_IN + I_OUT) transpose_item(C.w_out(), 1024, 1024, C.wout_t(), scr, it - I_IN, 32, C.lane);
        else if (it < I_IN + I_OUT + 16) transpose_item(C.w_dup(), 64, 512, C.wdup_t(), scr, it - I_IN - I_OUT, 16, C.lane);
        else transpose_item(C.w_iup(), 64, 512, C.wiup_t(), scr, it - I_IN - I_OUT - 16, 16, C.lane);
    }
}

__device__ __forceinline__ void phase1(const Ctx& C) {
    f32x4 g[4];
#pragma unroll
    for (int j = 0; j < 4; ++j) g[j] = *(const f32x4*)(C.norm_gain() + 4 * C.lane + 256 * j);
    f32x4 v[4], n1[4];
    { const f32x4* xr = (const f32x4*)(C.x() + (size_t)C.gw * DM) + C.lane; const f32x4* x1 = (const f32x4*)(C.x() + (size_t)(C.gw + C.ngw) * DM) + C.lane;
#pragma unroll
      for (int j = 0; j < 4; ++j) { v[j] = __builtin_nontemporal_load(xr + 64 * j); n1[j] = __builtin_nontemporal_load(x1 + 64 * j); } }
    f32x4 shv[4], scv[4]; int bcur = -1;
    for (int m = C.gw; m < NTOK; m += C.ngw) {
        const int b = m >> 12; const int mn = (m + 2 * C.ngw < NTOK) ? m + 2 * C.ngw : m;
        if (b != bcur) { bcur = b;
#pragma unroll
            for (int j = 0; j < 4; ++j) { shv[j] = *(const f32x4*)(C.ada() + b * 3072 + 4 * C.lane + 256 * j); scv[j] = *(const f32x4*)(C.ada() + b * 3072 + 1024 + 4 * C.lane + 256 * j) + 1.0f; } }
        f32x4 nv[4];
        { const f32x4* xr = (const f32x4*)(C.x() + (size_t)mn * DM) + C.lane;
#pragma unroll
          for (int j = 0; j < 4; ++j) nv[j] = __builtin_nontemporal_load(xr + 64 * j); }
        float s = 0.f;
#pragma unroll
        for (int j = 0; j < 4; ++j) s += (v[j].x * v[j].x + v[j].y * v[j].y) + (v[j].z * v[j].z + v[j].w * v[j].w);
        const float rs = __builtin_amdgcn_rsqf(wave_sum_dpp(s) * (1.0f / DM) + 1e-6f);
        u32x2* o = (u32x2*)(C.hn() + (size_t)m * DM) + C.lane;
#pragma unroll
        for (int j = 0; j < 4; ++j) {
            const f32x4 h = v[j] * rs * g[j] * scv[j] + shv[j];
            u32x2 w; w.x = pk2(h.x, h.y); w.y = pk2(h.z, h.w); o[64 * j] = w; }
#pragma unroll
        for (int j = 0; j < 4; ++j) { v[j] = n1[j]; n1[j] = nv[j]; }
    }
}

typedef short s16x4 __attribute__((ext_vector_type(4)));
__device__ __forceinline__ bf16x8 tr_frag(const bf16_t* base, int stride, int row0, int col0, int fr, int fq) {
    const bf16_t* a0 = base + (row0 + 8 * fq + (fr >> 2)) * stride + col0 + 4 * (fr & 3);
    const s16x4 lo = __builtin_amdgcn_ds_read_tr16_b64_v4i16((__attribute__((address_space(3))) s16x4*)a0);
    const s16x4 hi = __builtin_amdgcn_ds_read_tr16_b64_v4i16((__attribute__((address_space(3))) s16x4*)(a0 + 4 * stride));
    return (bf16x8){lo[0], lo[1], lo[2], lo[3], hi[0], hi[1], hi[2], hi[3]};
}

constexpr int LS = 72;
constexpr int XS = 68;
__device__ __forceinline__ int permc(int c) { return (c & 32) | ((c & 12) << 1) | ((c & 16) >> 2) | (c & 3); }
__device__ __forceinline__ bf16x8 zero8() { return (bf16x8){0, 0, 0, 0, 0, 0, 0, 0}; }
#define MFMA16(a, b, c) __builtin_amdgcn_mfma_f32_16x16x32_bf16(a, b, c, 0, 0, 0)
#define LDFRAG(base, row, col) (*(const bf16x8*)((base) + (row) * LS + (col)))

#define FR_(base, rowoff, coloff) (*(const bf16x8*)((base) + lfo + (rowoff) * LS + (coloff)))
#define DW_(base, rowoff, coloff, r) ((base)[ldo + ((rowoff) + (r)) * LS + (coloff)])
#define OPAQ() asm volatile("" : "+v"(lfo), "+v"(ldo), "+v"(lto), "+v"(lxo))
template <int VAR> __device__ __forceinline__ void rwkv_r1_wg(const Ctx& C, int b, int h, int ck0, int nck) {
    bf16_t* B0 = (bf16_t*)C.lds;
    bf16_t* B1 = B0 + 64 * LS;
    bf16_t* B2 = B1 + 64 * LS;
    bf16_t* B3 = B2 + 64 * LS;
    bf16_t* B4 = B3 + 64 * LS;
    bf16_t* B5 = B4 + 64 * LS;
    bf16_t* B6 = B5 + 64 * LS;
    bf16_t* B7 = B6 + 64 * LS;
    bf16_t* B8 = B7 + 64 * LS;
    float* F = (float*)(B8 + 64 * LS);
    float* Xr = F; float* Xk = F + 64 * XS; float* Xv = Xk + 64 * XS;
    bf16_t* LAab = (bf16_t*)F; bf16_t* LAak = LAab + 64 * LS; bf16_t* LArb = LAak + 64 * LS; bf16_t* LArk = LArb + 64 * LS; bf16_t* LTinv = LArk + 64 * LS;
    float* G = F + 3 * 64 * XS;
    float* LAd = G;
    float* Ltot = LAd + 1024;
    float* Linv = Ltot + 256;
    float* Lbp = Linv + 64;
    bf16_t* LX = (bf16_t*)LAd;
    bf16_t* LX2 = LX + 2 * 16 * 40;
    float* Lc = Lbp + 128;
    int tid = C.tid; asm volatile("" : "+v"(tid));
    const int lane = tid & 63, wid = C.wid, fr = lane & 15, fq = lane >> 4;
    const int tt = tid >> 3, cg8 = tid & 7, ch0 = h * 64 + 8 * cg8;
    const int wt = wid >> 1, wc0 = 2 * (wid & 1);
    __syncthreads();
    if (tid < 384) { const int a = tid >> 6, c = tid & 63;
        Lc[tid] = (a == 0) ? C.mu()[C_R + h * 64 + c] : (a == 1) ? C.mu()[C_K + h * 64 + c] : (a == 2) ? C.mu()[C_V + h * 64 + c] : (a == 3) ? C.k_k()[h * 64 + c] : (a == 4) ? C.mu()[C_WD + c] : C.mu()[C_AD + c]; }
    __syncthreads();
    float d0c[2], a0c[2], kkc[2], kac[2], rkc[2];
#pragma unroll
    for (int jj = 0; jj < 2; ++jj) { const int c = h * 64 + 16 * (wc0 + jj) + fr;
        d0c[jj] = C.w_d0()[c]; a0c[jj] = C.a0()[c]; kkc[jj] = C.k_k()[c]; kac[jj] = C.k_a()[c]; rkc[jj] = C.r_k()[c]; }
    int lfo = fr * LS + 8 * fq, ldo = 4 * fq * LS + fr, lto = fr * LS + 4 * fq, lxo = 4 * fq * XS + fr;

    u32x4 raw[10];
#define R1_LOAD_RAW(mm) do { const bf16_t* pj_ = C.proj(); const size_t mc_ = (size_t)(mm), mp_ = (size_t)(((mm) > 0) ? (mm) - 1 : (mm)); \
        raw[0] = *(const u32x4*)(pj_ + pjo(mc_, C_R + ch0)); raw[1] = *(const u32x4*)(pj_ + pjo(mc_, C_K + ch0)); raw[2] = *(const u32x4*)(pj_ + pjo(mc_, C_V + ch0)); \
        raw[3] = *(const u32x4*)(pj_ + pjo(mc_, C_WD + 8 * cg8)); raw[4] = *(const u32x4*)(pj_ + pjo(mc_, C_AD + 8 * cg8)); \
        raw[5] = *(const u32x4*)(pj_ + pjo(mp_, C_R + ch0)); raw[6] = *(const u32x4*)(pj_ + pjo(mp_, C_K + ch0)); raw[7] = *(const u32x4*)(pj_ + pjo(mp_, C_V + ch0)); \
        raw[8] = *(const u32x4*)(pj_ + pjo(mp_, C_WD + 8 * cg8)); raw[9] = *(const u32x4*)(pj_ + pjo(mp_, C_AD + 8 * cg8)); } while (0)
    R1_LOAD_RAW(b * NT + ck0 * 64 + tt);
    for (int ci = 0; ci < nck; ++ci) {
        const int ck = ck0 + ci; const int m = b * NT + ck * 64 + tt; const size_t chx = (size_t)((b * 8 + h) * 64 + ck);
        OPAQ();
        bf16x8 Bw[2][2], Bi[2][2];
        { int co = (h * 64 + 16 * wc0 + fr) * 64 + 8 * fq; asm volatile("" : "+v"(co));
#pragma unroll
          for (int jj = 0; jj < 2; ++jj)
#pragma unroll
            for (int ks = 0; ks < 2; ++ks) { Bw[jj][ks] = *(const bf16x8*)(C.wdup_t() + co + jj * 1024 + 32 * ks); Bi[jj][ks] = *(const bf16x8*)(C.wiup_t() + co + jj * 1024 + 32 * ks); } }
        if constexpr ((VAR & 2) == 0) {
        {
            const bool hp = (ck | tt) != 0;
            if (!hp) {
#pragma unroll
                for (int i = 5; i < 10; ++i) raw[i] = (u32x4){0u, 0u, 0u, 0u}; }
            const int o = tt * XS + 8 * cg8;
            {
                float v[8], pv[8], mu8[8]; unpack8(raw[2], v); unpack8(raw[7], pv);
                { const f32x4* p4 = (const f32x4*)(Lc + 128 + 8 * cg8); *(f32x4*)mu8 = p4[0]; *(f32x4*)(mu8 + 4) = p4[1]; }
#pragma unroll
                for (int i = 0; i < 8; ++i) v[i] += mu8[i] * (pv[i] - v[i]);
                *(f32x4*)(Xv + o) = (f32x4){v[0], v[1], v[2], v[3]}; *(f32x4*)(Xv + o + 4) = (f32x4){v[4], v[5], v[6], v[7]};
            }
            asm volatile("" ::: "memory");
            {
                float v[8], pv[8], mu8[8]; unpack8(raw[0], v); unpack8(raw[5], pv);
                { const f32x4* p4 = (const f32x4*)(Lc + 8 * cg8); *(f32x4*)mu8 = p4[0]; *(f32x4*)(mu8 + 4) = p4[1]; }
#pragma unroll
                for (int i = 0; i < 8; ++i) v[i] += mu8[i] * (pv[i] - v[i]);
                *(f32x4*)(Xr + o) = (f32x4){v[0], v[1], v[2], v[3]}; *(f32x4*)(Xr + o + 4) = (f32x4){v[4], v[5], v[6], v[7]};
            }
            asm volatile("" ::: "memory");
            {
                float v[8], pv[8], mu8[8], kw8[8]; unpack8(raw[1], v); unpack8(raw[6], pv);
                { const f32x4* p4 = (const f32x4*)(Lc + 64 + 8 * cg8); *(f32x4*)mu8 = p4[0]; *(f32x4*)(mu8 + 4) = p4[1]; p4 = (const f32x4*)(Lc + 192 + 8 * cg8); *(f32x4*)kw8 = p4[0]; *(f32x4*)(kw8 + 4) = p4[1]; }
                float ss = 0.f;
#pragma unroll
                for (int i = 0; i < 8; ++i) { v[i] += mu8[i] * (pv[i] - v[i]); const float q = v[i] * kw8[i]; ss += q * q; }
                ss = half8_sum(ss);
                if (cg8 == 0) Linv[tt] = frcp(fmaxf(__builtin_amdgcn_sqrtf(ss), 1e-12f));
                *(f32x4*)(Xk + o) = (f32x4){v[0], v[1], v[2], v[3]}; *(f32x4*)(Xk + o + 4) = (f32x4){v[4], v[5], v[6], v[7]};
            }
            asm volatile("" ::: "memory");
            {
                float v[8], pv[8], mu8[8]; unpack8(raw[3], v); unpack8(raw[8], pv);
                { const f32x4* p4 = (const f32x4*)(Lc + 256 + 8 * cg8); *(f32x4*)mu8 = p4[0]; *(f32x4*)(mu8 + 4) = p4[1]; }
#pragma unroll
                for (int i = 0; i < 8; ++i) v[i] = ftanh(v[i] + mu8[i] * (pv[i] - v[i]));
                *(u32x4*)(B0 + tt * LS + 8 * cg8) = pack8(v);
            }
            asm volatile("" ::: "memory");
            {
                float v[8], pv[8], mu8[8]; unpack8(raw[4], v); unpack8(raw[9], pv);
                { const f32x4* p4 = (const f32x4*)(Lc + 320 + 8 * cg8); *(f32x4*)mu8 = p4[0]; *(f32x4*)(mu8 + 4) = p4[1]; }
#pragma unroll
                for (int i = 0; i < 8; ++i) v[i] += mu8[i] * (pv[i] - v[i]);
                *(u32x4*)(B1 + tt * LS + 8 * cg8) = pack8(v);
            }
        }
        }
        LDS_BARRIER();
        float lw[2][4], aa[2][4];
        {
            f32x4 zw[2], za[2];
#pragma unroll
            for (int jj = 0; jj < 2; ++jj) { zw[jj] = (f32x4){0.f, 0.f, 0.f, 0.f}; za[jj] = (f32x4){0.f, 0.f, 0.f, 0.f}; }
#pragma unroll
            for (int ks = 0; ks < 2; ++ks) { const bf16x8 aw = FR_(B0, 16 * wt, 32 * ks), ai = FR_(B1, 16 * wt, 32 * ks);
#pragma unroll
                for (int jj = 0; jj < 2; ++jj) { zw[jj] = MFMA16(aw, Bw[jj][ks], zw[jj]); za[jj] = MFMA16(ai, Bi[jj][ks], za[jj]); } }
#pragma unroll
            for (int jj = 0; jj < 2; ++jj)
#pragma unroll
                for (int r = 0; r < 4; ++r) { lw[jj][r] = -0.6065306597126334f * sigmoidf_(d0c[jj] + zw[jj][r]); aa[jj][r] = sigmoidf_(a0c[jj] + za[jj][r]); }
        }
        float clx[2][4], cin[2][4];
#pragma unroll
        for (int jj = 0; jj < 2; ++jj) {
            const float s4 = (lw[jj][0] + lw[jj][1]) + (lw[jj][2] + lw[jj][3]); float x = s4;
            float t1 = __shfl_up(x, 16); if (fq >= 1) x += t1; t1 = __shfl_up(x, 32); if (fq >= 2) x += t1;
            const float eq = x - s4;
            clx[jj][0] = eq; cin[jj][0] = eq + lw[jj][0];
#pragma unroll
            for (int r = 1; r < 4; ++r) { clx[jj][r] = cin[jj][r - 1]; cin[jj][r] = cin[jj][r - 1] + lw[jj][r]; }
            if (fq == 3) Ltot[wt * 64 + 16 * (wc0 + jj) + fr] = x;
        }
        LDS_BARRIER();
        OPAQ();
        if constexpr ((VAR & 4) == 0) {
        {
            float bsum[4] = {0.f, 0.f, 0.f, 0.f};
            const int xb = lxo + 16 * wt * XS + 16 * wc0;
            const int db = 16 * wt * LS + 16 * wc0;
            const int tb = lto + 16 * wc0 * LS + 16 * wt;
#pragma unroll
            for (int jj = 0; jj < 2; ++jj) {
                const int c = 16 * (wc0 + jj) + fr;
                float off = 0.f, clL = 0.f;
#pragma unroll
                for (int q = 0; q < 4; ++q) { const float tv = Ltot[q * 64 + c]; clL += tv; if (q < wt) off += tv; }
                const float eL = fexp(clL);
                if ((VAR & 1) == 0 && wt == 0 && fq == 0) C.wl()[chx * 64 + c] = eL;
                float at[4], rt[4], bt[4], kt[4], bh[4], kh[4], vv[4]; float eprev = 0.f;
#pragma unroll
                for (int r = 0; r < 4; ++r) {
                    const float rr = Xr[xb + r * XS + 16 * jj], kr = Xk[xb + r * XS + 16 * jj]; vv[r] = Xv[xb + r * XS + 16 * jj];
                    const float kk = kr * kkc[jj] * Linv[16 * wt + 4 * fq + r]; const float a = aa[jj][r];
                    const float be = kk * a, km = kr * (1.0f + (a - 1.0f) * kac[jj]);
                    const float ci_ = off + cin[jj][r], cx = off + clx[jj][r];
                    const float ei = fexp(ci_), en = frcp(ei), el = eL * en;
                    at[r] = -kk * ((r == 0) ? fexp(cx) : eprev); eprev = ei; rt[r] = rr * ei; bt[r] = be * en; kt[r] = km * en; bh[r] = be * el; kh[r] = km * el;
                    bsum[r] += rr * km * rkc[jj];
                    B3[ldo + db + r * LS + 16 * jj] = f2bf(rt[r]);
                }
                u32x2 w;
                w.x = pk2(at[0], at[1]); w.y = pk2(at[2], at[3]); *(u32x2*)(B4 + tb + 16 * jj * LS) = w;
                w.x = pk2(bt[0], bt[1]); w.y = pk2(bt[2], bt[3]); *(u32x2*)(B1 + tb + 16 * jj * LS) = w;
                w.x = pk2(kt[0], kt[1]); w.y = pk2(kt[2], kt[3]); *(u32x2*)(B2 + tb + 16 * jj * LS) = w;
                w.x = pk2(bh[0], bh[1]); w.y = pk2(bh[2], bh[3]); *(u32x2*)(B5 + tb + 16 * jj * LS) = w;
                w.x = pk2(kh[0], kh[1]); w.y = pk2(kh[2], kh[3]); *(u32x2*)(B6 + tb + 16 * jj * LS) = w;
                w.x = pk2(vv[0], vv[1]); w.y = pk2(vv[2], vv[3]); *(u32x2*)(B7 + tb + 16 * jj * LS) = w;
            }
#pragma unroll
            for (int r = 0; r < 4; ++r) { const float s = row16_sum(bsum[r]); if (fr == 0) Lbp[(wid & 1) * 64 + 16 * wt + 4 * fq + r] = s; }
        }
        }
        LDS_BARRIER();
        OPAQ();
        if ((VAR & 1) == 0 && tid < 64) C.bonus()[(size_t)(b * NT + ck * 64 + tid) * 8 + h] = Lbp[tid] + Lbp[64 + tid];
        if constexpr ((VAR & 8) == 0) {
        {
            int fr3 = fr, fq3 = fq; asm volatile("" : "+v"(fr3), "+v"(fq3));
#pragma unroll
            for (int jj = 0; jj < 2; ++jj) {
                const int st = wc0 + jj;
                if (st <= wt) {
                    f32x4 ab = (f32x4){0.f, 0.f, 0.f, 0.f}, ak = ab, rb = ab, rk = ab;
#pragma unroll
                    for (int ks = 0; ks < 2; ++ks) {
                        const bf16x8 fa = tr_frag(B4, LS, 32 * ks, 16 * wt, fr3, fq3), frr = FR_(B3, 16 * wt, 32 * ks);
                        const bf16x8 fb = tr_frag(B1, LS, 32 * ks, 16 * st, fr3, fq3), fk = tr_frag(B2, LS, 32 * ks, 16 * st, fr3, fq3);
                        ab = MFMA16(fa, fb, ab); ak = MFMA16(fa, fk, ak); rb = MFMA16(frr, fb, rb); rk = MFMA16(frr, fk, rk);
                    }
                    int fro = fr, fqo = 4 * fq; asm volatile("" : "+v"(fro), "+v"(fqo));
                    const int s = 16 * st + fro;
#pragma unroll
                    for (int r = 0; r < 4; ++r) { const int t = 16 * wt + fqo + r; const bool lo = s < t, le = s <= t;
                        const float vab = lo ? ab[r] : 0.f;
                        DW_(LAab, 16 * wt, 16 * st, r) = f2bf(vab); DW_(LAak, 16 * wt, 16 * st, r) = f2bf(lo ? ak[r] : 0.f); DW_(LArb, 16 * wt, 16 * st, r) = f2bf(le ? rb[r] : 0.f); DW_(LArk, 16 * wt, 16 * st, r) = f2bf(le ? rk[r] : 0.f);
                        if (st == wt) LAd[wt * 256 + (4 * fq + r) * 16 + fr] = vab; }
                } else if (st == wt + 1 && (wt & 1) == 0) {
#pragma unroll
                    for (int r = 0; r < 4; ++r) { DW_(LAak, 16 * wt, 16 * st, r) = 0; DW_(LArb, 16 * wt, 16 * st, r) = 0; DW_(LArk, 16 * wt, 16 * st, r) = 0; DW_(LTinv, 16 * wt, 16 * st, r) = 0; }
                }
            }
            if (tid < 32) *(u32x4*)(B8 + (16 + (tid >> 1)) * LS + 8 * (tid & 1)) = (u32x4){0u, 0u, 0u, 0u};
        }
        }
        LDS_BARRIER();
        OPAQ();
        if constexpr ((VAR & 16) == 0) {
        if (wid == 0) {
            const float* Ad = LAd + fq * 256; float X[16];
#pragma unroll
            for (int i = 0; i < 16; ++i) X[i] = (i == fr) ? 1.0f : 0.f;
#pragma unroll
            for (int i = 1; i < 16; ++i) { float acc = X[i];
#pragma unroll
                for (int s = 0; s < i; ++s) acc += Ad[i * 16 + s] * X[s];
                X[i] = acc; }
            const int dg = ldo + 12 * fq * LS + 16 * fq;
#pragma unroll
            for (int i = 0; i < 16; ++i) LTinv[dg + i * LS] = f2bf(X[i]);
            const int dt = lfo + 16 * fq * LS + 8 * fq;
            *(u32x4*)(B8 + dt) = pack8(X); *(u32x4*)(B8 + dt + 8) = pack8(X + 8);
        } else {
            for (int tile = wid - 1; tile < 16; tile += 7) { const int vt = tile >> 2, t2 = tile & 3; f32x4 acc = (f32x4){0.f, 0.f, 0.f, 0.f};
#pragma unroll
                for (int ks = 0; ks < 2; ++ks) if (ks == 0 || t2 >= 2) acc = MFMA16(FR_(B7, 16 * vt, 32 * ks), FR_(LAak, 16 * t2, 32 * ks), acc);
#pragma unroll
                for (int r = 0; r < 4; ++r) DW_(B0, 16 * vt, 16 * t2, r) = f2bf(acc[r]); }
        }
        }
        LDS_BARRIER();
        OPAQ();
        if (ci + 1 < nck) R1_LOAD_RAW(m + 64);
        if ((VAR & 32) == 0 && wid < 2) {
            const int o = 32 * wid;
            bf16_t* lx = LX + wid * 16 * 40;
            const bool kv = fq < 2;
            const int xf = fr * 40 + 8 * fq, xd = 4 * fq * 40 + fr;
            {
                const bf16x8 fa = kv ? FR_(B8, o, o) : zero8(), fb = kv ? FR_(LAab, o + 16, o) : zero8();
                const f32x4 acc = MFMA16(fa, fb, ((f32x4){0.f, 0.f, 0.f, 0.f}));
#pragma unroll
                for (int r = 0; r < 4; ++r) lx[xd + r * 40] = f2bf(acc[r]);
            }
            asm volatile("s_waitcnt lgkmcnt(0)" ::: "memory");
            {
                const bf16x8 ft = kv ? FR_(LTinv, o + 16, o + 16) : zero8(), fx = kv ? *(const bf16x8*)(lx + xf) : zero8();
                const f32x4 acc = MFMA16(ft, fx, ((f32x4){0.f, 0.f, 0.f, 0.f}));
#pragma unroll
                for (int r = 0; r < 4; ++r) DW_(LTinv, o + 16, o, r) = f2bf(acc[r]);
                if (wid == 0) { const f32x4 acT = MFMA16(fx, ft, ((f32x4){0.f, 0.f, 0.f, 0.f}));
#pragma unroll
                    for (int r = 0; r < 4; ++r) DW_(B8, 0, 16, r) = f2bf(acT[r]); }
            }
        }
        LDS_BARRIER();
        if ((VAR & 32) == 0 && wid < 4) {
            const int jt = wid >> 1, ut = wid & 1;
            const f32x4 acc = MFMA16(FR_(B8, 16 * jt, 0), FR_(LAab, 32 + 16 * ut, 0), ((f32x4){0.f, 0.f, 0.f, 0.f}));
#pragma unroll
            for (int r = 0; r < 4; ++r) LX2[(16 * jt + 4 * fq + r) * 40 + 16 * ut + fr] = f2bf(acc[r]);
        }
        LDS_BARRIER();
        if ((VAR & 32) == 0 && wid < 4) {
            const int t2 = wid >> 1, jt = wid & 1;
            const f32x4 acc = MFMA16(FR_(LTinv, 32 + 16 * t2, 32), *(const bf16x8*)(LX2 + (16 * jt + fr) * 40 + 8 * fq), ((f32x4){0.f, 0.f, 0.f, 0.f}));
#pragma unroll
            for (int r = 0; r < 4; ++r) DW_(LTinv, 32 + 16 * t2, 16 * jt, r) = f2bf(acc[r]);
        }
        LDS_BARRIER();
        OPAQ();
        if constexpr ((VAR & 64) == 0) {
        {
#pragma unroll
            for (int jj = 0; jj < 2; ++jj) { const int t2 = wc0 + jj; f32x4 p1 = (f32x4){0.f, 0.f, 0.f, 0.f}, p2 = p1;
#pragma unroll
                for (int ks = 0; ks < 2; ++ks) if (ks == 0 || t2 >= 2) { const bf16x8 ft = FR_(LTinv, 16 * t2, 32 * ks);
                    p1 = MFMA16(FR_(B4, 16 * wt, 32 * ks), ft, p1); p2 = MFMA16(FR_(B0, 16 * wt, 32 * ks), ft, p2); }
#pragma unroll
                for (int r = 0; r < 4; ++r) { DW_(B1, 16 * wt, 16 * t2, r) = f2bf(p1[r]); DW_(B2, 16 * wt, 16 * t2, r) = f2bf(p2[r]); } }
        }
        }
        LDS_BARRIER();
        OPAQ();
        if constexpr ((VAR & 128) == 0) {
        {
            bf16_t* gq = C.q1p() + chx * 4096; bf16_t* gm = C.mp() + chx * 4096; bf16_t* gy = C.yid() + chx * 4096; bf16_t* gn = C.nd() + chx * 4096;
#pragma unroll
            for (int jj = 0; jj < 2; ++jj) {
                const int ct2 = wc0 + jj;
                f32x4 q1 = (f32x4){0.f, 0.f, 0.f, 0.f}, mm = q1, yi = q1, nn = q1;
#pragma unroll
                for (int ks = 0; ks < 2; ++ks) {
                    const bf16x8 fp1 = FR_(B1, 16 * wt, 32 * ks);
                    if (ks == 0 || ct2 >= 2) q1 = MFMA16(fp1, FR_(LArb, 16 * ct2, 32 * ks), q1);
                    mm = MFMA16(fp1, FR_(B5, 16 * ct2, 32 * ks), mm);
                    const bf16x8 fp2 = FR_(B2, 16 * ct2, 32 * ks), fv = FR_(B7, 16 * ct2, 32 * ks);
                    if (ks == 0 || wt >= 2) { yi = MFMA16(FR_(LArb, 16 * wt, 32 * ks), fp2, yi); yi = MFMA16(FR_(LArk, 16 * wt, 32 * ks), fv, yi); }
                    nn = MFMA16(FR_(B5, 16 * wt, 32 * ks), fp2, nn); nn = MFMA16(FR_(B6, 16 * wt, 32 * ks), fv, nn);
                }
                {
                    const int t = 16 * ct2 + fr, c0 = 16 * wt + 4 * fq; const u32x2 rv = *(const u32x2*)(B3 + lto + 16 * ct2 * LS + 16 * wt);
                    u32x2 w; w.x = pk2(q1[0] + __uint_as_float(rv.x << 16), q1[1] + __uint_as_float(rv.x & 0xffff0000u)); w.y = pk2(q1[2] + __uint_as_float(rv.y << 16), q1[3] + __uint_as_float(rv.y & 0xffff0000u));
                    *(u32x2*)(B0 + t * LS + permc(c0)) = w;
                    u32x2 w2; w2.x = pk2(mm[0], mm[1]); w2.y = pk2(mm[2], mm[3]); *(u32x2*)(B4 + t * LS + permc(c0)) = w2;
                }
                { u32x2 w; w.x = pk2(yi[0], yi[1]); w.y = pk2(yi[2], yi[3]); if ((VAR & 1) == 0) *(u32x2*)(gy + ((wt * 4 + ct2) * 64 + lane) * 4) = w;
                  u32x2 w2; w2.x = pk2(nn[0], nn[1]); w2.y = pk2(nn[2], nn[3]); if ((VAR & 1) == 0) *(u32x2*)(gn + ((wt * 4 + ct2) * 64 + lane) * 4) = w2; }
            }
        }
        }
        LDS_BARRIER();
        if constexpr ((VAR & 1) == 0 && (VAR & 128) == 0) {
            const int o = (tid >> 3) * LS + (tid & 7) * 8;
            *(u32x4*)(C.q1p() + chx * 4096 + tid * 8) = *(const u32x4*)(B0 + o); *(u32x4*)(C.mp() + chx * 4096 + tid * 8) = *(const u32x4*)(B4 + o);
        }
    }
}
#undef FR_
#undef DW_
#undef OPAQ

constexpr int R2_SLOT = 2 * 64 * 72 * 2 + 2 * 8192 + 256;
struct R2Set { u32x4 q, m, y, n, w; };
__device__ __forceinline__ void r2_issue(const Ctx& C, R2Set& r, size_t chx, int tid) {
    r.q = *(const u32x4*)(C.q1p() + chx * 4096 + tid * 8); r.m = *(const u32x4*)(C.mp() + chx * 4096 + tid * 8);
    r.y = *(const u32x4*)(C.yid() + chx * 4096 + tid * 8); r.n = *(const u32x4*)(C.nd() + chx * 4096 + tid * 8);
    r.w = *(const u32x4*)(C.wl() + chx * 64 + 4 * (tid & 15));
}
__device__ __forceinline__ void r2_put(const R2Set& r, unsigned char* slot, int tid) {
    bf16_t* LQ = (bf16_t*)slot; bf16_t* LM = LQ + 64 * 72; bf16_t* LY = LM + 64 * 72; bf16_t* LN = LY + 4096; float* LW = (float*)(LN + 4096);
    const int o = (tid >> 3) * 72 + (tid & 7) * 8;
    *(u32x4*)(LQ + o) = r.q; *(u32x4*)(LM + o) = r.m; *(u32x4*)(LY + tid * 8) = r.y; *(u32x4*)(LN + tid * 8) = r.n;
    if (tid < 16) *(u32x4*)(LW + 4 * tid) = r.w;
}
__device__ __forceinline__ void r2_step(const Ctx& C, f32x4 (&S)[4], const unsigned char* slot, int b, int h, int vt, int ck, int lane, int fr, int fq) {
    const bf16_t* LQ = (const bf16_t*)slot; const bf16_t* LM = LQ + 64 * 72; const bf16_t* LY = LM + 64 * 72; const bf16_t* LN = LY + 4096; const float* LW = (const float*)(LN + 4096);
    bf16x8 Sb[2];
#pragma unroll
    for (int ks = 0; ks < 2; ++ks) { u32x4 w; w.x = pk2(S[2 * ks][0], S[2 * ks][1]); w.y = pk2(S[2 * ks][2], S[2 * ks][3]); w.z = pk2(S[2 * ks + 1][0], S[2 * ks + 1][1]); w.w = pk2(S[2 * ks + 1][2], S[2 * ks + 1][3]);
        Sb[ks] = __builtin_bit_cast(bf16x8, w); }
    f32x4 Sn[4];
#pragma unroll
    for (int c4 = 0; c4 < 4; ++c4) {
        const u32x2 nv = *(const u32x2*)(LN + ((c4 * 4 + vt) * 64 + lane) * 4); const f32x4 wl = *(const f32x4*)(LW + 16 * c4 + 4 * fq);
        f32x4 acc = (f32x4){__uint_as_float(nv.x << 16), __uint_as_float(nv.x & 0xffff0000u), __uint_as_float(nv.y << 16), __uint_as_float(nv.y & 0xffff0000u)};
        acc = acc + wl * S[c4];
#pragma unroll
        for (int ks = 0; ks < 2; ++ks) acc = MFMA16(*(const bf16x8*)(LM + (16 * c4 + fr) * 72 + 32 * ks + 8 * fq), Sb[ks], acc);
        Sn[c4] = acc;
    }
#pragma unroll
    for (int t4 = 0; t4 < 4; ++t4) {
        const u32x2 yv = *(const u32x2*)(LY + ((t4 * 4 + vt) * 64 + lane) * 4);
        f32x4 acc = (f32x4){__uint_as_float(yv.x << 16), __uint_as_float(yv.x & 0xffff0000u), __uint_as_float(yv.y << 16), __uint_as_float(yv.y & 0xffff0000u)};
#pragma unroll
        for (int ks = 0; ks < 2; ++ks) acc = MFMA16(*(const bf16x8*)(LQ + (16 * t4 + fr) * 72 + 32 * ks + 8 * fq), Sb[ks], acc);
        bf16_t* yo = C.proj() + pjo((size_t)(b * NT + ck * 64 + 16 * t4 + 4 * fq), C_R + h * 64 + 16 * vt + fr);
#pragma unroll
        for (int r = 0; r < 4; ++r) yo[(size_t)r * 256] = f2bf(acc[r]);
    }
#pragma unroll
    for (int c4 = 0; c4 < 4; ++c4) S[c4] = Sn[c4];
}
__device__ __forceinline__ void rwkv_r2_wg(const Ctx& C, int b, int h) {
    const int tid = C.tid, lane = C.lane, wid = C.wid, fr = lane & 15, fq = lane >> 4;
    unsigned char* slot0 = C.lds; unsigned char* slot1 = C.lds + R2_SLOT;
    const size_t ch0 = (size_t)((b * 8 + h) * 64);
    f32x4 S[4];
#pragma unroll
    for (int i = 0; i < 4; ++i) S[i] = (f32x4){0.f, 0.f, 0.f, 0.f};
    R2Set r0, r1, r2, r3;
    __syncthreads();
    r2_issue(C, r0, ch0 + 0, tid); r2_issue(C, r1, ch0 + 1, tid); r2_issue(C, r2, ch0 + 2, tid); r2_issue(C, r3, ch0 + 3, tid);
    r2_put(r0, slot0, tid); r2_issue(C, r0, ch0 + 4, tid);
    LDS_BARRIER();
    for (int c = 0; c < NT / 64; c += 4) {
#define R2_ITER(i, rnext, snext, scur) do { const int cc = c + (i); const int cn = (cc + 5 < NT / 64) ? cc + 5 : NT / 64 - 1; \
        r2_put(rnext, snext, tid); r2_issue(C, rnext, ch0 + cn, tid);                  \
        if (wid < 4) r2_step(C, S, scur, b, h, wid, cc, lane, fr, fq); \
        LDS_BARRIER(); } while (0)
        R2_ITER(0, r1, slot1, slot0);
        R2_ITER(1, r2, slot0, slot1);
        R2_ITER(2, r3, slot1, slot0);
        R2_ITER(3, r0, slot0, slot1);
#undef R2_ITER
    }
}
constexpr int C_G = DIN;
__device__ __forceinline__ float* gate_ptr(bf16_t* proj, size_t m, int hm) { return (float*)(proj + pjo(m, C_G)) + 4 * hm; }

__device__ __forceinline__ void mlstm_gate_scan(const Ctx& C, int b, int hm, int ck) {
    const int lane = C.lane;
    const size_t mg = (size_t)(b * NT + ck * 64 + lane); const bf16_t* pr = C.proj();
    const float ig = bf2f(pr[pjo(mg, C_I + hm)]) + C.b_i()[hm]; const float fp = bf2f(pr[pjo(mg, C_F + hm)]) + C.b_f()[hm];
    const float lf = (fp >= 0.f) ? -log1pf(expf(-fp)) : fp - log1pf(expf(fp));
    float bc = lf;
#pragma unroll
    for (int o = 1; o < 64; o <<= 1) { const float tv = __shfl_up(bc, o); if (lane >= o) bc += tv; }
    const float e = ig - bc; float pm = e;
#pragma unroll
    for (int o = 1; o < 64; o <<= 1) { const float tv = __shfl_up(pm, o); if (lane >= o) pm = fmaxf(pm, tv); }
    *(f32x4*)gate_ptr(C.proj(), mg, hm) = (f32x4){bc, e, pm, 0.f};
}
__device__ __forceinline__ void mlstm_m1_stream(const Ctx& C) {
    const int lane = C.lane; const bool isk = lane >= 32; const int ch = 16 * (lane & 31);
    const int col = (isk ? C_KM : C_Q) + ch; const int cw = (isk ? 512 : 0) + ch;
    float w[4][16], bias[16];
#pragma unroll
    for (int i = 0; i < 16; i += 4) { const f32x4 bv = *(const f32x4*)(C.conv_b() + cw + i); bias[i] = bv.x; bias[i + 1] = bv.y; bias[i + 2] = bv.z; bias[i + 3] = bv.w;
#pragma unroll
        for (int j = 0; j < 4; ++j) { const f32x4 wv = *(const f32x4*)(C.conv_w() + j * 1024 + cw + i); w[j][i] = wv.x; w[j][i + 1] = wv.y; w[j][i + 2] = wv.z; w[j][i + 3] = wv.w; } }
    const float osc = isk ? 0.08838834764831845f : 1.0f;
    bf16_t* dst = (isk ? C.kc() : C.qc()) + ch;
    for (int t0 = 16 * C.gw; t0 < NTOK; t0 += 16 * C.ngw) {
        const int tb = t0 & (NT - 1);
        u32x4 ring[7][2];
        const bf16_t* p0 = C.proj() + pjo((size_t)t0, col);
#pragma unroll
        for (int k = 0; k < 7; ++k) {
            if (k < 3 && tb == 0) { ring[k][0] = (u32x4){0u, 0u, 0u, 0u}; ring[k][1] = ring[k][0]; }
            else { const bf16_t* p = p0 + (ptrdiff_t)(k - 3) * 256; ring[k][0] = *(const u32x4*)p; ring[k][1] = *(const u32x4*)(p + 8); }
        }
#pragma unroll
        for (int i = 0; i < 16; ++i) {
            const size_t m = (size_t)(t0 + i);
            float a[16], x0[16], x1[16], x2[16], x3[16];
            unpack8(ring[i % 7][0], x0); unpack8(ring[i % 7][1], x0 + 8); unpack8(ring[(i + 1) % 7][0], x1); unpack8(ring[(i + 1) % 7][1], x1 + 8);
            unpack8(ring[(i + 2) % 7][0], x2); unpack8(ring[(i + 2) % 7][1], x2 + 8); unpack8(ring[(i + 3) % 7][0], x3); unpack8(ring[(i + 3) % 7][1], x3 + 8);
            { const int rn = (i + 4 < 16) ? i + 4 : 15; const bf16_t* p = p0 + (size_t)rn * 256; ring[i % 7][0] = *(const u32x4*)p; ring[i % 7][1] = *(const u32x4*)(p + 8); }
#pragma unroll
            for (int c = 0; c < 16; ++c) { a[c] = bias[c] + w[0][c] * x0[c] + w[1][c] * x1[c] + w[2][c] * x2[c] + w[3][c] * x3[c]; a[c] = siluf_(a[c]) * osc; }
            *(u32x4*)(dst + m * 512) = pack8(a); *(u32x4*)(dst + m * 512 + 8) = pack8(a + 8);
        }
    }
}

__device__ __forceinline__ void mlstm_p0_item(const Ctx& C, int b, int hm, int ck) {
    const int lane = C.lane, fr = lane & 15, fq = lane >> 4;
    {
        const int it = (b << 8) | (ck << 2) | hm; const size_t m0 = (size_t)(b * NT + ck * 64);
        bf16_t* out = C.p0s() + (size_t)it * 4096;
        bf16x8 kf[4][4]; float es[4][4];
#pragma unroll
        for (int sj = 0; sj < 4; ++sj) {
#pragma unroll
            for (int ks = 0; ks < 4; ++ks) kf[sj][ks] = *(const bf16x8*)(C.kc() + (m0 + 16 * sj + fr) * 512 + hm * 128 + 32 * ks + 8 * fq);
#pragma unroll
            for (int r = 0; r < 4; ++r) es[sj][r] = gate_ptr(C.proj(), m0 + 16 * sj + 4 * fq + r, hm)[1]; }
#pragma unroll
        for (int ti = 0; ti < 4; ++ti) {
            bf16x8 qf[4];
#pragma unroll
            for (int ks = 0; ks < 4; ++ks) qf[ks] = *(const bf16x8*)(C.qc() + (m0 + 16 * ti + fr) * 512 + hm * 128 + 32 * ks + 8 * fq);
            const int t = 16 * ti + fr; const float pmt = gate_ptr(C.proj(), m0 + t, hm)[2];
#pragma unroll
            for (int sj = 0; sj < 4; ++sj) {
                f32x4 acc = (f32x4){0.f, 0.f, 0.f, 0.f};
                if (sj <= ti) {
#pragma unroll
                    for (int ks = 0; ks < 4; ++ks) acc = __builtin_amdgcn_mfma_f32_16x16x32_bf16(kf[sj][ks], qf[ks], acc, 0, 0, 0);
                }
                float o[4];
#pragma unroll
                for (int r = 0; r < 4; ++r) { const int s = 16 * sj + 4 * fq + r; o[r] = (sj <= ti && s <= t) ? acc[r] * fexp(es[sj][r] - pmt) : 0.f; }
                u32x2 w; w.x = pk2(o[0], o[1]); w.y = pk2(o[2], o[3]); *(u32x2*)(out + t * 64 + 16 * sj + 4 * fq) = w;
            }
        }
    }
}

#define LDS_WAIT_ALL() asm volatile("s_waitcnt lgkmcnt(0)" ::: "memory")
constexpr int VS = 52;
constexpr int ML_BUF = (2 * 64 * 136 + 2 * 64 * VS + 64 * 72) * 2 + 1280;
template <int VAR> __device__ __forceinline__ void mlstm_item(const Ctx& C, int b, int hm, int sl) {
    constexpr bool st_out = (VAR & 1) == 0;
    unsigned char* buf0 = C.lds; unsigned char* buf1 = C.lds + ML_BUF;
    bf16_t* LCb0 = (bf16_t*)(C.lds + 2 * ML_BUF); bf16_t* LCb1 = LCb0 + 48 * 136;
#define ML_Q(bf) ((bf16_t*)(bf))
#define ML_K(bf) (ML_Q(bf) + 64 * 136)
#define ML_V(bf) (ML_K(bf) + 64 * 136)
#define ML_WV(bf) (ML_V(bf) + 64 * VS)
#define ML_P(bf) (ML_WV(bf) + 64 * VS)
#define ML_F(bf) ((float*)(ML_P(bf) + 64 * 72))
    const int tid = C.tid, lane = C.lane, wid = C.wid;
    const int fr_ = lane & 15, fq_ = lane >> 4, tt_ = tid >> 3;
    __syncthreads();
    for (int e = tid; e < 2 * 48 * 136; e += NTHR) LCb0[e] = 0;
    for (int e = tid; e < 64 * VS; e += NTHR) { const bf16_t o = ((e % VS) == 32) ? (bf16_t)0x3f80 : (bf16_t)0; ML_V(buf0)[e] = o; ML_V(buf1)[e] = o; ML_WV(buf0)[e] = 0; ML_WV(buf1)[e] = 0; }
    for (int e = tid; e < 64 * 72; e += NTHR) { ML_P(buf0)[e] = 0; ML_P(buf1)[e] = 0; }
    const int cg8 = tid & 7, d0 = 16 * cg8;
    const int ti = wid >> 1, vtw = wid & 1;
    const int ct0_t = (wid < 4) ? ((wid == 0) ? 0 : (wid == 3 ? 2 : 1)) : ((wid == 4) ? 2 : 3), ct0_s = (wid < 4) ? ((wid == 2) ? 1 : 0) : ((wid == 4) ? 1 : wid - 5);
    const int ct1_t = (wid == 0) ? 2 : 3, ct1_s = (wid == 0) ? 2 : 3; const bool has2 = wid < 2;
    f32x4 Cst[3];
#pragma unroll
    for (int i = 0; i < 3; ++i) Cst[i] = (f32x4){0.f, 0.f, 0.f, 0.f};
    float mst = 0.f, carry_cur = 1.f, carry_nxt = 1.f;
    u32x4 pq0, pq1, pk0, pk1, pp; u32x2 pv; f32x4 pg, pgl; u32x4 pq0_b, pq1_b, pk0_b, pk1_b, pp_b; u32x2 pv_b; f32x4 pg_b, pgl_b;
    const bf16_t* p0base = C.p0s() + (size_t)(((b * 64) * 4 + hm)) * 4096 + tid * 8;
    {
        const size_t m = (size_t)(b * NT + tt_);
        const bf16_t* qs = C.qc() + m * 512 + hm * 128 + d0; const bf16_t* ks = C.kc() + m * 512 + hm * 128 + d0;
        pq0 = *(const u32x4*)qs; pq1 = *(const u32x4*)(qs + 8); pk0 = *(const u32x4*)ks; pk1 = *(const u32x4*)(ks + 8);
        pv = *(const u32x2*)(C.proj() + pjo(m, C_VM + hm * 128 + sl * 32 + 4 * cg8));
        pg = *(const f32x4*)gate_ptr(C.proj(), m, hm); pgl = *(const f32x4*)gate_ptr(C.proj(), (size_t)(b * NT + 63), hm); pp = *(const u32x4*)p0base;
        const size_t m2 = m + 64; qs += 64 * 512; ks += 64 * 512;
        pq0_b = *(const u32x4*)qs; pq1_b = *(const u32x4*)(qs + 8); pk0_b = *(const u32x4*)ks; pk1_b = *(const u32x4*)(ks + 8);
        pv_b = *(const u32x2*)(C.proj() + pjo(m2, C_VM + hm * 128 + sl * 32 + 4 * cg8));
        pg_b = *(const f32x4*)gate_ptr(C.proj(), m2, hm); pgl_b = *(const f32x4*)gate_ptr(C.proj(), (size_t)(b * NT + 127), hm); pp_b = *(const u32x4*)(p0base + 4 * 4096);
    }
    __syncthreads();
    { const int kst = 0; const int fr = fr_, fq = fq_, tt = tt_;
        asm volatile("" :: "v"(pg.w), "v"(pgl.y), "v"(pgl.w));
        {
            const float mxl = fmaxf(mst, pgl.z); carry_nxt = fexp(mst - mxl);
            if constexpr ((VAR & 16) == 0) {
                const float ws = fexp(pg.y - mxl);
                *(u32x4*)(ML_Q(buf0) + tt * 136 + d0) = pq0; *(u32x4*)(ML_Q(buf0) + tt * 136 + d0 + 8) = pq1;
                *(u32x4*)(ML_K(buf0) + tt * 136 + d0) = pk0; *(u32x4*)(ML_K(buf0) + tt * 136 + d0 + 8) = pk1;
                const float v0 = __uint_as_float(pv.x << 16), v1 = __uint_as_float(pv.x & 0xffff0000u), v2 = __uint_as_float(pv.y << 16), v3 = __uint_as_float(pv.y & 0xffff0000u);
                *(u32x2*)(ML_V(buf0) + tt * VS + 4 * cg8) = pv; *(u32x4*)(ML_P(buf0) + tt * 72 + 8 * cg8) = pp;
                u32x2 wv; wv.x = pk2(v0 * ws, v1 * ws); wv.y = pk2(v2 * ws, v3 * ws); *(u32x2*)(ML_WV(buf0) + tt * VS + 4 * cg8) = wv;
                if (cg8 == 0) { ML_WV(buf0)[tt * VS + 32] = f2bf(ws); const float mx = fmaxf(mst, pg.z); float* F = ML_F(buf0); F[tt] = pg.y; F[64 + tt] = mx; F[128 + tt] = fexp(mst - mx); F[192 + tt] = fexp(-(pg.x + mx)); F[256 + tt] = fexp(pg.z - mx); }
            }
            mst = pgl.x + mxl;
            const int cn = (kst + 2 < NT / 64) ? kst + 2 : NT / 64 - 1;
            const size_t m = (size_t)(b * NT + cn * 64 + tt);
            const bf16_t* qs = C.qc() + m * 512 + hm * 128 + d0; const bf16_t* ks = C.kc() + m * 512 + hm * 128 + d0;
            pq0 = *(const u32x4*)qs; pq1 = *(const u32x4*)(qs + 8); pk0 = *(const u32x4*)ks; pk1 = *(const u32x4*)(ks + 8);
            pv = *(const u32x2*)(C.proj() + pjo(m, C_VM + hm * 128 + sl * 32 + 4 * cg8));
            pg = *(const f32x4*)gate_ptr(C.proj(), m, hm); pgl = *(const f32x4*)gate_ptr(C.proj(), (size_t)(b * NT + cn * 64 + 63), hm); pp = *(const u32x4*)(p0base + (size_t)cn * 4 * 4096);
        }
    }
    carry_cur = carry_nxt;
    LDS_BARRIER();
    { const int kc = 0; const int fr = fr_, fq = fq_;
    }
    for (int ck2 = 0; ck2 < NT / 64; ck2 += 2) {
      { const int ck = ck2;
        int fr = fr_, fq = fq_, tt = tt_; asm volatile("" : "+v"(fr), "+v"(fq), "+v"(tt));
        { const int kst = ck + 1;
        asm volatile("" :: "v"(pg_b.w), "v"(pgl_b.y), "v"(pgl_b.w));
        {
            const float mxl = fmaxf(mst, pgl_b.z); carry_nxt = fexp(mst - mxl);
            if constexpr ((VAR & 16) == 0) {
                const float ws = fexp(pg_b.y - mxl);
                *(u32x4*)(ML_Q(buf1) + tt * 136 + d0) = pq0_b; *(u32x4*)(ML_Q(buf1) + tt * 136 + d0 + 8) = pq1_b;
                *(u32x4*)(ML_K(buf1) + tt * 136 + d0) = pk0_b; *(u32x4*)(ML_K(buf1) + tt * 136 + d0 + 8) = pk1_b;
                const float v0 = __uint_as_float(pv_b.x << 16), v1 = __uint_as_float(pv_b.x & 0xffff0000u), v2 = __uint_as_float(pv_b.y << 16), v3 = __uint_as_float(pv_b.y & 0xffff0000u);
                *(u32x2*)(ML_V(buf1) + tt * VS + 4 * cg8) = pv_b; *(u32x4*)(ML_P(buf1) + tt * 72 + 8 * cg8) = pp_b;
                u32x2 wv; wv.x = pk2(v0 * ws, v1 * ws); wv.y = pk2(v2 * ws, v3 * ws); *(u32x2*)(ML_WV(buf1) + tt * VS + 4 * cg8) = wv;
                if (cg8 == 0) { ML_WV(buf1)[tt * VS + 32] = f2bf(ws); const float mx = fmaxf(mst, pg_b.z); float* F = ML_F(buf1); F[tt] = pg_b.y; F[64 + tt] = mx; F[128 + tt] = fexp(mst - mx); F[192 + tt] = fexp(-(pg_b.x + mx)); F[256 + tt] = fexp(pg_b.z - mx); }
            }
            mst = pgl_b.x + mxl;
            const int cn = (kst + 2 < NT / 64) ? kst + 2 : NT / 64 - 1;
            const size_t m = (size_t)(b * NT + cn * 64 + tt);
            const bf16_t* qs = C.qc() + m * 512 + hm * 128 + d0; const bf16_t* ks = C.kc() + m * 512 + hm * 128 + d0;
            pq0_b = *(const u32x4*)qs; pq1_b = *(const u32x4*)(qs + 8); pk0_b = *(const u32x4*)ks; pk1_b = *(const u32x4*)(ks + 8);
            pv_b = *(const u32x2*)(C.proj() + pjo(m, C_VM + hm * 128 + sl * 32 + 4 * cg8));
            pg_b = *(const f32x4*)gate_ptr(C.proj(), m, hm); pgl_b = *(const f32x4*)gate_ptr(C.proj(), (size_t)(b * NT + cn * 64 + 63), hm); pp_b = *(const u32x4*)(p0base + (size_t)cn * 4 * 4096);
        }
        }
        { const int kc = ck + 1;
        }
        {
            const int mbase = b * NT + ck * 64;
            const bf16_t* LQ = ML_Q(buf0); const bf16_t* LK = ML_K(buf0); const bf16_t* LV = ML_V(buf0); const bf16_t* LWV = ML_WV(buf0); const bf16_t* LP = ML_P(buf0); const float* F = ML_F(buf0);
            const bf16_t* LCr = LCb0; bf16_t* LCw = LCb1;
            bf16x8 fp[2], fvr[2], fvd[2], fqq[4], fcr[4], fcd[4], kf[2], fw[3][2]; float inr[4], clr[4], rsr[4];
#pragma unroll
            for (int ks = 0; ks < 2; ++ks) { fp[ks] = *(const bf16x8*)(LP + (16 * ti + fr) * 72 + 32 * ks + 8 * fq); fvr[ks] = tr_frag(LV, VS, 32 * ks, 16 * vtw, fr, fq); fvd[ks] = tr_frag(LV, VS, 32 * ks, 32, fr, fq); }
#pragma unroll
            for (int ks = 0; ks < 4; ++ks) { fqq[ks] = *(const bf16x8*)(LQ + (16 * ti + fr) * 136 + 32 * ks + 8 * fq); fcr[ks] = *(const bf16x8*)(LCr + (16 * vtw + fr) * 136 + 32 * ks + 8 * fq); fcd[ks] = *(const bf16x8*)(LCr + (32 + fr) * 136 + 32 * ks + 8 * fq); }
#pragma unroll
            for (int ks = 0; ks < 2; ++ks) { kf[ks] = tr_frag(LK, 136, 32 * ks, 16 * wid, fr, fq);
#pragma unroll
                for (int vt2 = 0; vt2 < 3; ++vt2) fw[vt2][ks] = tr_frag(LWV, VS, 32 * ks, 16 * vt2, fr, fq); }
#pragma unroll
            for (int r = 0; r < 4; ++r) { inr[r] = F[128 + 16 * ti + 4 * fq + r]; clr[r] = F[192 + 16 * ti + 4 * fq + r]; rsr[r] = F[256 + 16 * ti + 4 * fq + r]; }
            LDS_WAIT_ALL();
            f32x4 numr = (f32x4){0.f, 0.f, 0.f, 0.f}, numd = numr;
            if constexpr ((VAR & 4) == 0) {
                f32x4 a1r = (f32x4){0.f, 0.f, 0.f, 0.f}, a1d = a1r, a2r = a1r, a2d = a1r;
#pragma unroll
                for (int ks = 0; ks < 2; ++ks) { a1r = __builtin_amdgcn_mfma_f32_16x16x32_bf16(fp[ks], fvr[ks], a1r, 0, 0, 0); a1d = __builtin_amdgcn_mfma_f32_16x16x32_bf16(fp[ks], fvd[ks], a1d, 0, 0, 0); }
#pragma unroll
                for (int ks = 0; ks < 4; ++ks) { a2r = __builtin_amdgcn_mfma_f32_16x16x32_bf16(fqq[ks], fcr[ks], a2r, 0, 0, 0); a2d = __builtin_amdgcn_mfma_f32_16x16x32_bf16(fqq[ks], fcd[ks], a2d, 0, 0, 0); }
#pragma unroll
                for (int r = 0; r < 4; ++r) { numr[r] = rsr[r] * a1r[r] + inr[r] * a2r[r]; numd[r] = rsr[r] * a1d[r] + inr[r] * a2d[r]; }
            }
            if constexpr ((VAR & 8) == 0) {
#pragma unroll
                for (int vt2 = 0; vt2 < 3; ++vt2) {
                    f32x4 acc = Cst[vt2] * carry_cur;
#pragma unroll
                    for (int ks = 0; ks < 2; ++ks) acc = __builtin_amdgcn_mfma_f32_16x16x32_bf16(fw[vt2][ks], kf[ks], acc, 0, 0, 0);
                    Cst[vt2] = acc;
#pragma unroll
                    for (int r = 0; r < 4; ++r) LCw[(16 * vt2 + 4 * fq + r) * 136 + 16 * wid + fr] = f2bf(acc[r]);
                }
            }
#pragma unroll
            for (int r = 0; r < 4; ++r) { const int t = 16 * ti + 4 * fq + r;
                const float den = __shfl(numd[r], lane & 48);
                const float dv = fmaxf(fabsf(den), clr[r]);
                if (st_out) C.proj()[pjo((size_t)(mbase + t), C_VM + hm * 128 + sl * 32 + 16 * vtw + fr)] = f2bf(numr[r] * frcp(dv)); }
        }
        carry_cur = carry_nxt;
        LDS_BARRIER();
      }
      { const int ck = ck2 + 1;
        int fr = fr_, fq = fq_, tt = tt_; asm volatile("" : "+v"(fr), "+v"(fq), "+v"(tt));
        { const int kst = ck + 1;
        asm volatile("" :: "v"(pg.w), "v"(pgl.y), "v"(pgl.w));
        {
            const float mxl = fmaxf(mst, pgl.z); carry_nxt = fexp(mst - mxl);
            if constexpr ((VAR & 16) == 0) {
                const float ws = fexp(pg.y - mxl);
                *(u32x4*)(ML_Q(buf0) + tt * 136 + d0) = pq0; *(u32x4*)(ML_Q(buf0) + tt * 136 + d0 + 8) = pq1;
                *(u32x4*)(ML_K(buf0) + tt * 136 + d0) = pk0; *(u32x4*)(ML_K(buf0) + tt * 136 + d0 + 8) = pk1;
                const float v0 = __uint_as_float(pv.x << 16), v1 = __uint_as_float(pv.x & 0xffff0000u), v2 = __uint_as_float(pv.y << 16), v3 = __uint_as_float(pv.y & 0xffff0000u);
                *(u32x2*)(ML_V(buf0) + tt * VS + 4 * cg8) = pv; *(u32x4*)(ML_P(buf0) + tt * 72 + 8 * cg8) = pp;
                u32x2 wv; wv.x = pk2(v0 * ws, v1 * ws); wv.y = pk2(v2 * ws, v3 * ws); *(u32x2*)(ML_WV(buf0) + tt * VS + 4 * cg8) = wv;
                if (cg8 == 0) { ML_WV(buf0)[tt * VS + 32] = f2bf(ws); const float mx = fmaxf(mst, pg.z); float* F = ML_F(buf0); F[tt] = pg.y; F[64 + tt] = mx; F[128 + tt] = fexp(mst - mx); F[192 + tt] = fexp(-(pg.x + mx)); F[256 + tt] = fexp(pg.z - mx); }
            }
            mst = pgl.x + mxl;
            const int cn = (kst + 2 < NT / 64) ? kst + 2 : NT / 64 - 1;
            const size_t m = (size_t)(b * NT + cn * 64 + tt);
            const bf16_t* qs = C.qc() + m * 512 + hm * 128 + d0; const bf16_t* ks = C.kc() + m * 512 + hm * 128 + d0;
            pq0 = *(const u32x4*)qs; pq1 = *(const u32x4*)(qs + 8); pk0 = *(const u32x4*)ks; pk1 = *(const u32x4*)(ks + 8);
            pv = *(const u32x2*)(C.proj() + pjo(m, C_VM + hm * 128 + sl * 32 + 4 * cg8));
            pg = *(const f32x4*)gate_ptr(C.proj(), m, hm); pgl = *(const f32x4*)gate_ptr(C.proj(), (size_t)(b * NT + cn * 64 + 63), hm); pp = *(const u32x4*)(p0base + (size_t)cn * 4 * 4096);
        }
        }
        { const int kc = ck + 1;
        }
        {
            const int mbase = b * NT + ck * 64;
            const bf16_t* LQ = ML_Q(buf1); const bf16_t* LK = ML_K(buf1); const bf16_t* LV = ML_V(buf1); const bf16_t* LWV = ML_WV(buf1); const bf16_t* LP = ML_P(buf1); const float* F = ML_F(buf1);
            const bf16_t* LCr = LCb1; bf16_t* LCw = LCb0;
            bf16x8 fp[2], fvr[2], fvd[2], fqq[4], fcr[4], fcd[4], kf[2], fw[3][2]; float inr[4], clr[4], rsr[4];
#pragma unroll
            for (int ks = 0; ks < 2; ++ks) { fp[ks] = *(const bf16x8*)(LP + (16 * ti + fr) * 72 + 32 * ks + 8 * fq); fvr[ks] = tr_frag(LV, VS, 32 * ks, 16 * vtw, fr, fq); fvd[ks] = tr_frag(LV, VS, 32 * ks, 32, fr, fq); }
#pragma unroll
            for (int ks = 0; ks < 4; ++ks) { fqq[ks] = *(const bf16x8*)(LQ + (16 * ti + fr) * 136 + 32 * ks + 8 * fq); fcr[ks] = *(const bf16x8*)(LCr + (16 * vtw + fr) * 136 + 32 * ks + 8 * fq); fcd[ks] = *(const bf16x8*)(LCr + (32 + fr) * 136 + 32 * ks + 8 * fq); }
#pragma unroll
            for (int ks = 0; ks < 2; ++ks) { kf[ks] = tr_frag(LK, 136, 32 * ks, 16 * wid, fr, fq);
#pragma unroll
                for (int vt2 = 0; vt2 < 3; ++vt2) fw[vt2][ks] = tr_frag(LWV, VS, 32 * ks, 16 * vt2, fr, fq); }
#pragma unroll
            for (int r = 0; r < 4; ++r) { inr[r] = F[128 + 16 * ti + 4 * fq + r]; clr[r] = F[192 + 16 * ti + 4 * fq + r]; rsr[r] = F[256 + 16 * ti + 4 * fq + r]; }
            LDS_WAIT_ALL();
            f32x4 numr = (f32x4){0.f, 0.f, 0.f, 0.f}, numd = numr;
            if constexpr ((VAR & 4) == 0) {
                f32x4 a1r = (f32x4){0.f, 0.f, 0.f, 0.f}, a1d = a1r, a2r = a1r, a2d = a1r;
#pragma unroll
                for (int ks = 0; ks < 2; ++ks) { a1r = __builtin_amdgcn_mfma_f32_16x16x32_bf16(fp[ks], fvr[ks], a1r, 0, 0, 0); a1d = __builtin_amdgcn_mfma_f32_16x16x32_bf16(fp[ks], fvd[ks], a1d, 0, 0, 0); }
#pragma unroll
                for (int ks = 0; ks < 4; ++ks) { a2r = __builtin_amdgcn_mfma_f32_16x16x32_bf16(fqq[ks], fcr[ks], a2r, 0, 0, 0); a2d = __builtin_amdgcn_mfma_f32_16x16x32_bf16(fqq[ks], fcd[ks], a2d, 0, 0, 0); }
#pragma unroll
                for (int r = 0; r < 4; ++r) { numr[r] = rsr[r] * a1r[r] + inr[r] * a2r[r]; numd[r] = rsr[r] * a1d[r] + inr[r] * a2d[r]; }
            }
            if constexpr ((VAR & 8) == 0) {
#pragma unroll
                for (int vt2 = 0; vt2 < 3; ++vt2) {
                    f32x4 acc = Cst[vt2] * carry_cur;
#pragma unroll
                    for (int ks = 0; ks < 2; ++ks) acc = __builtin_amdgcn_mfma_f32_16x16x32_bf16(fw[vt2][ks], kf[ks], acc, 0, 0, 0);
                    Cst[vt2] = acc;
#pragma unroll
                    for (int r = 0; r < 4; ++r) LCw[(16 * vt2 + 4 * fq + r) * 136 + 16 * wid + fr] = f2bf(acc[r]);
                }
            }
#pragma unroll
            for (int r = 0; r < 4; ++r) { const int t = 16 * ti + 4 * fq + r;
                const float den = __shfl(numd[r], lane & 48);
                const float dv = fmaxf(fabsf(den), clr[r]);
                if (st_out) C.proj()[pjo((size_t)(mbase + t), C_VM + hm * 128 + sl * 32 + 16 * vtw + fr)] = f2bf(numr[r] * frcp(dv)); }
        }
        carry_cur = carry_nxt;
        LDS_BARRIER();
      }
    }
#undef ML_Q
#undef ML_K
#undef ML_V
#undef ML_WV
#undef ML_P
#undef ML_F
}
__device__ __forceinline__ void phase3(const Ctx& C, int sub) {
    const int g = blockIdx.x;
    if (sub == 0 || sub == 1) {
        mlstm_m1_stream(C);
        asm volatile("s_waitcnt vmcnt(0)" ::: "memory"); __syncthreads();
        const int bb = g >> 5, ck = 2 * (g & 31) + (C.wid >> 2), hm = C.wid & 3;
        mlstm_gate_scan(C, bb, hm, ck);
        asm volatile("s_waitcnt vmcnt(0)" ::: "memory");
        mlstm_p0_item(C, bb, hm, ck);
    }
    if (sub >= 3) rwkv_r1_wg<(PROBE_SUB >= 3 ? PROBE_SUB : 0) | 1>(C, g >> 5, (g >> 2) & 7, (g & 3) * 16, 16); else if (sub != 1) rwkv_r1_wg<0>(C, g >> 5, (g >> 2) & 7, (g & 3) * 16, 16);
}
__device__ __forceinline__ void phase4(const Ctx& C, int sub) {
    for (int item = blockIdx.x; item < 256; item += gridDim.x) {
        if (item < 64) { if (sub != 2 && sub != 3) rwkv_r2_wg(C, item >> 3, item & 7); }
        else if (item < 128) { }
        else { const int i = item - 128; if (sub == 3) mlstm_item<PROBE_SUB | 1>(C, i >> 4, (i >> 2) & 3, i & 3); else if (sub != 1) mlstm_item<0>(C, i >> 4, (i >> 2) & 3, i & 3); }
        __syncthreads();
    }
}

__device__ __forceinline__ void ld8f(const float* p, float* o) { const f32x4 a = *(const f32x4*)p, b = *(const f32x4*)(p + 4); o[0] = a.x; o[1] = a.y; o[2] = a.z; o[3] = a.w; o[4] = b.x; o[5] = b.y; o[6] = b.z; o[7] = b.w; }
__device__ __forceinline__ void phase5(const Ctx& C) {
    const int lane = C.lane; const int c0 = 8 * lane;
    float muv[8], gnw[8], gnb[8], lnw[8], skp[8];
    ld8f(C.mu() + C_V + c0, muv); ld8f(C.gn_w() + c0, gnw); ld8f(C.gn_b() + c0, gnb); ld8f(C.ln_w() + c0, lnw); ld8f(C.skip() + c0, skp);
    for (int m = C.gw; m < NTOK; m += C.ngw) {
        const bool hp = (m & (NT - 1)) != 0;
        const bf16_t* pj = C.proj(); const size_t mm = (size_t)m, mp = (size_t)(m > 0 ? m - 1 : m); bf16_t* yo = C.ymix() + (size_t)m * DM;
        float outr[8], outm[8];
        {
            float y[8], v[8], pv[8], z[8];
            unpack8(*(const u32x4*)(pj + pjo(mm, C_R + c0)), y);
            unpack8(*(const u32x4*)(pj + pjo(mm, C_V + c0)), v); unpack8(*(const u32x4*)(pj + pjo(mm, C_ZR + c0)), z);
            unpack8(*(const u32x4*)(pj + pjo(mp, C_V + c0)), pv);
            if (!hp) {
#pragma unroll
                for (int i = 0; i < 8; ++i) { pv[i] = 0.f; } }
            float s = 0.f; const float bs = C.bonus()[(size_t)m * 8 + (lane >> 3)];
#pragma unroll
            for (int i = 0; i < 8; ++i) { v[i] += muv[i] * (pv[i] - v[i]); s += y[i]; }
            s = half8_sum(s);
            const float mean = s * (1.0f / 64.0f); float q = 0.f;
#pragma unroll
            for (int i = 0; i < 8; ++i) { y[i] -= mean; q += y[i] * y[i]; }
            q = half8_sum(q);
            const float rstd = __builtin_amdgcn_rsqf(q * (1.0f / 64.0f) + 64e-5f);
#pragma unroll
            for (int i = 0; i < 8; ++i) { const float yn = y[i] * rstd * gnw[i] + gnb[i]; outr[i] = (yn + bs * v[i]) * siluf_(z[i]); }
        }
        {
            float h[8], o[8], z[8], qc[8];
            unpack8(*(const u32x4*)(pj + pjo(mm, C_VM + c0)), h);
            unpack8(*(const u32x4*)(pj + pjo(mm, C_O + c0)), o); unpack8(*(const u32x4*)(pj + pjo(mm, C_ZM + c0)), z); unpack8(*(const u32x4*)(C.qc() + (size_t)m * 512 + c0), qc);
            float s = 0.f;
#pragma unroll
            for (int i = 0; i < 8; ++i) s += h[i];
            s = row16_sum(s);
            const float mean = s * (1.0f / 128.0f); float q = 0.f;
#pragma unroll
            for (int i = 0; i < 8; ++i) { h[i] -= mean; q += h[i] * h[i]; }
            q = row16_sum(q);
            const float rstd = __builtin_amdgcn_rsqf(q * (1.0f / 128.0f) + 1e-6f);
#pragma unroll
            for (int i = 0; i < 8; ++i) { const float hn = h[i] * rstd * lnw[i]; outm[i] = (sigmoidf_(o[i]) * hn + skp[i] * qc[i]) * siluf_(z[i]); }
        }
        *(u32x4*)(yo + c0) = pack8(outr);
        *(u32x4*)(yo + 512 + c0) = pack8(outm);
    }
}

struct RowIn { f32x4 x[4]; u32x4 mx[2]; };
__device__ __forceinline__ void p7_load(const Ctx& C, RowIn& r, int m) {
    const f32x4* xr = (const f32x4*)(C.x() + (size_t)m * DM) + C.lane;
#pragma unroll
    for (int j = 0; j < 4; ++j) r.x[j] = __builtin_nontemporal_load(xr + 64 * j);
    const u32x2* mr = (const u32x2*)(C.mixo() + (size_t)m * DM) + C.lane;
    const u32x2 a0 = __builtin_nontemporal_load(mr), a1 = __builtin_nontemporal_load(mr + 64), a2 = __builtin_nontemporal_load(mr + 128), a3 = __builtin_nontemporal_load(mr + 192);
    r.mx[0] = (u32x4){a0.x, a0.y, a1.x, a1.y}; r.mx[1] = (u32x4){a2.x, a2.y, a3.x, a3.y};
}
template <int VAR> __device__ __forceinline__ void phase7(const Ctx& C) {
    f32x4 g[4];
#pragma unroll
    for (int j = 0; j < 4; ++j) g[j] = *(const f32x4*)(C.fgain() + 4 * C.lane + 256 * j);
    RowIn cur, nx1; p7_load(C, cur, C.gw); p7_load(C, nx1, C.gw + C.ngw);
    if constexpr ((VAR & 2) != 0) { asm volatile("" : "+v"(cur.x[0]), "+v"(nx1.x[0])); }
    f32x4 gtv[4]; int bcur = -1;
    for (int m = C.gw; m < NTOK; m += C.ngw) {
        const int b = m >> 12; const int mn = (m + 2 * C.ngw < NTOK) ? m + 2 * C.ngw : m;
        if (b != bcur) { bcur = b;
#pragma unroll
            for (int j = 0; j < 4; ++j) gtv[j] = *(const f32x4*)(C.ada() + b * 3072 + 2048 + 4 * C.lane + 256 * j); }
        RowIn nxt; if constexpr ((VAR & 2) == 0) p7_load(C, nxt, mn); else nxt = nx1;
        f32x4 h[4]; float s = 0.f;
#pragma unroll
        for (int j = 0; j < 4; ++j) {
            const f32x4 gt = gtv[j];
            const unsigned w0 = (j & 1) ? cur.mx[j >> 1].z : cur.mx[j >> 1].x, w1 = (j & 1) ? cur.mx[j >> 1].w : cur.mx[j >> 1].y;
            const f32x4 mv = (f32x4){__uint_as_float(w0 << 16), __uint_as_float(w0 & 0xffff0000u), __uint_as_float(w1 << 16), __uint_as_float(w1 & 0xffff0000u)};
            h[j] = cur.x[j] + gt * mv; s += (h[j].x * h[j].x + h[j].y * h[j].y) + (h[j].z * h[j].z + h[j].w * h[j].w); }
        const float rs = __builtin_amdgcn_rsqf(wave_sum_dpp(s) * (1.0f / DM) + 1e-6f);
        f32x4* o = (f32x4*)(C.out() + (size_t)m * DM) + C.lane;
#pragma unroll
        for (int j = 0; j < 4; ++j) { if constexpr ((VAR & 1) == 0) __builtin_nontemporal_store(h[j] * rs * g[j], o + 64 * j); else asm volatile("" :: "v"(h[j] * rs * g[j])); }
        cur = nx1; nx1 = nxt;
    }
}

#define LAS __attribute__((address_space(3)))
#define XB_TMO      128
#define XB_XCNT(j)  (256  + 64 * (j))
#define XB_XSUB(j)  (1280 + 64 * (j))
#define XB_XGEN(j)  (2304 + 64 * (j))
#define XB_TOP      3328
#define XB_TOPGEN   3392
#define XCD_BAR_WORDS 3456
#define XB_SPIN_CAP (1u << 18)

__device__ __forceinline__ unsigned xb_ld(unsigned* p)              { return __hip_atomic_load(p, __ATOMIC_RELAXED, __HIP_MEMORY_SCOPE_AGENT); }
__device__ __forceinline__ unsigned xb_add(unsigned* p, unsigned v) { return __hip_atomic_fetch_add(p, v, __ATOMIC_RELAXED, __HIP_MEMORY_SCOPE_AGENT); }
__device__ __forceinline__ unsigned xb_xcc_id() { return (unsigned)__builtin_amdgcn_s_getreg((3 << 11) | 20) & 0xFu; }
#define XB_SPIN(cond, bar) do { unsigned _sp = 0; while (cond) { __builtin_amdgcn_s_sleep(1); \
    if ((++_sp & 255u) == 0u) { if (xb_ld(&(bar)[XB_TMO])) break; if (_sp > XB_SPIN_CAP) { atomicAdd(&(bar)[XB_TMO], 1u); break; } } } } while (0)

struct XcdBarrier {
    unsigned* bar; unsigned x;
    volatile LAS unsigned* st;
};

__device__ __forceinline__ XcdBarrier xcd_barrier_post(unsigned* bar, volatile LAS unsigned* st) {
    XcdBarrier b; b.bar = bar; b.x = xb_xcc_id(); b.st = st;
    if (threadIdx.x == 0) (void)xb_add(&bar[XB_XCNT(b.x)], 1u);
    return b;
}
__device__ __forceinline__ void xcd_barrier_complete(unsigned* bar, unsigned x, unsigned& nloc, unsigned& nx) {
    const unsigned G = gridDim.x * gridDim.y * gridDim.z;
    unsigned sum, cnt, mine, sp = 0u;
    for (;;) {
        sum = 0u; cnt = 0u; mine = 0u;
#pragma unroll
        for (unsigned j = 0; j < 16; ++j) { const unsigned c = xb_ld(&bar[XB_XCNT(j)]); sum += c; cnt += (c > 0u) ? 1u : 0u; mine = (j == x) ? c : mine; }
        if (sum == G) break;
        __builtin_amdgcn_s_sleep(1);
        if ((++sp & 255u) == 0u) { if (xb_ld(&bar[XB_TMO])) break; if (sp > XB_SPIN_CAP) { atomicAdd(&bar[XB_TMO], 1u); break; } }
    }
    nloc = mine > 0u ? mine : 1u; nx = cnt > 0u ? cnt : 1u;
}

__device__ __forceinline__ void xcd_barrier(const XcdBarrier& b) {
    asm volatile("s_waitcnt vmcnt(0)" ::: "memory");
    __syncthreads();
    if (threadIdx.x == 0) {
        unsigned* bar = b.bar;
        __builtin_amdgcn_s_waitcnt(0);
        unsigned nloc = b.st[0], nx = b.st[1];
        if (nloc == 0u) { xcd_barrier_complete(bar, b.x, nloc, nx); b.st[0] = nloc; b.st[1] = nx; }
        const unsigned old = xb_add(&bar[XB_XSUB(b.x)], 1u);
        const unsigned gen = old / nloc;
        if (old + 1u == (gen + 1u) * nloc) {
            __builtin_amdgcn_fence(__ATOMIC_RELEASE, "agent");
            asm volatile("s_waitcnt vmcnt(0)" ::: "memory");
            const unsigned og = xb_add(&bar[XB_TOP], 1u);
            const unsigned tg = og / nx;
            if (og + 1u == (tg + 1u) * nx) xb_add(&bar[XB_TOPGEN], 1u);
            else XB_SPIN(xb_ld(&bar[XB_TOPGEN]) == tg, bar);
            __builtin_amdgcn_fence(__ATOMIC_ACQUIRE, "agent");
            xb_add(&bar[XB_XGEN(b.x)], 1u);
            asm volatile("s_waitcnt vmcnt(0)" ::: "memory");
        } else {
            XB_SPIN(xb_ld(&bar[XB_XGEN(b.x)]) == gen, bar);
            __builtin_amdgcn_fence(__ATOMIC_ACQUIRE, "agent");
            asm volatile("s_waitcnt vmcnt(0)" ::: "memory");
        }
    }
    __syncthreads();
}

#ifndef PROBE_REP
#define PROBE_REP -1
#endif
#ifndef PROBE_SUB
#define PROBE_SUB 0
#endif
__global__ void __launch_bounds__(NTHR, 2) fwd_kernel(Params p) {
    extern __shared__ __attribute__((aligned(16))) unsigned char lds_raw[];
    cg::grid_group grid = cg::this_grid();
    Ctx C{p};
    C.lds = lds_raw; C.tid = threadIdx.x; C.lane = C.tid & 63; C.wid = __builtin_amdgcn_readfirstlane(C.tid >> 6);
    C.gw = blockIdx.x * NWV + C.wid; C.ngw = gridDim.x * NWV;
    const int lo = p.ph_lo, hi = p.ph_hi;
    unsigned* barw = (unsigned*)(p.ws + WS_CTL);
    volatile LAS unsigned* bst = (volatile LAS unsigned*)((LAS unsigned char*)lds_raw + LDS_BYTES - 16);
    if (threadIdx.x < 4) bst[threadIdx.x] = 0u;
    if (blockIdx.x == 0) for (int e = threadIdx.x; e < XCD_BAR_WORDS; e += NTHR) barw[e] = 0u;
    XcdBarrier xbar; xbar.bar = barw; xbar.x = 0; xbar.st = bst;
#define RUN(k) (lo <= (k) && (k) < hi)
#define GSYNC() xcd_barrier(xbar)
#define SEAM(k) do { if (RUN(k) && RUN((k) + 1)) GSYNC(); } while (0)
    if (RUN(0)) phase0(C);
    if (RUN(0) && RUN(1)) { grid.sync(); xbar = xcd_barrier_post(barw, bst); }
#if PROBE_REP == 8
    GSYNC(); GSYNC(); GSYNC(); GSYNC(); GSYNC(); GSYNC(); GSYNC(); GSYNC();
#endif
    if (RUN(1)) { phase1(C); weight_copies(C); }
#if PROBE_REP == 1
    GSYNC(); phase0(C); GSYNC(); phase1(C); weight_copies(C);
#endif
    SEAM(1);
    if (RUN(2)) {
        pg8::Gemm g{C.hn(), C.win_t(), NTOK, NPAD, DM}; pg8::StaticOrder S; S.init(NTOK, NPAD, (int)gridDim.x, (int)blockIdx.x);
        pg8::EpiBf16<0> E{C.proj(), 256, nullptr, 256, (size_t)NTOK * 256};
        pg8::gemm_phase<pg8::EpiBf16<0>, pg8::StaticOrder, false>((PG8_LAS unsigned char*)lds_raw, g, S, E, nullptr);
#if PROBE_REP == 2
        GSYNC(); pg8::gemm_phase<pg8::EpiBf16<0>, pg8::StaticOrder, false>((PG8_LAS unsigned char*)lds_raw, g, S, E, nullptr);
#endif
    }
    SEAM(2);
    if (RUN(3)) phase3(C, 0);
#if PROBE_REP == 3
    GSYNC(); phase3(C, PROBE_SUB);
#endif
    SEAM(3);
#if PROBE_REP == 6
    phase4(C, 3); GSYNC();
#endif
    if (RUN(4)) phase4(C, 0);
#if PROBE_REP == 4
    GSYNC(); phase4(C, PROBE_SUB);
#endif
    SEAM(4);
    if (RUN(5)) phase5(C);
#if PROBE_REP == 5
    GSYNC(); phase5(C);
#endif
    SEAM(5);
    if (RUN(6)) {
        pg8::Gemm g{C.ymix(), C.wout_t(), NTOK, DM, DM}; pg8::StaticOrder S; S.init(NTOK, DM, (int)gridDim.x, (int)blockIdx.x);
        pg8::EpiBf16<0> E{C.mixo(), DM, nullptr, 0, 0};
        pg8::gemm_phase<pg8::EpiBf16<0>, pg8::StaticOrder, false>((PG8_LAS unsigned char*)lds_raw, g, S, E, nullptr);
#if PROBE_REP == 7
        GSYNC(); pg8::gemm_phase<pg8::EpiBf16<0>, pg8::StaticOrder, false>((PG8_LAS unsigned char*)lds_raw, g, S, E, nullptr);
#endif
    }
    SEAM(6);
#if PROBE_REP == 9
    phase7<PROBE_SUB>(C); GSYNC();
#endif
    if (RUN(7)) phase7<0>(C);
#undef RUN
#undef SEAM
}

#ifndef N_LAUNCHES
#define N_LAUNCHES 1
#endif
extern "C" void kernel_launch(void* const* d_in, const int* in_sizes, int n_in, void* d_out, int out_size, void* d_ws, size_t ws_size, hipStream_t stream) {
    static int grid = 0;
    if (grid == 0) {
        if (n_in != 24 || out_size != NTOK * DM || ws_size < WS_END) { fprintf(stderr, "kernel_launch: unexpected shapes (n_in %d, out %d, ws %zu < %zu)\n", n_in, out_size, ws_size, (size_t)WS_END); grid = -1; return; }
        int dev = 0, cus = 0, per_cu = 0;
        hipGetDevice(&dev); hipDeviceGetAttribute(&cus, hipDeviceAttributeMultiprocessorCount, dev);
        if (hipFuncSetAttribute((const void*)fwd_kernel, hipFuncAttributeMaxDynamicSharedMemorySize, LDS_BYTES) != hipSuccess) { fprintf(stderr, "kernel_launch: hipFuncSetAttribute failed\n"); grid = -1; return; }
        if (hipOccupancyMaxActiveBlocksPerMultiprocessor(&per_cu, (const void*)fwd_kernel, NTHR, LDS_BYTES) != hipSuccess || per_cu < 1) { fprintf(stderr, "kernel_launch: occupancy query says %d\n", per_cu); per_cu = 1; }
        (void)hipGetLastError();
        if (cus < 256) { fprintf(stderr, "kernel_launch: this build needs 256 CUs (got %d)\n", cus); grid = -1; return; }
        grid = 256;
        fprintf(stderr, "kernel_launch: grid %d, per_cu %d\n", grid, per_cu);
    }
    if (grid < 0) return;
    Params p{};
    for (int i = 0; i < 24; ++i) p.in[i] = (const float*)d_in[i];
    p.out = (float*)d_out; p.ws = (unsigned char*)d_ws;
    if (N_LAUNCHES == 1) {
        p.ph_lo = 0; p.ph_hi = NPHASE; void* args[] = {&p};
        hipError_t e = hipLaunchCooperativeKernel((const void*)fwd_kernel, dim3(grid), dim3(NTHR), args, LDS_BYTES, stream);
        if (e != hipSuccess) fprintf(stderr, "cooperative launch failed: %s (grid %d)\n", hipGetErrorString(e), grid);
    } else {
        for (int ph = 0; ph < NPHASE; ++ph) { p.ph_lo = ph; p.ph_hi = ph + 1; hipLaunchKernelGGL(fwd_kernel, dim3(grid), dim3(NTHR), LDS_BYTES, stream, p); }
    }
}
```

```cpp
#include <hip/hip_runtime.h>
#include <hip/hip_cooperative_groups.h>
#include <cstdio>
#define PROBE_REP -1
#define PROBE_SUB 0
namespace pg8 {
#define PG8_LAS __attribute__((address_space(3)))
typedef unsigned short bf16_t;
typedef short bf16x8 __attribute__((ext_vector_type(8)));
typedef float f32x4 __attribute__((ext_vector_type(4)));
typedef unsigned u32x4 __attribute__((ext_vector_type(4)));
constexpr int BM = 256, BK = 64, HALF = 128, HTB = HALF * BK * 2  , STAGE_BYTES = 8 * HTB, NXCD = 8, WGM = 8;

__host__ __device__ __forceinline__ int lds_byte(int r, int c) { const int st = (r >> 4) * 2 + (c >> 5), rr = r & 15, cc = c & 31, ob = rr * 64 + cc * 2; return st * 1024 + (ob ^ (((ob >> 9) & 1) << 5)); }
__host__ __device__ __forceinline__ void stage_rc(int b, int& R, int& C) { const int st = b / 1024, sb = b % 1024, swz = sb ^ (((sb >> 9) & 1) << 5); R = (st >> 1) * 16 + swz / 64; C = (st & 1) * 32 + (swz % 64) / 2; }
__host__ __device__ __forceinline__ int perm32(int rho) { const int n = rho >> 4, i = rho & 15; return 8 * (i >> 2) + 4 * n + (i & 3); }

struct Unit { int pm, pn; };
struct Gemm { const bf16_t* A; const bf16_t* Bt; int M, N, K; };

struct StaticOrder {
    int nM, nN, nwg, G, c;
    __host__ __device__ void init(int M, int N, int G_, int c_) { nM = M / BM; nN = N / BM; nwg = nM * nN; G = G_; c = c_; }
    __host__ __device__ bool next(int i, Unit& u) const {
        const long L = (long)i * G + c; if (L >= nwg) return false;
        int wgid = (int)L; { const int q = nwg / NXCD, r = nwg % NXCD, xcd = wgid % NXCD, off = wgid / NXCD; wgid = (xcd < r ? xcd * (q + 1) : r * (q + 1) + (xcd - r) * q) + off; }
        const int nig = WGM * nN, gid = wgid / nig, fm = gid * WGM, gsz = (nM - fm) < WGM ? (nM - fm) : WGM;
        u.pm = fm + ((wgid % nig) % gsz); u.pn = (wgid % nig) / gsz; return true;
    }
    __device__ __forceinline__ void a_ready(const Unit&) const {}
    __device__ __forceinline__ void done(const Unit&) const {}
};
struct CountedOrder : StaticOrder {
    const unsigned* ready; unsigned need; unsigned* tmo;
    __device__ __forceinline__ void a_ready(const Unit& u) const {
        if (threadIdx.x < 64) {
            const unsigned long long t0 = __builtin_amdgcn_s_memrealtime(); unsigned polls = 0;
            while ((unsigned)__builtin_amdgcn_readfirstlane(__hip_atomic_load(ready + 64 * u.pm, __ATOMIC_RELAXED, __HIP_MEMORY_SCOPE_AGENT)) < need) {
                if ((++polls & 255u) == 0u && __builtin_amdgcn_readfirstlane(__hip_atomic_load(tmo, __ATOMIC_RELAXED, __HIP_MEMORY_SCOPE_AGENT)) != 0u) break;
                if (__builtin_amdgcn_s_memrealtime() - t0 > 2000000ull) {
                    if (threadIdx.x == 0) { unsigned expect = 0u; __hip_atomic_compare_exchange_strong(tmo + 1, &expect, 0x600u | (unsigned)(u.pm & 0xff), __ATOMIC_RELAXED, __ATOMIC_RELAXED, __HIP_MEMORY_SCOPE_AGENT); __hip_atomic_store(tmo, 1u, __ATOMIC_RELAXED, __HIP_MEMORY_SCOPE_AGENT); }
                    break; }
                __builtin_amdgcn_s_sleep(2); }
            __builtin_amdgcn_fence(__ATOMIC_ACQUIRE, "agent");
            asm volatile("s_waitcnt vmcnt(0)" ::: "memory");
        }
#if !defined(BROKEN_HOOK_NO_BARRIER)
        asm volatile("" ::: "memory"); __builtin_amdgcn_s_barrier(); asm volatile("" ::: "memory");
#endif
    }
};

__device__ __forceinline__ unsigned cvt_pk_bf16(float lo, float hi) { unsigned r; asm volatile("v_cvt_pk_bf16_f32 %0, %1, %2" : "=v"(r) : "v"(lo), "v"(hi)); return r; }
typedef float f32x2 __attribute__((ext_vector_type(2)));
__device__ __forceinline__ f32x2 gelu_pk(f32x2 v) {
    const f32x2 av = __builtin_elementwise_abs(v), d = av * 0.2316418882f + 1.0f;
    f32x2 t; t.x = __builtin_amdgcn_rcpf(d.x); t.y = __builtin_amdgcn_rcpf(d.y);
    f32x2 q = t * 0.5307027145f + (-0.7265760135f); q = q * t + 0.7107068705f; q = q * t + (-0.142248368f); q = q * t + 0.127414796f; q = q * t;
    const f32x2 s = (v * v) * (-0.72134752044f);
    f32x2 e; e.x = __builtin_amdgcn_exp2f(s.x); e.y = __builtin_amdgcn_exp2f(s.y);
    const f32x2 m = v * (q * e), r = v - m;
    f32x2 o; o.x = v.x < 0.f ? m.x : r.x; o.y = v.y < 0.f ? m.y : r.y; return o;
}

struct EpiF32 {
    static constexpr bool PERM = false, AFTER_DRAIN = false;
    float* C; int ldc; const float* bias;
    __device__ __forceinline__ void operator()(const f32x4 (&acc)[2][2][4][2], const Unit& u, int wr, int wc, int fr, int fq) const {
        const int row0 = u.pm * BM + wr * 64 + fr, col0 = u.pn * BM + wc * 32 + 4 * fq;
        f32x4 bv[2][2];
#pragma unroll
        for (int bj = 0; bj < 2; ++bj)
#pragma unroll
            for (int n = 0; n < 2; ++n) bv[bj][n] = bias ? *(const f32x4*)(bias + col0 + bj * HALF + n * 16) : (f32x4){0.f, 0.f, 0.f, 0.f};
#pragma unroll
        for (int ai = 0; ai < 2; ++ai)
#pragma unroll
            for (int m = 0; m < 4; ++m) { float* rowp = C + (size_t)(row0 + ai * HALF + m * 16) * ldc + col0;
#pragma unroll
                for (int bj = 0; bj < 2; ++bj)
#pragma unroll
                    for (int n = 0; n < 2; ++n) *(f32x4*)(rowp + bj * HALF + n * 16) = acc[ai][bj][m][n] + bv[bj][n]; }
    }
};
template <int ACT  > struct EpiBf16 {
    static constexpr bool PERM = true, AFTER_DRAIN = false;
    bf16_t* O; int ldc; const float* bias; int split_cols; size_t split_stride;
    __device__ __forceinline__ void operator()(const f32x4 (&acc)[2][2][4][2], const Unit& u, int wr, int wc, int fr, int fq) const {
        const int row0 = u.pm * BM + wr * 64 + fr; int colt = u.pn * BM; bf16_t* base = O;
        if (split_cols) { const int t = colt / split_cols; base += (size_t)t * split_stride; colt -= t * split_cols; }
        const int col0 = colt + wc * 32 + 8 * fq, bcol0 = u.pn * BM + wc * 32 + 8 * fq;
        f32x4 bv[2][2];
#pragma unroll
        for (int bj = 0; bj < 2; ++bj)
#pragma unroll
            for (int n = 0; n < 2; ++n) bv[bj][n] = bias ? *(const f32x4*)(bias + bcol0 + bj * HALF + 4 * n) : (f32x4){0.f, 0.f, 0.f, 0.f};
#pragma unroll
        for (int ai = 0; ai < 2; ++ai)
#pragma unroll
            for (int m = 0; m < 4; ++m) { bf16_t* rowp = base + (size_t)(row0 + ai * HALF + m * 16) * ldc + col0;
#pragma unroll
                for (int bj = 0; bj < 2; ++bj) { f32x4 v0 = acc[ai][bj][m][0] + bv[bj][0], v1 = acc[ai][bj][m][1] + bv[bj][1];
                    if (ACT == 1) { f32x2 a = gelu_pk((f32x2){v0[0], v0[1]}), b = gelu_pk((f32x2){v0[2], v0[3]}), c = gelu_pk((f32x2){v1[0], v1[1]}), d = gelu_pk((f32x2){v1[2], v1[3]});
                        v0 = (f32x4){a.x, a.y, b.x, b.y}; v1 = (f32x4){c.x, c.y, d.x, d.y}; }
                    if (ACT == 2) {
#pragma unroll
                        for (int j = 0; j < 4; ++j) { v0[j] = 0.5f * v0[j] * (1.0f + erff(v0[j] * 0.70710678f)); v1[j] = 0.5f * v1[j] * (1.0f + erff(v1[j] * 0.70710678f)); } }
                    u32x4 w; w.x = cvt_pk_bf16(v0[0], v0[1]); w.y = cvt_pk_bf16(v0[2], v0[3]); w.z = cvt_pk_bf16(v1[0], v1[1]); w.w = cvt_pk_bf16(v1[2], v1[3]);
                    *(u32x4*)(rowp + bj * HALF) = w; } }
    }
};

struct PanelStats {
    unsigned* xbuf;
    unsigned* cnt;
    unsigned* tmo;
    int ntn; float eps;
    unsigned code;
    __device__ __forceinline__ bool run(const f32x4 (&v)[2][2][4][2], const Unit& u, int wr, int wc, int fr, int fq, PG8_LAS unsigned char* lds, int wid, int lane) const {
        typedef float f32x2v __attribute__((ext_vector_type(2)));
        PG8_LAS f32x2v* P = (PG8_LAS f32x2v*)lds;
        PG8_LAS f32x2v* S = (PG8_LAS f32x2v*)(lds + 8192);
        PG8_LAS unsigned* flag = (PG8_LAS unsigned*)(lds + 8192 + 2048);
#pragma unroll
        for (int ai = 0; ai < 2; ++ai)
#pragma unroll
            for (int m = 0; m < 4; ++m) {
                float s = 0.f;
#pragma unroll
                for (int bj = 0; bj < 2; ++bj)
#pragma unroll
                    for (int n = 0; n < 2; ++n) { const f32x4 x = v[ai][bj][m][n]; s += (x[0] + x[1]) + (x[2] + x[3]); }
                s += __shfl_xor(s, 16); s += __shfl_xor(s, 32);
                const float mw = s * (1.0f / 64.0f); float q = 0.f;
#pragma unroll
                for (int bj = 0; bj < 2; ++bj)
#pragma unroll
                    for (int n = 0; n < 2; ++n) { const f32x4 d = v[ai][bj][m][n] - mw; q += (d[0] * d[0] + d[1] * d[1]) + (d[2] * d[2] + d[3] * d[3]); }
                q += __shfl_xor(q, 16); q += __shfl_xor(q, 32);
                if (fq == 0) P[(ai * HALF + wr * 64 + m * 16 + fr) * 4 + wc] = (f32x2v){mw, q};
            }
        asm volatile("s_waitcnt lgkmcnt(0)" ::: "memory"); __builtin_amdgcn_s_barrier(); asm volatile("" ::: "memory");
#if defined(BROKEN_NO_WAIT)
        if (blockIdx.x >= 64) { const long long t0 = clock64(); while (clock64() - t0 < 60000) __builtin_amdgcn_s_sleep(8); }
#endif
        const int row = wid * 32 + (lane & 31);
        if (lane < 32) {
            const f32x2v a = P[row * 4 + 0], b = P[row * 4 + 1], c = P[row * 4 + 2], d = P[row * 4 + 3];
            const float mt = (a.x + b.x + c.x + d.x) * 0.25f;
            const float da = a.x - mt, db = b.x - mt, dc = c.x - mt, dd = d.x - mt;
            const float m2 = (a.y + b.y) + (c.y + d.y) + 64.0f * ((da * da + db * db) + (dc * dc + dd * dd));
            unsigned long long* slot = (unsigned long long*)xbuf + ((size_t)(u.pm * BM + row) * 4 + u.pn);
            __hip_atomic_store(slot, ((unsigned long long)__float_as_uint(m2) << 32) | __float_as_uint(mt), __ATOMIC_RELAXED, __HIP_MEMORY_SCOPE_AGENT);
        }
        asm volatile("s_waitcnt vmcnt(0)" ::: "memory");
        if (lane == 0) __hip_atomic_fetch_add(cnt + 64 * u.pm, 1u, __ATOMIC_RELAXED, __HIP_MEMORY_SCOPE_AGENT);
        if (wid == 0) {
            bool dead = false; const unsigned long long t0 = __builtin_amdgcn_s_memrealtime(); const unsigned want = 8u * (unsigned)ntn;
            for (;;) {
#if defined(BROKEN_NO_WAIT)
                break;
#endif
                if ((unsigned)__builtin_amdgcn_readfirstlane(__hip_atomic_load(cnt + 64 * u.pm, __ATOMIC_RELAXED, __HIP_MEMORY_SCOPE_AGENT)) >= want) break;
                if (__builtin_amdgcn_s_memrealtime() - t0 > 2000000ull) {
                    if (lane == 0) { unsigned expect = 0u; __hip_atomic_compare_exchange_strong(tmo + 1, &expect, code | (unsigned)(u.pm & 0xff), __ATOMIC_RELAXED, __ATOMIC_RELAXED, __HIP_MEMORY_SCOPE_AGENT);
                                     __hip_atomic_store(tmo, 1u, __ATOMIC_RELAXED, __HIP_MEMORY_SCOPE_AGENT); }
                    dead = true; break; }
                __builtin_amdgcn_s_sleep(2);
            }
            __builtin_amdgcn_fence(__ATOMIC_ACQUIRE, "agent");
            if (lane == 0) flag[0] = dead ? 1u : 0u;
        }
        asm volatile("s_waitcnt vmcnt(0) lgkmcnt(0)" ::: "memory"); __builtin_amdgcn_s_barrier(); asm volatile("" ::: "memory");
        const bool bad = flag[0] != 0u;
        if (lane < 32) {
            const unsigned long long* slot = (const unsigned long long*)xbuf + (size_t)(u.pm * BM + row) * 4; float mt[4], m2[4]; float ms = 0.f;
#pragma unroll
            for (int t = 0; t < 4; ++t) { if (t < ntn) { const unsigned long long w = __hip_atomic_load(slot + t, __ATOMIC_RELAXED, __HIP_MEMORY_SCOPE_AGENT); mt[t] = __uint_as_float((unsigned)w); m2[t] = __uint_as_float((unsigned)(w >> 32)); } else { mt[t] = 0.f; m2[t] = 0.f; } ms += mt[t]; }
            const float mean = ms / (float)ntn; float q = 0.f;
#pragma unroll
            for (int t = 0; t < 4; ++t) if (t < ntn) { const float dm = mt[t] - mean; q += m2[t] + 256.0f * dm * dm; }
            S[row] = (f32x2v){mean, 1.0f / sqrtf(q / (256.0f * (float)ntn) + eps)};
        }
        asm volatile("s_waitcnt lgkmcnt(0)" ::: "memory"); __builtin_amdgcn_s_barrier(); asm volatile("" ::: "memory");
        return bad;
    }
};
struct EpiLnRes {
    static constexpr bool PERM = false, AFTER_DRAIN = true;
    const float* base; float* out; int ldc; const float* bias; PanelStats st; unsigned poison;
    __device__ __forceinline__ void refuse(size_t i0, size_t stride, int M, int N) const { const float q = __builtin_nanf(""); for (size_t i = i0; i < (size_t)M * N; i += stride) out[(i / N) * ldc + i % N] = q;
        if (i0 == 0) { unsigned expect = 0u; __hip_atomic_compare_exchange_strong(st.tmo + 1, &expect, 0x7f0u, __ATOMIC_RELAXED, __ATOMIC_RELAXED, __HIP_MEMORY_SCOPE_AGENT); __hip_atomic_store(st.tmo, 1u, __ATOMIC_RELAXED, __HIP_MEMORY_SCOPE_AGENT); } }
    __device__ __forceinline__ void fused(f32x4 (&acc)[2][2][4][2], const Unit& u, int wr, int wc, int fr, int fq, PG8_LAS unsigned char* lds, int wid, int lane) const {
        typedef float f32x2v __attribute__((ext_vector_type(2)));
        const PG8_LAS f32x2v* S = (const PG8_LAS f32x2v*)(lds + 8192);
        const int col0 = u.pn * BM + wc * 32 + 4 * fq;
#pragma unroll
        for (int bj = 0; bj < 2; ++bj)
#pragma unroll
            for (int n = 0; n < 2; ++n) { const f32x4 bv = bias ? *(const f32x4*)(bias + col0 + bj * HALF + n * 16) : (f32x4){0.f, 0.f, 0.f, 0.f};
#pragma unroll
                for (int ai = 0; ai < 2; ++ai)
#pragma unroll
                    for (int m = 0; m < 4; ++m) acc[ai][bj][m][n] += bv; }
        const bool bad = st.run(acc, u, wr, wc, fr, fq, lds, wid, lane) || poison != 0u;
        const float qnan = __builtin_nanf("");
#pragma unroll
        for (int ai = 0; ai < 2; ++ai)
#pragma unroll
            for (int m = 0; m < 4; ++m) { const int r = ai * HALF + wr * 64 + m * 16 + fr; const f32x2v sr = S[r]; const size_t off = (size_t)(u.pm * BM + r) * ldc + col0;
#pragma unroll
                for (int bj = 0; bj < 2; ++bj)
#pragma unroll
                    for (int n = 0; n < 2; ++n) { const f32x4 bs = *(const f32x4*)(base + off + bj * HALF + n * 16); f32x4 o = bs + (acc[ai][bj][m][n] - sr.x) * sr.y;
                        if (bad) o = (f32x4){qnan, qnan, qnan, qnan}; *(f32x4*)(out + off + bj * HALF + n * 16) = o; }
                asm volatile("" ::: "memory"); }
    }
};
struct EpiLnResLn {
    static constexpr bool PERM = false, AFTER_DRAIN = true;
    const float* base; float* out; bf16_t* xn; int ldc; const float* bias; PanelStats st1, st2; unsigned poison;
    __device__ __forceinline__ void refuse(size_t i0, size_t stride, int M, int N) const { const float q = __builtin_nanf(""); for (size_t i = i0; i < (size_t)M * N; i += stride) { const size_t o = (i / N) * ldc + i % N; out[o] = q; xn[o] = (bf16_t)0x7fc0u; }
        if (i0 == 0) { unsigned expect = 0u; __hip_atomic_compare_exchange_strong(st1.tmo + 1, &expect, 0x7f0u, __ATOMIC_RELAXED, __ATOMIC_RELAXED, __HIP_MEMORY_SCOPE_AGENT); __hip_atomic_store(st1.tmo, 1u, __ATOMIC_RELAXED, __HIP_MEMORY_SCOPE_AGENT); } }
    __device__ __forceinline__ void fused(f32x4 (&acc)[2][2][4][2], const Unit& u, int wr, int wc, int fr, int fq, PG8_LAS unsigned char* lds, int wid, int lane) const {
        typedef float f32x2v __attribute__((ext_vector_type(2))); typedef unsigned u32x2v __attribute__((ext_vector_type(2)));
        const PG8_LAS f32x2v* S = (const PG8_LAS f32x2v*)(lds + 8192);
        const int col0 = u.pn * BM + wc * 32 + 4 * fq;
#pragma unroll
        for (int bj = 0; bj < 2; ++bj)
#pragma unroll
            for (int n = 0; n < 2; ++n) { const f32x4 bv = bias ? *(const f32x4*)(bias + col0 + bj * HALF + n * 16) : (f32x4){0.f, 0.f, 0.f, 0.f};
#pragma unroll
                for (int ai = 0; ai < 2; ++ai)
#pragma unroll
                    for (int m = 0; m < 4; ++m) acc[ai][bj][m][n] += bv; }
        bool bad = st1.run(acc, u, wr, wc, fr, fq, lds, wid, lane) || poison != 0u;
        const float qnan = __builtin_nanf("");
#pragma unroll
        for (int ai = 0; ai < 2; ++ai)
#pragma unroll
            for (int m = 0; m < 4; ++m) { const int r = ai * HALF + wr * 64 + m * 16 + fr; const f32x2v sr = S[r]; const size_t off = (size_t)(u.pm * BM + r) * ldc + col0;
#pragma unroll
                for (int bj = 0; bj < 2; ++bj)
#pragma unroll
                    for (int n = 0; n < 2; ++n) { const f32x4 bs = *(const f32x4*)(base + off + bj * HALF + n * 16); acc[ai][bj][m][n] = bs + (acc[ai][bj][m][n] - sr.x) * sr.y; }
                asm volatile("" : "+v"(acc[ai][0][m][0]), "+v"(acc[ai][0][m][1]), "+v"(acc[ai][1][m][0]), "+v"(acc[ai][1][m][1]));
                if (m & 1) asm volatile("" ::: "memory"); }
        const bool bad1 = bad;
        bad = st2.run(acc, u, wr, wc, fr, fq, lds, wid, lane) || bad;
#pragma unroll
        for (int ai = 0; ai < 2; ++ai)
#pragma unroll
            for (int m = 0; m < 4; ++m) { const int r = ai * HALF + wr * 64 + m * 16 + fr; const f32x2v sr = S[r]; const size_t off = (size_t)(u.pm * BM + r) * ldc + col0;
#pragma unroll
                for (int bj = 0; bj < 2; ++bj)
#pragma unroll
                    for (int n = 0; n < 2; ++n) { const f32x4 x1 = acc[ai][bj][m][n]; *(f32x4*)(out + off + bj * HALF + n * 16) = bad1 ? (f32x4){qnan, qnan, qnan, qnan} : x1;
                        const f32x4 o = (x1 - sr.x) * sr.y; u32x2v w; w.x = cvt_pk_bf16(o[0], o[1]); w.y = cvt_pk_bf16(o[2], o[3]);
                        if (bad) { w.x = 0x7fc07fc0u; w.y = 0x7fc07fc0u; } *(u32x2v*)(xn + off + bj * HALF + n * 16) = w; }
                asm volatile("" ::: "memory"); }
    }
};

template <class Epi, class Sched, bool STAMP = false>
__device__ __forceinline__ void gemm_phase(PG8_LAS unsigned char* lds, const Gemm g, const Sched& S, const Epi& E, unsigned long long* stamps) {
    const int tid = threadIdx.x, wid = __builtin_amdgcn_readfirstlane(tid >> 6), lane = tid & 63, wr = wid >> 2, wc = wid & 3, fr = lane & 15, fq = lane >> 4;
    const int K = g.K, nt = K / BK;
    int ts_lo = 0, ts_hi = 0, nts = 0; const unsigned long long rt_entry = STAMP ? (unsigned long long)wall_clock64() : 0ull;
#define PG8_STAMP() do { if (STAMP && wid == 0 && nts < 64) { const unsigned long long _c = (unsigned long long)clock64(); \
        ts_lo = (lane == nts) ? (int)(unsigned)_c : ts_lo; ts_hi = (lane == nts) ? (int)(unsigned)(_c >> 32) : ts_hi; ++nts; } } while (0)
    PG8_STAMP();
    unsigned voffA[2], voffB[2];
#pragma unroll
    for (int i = 0; i < 2; ++i) { int R, C; stage_rc(tid * 16 + i * 8192, R, C); const int Rb = Epi::PERM ? ((R & ~31) + perm32(R & 31)) : R;
        voffA[i] = (unsigned)(R * K + C) * 2u; voffB[i] = (unsigned)(Rb * K + C) * 2u; }
    const size_t kstep = (size_t)(BK * 2);
    const size_t hstep = (size_t)HALF * K * 2;
    const size_t tstep = 2 * hstep;
    const unsigned ldsw = (unsigned)wid * 1024u;
    const int aoff = lds_byte(wr * 64 + fr, fq * 8), boff = lds_byte(wc * 32 + fr, fq * 8);
#define PG8_SA(b, h) (((b) * 2 + (h)) * HTB)
#define PG8_SB(b, h) ((4 + (b) * 2 + (h)) * HTB)
#define PG8_STAGE(bufoff, gbase, voff) do { _Pragma("unroll") for (int _i = 0; _i < 2; ++_i) \
        __builtin_amdgcn_global_load_lds((const unsigned*)((const char*)(gbase) + (voff)[_i]), (PG8_LAS unsigned*)(lds + (bufoff) + ldsw + _i * 8192), 16, 0, 0); } while (0)
#define PG8_LDA(dst, b, h) do { _Pragma("unroll") for (int m = 0; m < 4; ++m) _Pragma("unroll") for (int k = 0; k < 2; ++k) dst[m][k] = *(const PG8_LAS bf16x8*)(lds + PG8_SA(b, h) + aoff + m * 2048 + k * 1024); } while (0)
#define PG8_LDB(dst, b, h) do { _Pragma("unroll") for (int n = 0; n < 2; ++n) _Pragma("unroll") for (int k = 0; k < 2; ++k) dst[n][k] = *(const PG8_LAS bf16x8*)(lds + PG8_SB(b, h) + boff + n * 2048 + k * 1024); } while (0)
#define PG8_MMA(ai, bj, At, Bt) do { __builtin_amdgcn_s_setprio(1); _Pragma("unroll") for (int m = 0; m < 4; ++m) _Pragma("unroll") for (int n = 0; n < 2; ++n) _Pragma("unroll") for (int k = 0; k < 2; ++k) \
        acc[ai][bj][m][n] = __builtin_amdgcn_mfma_f32_16x16x32_bf16(Bt[n][k], At[m][k], acc[ai][bj][m][n], 0, 0, 0); __builtin_amdgcn_s_setprio(0); } while (0)
#define PG8_WAIT_V(n) asm volatile("s_waitcnt vmcnt(" #n ")" ::: "memory")
#define PG8_WAIT_L(n) asm volatile("s_waitcnt lgkmcnt(" #n ")" ::: "memory")
#define PG8_BAR __builtin_amdgcn_s_barrier()
#define PG8_SCHED __builtin_amdgcn_sched_barrier(0)
    Unit cur, nxt; int ui = 0;
    if (!S.next(0, cur)) return;
    f32x4 acc[2][2][4][2];
#pragma unroll
    for (int a = 0; a < 2; ++a)
#pragma unroll
        for (int b = 0; b < 2; ++b)
#pragma unroll
            for (int m = 0; m < 4; ++m)
#pragma unroll
                for (int n = 0; n < 2; ++n) acc[a][b][m][n] = (f32x4){0.f, 0.f, 0.f, 0.f};
    bf16x8 At[4][2], B0[2][2], B1[2][2];
    const char* cA = (const char*)g.A + (size_t)cur.pm * tstep; const char* cB = (const char*)g.Bt + (size_t)cur.pn * tstep;
    S.a_ready(cur);
    PG8_STAGE(PG8_SB(0, 0), cB, voffB); PG8_STAGE(PG8_SA(0, 0), cA, voffA); PG8_STAGE(PG8_SB(0, 1), cB + hstep, voffB); PG8_STAGE(PG8_SA(0, 1), cA + hstep, voffA);
    if (wr == 1) PG8_BAR;
    PG8_WAIT_V(4); PG8_BAR;
    PG8_STAGE(PG8_SB(1, 0), cB + kstep, voffB); PG8_STAGE(PG8_SA(1, 0), cA + kstep, voffA); PG8_STAGE(PG8_SB(1, 1), cB + hstep + kstep, voffB);
    PG8_WAIT_V(6); PG8_BAR;
    PG8_STAMP();
    for (;;) {
        const bool has_next = S.next(ui + 1, nxt);
        const char* nA = has_next ? (const char*)g.A + (size_t)nxt.pm * tstep : cA; const char* nB = has_next ? (const char*)g.Bt + (size_t)nxt.pn * tstep : cB;
        for (int t = 0; t < nt; t += 2) {
            const bool last = (t == nt - 2);
            const char* a1 = cA + (size_t)(t + 1) * kstep;
            const char* a2 = last ? nA : cA + (size_t)(t + 2) * kstep; const char* b2 = last ? nB : cB + (size_t)(t + 2) * kstep;
            const char* a3 = a2 + kstep; const char* b3 = b2 + kstep;
            if (last && has_next) S.a_ready(nxt);
            PG8_LDB(B0, 0, 0); PG8_SCHED; PG8_LDA(At, 0, 0); PG8_STAGE(PG8_SA(1, 1), a1 + hstep, voffA);
            PG8_WAIT_L(8); PG8_BAR; PG8_WAIT_L(0); PG8_MMA(0, 0, At, B0); PG8_BAR; PG8_SCHED;
            PG8_LDB(B1, 0, 1); PG8_STAGE(PG8_SB(0, 0), b2, voffB);
            PG8_BAR; PG8_WAIT_L(0); PG8_MMA(0, 1, At, B1); PG8_BAR;
            PG8_LDA(At, 0, 1); PG8_STAGE(PG8_SA(0, 0), a2, voffA);
            PG8_BAR; PG8_WAIT_L(0); PG8_MMA(1, 0, At, B0); PG8_BAR; PG8_SCHED;
            PG8_STAGE(PG8_SB(0, 1), b2 + hstep, voffB);
            PG8_WAIT_V(6); PG8_BAR; PG8_MMA(1, 1, At, B1); PG8_BAR;
            PG8_LDB(B0, 1, 0); PG8_SCHED; PG8_LDA(At, 1, 0); PG8_STAGE(PG8_SA(0, 1), a2 + hstep, voffA);
            PG8_WAIT_L(8); PG8_BAR; PG8_WAIT_L(0); PG8_MMA(0, 0, At, B0); PG8_BAR; PG8_SCHED;
            PG8_LDB(B1, 1, 1); PG8_STAGE(PG8_SB(1, 0), b3, voffB);
            PG8_BAR; PG8_WAIT_L(0); PG8_MMA(0, 1, At, B1); PG8_BAR;
            PG8_LDA(At, 1, 1); PG8_STAGE(PG8_SA(1, 0), a3, voffA);
            PG8_BAR; PG8_WAIT_L(0); PG8_MMA(1, 0, At, B0); PG8_BAR; PG8_SCHED;
            PG8_STAGE(PG8_SB(1, 1), b3 + hstep, voffB);
            PG8_WAIT_V(6); PG8_BAR; PG8_MMA(1, 1, At, B1); PG8_BAR;
        }
        PG8_STAMP();
        if constexpr (!Epi::AFTER_DRAIN) { E(acc, cur, wr, wc, fr, fq); S.done(cur); }
        PG8_STAMP();
        if (!has_next) break;
#pragma unroll
        for (int a = 0; a < 2; ++a)
#pragma unroll
            for (int b = 0; b < 2; ++b)
#pragma unroll
                for (int m = 0; m < 4; ++m)
#pragma unroll
                    for (int n = 0; n < 2; ++n) acc[a][b][m][n] = (f32x4){0.f, 0.f, 0.f, 0.f};
        cur = nxt; cA = nA; cB = nB; ++ui;
    }
    PG8_WAIT_V(0);
    if (wr == 0) PG8_BAR;
    PG8_BAR;
    if constexpr (Epi::AFTER_DRAIN) { E.fused(acc, cur, wr, wc, fr, fq, lds, wid, lane); S.done(cur); }
    PG8_STAMP();
    if (STAMP && wid == 0) { stamps[lane] = lane < nts ? (((unsigned long long)(unsigned)ts_hi << 32) | (unsigned)ts_lo) : 0ull;
        if (lane == 62) stamps[62] = rt_entry; if (lane == 63) stamps[63] = (unsigned long long)wall_clock64(); }
#undef PG8_STAMP
#undef PG8_SA
#undef PG8_SB
#undef PG8_STAGE
#undef PG8_LDA
#undef PG8_LDB
#undef PG8_MMA
#undef PG8_WAIT_V
#undef PG8_WAIT_L
#undef PG8_BAR
#undef PG8_SCHED
}
}

namespace cg = cooperative_groups;
typedef unsigned short bf16_t;
typedef short bf16x8 __attribute__((ext_vector_type(8)));
typedef float f32x4 __attribute__((ext_vector_type(4)));
typedef unsigned u32x4 __attribute__((ext_vector_type(4)));
typedef unsigned u32x2 __attribute__((ext_vector_type(2)));

constexpr int NB = 8, NT = 4096, DM = 1024, NTOK = NB * NT;
constexpr int DIN = 4744, NPAD = 4864;
constexpr int C_R = 0, C_K = 512, C_V = 1024, C_WD = 1536, C_AD = 1600, C_ZR = 1664, C_Q = 2176, C_KM = 2688, C_VM = 3200, C_O = 3712, C_I = 4224, C_F = 4228, C_ZM = 4232;
constexpr int NTHR = 512, NWV = 8;
constexpr int LDS_BYTES = 147456;
constexpr int NPHASE = 8;

constexpr size_t MiB = 1u << 20;
constexpr size_t WS_CTL = 0, CTL_BYTES = 1 * MiB;
constexpr size_t WS_ADA = 1 * MiB;
constexpr size_t WS_LORA = 1 * MiB + 512 * 1024;
constexpr size_t WS_WL = 14 * MiB, WS_BONUS = 15 * MiB;
constexpr size_t WS_WIN = 2 * MiB;
constexpr size_t WS_WOUT = 12 * MiB;
constexpr size_t WS_X = 16 * MiB;
constexpr size_t WS_PROJ = 144 * MiB;
constexpr size_t WS_Y = 448 * MiB;
constexpr size_t WS_END = 512 * MiB;

__device__ __forceinline__ size_t pjo(size_t m, int col) { return (size_t)(col >> 8) * ((size_t)NTOK * 256) + m * 256 + (size_t)(col & 255); }
struct Params { const float* in[24]; float* out; unsigned char* ws; int ph_lo, ph_hi; };

struct Ctx {
    const Params& p;
    __device__ __forceinline__ const float* x() const { return p.in[0]; }
    __device__ __forceinline__ const float* c() const { return p.in[1]; }
    __device__ __forceinline__ const float* w_ada() const { return p.in[2]; }
    __device__ __forceinline__ const float* b_ada() const { return p.in[3]; }
    __device__ __forceinline__ const float* norm_gain() const { return p.in[4]; }
    __device__ __forceinline__ const float* w_in() const { return p.in[5]; }
    __device__ __forceinline__ const float* mu() const { return p.in[6]; }
    __device__ __forceinline__ const float* w_dup() const { return p.in[7]; }
    __device__ __forceinline__ const float* w_d0() const { return p.in[8]; }
    __device__ __forceinline__ const float* w_iup() const { return p.in[9]; }
    __device__ __forceinline__ const float* a0() const { return p.in[10]; }
    __device__ __forceinline__ const float* k_k() const { return p.in[11]; }
    __device__ __forceinline__ const float* k_a() const { return p.in[12]; }
    __device__ __forceinline__ const float* r_k() const { return p.in[13]; }
    __device__ __forceinline__ const float* gn_w() const { return p.in[14]; }
    __device__ __forceinline__ const float* gn_b() const { return p.in[15]; }
    __device__ __forceinline__ const float* conv_w() const { return p.in[16]; }
    __device__ __forceinline__ const float* conv_b() const { return p.in[17]; }
    __device__ __forceinline__ const float* b_i() const { return p.in[18]; }
    __device__ __forceinline__ const float* b_f() const { return p.in[19]; }
    __device__ __forceinline__ const float* ln_w() const { return p.in[20]; }
    __device__ __forceinline__ const float* skip() const { return p.in[21]; }
    __device__ __forceinline__ const float* w_out() const { return p.in[22]; }
    __device__ __forceinline__ const float* fgain() const { return p.in[23]; }
    __device__ __forceinline__ float* out() const { return p.out; }
    __device__ __forceinline__ float* sumsq() const { return (float*)(p.ws + (WS_Y)); }
    __device__ __forceinline__ float* ada() const { return (float*)(p.ws + (WS_ADA)); }
    __device__ __forceinline__ bf16_t* win_t() const { return (bf16_t*)(p.ws + (WS_WIN)); }
    __device__ __forceinline__ bf16_t* wout_t() const { return (bf16_t*)(p.ws + (WS_WOUT)); }
    __device__ __forceinline__ bf16_t* hn() const { return (bf16_t*)(p.ws + (WS_X)); }
    __device__ __forceinline__ bf16_t* proj() const { return (bf16_t*)(p.ws + (WS_PROJ)); }
    __device__ __forceinline__ bf16_t* y() const { return (bf16_t*)(p.ws + (WS_Y)); }
    __device__ __forceinline__ bf16_t* wdup_t() const { return (bf16_t*)(p.ws + (WS_LORA)); }
    __device__ __forceinline__ bf16_t* wiup_t() const { return (bf16_t*)(p.ws + (WS_LORA + 65536)); }
    __device__ __forceinline__ bf16_t* q1p() const { return (bf16_t*)(p.ws + (WS_X)); }
    __device__ __forceinline__ bf16_t* mp() const { return (bf16_t*)(p.ws + (WS_X + 32 * MiB)); }
    __device__ __forceinline__ bf16_t* yid() const { return (bf16_t*)(p.ws + (WS_X + 64 * MiB)); }
    __device__ __forceinline__ bf16_t* nd() const { return (bf16_t*)(p.ws + (WS_X + 96 * MiB)); }
    __device__ __forceinline__ float* wl() const { return (float*)(p.ws + (WS_WL)); }
    __device__ __forceinline__ float* bonus() const { return (float*)(p.ws + (WS_BONUS)); }
    __device__ __forceinline__ bf16_t* qc() const { return (bf16_t*)(p.ws + WS_Y); }
    __device__ __forceinline__ bf16_t* kc() const { return (bf16_t*)(p.ws + WS_Y + 32 * MiB); }
    __device__ __forceinline__ bf16_t* mixo() const { return (bf16_t*)(p.ws + WS_Y); }
    __device__ __forceinline__ bf16_t* p0s() const { return (bf16_t*)p.out; }
    __device__ __forceinline__ bf16_t* ymix() const { return (bf16_t*)(p.ws + WS_X); }
    unsigned char* lds; int tid, lane, wid, gw, ngw;
};

__device__ __forceinline__ float bf2f(bf16_t v) { return __uint_as_float(((unsigned)v) << 16); }
typedef __bf16 bf16v2_t __attribute__((ext_vector_type(2))); typedef float f32v2_t __attribute__((ext_vector_type(2)));
__device__ __forceinline__ unsigned pk2(float lo, float hi) { const f32v2_t v = {lo, hi}; const bf16v2_t b = __builtin_convertvector(v, bf16v2_t); return __builtin_bit_cast(unsigned, b); }
__device__ __forceinline__ bf16_t f2bf(float f) { return __builtin_bit_cast(bf16_t, (__bf16)f); }
__device__ __forceinline__ void unpack8(const u32x4 v, float* o) {
    o[0] = __uint_as_float(v.x << 16); o[1] = __uint_as_float(v.x & 0xffff0000u); o[2] = __uint_as_float(v.y << 16); o[3] = __uint_as_float(v.y & 0xffff0000u);
    o[4] = __uint_as_float(v.z << 16); o[5] = __uint_as_float(v.z & 0xffff0000u); o[6] = __uint_as_float(v.w << 16); o[7] = __uint_as_float(v.w & 0xffff0000u);
}
__device__ __forceinline__ u32x4 pack8(const float* v) { u32x4 o; o.x = pk2(v[0], v[1]); o.y = pk2(v[2], v[3]); o.z = pk2(v[4], v[5]); o.w = pk2(v[6], v[7]); return o; }
__device__ __forceinline__ float wave_sum(float v) {
#pragma unroll
    for (int o = 1; o < 64; o <<= 1) v += __shfl_xor(v, o);
    return v;
}
#define LDS_BARRIER() do { asm volatile("s_waitcnt lgkmcnt(0)" ::: "memory"); __builtin_amdgcn_s_barrier(); asm volatile("" ::: "memory"); } while (0)
__device__ __forceinline__ float fexp(float x) { return __builtin_amdgcn_exp2f(x * 1.4426950408889634f); }
__device__ __forceinline__ float frcp(float x) { return __builtin_amdgcn_rcpf(x); }
__device__ __forceinline__ float sigmoidf_(float z) { return frcp(1.0f + fexp(-z)); }
__device__ __forceinline__ float siluf_(float z) { return z * frcp(1.0f + fexp(-z)); }
__device__ __forceinline__ float ftanh(float x) { return 1.0f - 2.0f * frcp(1.0f + fexp(2.0f * x)); }
template <int CTRL> __device__ __forceinline__ float dppf(float v) { return __int_as_float(__builtin_amdgcn_update_dpp(0, __float_as_int(v), CTRL, 0xF, 0xF, true)); }
__device__ __forceinline__ float row16_sum(float v) {
    v += dppf<0xB1>(v); v += dppf<0x4E>(v); v += dppf<0x141>(v); v += dppf<0x140>(v); return v;
}
__device__ __forceinline__ float half8_sum(float v) {
    v += dppf<0xB1>(v); v += dppf<0x4E>(v); v += dppf<0x141>(v); return v;
}
__device__ __forceinline__ float wave_sum_dpp(float v) {
    v = row16_sum(v);
    const int iv = __float_as_int(v);
    const float r0 = __int_as_float(__builtin_amdgcn_readlane(iv, 0)), r1 = __int_as_float(__builtin_amdgcn_readlane(iv, 16)), r2 = __int_as_float(__builtin_amdgcn_readlane(iv, 32)), r3 = __int_as_float(__builtin_amdgcn_readlane(iv, 48));
    return (r0 + r1) + (r2 + r3);
}

__device__ __forceinline__ void transpose_item(const float* W, int K, int N, bf16_t* WT, float* scr, int item, int nblk, int lane) {
    const int kb = item / nblk, nb = item % nblk, k0 = 64 * kb, n0 = 32 * nb;
#pragma unroll
    for (int i = 0; i < 32; ++i) { const int kk = 2 * i + (lane >> 5); const int n = n0 + (lane & 31); scr[kk * 33 + (lane & 31)] = (n < N) ? W[(size_t)(k0 + kk) * N + n] : 0.f; }
    __builtin_amdgcn_s_waitcnt(0); asm volatile("" ::: "memory");
    const int c = lane & 7;
#pragma unroll
    for (int j = 0; j < 4; ++j) { const int n = (lane >> 3) + 8 * j; const float* s = scr + (8 * c) * 33 + n;
        u32x4 o; o.x = pk2(s[0 * 33], s[1 * 33]); o.y = pk2(s[2 * 33], s[3 * 33]); o.z = pk2(s[4 * 33], s[5 * 33]); o.w = pk2(s[6 * 33], s[7 * 33]);
        *(u32x4*)(WT + (size_t)(n0 + n) * K + k0 + 8 * c) = o; }
    __builtin_amdgcn_s_waitcnt(0); asm volatile("" ::: "memory");
}
__device__ __forceinline__ void phase0(const Ctx& C) {
    if (blockIdx.x >= 48) return;
    float* Ls = (float*)C.lds;
    float* Lp = Ls + 8192;
    for (int e = C.tid; e < 8192; e += NTHR) Ls[e] = siluf_(C.c()[e]);
    __syncthreads();
    const int lane = C.lane, wid = C.wid, grp = wid >> 2, kq = wid & 3, kp = lane >> 3, c4 = 4 * (lane & 7);
    const int col0 = (2 * blockIdx.x + grp) * 32;
    f32x4 acc[8];
#pragma unroll
    for (int b = 0; b < 8; ++b) acc[b] = (f32x4){0.f, 0.f, 0.f, 0.f};
#pragma unroll 16
    for (int it = 0; it < 32; ++it) {
        const int k = kq * 256 + it * 8 + kp;
        const f32x4 w = *(const f32x4*)(C.w_ada() + (size_t)k * 3072 + col0 + c4);
#pragma unroll
        for (int b = 0; b < 8; ++b) acc[b] = acc[b] + w * Ls[b * 1024 + k];
    }
#pragma unroll
    for (int b = 0; b < 8; ++b) {
#pragma unroll
        for (int o = 8; o < 64; o <<= 1) { acc[b].x += __shfl_xor(acc[b].x, o); acc[b].y += __shfl_xor(acc[b].y, o); acc[b].z += __shfl_xor(acc[b].z, o); acc[b].w += __shfl_xor(acc[b].w, o); }
        if (kp == 0) *(f32x4*)(Lp + ((grp * 4 + kq) * 8 + b) * 32 + c4) = acc[b];
    }
    __syncthreads();
    if (C.tid < 512) { const int g2 = C.tid >> 8, b = (C.tid >> 5) & 7, c = C.tid & 31; const int col = (2 * blockIdx.x + g2) * 32 + c;
        float s = C.b_ada()[col];
#pragma unroll
        for (int q = 0; q < 4; ++q) s += Lp[((g2 * 4 + q) * 8 + b) * 32 + c];
        C.ada()[b * 3072 + col] = s; }
}
__device__ __forceinline__ void weight_copies(const Ctx& C) {
    float* scr = (float*)(C.lds + C.wid * 16384);
    constexpr int NBI = NPAD / 32, I_IN = 16 * NBI, I_OUT = 16 * 32;
    for (int it = C.gw; it < I_IN + I_OUT + 32; it += C.ngw) {
        if (it < I_IN) transpose_item(C.w_in(), 1024, DIN, C.win_t(), scr, it, NBI, C.lane);
        else if (it < I_IN + I_OUT) transpose_item(C.w_out(), 1024, 1024, C.wout_t(), scr, it - I_IN, 32, C.lane);
        else if (it < I_IN + I_OUT + 16) transpose_item(C.w_dup(), 64, 512, C.wdup_t(), scr, it - I_IN - I_OUT, 16, C.lane);
        else transpose_item(C.w_iup(), 64, 512, C.wiup_t(), scr, it - I_IN - I_OUT - 16, 16, C.lane);
    }
}

__device__ __forceinline__ void phase1(const Ctx& C) {
    f32x4 g[4];
#pragma unroll
    for (int j = 0; j < 4; ++j) g[j] = *(const f32x4*)(C.norm_gain() + 4 * C.lane + 256 * j);
    f32x4 v[4], n1[4];
    { const f32x4* xr = (const f32x4*)(C.x() + (size_t)C.gw * DM) + C.lane; const f32x4* x1 = (const f32x4*)(C.x() + (size_t)(C.gw + C.ngw) * DM) + C.lane;
#pragma unroll
      for (int j = 0; j < 4; ++j) { v[j] = __builtin_nontemporal_load(xr + 64 * j); n1[j] = __builtin_nontemporal_load(x1 + 64 * j); } }
    f32x4 shv[4], scv[4]; int bcur = -1;
    for (int m = C.gw; m < NTOK; m += C.ngw) {
        const int b = m >> 12; const int mn = (m + 2 * C.ngw < NTOK) ? m + 2 * C.ngw : m;
        if (b != bcur) { bcur = b;
#pragma unroll
            for (int j = 0; j < 4; ++j) { shv[j] = *(const f32x4*)(C.ada() + b * 3072 + 4 * C.lane + 256 * j); scv[j] = *(const f32x4*)(C.ada() + b * 3072 + 1024 + 4 * C.lane + 256 * j) + 1.0f; } }
        f32x4 nv[4];
        { const f32x4* xr = (const f32x4*)(C.x() + (size_t)mn * DM) + C.lane;
#pragma unroll
          for (int j = 0; j < 4; ++j) nv[j] = __builtin_nontemporal_load(xr + 64 * j); }
        float s = 0.f;
#pragma unroll
        for (int j = 0; j < 4; ++j) s += (v[j].x * v[j].x + v[j].y * v[j].y) + (v[j].z * v[j].z + v[j].w * v[j].w);
        const float rs = __builtin_amdgcn_rsqf(wave_sum_dpp(s) * (1.0f / DM) + 1e-6f);
        u32x2* o = (u32x2*)(C.hn() + (size_t)m * DM) + C.lane;
#pragma unroll
        for (int j = 0; j < 4; ++j) {
            const f32x4 h = v[j] * rs * g[j] * scv[j] + shv[j];
            u32x2 w; w.x = pk2(h.x, h.y); w.y = pk2(h.z, h.w); o[64 * j] = w; }
#pragma unroll
        for (int j = 0; j < 4; ++j) { v[j] = n1[j]; n1[j] = nv[j]; }
    }
}

typedef short s16x4 __attribute__((ext_vector_type(4)));
__device__ __forceinline__ bf16x8 tr_frag(const bf16_t* base, int stride, int row0, int col0, int fr, int fq) {
    const bf16_t* a0 = base + (row0 + 8 * fq + (fr >> 2)) * stride + col0 + 4 * (fr & 3);
    const s16x4 lo = __builtin_amdgcn_ds_read_tr16_b64_v4i16((__attribute__((address_space(3))) s16x4*)a0);
    const s16x4 hi = __builtin_amdgcn_ds_read_tr16_b64_v4i16((__attribute__((address_space(3))) s16x4*)(a0 + 4 * stride));
    return (bf16x8){lo[0], lo[1], lo[2], lo[3], hi[0], hi[1], hi[2], hi[3]};
}

constexpr int LS = 72;
constexpr int XS = 68;
__device__ __forceinline__ int permc(int c) { return (c & 32) | ((c & 12) << 1) | ((c & 16) >> 2) | (c & 3); }
__device__ __forceinline__ bf16x8 zero8() { return (bf16x8){0, 0, 0, 0, 0, 0, 0, 0}; }
#define MFMA16(a, b, c) __builtin_amdgcn_mfma_f32_16x16x32_bf16(a, b, c, 0, 0, 0)
#define LDFRAG(base, row, col) (*(const bf16x8*)((base) + (row) * LS + (col)))

#define FR_(base, rowoff, coloff) (*(const bf16x8*)((base) + lfo + (rowoff) * LS + (coloff)))
#define DW_(base, rowoff, coloff, r) ((base)[ldo + ((rowoff) + (r)) * LS + (coloff)])
#define OPAQ() asm volatile("" : "+v"(lfo), "+v"(ldo), "+v"(lto), "+v"(lxo))
template <int VAR> __device__ __forceinline__ void rwkv_r1_wg(const Ctx& C, int b, int h, int ck0, int nck) {
    bf16_t* B0 = (bf16_t*)C.lds;
    bf16_t* B1 = B0 + 64 * LS;
    bf16_t* B2 = B1 + 64 * LS;
    bf16_t* B3 = B2 + 64 * LS;
    bf16_t* B4 = B3 + 64 * LS;
    bf16_t* B5 = B4 + 64 * LS;
    bf16_t* B6 = B5 + 64 * LS;
    bf16_t* B7 = B6 + 64 * LS;
    bf16_t* B8 = B7 + 64 * LS;
    float* F = (float*)(B8 + 64 * LS);
    float* Xr = F; float* Xk = F + 64 * XS; float* Xv = Xk + 64 * XS;
    bf16_t* LAab = (bf16_t*)F; bf16_t* LAak = LAab + 64 * LS; bf16_t* LArb = LAak + 64 * LS; bf16_t* LArk = LArb + 64 * LS; bf16_t* LTinv = LArk + 64 * LS;
    float* G = F + 3 * 64 * XS;
    float* LAd = G;
    float* Ltot = LAd + 1024;
    float* Linv = Ltot + 256;
    float* Lbp = Linv + 64;
    bf16_t* LX = (bf16_t*)LAd;
    bf16_t* LX2 = LX + 2 * 16 * 40;
    float* Lc = Lbp + 128;
    int tid = C.tid; asm volatile("" : "+v"(tid));
    const int lane = tid & 63, wid = C.wid, fr = lane & 15, fq = lane >> 4;
    const int tt = tid >> 3, cg8 = tid & 7, ch0 = h * 64 + 8 * cg8;
    const int wt = wid >> 1, wc0 = 2 * (wid & 1);
    __syncthreads();
    if (tid < 384) { const int a = tid >> 6, c = tid & 63;
        Lc[tid] = (a == 0) ? C.mu()[C_R + h * 64 + c] : (a == 1) ? C.mu()[C_K + h * 64 + c] : (a == 2) ? C.mu()[C_V + h * 64 + c] : (a == 3) ? C.k_k()[h * 64 + c] : (a == 4) ? C.mu()[C_WD + c] : C.mu()[C_AD + c]; }
    __syncthreads();
    float d0c[2], a0c[2], kkc[2], kac[2], rkc[2];
#pragma unroll
    for (int jj = 0; jj < 2; ++jj) { const int c = h * 64 + 16 * (wc0 + jj) + fr;
        d0c[jj] = C.w_d0()[c]; a0c[jj] = C.a0()[c]; kkc[jj] = C.k_k()[c]; kac[jj] = C.k_a()[c]; rkc[jj] = C.r_k()[c]; }
    int lfo = fr * LS + 8 * fq, ldo = 4 * fq * LS + fr, lto = fr * LS + 4 * fq, lxo = 4 * fq * XS + fr;

    u32x4 raw[10];
#define R1_LOAD_RAW(mm) do { const bf16_t* pj_ = C.proj(); const size_t mc_ = (size_t)(mm), mp_ = (size_t)(((mm) > 0) ? (mm) - 1 : (mm)); \
        raw[0] = *(const u32x4*)(pj_ + pjo(mc_, C_R + ch0)); raw[1] = *(const u32x4*)(pj_ + pjo(mc_, C_K + ch0)); raw[2] = *(const u32x4*)(pj_ + pjo(mc_, C_V + ch0)); \
        raw[3] = *(const u32x4*)(pj_ + pjo(mc_, C_WD + 8 * cg8)); raw[4] = *(const u32x4*)(pj_ + pjo(mc_, C_AD + 8 * cg8)); \
        raw[5] = *(const u32x4*)(pj_ + pjo(mp_, C_R + ch0)); raw[6] = *(const u32x4*)(pj_ + pjo(mp_, C_K + ch0)); raw[7] = *(const u32x4*)(pj_ + pjo(mp_, C_V + ch0)); \
        raw[8] = *(const u32x4*)(pj_ + pjo(mp_, C_WD + 8 * cg8)); raw[9] = *(const u32x4*)(pj_ + pjo(mp_, C_AD + 8 * cg8)); } while (0)
    R1_LOAD_RAW(b * NT + ck0 * 64 + tt);
    for (int ci = 0; ci < nck; ++ci) {
        const int ck = ck0 + ci; const int m = b * NT + ck * 64 + tt; const size_t chx = (size_t)((b * 8 + h) * 64 + ck);
        OPAQ();
        bf16x8 Bw[2][2], Bi[2][2];
        { int co = (h * 64 + 16 * wc0 + fr) * 64 + 8 * fq; asm volatile("" : "+v"(co));
#pragma unroll
          for (int jj = 0; jj < 2; ++jj)
#pragma unroll
            for (int ks = 0; ks < 2; ++ks) { Bw[jj][ks] = *(const bf16x8*)(C.wdup_t() + co + jj * 1024 + 32 * ks); Bi[jj][ks] = *(const bf16x8*)(C.wiup_t() + co + jj * 1024 + 32 * ks); } }
        if constexpr ((VAR & 2) == 0) {
        {
            const bool hp = (ck | tt) != 0;
            if (!hp) {
#pragma unroll
                for (int i = 5; i < 10; ++i) raw[i] = (u32x4){0u, 0u, 0u, 0u}; }
            const int o = tt * XS + 8 * cg8;
            {
                float v[8], pv[8], mu8[8]; unpack8(raw[2], v); unpack8(raw[7], pv);
                { const f32x4* p4 = (const f32x4*)(Lc + 128 + 8 * cg8); *(f32x4*)mu8 = p4[0]; *(f32x4*)(mu8 + 4) = p4[1]; }
#pragma unroll
                for (int i = 0; i < 8; ++i) v[i] += mu8[i] * (pv[i] - v[i]);
                *(f32x4*)(Xv + o) = (f32x4){v[0], v[1], v[2], v[3]}; *(f32x4*)(Xv + o + 4) = (f32x4){v[4], v[5], v[6], v[7]};
            }
            asm volatile("" ::: "memory");
            {
                float v[8], pv[8], mu8[8]; unpack8(raw[0], v); unpack8(raw[5], pv);
                { const f32x4* p4 = (const f32x4*)(Lc + 8 * cg8); *(f32x4*)mu8 = p4[0]; *(f32x4*)(mu8 + 4) = p4[1]; }
#pragma unroll
                for (int i = 0; i < 8; ++i) v[i] += mu8[i] * (pv[i] - v[i]);
                *(f32x4*)(Xr + o) = (f32x4){v[0], v[1], v[2], v[3]}; *(f32x4*)(Xr + o + 4) = (f32x4){v[4], v[5], v[6], v[7]};
            }
            asm volatile("" ::: "memory");
            {
                float v[8], pv[8], mu8[8], kw8[8]; unpack8(raw[1], v); unpack8(raw[6], pv);
                { const f32x4* p4 = (const f32x4*)(Lc + 64 + 8 * cg8); *(f32x4*)mu8 = p4[0]; *(f32x4*)(mu8 + 4) = p4[1]; p4 = (const f32x4*)(Lc + 192 + 8 * cg8); *(f32x4*)kw8 = p4[0]; *(f32x4*)(kw8 + 4) = p4[1]; }
                float ss = 0.f;
#pragma unroll
                for (int i = 0; i < 8; ++i) { v[i] += mu8[i] * (pv[i] - v[i]); const float q = v[i] * kw8[i]; ss += q * q; }
                ss = half8_sum(ss);
                if (cg8 == 0) Linv[tt] = frcp(fmaxf(__builtin_amdgcn_sqrtf(ss), 1e-12f));
                *(f32x4*)(Xk + o) = (f32x4){v[0], v[1], v[2], v[3]}; *(f32x4*)(Xk + o + 4) = (f32x4){v[4], v[5], v[6], v[7]};
            }
            asm volatile("" ::: "memory");
            {
                float v[8], pv[8], mu8[8]; unpack8(raw[3], v); unpack8(raw[8], pv);
                { const f32x4* p4 = (const f32x4*)(Lc + 256 + 8 * cg8); *(f32x4*)mu8 = p4[0]; *(f32x4*)(mu8 + 4) = p4[1]; }
#pragma unroll
                for (int i = 0; i < 8; ++i) v[i] = ftanh(v[i] + mu8[i] * (pv[i] - v[i]));
                *(u32x4*)(B0 + tt * LS + 8 * cg8) = pack8(v);
            }
            asm volatile("" ::: "memory");
            {
                float v[8], pv[8], mu8[8]; unpack8(raw[4], v); unpack8(raw[9], pv);
                { const f32x4* p4 = (const f32x4*)(Lc + 320 + 8 * cg8); *(f32x4*)mu8 = p4[0]; *(f32x4*)(mu8 + 4) = p4[1]; }
#pragma unroll
                for (int i = 0; i < 8; ++i) v[i] += mu8[i] * (pv[i] - v[i]);
                *(u32x4*)(B1 + tt * LS + 8 * cg8) = pack8(v);
            }
        }
        }
        LDS_BARRIER();
        float lw[2][4], aa[2][4];
        {
            f32x4 zw[2], za[2];
#pragma unroll
            for (int jj = 0; jj < 2; ++jj) { zw[jj] = (f32x4){0.f, 0.f, 0.f, 0.f}; za[jj] = (f32x4){0.f, 0.f, 0.f, 0.f}; }
#pragma unroll
            for (int ks = 0; ks < 2; ++ks) { const bf16x8 aw = FR_(B0, 16 * wt, 32 * ks), ai = FR_(B1, 16 * wt, 32 * ks);
#pragma unroll
                for (int jj = 0; jj < 2; ++jj) { zw[jj] = MFMA16(aw, Bw[jj][ks], zw[jj]); za[jj] = MFMA16(ai, Bi[jj][ks], za[jj]); } }
#pragma unroll
            for (int jj = 0; jj < 2; ++jj)
#pragma unroll
                for (int r = 0; r < 4; ++r) { lw[jj][r] = -0.6065306597126334f * sigmoidf_(d0c[jj] + zw[jj][r]); aa[jj][r] = sigmoidf_(a0c[jj] + za[jj][r]); }
        }
        float clx[2][4], cin[2][4];
#pragma unroll
        for (int jj = 0; jj < 2; ++jj) {
            const float s4 = (lw[jj][0] + lw[jj][1]) + (lw[jj][2] + lw[jj][3]); float x = s4;
            float t1 = __shfl_up(x, 16); if (fq >= 1) x += t1; t1 = __shfl_up(x, 32); if (fq >= 2) x += t1;
            const float eq = x - s4;
            clx[jj][0] = eq; cin[jj][0] = eq + lw[jj][0];
#pragma unroll
            for (int r = 1; r < 4; ++r) { clx[jj][r] = cin[jj][r - 1]; cin[jj][r] = cin[jj][r - 1] + lw[jj][r]; }
            if (fq == 3) Ltot[wt * 64 + 16 * (wc0 + jj) + fr] = x;
        }
        LDS_BARRIER();
        OPAQ();
        if constexpr ((VAR & 4) == 0) {
        {
            float bsum[4] = {0.f, 0.f, 0.f, 0.f};
            const int xb = lxo + 16 * wt * XS + 16 * wc0;
            const int db = 16 * wt * LS + 16 * wc0;
            const int tb = lto + 16 * wc0 * LS + 16 * wt;
#pragma unroll
            for (int jj = 0; jj < 2; ++jj) {
                const int c = 16 * (wc0 + jj) + fr;
                float off = 0.f, clL = 0.f;
#pragma unroll
                for (int q = 0; q < 4; ++q) { const float tv = Ltot[q * 64 + c]; clL += tv; if (q < wt) off += tv; }
                const float eL = fexp(clL);
                if ((VAR & 1) == 0 && wt == 0 && fq == 0) C.wl()[chx * 64 + c] = eL;
                float at[4], rt[4], bt[4], kt[4], bh[4], kh[4], vv[4]; float eprev = 0.f;
#pragma unroll
                for (int r = 0; r < 4; ++r) {
                    const float rr = Xr[xb + r * XS + 16 * jj], kr = Xk[xb + r * XS + 16 * jj]; vv[r] = Xv[xb + r * XS + 16 * jj];
                    const float kk = kr * kkc[jj] * Linv[16 * wt + 4 * fq + r]; const float a = aa[jj][r];
                    const float be = kk * a, km = kr * (1.0f + (a - 1.0f) * kac[jj]);
                    const float ci_ = off + cin[jj][r], cx = off + clx[jj][r];
                    const float ei = fexp(ci_), en = frcp(ei), el = eL * en;
                    at[r] = -kk * ((r == 0) ? fexp(cx) : eprev); eprev = ei; rt[r] = rr * ei; bt[r] = be * en; kt[r] = km * en; bh[r] = be * el; kh[r] = km * el;
                    bsum[r] += rr * km * rkc[jj];
                    B3[ldo + db + r * LS + 16 * jj] = f2bf(rt[r]);
                }
                u32x2 w;
                w.x = pk2(at[0], at[1]); w.y = pk2(at[2], at[3]); *(u32x2*)(B4 + tb + 16 * jj * LS) = w;
                w.x = pk2(bt[0], bt[1]); w.y = pk2(bt[2], bt[3]); *(u32x2*)(B1 + tb + 16 * jj * LS) = w;
                w.x = pk2(kt[0], kt[1]); w.y = pk2(kt[2], kt[3]); *(u32x2*)(B2 + tb + 16 * jj * LS) = w;
                w.x = pk2(bh[0], bh[1]); w.y = pk2(bh[2], bh[3]); *(u32x2*)(B5 + tb + 16 * jj * LS) = w;
                w.x = pk2(kh[0], kh[1]); w.y = pk2(kh[2], kh[3]); *(u32x2*)(B6 + tb + 16 * jj * LS) = w;
                w.x = pk2(vv[0], vv[1]); w.y = pk2(vv[2], vv[3]); *(u32x2*)(B7 + tb + 16 * jj * LS) = w;
            }
#pragma unroll
            for (int r = 0; r < 4; ++r) { const float s = row16_sum(bsum[r]); if (fr == 0) Lbp[(wid & 1) * 64 + 16 * wt + 4 * fq + r] = s; }
        }
        }
        LDS_BARRIER();
        OPAQ();
        if ((VAR & 1) == 0 && tid < 64) C.bonus()[(size_t)(b * NT + ck * 64 + tid) * 8 + h] = Lbp[tid] + Lbp[64 + tid];
        if constexpr ((VAR & 8) == 0) {
        {
            int fr3 = fr, fq3 = fq; asm volatile("" : "+v"(fr3), "+v"(fq3));
#pragma unroll
            for (int jj = 0; jj < 2; ++jj) {
                const int st = wc0 + jj;
                if (st <= wt) {
                    f32x4 ab = (f32x4){0.f, 0.f, 0.f, 0.f}, ak = ab, rb = ab, rk = ab;
#pragma unroll
                    for (int ks = 0; ks < 2; ++ks) {
                        const bf16x8 fa = tr_frag(B4, LS, 32 * ks, 16 * wt, fr3, fq3), frr = FR_(B3, 16 * wt, 32 * ks);
                        const bf16x8 fb = tr_frag(B1, LS, 32 * ks, 16 * st, fr3, fq3), fk = tr_frag(B2, LS, 32 * ks, 16 * st, fr3, fq3);
                        ab = MFMA16(fb, fa, ab); ak = MFMA16(fk, fa, ak); rb = MFMA16(fb, frr, rb); rk = MFMA16(fk, frr, rk);
                    }
                    int fro = fr, fqo = 4 * fq; asm volatile("" : "+v"(fro), "+v"(fqo));
                    const int t = 16 * wt + fro;
                    float vab[4], vak[4], vrb[4], vrk[4];
#pragma unroll
                    for (int r = 0; r < 4; ++r) { const int sx = 16 * st + fqo + r; const bool lo = sx < t, le = sx <= t;
                        vab[r] = lo ? ab[r] : 0.f; vak[r] = lo ? ak[r] : 0.f; vrb[r] = le ? rb[r] : 0.f; vrk[r] = le ? rk[r] : 0.f; }
                    const int o = lto + 16 * wt * LS + 16 * st;
                    u32x2 w;
                    w.x = pk2(vab[0], vab[1]); w.y = pk2(vab[2], vab[3]); *(u32x2*)(LAab + o) = w;
                    w.x = pk2(vak[0], vak[1]); w.y = pk2(vak[2], vak[3]); *(u32x2*)(LAak + o) = w;
                    w.x = pk2(vrb[0], vrb[1]); w.y = pk2(vrb[2], vrb[3]); *(u32x2*)(LArb + o) = w;
                    w.x = pk2(vrk[0], vrk[1]); w.y = pk2(vrk[2], vrk[3]); *(u32x2*)(LArk + o) = w;
                    if (st == wt) *(f32x4*)(LAd + wt * 256 + fr * 16 + 4 * fq) = (f32x4){vab[0], vab[1], vab[2], vab[3]};
                } else if (st == wt + 1 && (wt & 1) == 0) {
                    const int o = lto + 16 * wt * LS + 16 * st; const u32x2 z = (u32x2){0u, 0u};
                    *(u32x2*)(LAak + o) = z; *(u32x2*)(LArb + o) = z; *(u32x2*)(LArk + o) = z; *(u32x2*)(LTinv + o) = z;
                }
            }
            if (tid < 32) *(u32x4*)(B8 + (16 + (tid >> 1)) * LS + 8 * (tid & 1)) = (u32x4){0u, 0u, 0u, 0u};
        }
        }
        LDS_BARRIER();
        OPAQ();
        if constexpr ((VAR & 16) == 0) {
        if (wid == 0) {
            const float* Ad = LAd + fq * 256; float X[16];
#pragma unroll
            for (int i = 0; i < 16; ++i) X[i] = (i == fr) ? 1.0f : 0.f;
#pragma unroll
            for (int i = 1; i < 16; ++i) { float acc = X[i];
#pragma unroll
                for (int s = 0; s < i; ++s) acc += Ad[i * 16 + s] * X[s];
                X[i] = acc; }
            const int dg = ldo + 12 * fq * LS + 16 * fq;
#pragma unroll
            for (int i = 0; i < 16; ++i) LTinv[dg + i * LS] = f2bf(X[i]);
            const int dt = lfo + 16 * fq * LS + 8 * fq;
            *(u32x4*)(B8 + dt) = pack8(X); *(u32x4*)(B8 + dt + 8) = pack8(X + 8);
        } else {
            for (int tile = wid - 1; tile < 16; tile += 7) { const int vt = tile >> 2, t2 = tile & 3; f32x4 acc = (f32x4){0.f, 0.f, 0.f, 0.f};
#pragma unroll
                for (int ks = 0; ks < 2; ++ks) if (ks == 0 || t2 >= 2) acc = MFMA16(FR_(LAak, 16 * t2, 32 * ks), FR_(B7, 16 * vt, 32 * ks), acc);
                u32x2 w; w.x = pk2(acc[0], acc[1]); w.y = pk2(acc[2], acc[3]); *(u32x2*)(B0 + lto + 16 * vt * LS + 16 * t2) = w; }
        }
        }
        LDS_BARRIER();
        OPAQ();
        if (ci + 1 < nck) R1_LOAD_RAW(m + 64);
        if ((VAR & 32) == 0 && wid < 2) {
            const int o = 32 * wid;
            bf16_t* lx = LX + wid * 16 * 40;
            const bool kv = fq < 2;
            const int xf = fr * 40 + 8 * fq, xd = 4 * fq * 40 + fr;
            {
                const bf16x8 fa = kv ? FR_(B8, o, o) : zero8(), fb = kv ? FR_(LAab, o + 16, o) : zero8();
                const f32x4 acc = MFMA16(fa, fb, ((f32x4){0.f, 0.f, 0.f, 0.f}));
#pragma unroll
                for (int r = 0; r < 4; ++r) lx[xd + r * 40] = f2bf(acc[r]);
            }
            asm volatile("s_waitcnt lgkmcnt(0)" ::: "memory");
            {
                const bf16x8 ft = kv ? FR_(LTinv, o + 16, o + 16) : zero8(), fx = kv ? *(const bf16x8*)(lx + xf) : zero8();
                const f32x4 acc = MFMA16(ft, fx, ((f32x4){0.f, 0.f, 0.f, 0.f}));
#pragma unroll
                for (int r = 0; r < 4; ++r) DW_(LTinv, o + 16, o, r) = f2bf(acc[r]);
                if (wid == 0) { const f32x4 acT = MFMA16(fx, ft, ((f32x4){0.f, 0.f, 0.f, 0.f}));
#pragma unroll
                    for (int r = 0; r < 4; ++r) DW_(B8, 0, 16, r) = f2bf(acT[r]); }
            }
        }
        LDS_BARRIER();
        if ((VAR & 32) == 0 && wid < 4) {
            const int jt = wid >> 1, ut = wid & 1;
            const f32x4 acc = MFMA16(FR_(B8, 16 * jt, 0), FR_(LAab, 32 + 16 * ut, 0), ((f32x4){0.f, 0.f, 0.f, 0.f}));
#pragma unroll
            for (int r = 0; r < 4; ++r) LX2[(16 * jt + 4 * fq + r) * 40 + 16 * ut + fr] = f2bf(acc[r]);
        }
        LDS_BARRIER();
        if ((VAR & 32) == 0 && wid < 4) {
            const int t2 = wid >> 1, jt = wid & 1;
            const f32x4 acc = MFMA16(FR_(LTinv, 32 + 16 * t2, 32), *(const bf16x8*)(LX2 + (16 * jt + fr) * 40 + 8 * fq), ((f32x4){0.f, 0.f, 0.f, 0.f}));
#pragma unroll
            for (int r = 0; r < 4; ++r) DW_(LTinv, 32 + 16 * t2, 16 * jt, r) = f2bf(acc[r]);
        }
        LDS_BARRIER();
        OPAQ();
        if constexpr ((VAR & 64) == 0) {
        {
#pragma unroll
            for (int jj = 0; jj < 2; ++jj) { const int t2 = wc0 + jj; f32x4 p1 = (f32x4){0.f, 0.f, 0.f, 0.f}, p2 = p1;
#pragma unroll
                for (int ks = 0; ks < 2; ++ks) if (ks == 0 || t2 >= 2) { const bf16x8 ft = FR_(LTinv, 16 * t2, 32 * ks);
                    p1 = MFMA16(ft, FR_(B4, 16 * wt, 32 * ks), p1); p2 = MFMA16(ft, FR_(B0, 16 * wt, 32 * ks), p2); }
                u32x2 w; w.x = pk2(p1[0], p1[1]); w.y = pk2(p1[2], p1[3]); *(u32x2*)(B1 + lto + 16 * wt * LS + 16 * t2) = w;
                w.x = pk2(p2[0], p2[1]); w.y = pk2(p2[2], p2[3]); *(u32x2*)(B2 + lto + 16 * wt * LS + 16 * t2) = w; }
        }
        }
        LDS_BARRIER();
        OPAQ();
        if constexpr ((VAR & 128) == 0) {
        {
            bf16_t* gq = C.q1p() + chx * 4096; bf16_t* gm = C.mp() + chx * 4096; bf16_t* gy = C.yid() + chx * 4096; bf16_t* gn = C.nd() + chx * 4096;
#pragma unroll
            for (int jj = 0; jj < 2; ++jj) {
                const int ct2 = wc0 + jj;
                f32x4 q1 = (f32x4){0.f, 0.f, 0.f, 0.f}, mm = q1, yi = q1, nn = q1;
#pragma unroll
                for (int ks = 0; ks < 2; ++ks) {
                    const bf16x8 fp1 = FR_(B1, 16 * wt, 32 * ks);
                    if (ks == 0 || ct2 >= 2) q1 = MFMA16(fp1, FR_(LArb, 16 * ct2, 32 * ks), q1);
                    mm = MFMA16(fp1, FR_(B5, 16 * ct2, 32 * ks), mm);
                    const bf16x8 fp2 = FR_(B2, 16 * ct2, 32 * ks), fv = FR_(B7, 16 * ct2, 32 * ks);
                    if (ks == 0 || wt >= 2) { yi = MFMA16(FR_(LArb, 16 * wt, 32 * ks), fp2, yi); yi = MFMA16(FR_(LArk, 16 * wt, 32 * ks), fv, yi); }
                    nn = MFMA16(FR_(B5, 16 * wt, 32 * ks), fp2, nn); nn = MFMA16(FR_(B6, 16 * wt, 32 * ks), fv, nn);
                }
                {
                    const int t = 16 * ct2 + fr, c0 = 16 * wt + 4 * fq; const u32x2 rv = *(const u32x2*)(B3 + lto + 16 * ct2 * LS + 16 * wt);
                    u32x2 w; w.x = pk2(q1[0] + __uint_as_float(rv.x << 16), q1[1] + __uint_as_float(rv.x & 0xffff0000u)); w.y = pk2(q1[2] + __uint_as_float(rv.y << 16), q1[3] + __uint_as_float(rv.y & 0xffff0000u));
                    *(u32x2*)(B0 + t * LS + permc(c0)) = w;
                    u32x2 w2; w2.x = pk2(mm[0], mm[1]); w2.y = pk2(mm[2], mm[3]); *(u32x2*)(B4 + t * LS + permc(c0)) = w2;
                }
                { u32x2 w; w.x = pk2(yi[0], yi[1]); w.y = pk2(yi[2], yi[3]); if ((VAR & 1) == 0) *(u32x2*)(gy + ((wt * 4 + ct2) * 64 + lane) * 4) = w;
                  u32x2 w2; w2.x = pk2(nn[0], nn[1]); w2.y = pk2(nn[2], nn[3]); if ((VAR & 1) == 0) *(u32x2*)(gn + ((wt * 4 + ct2) * 64 + lane) * 4) = w2; }
            }
        }
        }
        LDS_BARRIER();
        if constexpr ((VAR & 1) == 0 && (VAR & 128) == 0) {
            const int o = (tid >> 3) * LS + (tid & 7) * 8;
            *(u32x4*)(C.q1p() + chx * 4096 + tid * 8) = *(const u32x4*)(B0 + o); *(u32x4*)(C.mp() + chx * 4096 + tid * 8) = *(const u32x4*)(B4 + o);
        }
    }
}
#undef FR_
#undef DW_
#undef OPAQ

constexpr int R2_SLOT = 2 * 64 * 72 * 2 + 2 * 8192 + 256;
struct R2Set { u32x4 q, m, y, n, w; };
__device__ __forceinline__ void r2_issue(const Ctx& C, R2Set& r, size_t chx, int tid) {
    r.q = *(const u32x4*)(C.q1p() + chx * 4096 + tid * 8); r.m = *(const u32x4*)(C.mp() + chx * 4096 + tid * 8);
    r.y = *(const u32x4*)(C.yid() + chx * 4096 + tid * 8); r.n = *(const u32x4*)(C.nd() + chx * 4096 + tid * 8);
    r.w = *(const u32x4*)(C.wl() + chx * 64 + 4 * (tid & 15));
}
__device__ __forceinline__ void r2_put(const R2Set& r, unsigned char* slot, int tid) {
    bf16_t* LQ = (bf16_t*)slot; bf16_t* LM = LQ + 64 * 72; bf16_t* LY = LM + 64 * 72; bf16_t* LN = LY + 4096; float* LW = (float*)(LN + 4096);
    const int o = (tid >> 3) * 72 + (tid & 7) * 8;
    *(u32x4*)(LQ + o) = r.q; *(u32x4*)(LM + o) = r.m; *(u32x4*)(LY + tid * 8) = r.y; *(u32x4*)(LN + tid * 8) = r.n;
    if (tid < 16) *(u32x4*)(LW + 4 * tid) = r.w;
}
__device__ __forceinline__ void r2_step(const Ctx& C, f32x4 (&S)[4], const unsigned char* slot, int b, int h, int vt, int ck, int lane, int fr, int fq) {
    const bf16_t* LQ = (const bf16_t*)slot; const bf16_t* LM = LQ + 64 * 72; const bf16_t* LY = LM + 64 * 72; const bf16_t* LN = LY + 4096; const float* LW = (const float*)(LN + 4096);
    bf16x8 Sb[2];
#pragma unroll
    for (int ks = 0; ks < 2; ++ks) { u32x4 w; w.x = pk2(S[2 * ks][0], S[2 * ks][1]); w.y = pk2(S[2 * ks][2], S[2 * ks][3]); w.z = pk2(S[2 * ks + 1][0], S[2 * ks + 1][1]); w.w = pk2(S[2 * ks + 1][2], S[2 * ks + 1][3]);
        Sb[ks] = __builtin_bit_cast(bf16x8, w); }
    f32x4 Sn[4];
#pragma unroll
    for (int c4 = 0; c4 < 4; ++c4) {
        const u32x2 nv = *(const u32x2*)(LN + ((c4 * 4 + vt) * 64 + lane) * 4); const f32x4 wl = *(const f32x4*)(LW + 16 * c4 + 4 * fq);
        f32x4 acc = (f32x4){__uint_as_float(nv.x << 16), __uint_as_float(nv.x & 0xffff0000u), __uint_as_float(nv.y << 16), __uint_as_float(nv.y & 0xffff0000u)};
        acc = acc + wl * S[c4];
#pragma unroll
        for (int ks = 0; ks < 2; ++ks) acc = MFMA16(*(const bf16x8*)(LM + (16 * c4 + fr) * 72 + 32 * ks + 8 * fq), Sb[ks], acc);
        Sn[c4] = acc;
    }
#pragma unroll
    for (int t4 = 0; t4 < 4; ++t4) {
        const u32x2 yv = *(const u32x2*)(LY + ((t4 * 4 + vt) * 64 + lane) * 4);
        f32x4 acc = (f32x4){__uint_as_float(yv.x << 16), __uint_as_float(yv.x & 0xffff0000u), __uint_as_float(yv.y << 16), __uint_as_float(yv.y & 0xffff0000u)};
#pragma unroll
        for (int ks = 0; ks < 2; ++ks) acc = MFMA16(*(const bf16x8*)(LQ + (16 * t4 + fr) * 72 + 32 * ks + 8 * fq), Sb[ks], acc);
        bf16_t* yo = C.proj() + pjo((size_t)(b * NT + ck * 64 + 16 * t4 + 4 * fq), C_R + h * 64 + 16 * vt + fr);
#pragma unroll
        for (int r = 0; r < 4; ++r) yo[(size_t)r * 256] = f2bf(acc[r]);
    }
#pragma unroll
    for (int c4 = 0; c4 < 4; ++c4) S[c4] = Sn[c4];
}
__device__ __forceinline__ void rwkv_r2_wg(const Ctx& C, int b, int h) {
    const int tid = C.tid, lane = C.lane, wid = C.wid, fr = lane & 15, fq = lane >> 4;
    unsigned char* slot0 = C.lds; unsigned char* slot1 = C.lds + R2_SLOT;
    const size_t ch0 = (size_t)((b * 8 + h) * 64);
    f32x4 S[4];
#pragma unroll
    for (int i = 0; i < 4; ++i) S[i] = (f32x4){0.f, 0.f, 0.f, 0.f};
    R2Set r0, r1, r2, r3;
    __syncthreads();
    r2_issue(C, r0, ch0 + 0, tid); r2_issue(C, r1, ch0 + 1, tid); r2_issue(C, r2, ch0 + 2, tid); r2_issue(C, r3, ch0 + 3, tid);
    r2_put(r0, slot0, tid); r2_issue(C, r0, ch0 + 4, tid);
    LDS_BARRIER();
    for (int c = 0; c < NT / 64; c += 4) {
#define R2_ITER(i, rnext, snext, scur) do { const int cc = c + (i); const int cn = (cc + 5 < NT / 64) ? cc + 5 : NT / 64 - 1; \
        r2_put(rnext, snext, tid); r2_issue(C, rnext, ch0 + cn, tid);                  \
        if (wid < 4) r2_step(C, S, scur, b, h, wid, cc, lane, fr, fq); \
        LDS_BARRIER(); } while (0)
        R2_ITER(0, r1, slot1, slot0);
        R2_ITER(1, r2, slot0, slot1);
        R2_ITER(2, r3, slot1, slot0);
        R2_ITER(3, r0, slot0, slot1);
#undef R2_ITER
    }
}
constexpr int C_G = DIN;
__device__ __forceinline__ float* gate_ptr(bf16_t* proj, size_t m, int hm) { return (float*)(proj + pjo(m, C_G)) + 4 * hm; }

__device__ __forceinline__ void mlstm_gate_scan(const Ctx& C, int b, int hm, int ck) {
    const int lane = C.lane;
    const size_t mg = (size_t)(b * NT + ck * 64 + lane); const bf16_t* pr = C.proj();
    const float ig = bf2f(pr[pjo(mg, C_I + hm)]) + C.b_i()[hm]; const float fp = bf2f(pr[pjo(mg, C_F + hm)]) + C.b_f()[hm];
    const float lf = (fp >= 0.f) ? -log1pf(expf(-fp)) : fp - log1pf(expf(fp));
    float bc = lf;
#pragma unroll
    for (int o = 1; o < 64; o <<= 1) { const float tv = __shfl_up(bc, o); if (lane >= o) bc += tv; }
    const float e = ig - bc; float pm = e;
#pragma unroll
    for (int o = 1; o < 64; o <<= 1) { const float tv = __shfl_up(pm, o); if (lane >= o) pm = fmaxf(pm, tv); }
    *(f32x4*)gate_ptr(C.proj(), mg, hm) = (f32x4){bc, e, pm, 0.f};
}
__device__ __forceinline__ void mlstm_m1_stream(const Ctx& C) {
    const int lane = C.lane; const bool isk = lane >= 32; const int ch = 16 * (lane & 31);
    const int col = (isk ? C_KM : C_Q) + ch; const int cw = (isk ? 512 : 0) + ch;
    float w[4][16], bias[16];
#pragma unroll
    for (int i = 0; i < 16; i += 4) { const f32x4 bv = *(const f32x4*)(C.conv_b() + cw + i); bias[i] = bv.x; bias[i + 1] = bv.y; bias[i + 2] = bv.z; bias[i + 3] = bv.w;
#pragma unroll
        for (int j = 0; j < 4; ++j) { const f32x4 wv = *(const f32x4*)(C.conv_w() + j * 1024 + cw + i); w[j][i] = wv.x; w[j][i + 1] = wv.y; w[j][i + 2] = wv.z; w[j][i + 3] = wv.w; } }
    const float osc = isk ? 0.08838834764831845f : 1.0f;
    bf16_t* dst = (isk ? C.kc() : C.qc()) + ch;
    for (int t0 = 16 * C.gw; t0 < NTOK; t0 += 16 * C.ngw) {
        const int tb = t0 & (NT - 1);
        u32x4 ring[7][2];
        const bf16_t* p0 = C.proj() + pjo((size_t)t0, col);
#pragma unroll
        for (int k = 0; k < 7; ++k) {
            if (k < 3 && tb == 0) { ring[k][0] = (u32x4){0u, 0u, 0u, 0u}; ring[k][1] = ring[k][0]; }
            else { const bf16_t* p = p0 + (ptrdiff_t)(k - 3) * 256; ring[k][0] = *(const u32x4*)p; ring[k][1] = *(const u32x4*)(p + 8); }
        }
#pragma unroll
        for (int i = 0; i < 16; ++i) {
            const size_t m = (size_t)(t0 + i);
            float a[16], x0[16], x1[16], x2[16], x3[16];
            unpack8(ring[i % 7][0], x0); unpack8(ring[i % 7][1], x0 + 8); unpack8(ring[(i + 1) % 7][0], x1); unpack8(ring[(i + 1) % 7][1], x1 + 8);
            unpack8(ring[(i + 2) % 7][0], x2); unpack8(ring[(i + 2) % 7][1], x2 + 8); unpack8(ring[(i + 3) % 7][0], x3); unpack8(ring[(i + 3) % 7][1], x3 + 8);
            { const int rn = (i + 4 < 16) ? i + 4 : 15; const bf16_t* p = p0 + (size_t)rn * 256; ring[i % 7][0] = *(const u32x4*)p; ring[i % 7][1] = *(const u32x4*)(p + 8); }
#pragma unroll
            for (int c = 0; c < 16; ++c) { a[c] = bias[c] + w[0][c] * x0[c] + w[1][c] * x1[c] + w[2][c] * x2[c] + w[3][c] * x3[c]; a[c] = siluf_(a[c]) * osc; }
            *(u32x4*)(dst + m * 512) = pack8(a); *(u32x4*)(dst + m * 512 + 8) = pack8(a + 8);
        }
    }
}

__device__ __forceinline__ void mlstm_p0_item(const Ctx& C, int b, int hm, int ck) {
    const int lane = C.lane, fr = lane & 15, fq = lane >> 4;
    {
        const int it = (b << 8) | (ck << 2) | hm; const size_t m0 = (size_t)(b * NT + ck * 64);
        bf16_t* out = C.p0s() + (size_t)it * 4096;
        bf16x8 kf[4][4]; float es[4][4];
#pragma unroll
        for (int sj = 0; sj < 4; ++sj) {
#pragma unroll
            for (int ks = 0; ks < 4; ++ks) kf[sj][ks] = *(const bf16x8*)(C.kc() + (m0 + 16 * sj + fr) * 512 + hm * 128 + 32 * ks + 8 * fq);
#pragma unroll
            for (int r = 0; r < 4; ++r) es[sj][r] = gate_ptr(C.proj(), m0 + 16 * sj + 4 * fq + r, hm)[1]; }
#pragma unroll
        for (int ti = 0; ti < 4; ++ti) {
            bf16x8 qf[4];
#pragma unroll
            for (int ks = 0; ks < 4; ++ks) qf[ks] = *(const bf16x8*)(C.qc() + (m0 + 16 * ti + fr) * 512 + hm * 128 + 32 * ks + 8 * fq);
            const int t = 16 * ti + fr; const float pmt = gate_ptr(C.proj(), m0 + t, hm)[2];
#pragma unroll
            for (int sj = 0; sj < 4; ++sj) {
                f32x4 acc = (f32x4){0.f, 0.f, 0.f, 0.f};
                if (sj <= ti) {
#pragma unroll
                    for (int ks = 0; ks < 4; ++ks) acc = __builtin_amdgcn_mfma_f32_16x16x32_bf16(kf[sj][ks], qf[ks], acc, 0, 0, 0);
                }
                float o[4];
#pragma unroll
                for (int r = 0; r < 4; ++r) { const int s = 16 * sj + 4 * fq + r; o[r] = (sj <= ti && s <= t) ? acc[r] * fexp(es[sj][r] - pmt) : 0.f; }
                u32x2 w; w.x = pk2(o[0], o[1]); w.y = pk2(o[2], o[3]); *(u32x2*)(out + t * 64 + 16 * sj + 4 * fq) = w;
            }
        }
    }
}

#define LDS_WAIT_ALL() asm volatile("s_waitcnt lgkmcnt(0)" ::: "memory")
constexpr int VS = 52;
constexpr int ML_BUF = (2 * 64 * 136 + 2 * 64 * VS + 64 * 72) * 2 + 1280;
template <int VAR> __device__ __forceinline__ void mlstm_item(const Ctx& C, int b, int hm, int sl) {
    constexpr bool st_out = (VAR & 1) == 0;
    unsigned char* buf0 = C.lds; unsigned char* buf1 = C.lds + ML_BUF;
    bf16_t* LCb0 = (bf16_t*)(C.lds + 2 * ML_BUF); bf16_t* LCb1 = LCb0 + 48 * 136;
#define ML_Q(bf) ((bf16_t*)(bf))
#define ML_K(bf) (ML_Q(bf) + 64 * 136)
#define ML_V(bf) (ML_K(bf) + 64 * 136)
#define ML_WV(bf) (ML_V(bf) + 64 * VS)
#define ML_P(bf) (ML_WV(bf) + 64 * VS)
#define ML_F(bf) ((float*)(ML_P(bf) + 64 * 72))
    const int tid = C.tid, lane = C.lane, wid = C.wid;
    const int fr_ = lane & 15, fq_ = lane >> 4, tt_ = tid >> 3;
    __syncthreads();
    for (int e = tid; e < 2 * 48 * 136; e += NTHR) LCb0[e] = 0;
    for (int e = tid; e < 64 * VS; e += NTHR) { const bf16_t o = ((e % VS) == 32) ? (bf16_t)0x3f80 : (bf16_t)0; ML_V(buf0)[e] = o; ML_V(buf1)[e] = o; ML_WV(buf0)[e] = 0; ML_WV(buf1)[e] = 0; }
    for (int e = tid; e < 64 * 72; e += NTHR) { ML_P(buf0)[e] = 0; ML_P(buf1)[e] = 0; }
    const int cg8 = tid & 7, d0 = 16 * cg8;
    const int ti = wid >> 1, vtw = wid & 1;
    const int ct0_t = (wid < 4) ? ((wid == 0) ? 0 : (wid == 3 ? 2 : 1)) : ((wid == 4) ? 2 : 3), ct0_s = (wid < 4) ? ((wid == 2) ? 1 : 0) : ((wid == 4) ? 1 : wid - 5);
    const int ct1_t = (wid == 0) ? 2 : 3, ct1_s = (wid == 0) ? 2 : 3; const bool has2 = wid < 2;
    f32x4 Cst[3];
#pragma unroll
    for (int i = 0; i < 3; ++i) Cst[i] = (f32x4){0.f, 0.f, 0.f, 0.f};
    float mst = 0.f, carry_cur = 1.f, carry_nxt = 1.f;
    u32x4 pq0, pq1, pk0, pk1, pp; u32x2 pv; f32x4 pg, pgl; u32x4 pq0_b, pq1_b, pk0_b, pk1_b, pp_b; u32x2 pv_b; f32x4 pg_b, pgl_b;
    const bf16_t* p0base = C.p0s() + (size_t)(((b * 64) * 4 + hm)) * 4096 + tid * 8;
    {
        const size_t m = (size_t)(b * NT + tt_);
        const bf16_t* qs = C.qc() + m * 512 + hm * 128 + d0; const bf16_t* ks = C.kc() + m * 512 + hm * 128 + d0;
        pq0 = *(const u32x4*)qs; pq1 = *(const u32x4*)(qs + 8); pk0 = *(const u32x4*)ks; pk1 = *(const u32x4*)(ks + 8);
        pv = *(const u32x2*)(C.proj() + pjo(m, C_VM + hm * 128 + sl * 32 + 4 * cg8));
        pg = *(const f32x4*)gate_ptr(C.proj(), m, hm); pgl = *(const f32x4*)gate_ptr(C.proj(), (size_t)(b * NT + 63), hm); pp = *(const u32x4*)p0base;
        const size_t m2 = m + 64; qs += 64 * 512; ks += 64 * 512;
        pq0_b = *(const u32x4*)qs; pq1_b = *(const u32x4*)(qs + 8); pk0_b = *(const u32x4*)ks; pk1_b = *(const u32x4*)(ks + 8);
        pv_b = *(const u32x2*)(C.proj() + pjo(m2, C_VM + hm * 128 + sl * 32 + 4 * cg8));
        pg_b = *(const f32x4*)gate_ptr(C.proj(), m2, hm); pgl_b = *(const f32x4*)gate_ptr(C.proj(), (size_t)(b * NT + 127), hm); pp_b = *(const u32x4*)(p0base + 4 * 4096);
    }
    __syncthreads();
    { const int kst = 0; const int fr = fr_, fq = fq_, tt = tt_;
        asm volatile("" :: "v"(pg.w), "v"(pgl.y), "v"(pgl.w));
        {
            const float mxl = fmaxf(mst, pgl.z); carry_nxt = fexp(mst - mxl);
            if constexpr ((VAR & 16) == 0) {
                const float ws = fexp(pg.y - mxl);
                *(u32x4*)(ML_Q(buf0) + tt * 136 + d0) = pq0; *(u32x4*)(ML_Q(buf0) + tt * 136 + d0 + 8) = pq1;
                *(u32x4*)(ML_K(buf0) + tt * 136 + d0) = pk0; *(u32x4*)(ML_K(buf0) + tt * 136 + d0 + 8) = pk1;
                const float v0 = __uint_as_float(pv.x << 16), v1 = __uint_as_float(pv.x & 0xffff0000u), v2 = __uint_as_float(pv.y << 16), v3 = __uint_as_float(pv.y & 0xffff0000u);
                *(u32x2*)(ML_V(buf0) + tt * VS + 4 * cg8) = pv; *(u32x4*)(ML_P(buf0) + tt * 72 + 8 * cg8) = pp;
                u32x2 wv; wv.x = pk2(v0 * ws, v1 * ws); wv.y = pk2(v2 * ws, v3 * ws); *(u32x2*)(ML_WV(buf0) + tt * VS + 4 * cg8) = wv;
                if (cg8 == 0) { ML_WV(buf0)[tt * VS + 32] = f2bf(ws); const float mx = fmaxf(mst, pg.z); float* F = ML_F(buf0); F[tt] = pg.y; F[64 + tt] = mx; F[128 + tt] = fexp(mst - mx); F[192 + tt] = fexp(-(pg.x + mx)); F[256 + tt] = fexp(pg.z - mx); }
            }
            mst = pgl.x + mxl;
            const int cn = (kst + 2 < NT / 64) ? kst + 2 : NT / 64 - 1;
            const size_t m = (size_t)(b * NT + cn * 64 + tt);
            const bf16_t* qs = C.qc() + m * 512 + hm * 128 + d0; const bf16_t* ks = C.kc() + m * 512 + hm * 128 + d0;
            pq0 = *(const u32x4*)qs; pq1 = *(const u32x4*)(qs + 8); pk0 = *(const u32x4*)ks; pk1 = *(const u32x4*)(ks + 8);
            pv = *(const u32x2*)(C.proj() + pjo(m, C_VM + hm * 128 + sl * 32 + 4 * cg8));
            pg = *(const f32x4*)gate_ptr(C.proj(), m, hm); pgl = *(const f32x4*)gate_ptr(C.proj(), (size_t)(b * NT + cn * 64 + 63), hm); pp = *(const u32x4*)(p0base + (size_t)cn * 4 * 4096);
        }
    }
    carry_cur = carry_nxt;
    LDS_BARRIER();
    { const int kc = 0; const int fr = fr_, fq = fq_;
    }
    for (int ck2 = 0; ck2 < NT / 64; ck2 += 2) {
      { const int ck = ck2;
        int fr = fr_, fq = fq_, tt = tt_; asm volatile("" : "+v"(fr), "+v"(fq), "+v"(tt));
        { const int kst = ck + 1;
        asm volatile("" :: "v"(pg_b.w), "v"(pgl_b.y), "v"(pgl_b.w));
        {
            const float mxl = fmaxf(mst, pgl_b.z); carry_nxt = fexp(mst - mxl);
            if constexpr ((VAR & 16) == 0) {
                const float ws = fexp(pg_b.y - mxl);
                *(u32x4*)(ML_Q(buf1) + tt * 136 + d0) = pq0_b; *(u32x4*)(ML_Q(buf1) + tt * 136 + d0 + 8) = pq1_b;
                *(u32x4*)(ML_K(buf1) + tt * 136 + d0) = pk0_b; *(u32x4*)(ML_K(buf1) + tt * 136 + d0 + 8) = pk1_b;
                const float v0 = __uint_as_float(pv_b.x << 16), v1 = __uint_as_float(pv_b.x & 0xffff0000u), v2 = __uint_as_float(pv_b.y << 16), v3 = __uint_as_float(pv_b.y & 0xffff0000u);
                *(u32x2*)(ML_V(buf1) + tt * VS + 4 * cg8) = pv_b; *(u32x4*)(ML_P(buf1) + tt * 72 + 8 * cg8) = pp_b;
                u32x2 wv; wv.x = pk2(v0 * ws, v1 * ws); wv.y = pk2(v2 * ws, v3 * ws); *(u32x2*)(ML_WV(buf1) + tt * VS + 4 * cg8) = wv;
                if (cg8 == 0) { ML_WV(buf1)[tt * VS + 32] = f2bf(ws); const float mx = fmaxf(mst, pg_b.z); float* F = ML_F(buf1); F[tt] = pg_b.y; F[64 + tt] = mx; F[128 + tt] = fexp(mst - mx); F[192 + tt] = fexp(-(pg_b.x + mx)); F[256 + tt] = fexp(pg_b.z - mx); }
            }
            mst = pgl_b.x + mxl;
            const int cn = (kst + 2 < NT / 64) ? kst + 2 : NT / 64 - 1;
            const size_t m = (size_t)(b * NT + cn * 64 + tt);
            const bf16_t* qs = C.qc() + m * 512 + hm * 128 + d0; const bf16_t* ks = C.kc() + m * 512 + hm * 128 + d0;
            pq0_b = *(const u32x4*)qs; pq1_b = *(const u32x4*)(qs + 8); pk0_b = *(const u32x4*)ks; pk1_b = *(const u32x4*)(ks + 8);
            pv_b = *(const u32x2*)(C.proj() + pjo(m, C_VM + hm * 128 + sl * 32 + 4 * cg8));
            pg_b = *(const f32x4*)gate_ptr(C.proj(), m, hm); pgl_b = *(const f32x4*)gate_ptr(C.proj(), (size_t)(b * NT + cn * 64 + 63), hm); pp_b = *(const u32x4*)(p0base + (size_t)cn * 4 * 4096);
        }
        }
        { const int kc = ck + 1;
        }
        {
            const int mbase = b * NT + ck * 64;
            const bf16_t* LQ = ML_Q(buf0); const bf16_t* LK = ML_K(buf0); const bf16_t* LV = ML_V(buf0); const bf16_t* LWV = ML_WV(buf0); const bf16_t* LP = ML_P(buf0); const float* F = ML_F(buf0);
            const bf16_t* LCr = LCb0; bf16_t* LCw = LCb1;
            bf16x8 fp[2], fvr[2], fvd[2], fqq[4], fcr[4], fcd[4], kf[2], fw[3][2]; float inr[4], clr[4], rsr[4];
#pragma unroll
            for (int ks = 0; ks < 2; ++ks) { fp[ks] = *(const bf16x8*)(LP + (16 * ti + fr) * 72 + 32 * ks + 8 * fq); fvr[ks] = tr_frag(LV, VS, 32 * ks, 16 * vtw, fr, fq); fvd[ks] = tr_frag(LV, VS, 32 * ks, 32, fr, fq); }
#pragma unroll
            for (int ks = 0; ks < 4; ++ks) { fqq[ks] = *(const bf16x8*)(LQ + (16 * ti + fr) * 136 + 32 * ks + 8 * fq); fcr[ks] = *(const bf16x8*)(LCr + (16 * vtw + fr) * 136 + 32 * ks + 8 * fq); fcd[ks] = *(const bf16x8*)(LCr + (32 + fr) * 136 + 32 * ks + 8 * fq); }
#pragma unroll
            for (int ks = 0; ks < 2; ++ks) { kf[ks] = tr_frag(LK, 136, 32 * ks, 16 * wid, fr, fq);
#pragma unroll
                for (int vt2 = 0; vt2 < 3; ++vt2) fw[vt2][ks] = tr_frag(LWV, VS, 32 * ks, 16 * vt2, fr, fq); }
#pragma unroll
            for (int r = 0; r < 4; ++r) { inr[r] = F[128 + 16 * ti + 4 * fq + r]; clr[r] = F[192 + 16 * ti + 4 * fq + r]; rsr[r] = F[256 + 16 * ti + 4 * fq + r]; }
            LDS_WAIT_ALL();
            f32x4 numr = (f32x4){0.f, 0.f, 0.f, 0.f}, numd = numr;
            if constexpr ((VAR & 4) == 0) {
                f32x4 a1r = (f32x4){0.f, 0.f, 0.f, 0.f}, a1d = a1r, a2r = a1r, a2d = a1r;
#pragma unroll
                for (int ks = 0; ks < 2; ++ks) { a1r = __builtin_amdgcn_mfma_f32_16x16x32_bf16(fp[ks], fvr[ks], a1r, 0, 0, 0); a1d = __builtin_amdgcn_mfma_f32_16x16x32_bf16(fp[ks], fvd[ks], a1d, 0, 0, 0); }
#pragma unroll
                for (int ks = 0; ks < 4; ++ks) { a2r = __builtin_amdgcn_mfma_f32_16x16x32_bf16(fqq[ks], fcr[ks], a2r, 0, 0, 0); a2d = __builtin_amdgcn_mfma_f32_16x16x32_bf16(fqq[ks], fcd[ks], a2d, 0, 0, 0); }
#pragma unroll
                for (int r = 0; r < 4; ++r) { numr[r] = rsr[r] * a1r[r] + inr[r] * a2r[r]; numd[r] = rsr[r] * a1d[r] + inr[r] * a2d[r]; }
            }
            if constexpr ((VAR & 8) == 0) {
#pragma unroll
                for (int vt2 = 0; vt2 < 3; ++vt2) {
                    f32x4 acc = Cst[vt2] * carry_cur;
#pragma unroll
                    for (int ks = 0; ks < 2; ++ks) acc = __builtin_amdgcn_mfma_f32_16x16x32_bf16(kf[ks], fw[vt2][ks], acc, 0, 0, 0);
                    Cst[vt2] = acc;
                    { u32x2 w; w.x = pk2(acc[0], acc[1]); w.y = pk2(acc[2], acc[3]); *(u32x2*)(LCw + (16 * vt2 + fr) * 136 + 16 * wid + 4 * fq) = w; }
                }
            }
#pragma unroll
            for (int r = 0; r < 4; ++r) { const int t = 16 * ti + 4 * fq + r;
                const float den = __shfl(numd[r], lane & 48);
                const float dv = fmaxf(fabsf(den), clr[r]);
                if (st_out) C.proj()[pjo((size_t)(mbase + t), C_VM + hm * 128 + sl * 32 + 16 * vtw + fr)] = f2bf(numr[r] * frcp(dv)); }
        }
        carry_cur = carry_nxt;
        LDS_BARRIER();
      }
      { const int ck = ck2 + 1;
        int fr = fr_, fq = fq_, tt = tt_; asm volatile("" : "+v"(fr), "+v"(fq), "+v"(tt));
        { const int kst = ck + 1;
        asm volatile("" :: "v"(pg.w), "v"(pgl.y), "v"(pgl.w));
        {
            const float mxl = fmaxf(mst, pgl.z); carry_nxt = fexp(mst - mxl);
            if constexpr ((VAR & 16) == 0) {
                const float ws = fexp(pg.y - mxl);
                *(u32x4*)(ML_Q(buf0) + tt * 136 + d0) = pq0; *(u32x4*)(ML_Q(buf0) + tt * 136 + d0 + 8) = pq1;
                *(u32x4*)(ML_K(buf0) + tt * 136 + d0) = pk0; *(u32x4*)(ML_K(buf0) + tt * 136 + d0 + 8) = pk1;
                const float v0 = __uint_as_float(pv.x << 16), v1 = __uint_as_float(pv.x & 0xffff0000u), v2 = __uint_as_float(pv.y << 16), v3 = __uint_as_float(pv.y & 0xffff0000u);
                *(u32x2*)(ML_V(buf0) + tt * VS + 4 * cg8) = pv; *(u32x4*)(ML_P(buf0) + tt * 72 + 8 * cg8) = pp;
                u32x2 wv; wv.x = pk2(v0 * ws, v1 * ws); wv.y = pk2(v2 * ws, v3 * ws); *(u32x2*)(ML_WV(buf0) + tt * VS + 4 * cg8) = wv;
                if (cg8 == 0) { ML_WV(buf0)[tt * VS + 32] = f2bf(ws); const float mx = fmaxf(mst, pg.z); float* F = ML_F(buf0); F[tt] = pg.y; F[64 + tt] = mx; F[128 + tt] = fexp(mst - mx); F[192 + tt] = fexp(-(pg.x + mx)); F[256 + tt] = fexp(pg.z - mx); }
            }
            mst = pgl.x + mxl;
            const int cn = (kst + 2 < NT / 64) ? kst + 2 : NT / 64 - 1;
            const size_t m = (size_t)(b * NT + cn * 64 + tt);
            const bf16_t* qs = C.qc() + m * 512 + hm * 128 + d0; const bf16_t* ks = C.kc() + m * 512 + hm * 128 + d0;
            pq0 = *(const u32x4*)qs; pq1 = *(const u32x4*)(qs + 8); pk0 = *(const u32x4*)ks; pk1 = *(const u32x4*)(ks + 8);
            pv = *(const u32x2*)(C.proj() + pjo(m, C_VM + hm * 128 + sl * 32 + 4 * cg8));
            pg = *(const f32x4*)gate_ptr(C.proj(), m, hm); pgl = *(const f32x4*)gate_ptr(C.proj(), (size_t)(b * NT + cn * 64 + 63), hm); pp = *(const u32x4*)(p0base + (size_t)cn * 4 * 4096);
        }
        }
        { const int kc = ck + 1;
        }
        {
            const int mbase = b * NT + ck * 64;
            const bf16_t* LQ = ML_Q(buf1); const bf16_t* LK = ML_K(buf1); const bf16_t* LV = ML_V(buf1); const bf16_t* LWV = ML_WV(buf1); const bf16_t* LP = ML_P(buf1); const float* F = ML_F(buf1);
            const bf16_t* LCr = LCb1; bf16_t* LCw = LCb0;
            bf16x8 fp[2], fvr[2], fvd[2], fqq[4], fcr[4], fcd[4], kf[2], fw[3][2]; float inr[4], clr[4], rsr[4];
#pragma unroll
            for (int ks = 0; ks < 2; ++ks) { fp[ks] = *(const bf16x8*)(LP + (16 * ti + fr) * 72 + 32 * ks + 8 * fq); fvr[ks] = tr_frag(LV, VS, 32 * ks, 16 * vtw, fr, fq); fvd[ks] = tr_frag(LV, VS, 32 * ks, 32, fr, fq); }
#pragma unroll
            for (int ks = 0; ks < 4; ++ks) { fqq[ks] = *(const bf16x8*)(LQ + (16 * ti + fr) * 136 + 32 * ks + 8 * fq); fcr[ks] = *(const bf16x8*)(LCr + (16 * vtw + fr) * 136 + 32 * ks + 8 * fq); fcd[ks] = *(const bf16x8*)(LCr + (32 + fr) * 136 + 32 * ks + 8 * fq); }
#pragma unroll
            for (int ks = 0; ks < 2; ++ks) { kf[ks] = tr_frag(LK, 136, 32 * ks, 16 * wid, fr, fq);
#pragma unroll
                for (int vt2 = 0; vt2 < 3; ++vt2) fw[vt2][ks] = tr_frag(LWV, VS, 32 * ks, 16 * vt2, fr, fq); }
#pragma unroll
            for (int r = 0; r < 4; ++r) { inr[r] = F[128 + 16 * ti + 4 * fq + r]; clr[r] = F[192 + 16 * ti + 4 * fq + r]; rsr[r] = F[256 + 16 * ti + 4 * fq + r]; }
            LDS_WAIT_ALL();
            f32x4 numr = (f32x4){0.f, 0.f, 0.f, 0.f}, numd = numr;
            if constexpr ((VAR & 4) == 0) {
                f32x4 a1r = (f32x4){0.f, 0.f, 0.f, 0.f}, a1d = a1r, a2r = a1r, a2d = a1r;
#pragma unroll
                for (int ks = 0; ks < 2; ++ks) { a1r = __builtin_amdgcn_mfma_f32_16x16x32_bf16(fp[ks], fvr[ks], a1r, 0, 0, 0); a1d = __builtin_amdgcn_mfma_f32_16x16x32_bf16(fp[ks], fvd[ks], a1d, 0, 0, 0); }
#pragma unroll
                for (int ks = 0; ks < 4; ++ks) { a2r = __builtin_amdgcn_mfma_f32_16x16x32_bf16(fqq[ks], fcr[ks], a2r, 0, 0, 0); a2d = __builtin_amdgcn_mfma_f32_16x16x32_bf16(fqq[ks], fcd[ks], a2d, 0, 0, 0); }
#pragma unroll
                for (int r = 0; r < 4; ++r) { numr[r] = rsr[r] * a1r[r] + inr[r] * a2r[r]; numd[r] = rsr[r] * a1d[r] + inr[r] * a2d[r]; }
            }
            if constexpr ((VAR & 8) == 0) {
#pragma unroll
                for (int vt2 = 0; vt2 < 3; ++vt2) {
                    f32x4 acc = Cst[vt2] * carry_cur;
#pragma unroll
                    for (int ks = 0; ks < 2; ++ks) acc = __builtin_amdgcn_mfma_f32_16x16x32_bf16(kf[ks], fw[vt2][ks], acc, 0, 0, 0);
                    Cst[vt2] = acc;
                    { u32x2 w; w.x = pk2(acc[0], acc[1]); w.y = pk2(acc[2], acc[3]); *(u32x2*)(LCw + (16 * vt2 + fr) * 136 + 16 * wid + 4 * fq) = w; }
                }
            }
#pragma unroll
            for (int r = 0; r < 4; ++r) { const int t = 16 * ti + 4 * fq + r;
                const float den = __shfl(numd[r], lane & 48);
                const float dv = fmaxf(fabsf(den), clr[r]);
                if (st_out) C.proj()[pjo((size_t)(mbase + t), C_VM + hm * 128 + sl * 32 + 16 * vtw + fr)] = f2bf(numr[r] * frcp(dv)); }
        }
        carry_cur = carry_nxt;
        LDS_BARRIER();
      }
    }
#undef ML_Q
#undef ML_K
#undef ML_V
#undef ML_WV
#undef ML_P
#undef ML_F
}
__device__ __forceinline__ void phase3(const Ctx& C, int sub) {
    const int g = blockIdx.x;
    if (sub == 0 || sub == 1) {
        mlstm_m1_stream(C);
        asm volatile("s_waitcnt vmcnt(0)" ::: "memory"); __syncthreads();
        const int bb = g >> 5, ck = 2 * (g & 31) + (C.wid >> 2), hm = C.wid & 3;
        mlstm_gate_scan(C, bb, hm, ck);
        asm volatile("s_waitcnt vmcnt(0)" ::: "memory");
        mlstm_p0_item(C, bb, hm, ck);
    }
    if (sub >= 3) rwkv_r1_wg<(PROBE_SUB >= 3 ? PROBE_SUB : 0) | 1>(C, g >> 5, (g >> 2) & 7, (g & 3) * 16, 16); else if (sub != 1) rwkv_r1_wg<0>(C, g >> 5, (g >> 2) & 7, (g & 3) * 16, 16);
}
__device__ __forceinline__ void phase4(const Ctx& C, int sub) {
    for (int item = blockIdx.x; item < 256; item += gridDim.x) {
        if (item < 64) { if (sub != 2 && sub != 3) rwkv_r2_wg(C, item >> 3, item & 7); }
        else if (item < 128) { }
        else { const int i = item - 128; if (sub == 3) mlstm_item<PROBE_SUB | 1>(C, i >> 4, (i >> 2) & 3, i & 3); else if (sub != 1) mlstm_item<0>(C, i >> 4, (i >> 2) & 3, i & 3); }
        __syncthreads();
    }
}

__device__ __forceinline__ void ld8f(const float* p, float* o) { const f32x4 a = *(const f32x4*)p, b = *(const f32x4*)(p + 4); o[0] = a.x; o[1] = a.y; o[2] = a.z; o[3] = a.w; o[4] = b.x; o[5] = b.y; o[6] = b.z; o[7] = b.w; }
__device__ __forceinline__ void phase5(const Ctx& C) {
    const int lane = C.lane; const int c0 = 8 * lane;
    float muv[8], gnw[8], gnb[8], lnw[8], skp[8];
    ld8f(C.mu() + C_V + c0, muv); ld8f(C.gn_w() + c0, gnw); ld8f(C.gn_b() + c0, gnb); ld8f(C.ln_w() + c0, lnw); ld8f(C.skip() + c0, skp);
    for (int m = C.gw; m < NTOK; m += C.ngw) {
        const bool hp = (m & (NT - 1)) != 0;
        const bf16_t* pj = C.proj(); const size_t mm = (size_t)m, mp = (size_t)(m > 0 ? m - 1 : m); bf16_t* yo = C.ymix() + (size_t)m * DM;
        float outr[8], outm[8];
        {
            float y[8], v[8], pv[8], z[8];
            unpack8(*(const u32x4*)(pj + pjo(mm, C_R + c0)), y);
            unpack8(*(const u32x4*)(pj + pjo(mm, C_V + c0)), v); unpack8(*(const u32x4*)(pj + pjo(mm, C_ZR + c0)), z);
            unpack8(*(const u32x4*)(pj + pjo(mp, C_V + c0)), pv);
            if (!hp) {
#pragma unroll
                for (int i = 0; i < 8; ++i) { pv[i] = 0.f; } }
            float s = 0.f; const float bs = C.bonus()[(size_t)m * 8 + (lane >> 3)];
#pragma unroll
            for (int i = 0; i < 8; ++i) { v[i] += muv[i] * (pv[i] - v[i]); s += y[i]; }
            s = half8_sum(s);
            const float mean = s * (1.0f / 64.0f); float q = 0.f;
#pragma unroll
            for (int i = 0; i < 8; ++i) { y[i] -= mean; q += y[i] * y[i]; }
            q = half8_sum(q);
            const float rstd = __builtin_amdgcn_rsqf(q * (1.0f / 64.0f) + 64e-5f);
#pragma unroll
            for (int i = 0; i < 8; ++i) { const float yn = y[i] * rstd * gnw[i] + gnb[i]; outr[i] = (yn + bs * v[i]) * siluf_(z[i]); }
        }
        {
            float h[8], o[8], z[8], qc[8];
            unpack8(*(const u32x4*)(pj + pjo(mm, C_VM + c0)), h);
            unpack8(*(const u32x4*)(pj + pjo(mm, C_O + c0)), o); unpack8(*(const u32x4*)(pj + pjo(mm, C_ZM + c0)), z); unpack8(*(const u32x4*)(C.qc() + (size_t)m * 512 + c0), qc);
            float s = 0.f;
#pragma unroll
            for (int i = 0; i < 8; ++i) s += h[i];
            s = row16_sum(s);
            const float mean = s * (1.0f / 128.0f); float q = 0.f;
#pragma unroll
            for (int i = 0; i < 8; ++i) { h[i] -= mean; q += h[i] * h[i]; }
            q = row16_sum(q);
            const float rstd = __builtin_amdgcn_rsqf(q * (1.0f / 128.0f) + 1e-6f);
#pragma unroll
            for (int i = 0; i < 8; ++i) { const float hn = h[i] * rstd * lnw[i]; outm[i] = (sigmoidf_(o[i]) * hn + skp[i] * qc[i]) * siluf_(z[i]); }
        }
        *(u32x4*)(yo + c0) = pack8(outr);
        *(u32x4*)(yo + 512 + c0) = pack8(outm);
    }
}

struct RowIn { f32x4 x[4]; u32x4 mx[2]; };
__device__ __forceinline__ void p7_load(const Ctx& C, RowIn& r, int m) {
    const f32x4* xr = (const f32x4*)(C.x() + (size_t)m * DM) + C.lane;
#pragma unroll
    for (int j = 0; j < 4; ++j) r.x[j] = __builtin_nontemporal_load(xr + 64 * j);
    const u32x2* mr = (const u32x2*)(C.mixo() + (size_t)m * DM) + C.lane;
    const u32x2 a0 = __builtin_nontemporal_load(mr), a1 = __builtin_nontemporal_load(mr + 64), a2 = __builtin_nontemporal_load(mr + 128), a3 = __builtin_nontemporal_load(mr + 192);
    r.mx[0] = (u32x4){a0.x, a0.y, a1.x, a1.y}; r.mx[1] = (u32x4){a2.x, a2.y, a3.x, a3.y};
}
template <int VAR> __device__ __forceinline__ void phase7(const Ctx& C) {
    f32x4 g[4];
#pragma unroll
    for (int j = 0; j < 4; ++j) g[j] = *(const f32x4*)(C.fgain() + 4 * C.lane + 256 * j);
    RowIn cur, nx1; p7_load(C, cur, C.gw); p7_load(C, nx1, C.gw + C.ngw);
    if constexpr ((VAR & 2) != 0) { asm volatile("" : "+v"(cur.x[0]), "+v"(nx1.x[0])); }
    f32x4 gtv[4]; int bcur = -1;
    for (int m = C.gw; m < NTOK; m += C.ngw) {
        const int b = m >> 12; const int mn = (m + 2 * C.ngw < NTOK) ? m + 2 * C.ngw : m;
        if (b != bcur) { bcur = b;
#pragma unroll
            for (int j = 0; j < 4; ++j) gtv[j] = *(const f32x4*)(C.ada() + b * 3072 + 2048 + 4 * C.lane + 256 * j); }
        RowIn nxt; if constexpr ((VAR & 2) == 0) p7_load(C, nxt, mn); else nxt = nx1;
        f32x4 h[4]; float s = 0.f;
#pragma unroll
        for (int j = 0; j < 4; ++j) {
            const f32x4 gt = gtv[j];
            const unsigned w0 = (j & 1) ? cur.mx[j >> 1].z : cur.mx[j >> 1].x, w1 = (j & 1) ? cur.mx[j >> 1].w : cur.mx[j >> 1].y;
            const f32x4 mv = (f32x4){__uint_as_float(w0 << 16), __uint_as_float(w0 & 0xffff0000u), __uint_as_float(w1 << 16), __uint_as_float(w1 & 0xffff0000u)};
            h[j] = cur.x[j] + gt * mv; s += (h[j].x * h[j].x + h[j].y * h[j].y) + (h[j].z * h[j].z + h[j].w * h[j].w); }
        const float rs = __builtin_amdgcn_rsqf(wave_sum_dpp(s) * (1.0f / DM) + 1e-6f);
        f32x4* o = (f32x4*)(C.out() + (size_t)m * DM) + C.lane;
#pragma unroll
        for (int j = 0; j < 4; ++j) { if constexpr ((VAR & 1) == 0) __builtin_nontemporal_store(h[j] * rs * g[j], o + 64 * j); else asm volatile("" :: "v"(h[j] * rs * g[j])); }
        cur = nx1; nx1 = nxt;
    }
}

#define LAS __attribute__((address_space(3)))
#define XB_TMO      128
#define XB_XCNT(j)  (256  + 64 * (j))
#define XB_XSUB(j)  (1280 + 64 * (j))
#define XB_XGEN(j)  (2304 + 64 * (j))
#define XB_TOP      3328
#define XB_TOPGEN   3392
#define XCD_BAR_WORDS 3456
#define XB_SPIN_CAP (1u << 18)

__device__ __forceinline__ unsigned xb_ld(unsigned* p)              { return __hip_atomic_load(p, __ATOMIC_RELAXED, __HIP_MEMORY_SCOPE_AGENT); }
__device__ __forceinline__ unsigned xb_add(unsigned* p, unsigned v) { return __hip_atomic_fetch_add(p, v, __ATOMIC_RELAXED, __HIP_MEMORY_SCOPE_AGENT); }
__device__ __forceinline__ unsigned xb_xcc_id() { return (unsigned)__builtin_amdgcn_s_getreg((3 << 11) | 20) & 0xFu; }
#define XB_SPIN(cond, bar) do { unsigned _sp = 0; while (cond) { __builtin_amdgcn_s_sleep(1); \
    if ((++_sp & 255u) == 0u) { if (xb_ld(&(bar)[XB_TMO])) break; if (_sp > XB_SPIN_CAP) { atomicAdd(&(bar)[XB_TMO], 1u); break; } } } } while (0)

struct XcdBarrier {
    unsigned* bar; unsigned x;
    volatile LAS unsigned* st;
};

__device__ __forceinline__ XcdBarrier xcd_barrier_post(unsigned* bar, volatile LAS unsigned* st) {
    XcdBarrier b; b.bar = bar; b.x = xb_xcc_id(); b.st = st;
    if (threadIdx.x == 0) (void)xb_add(&bar[XB_XCNT(b.x)], 1u);
    return b;
}
__device__ __forceinline__ void xcd_barrier_complete(unsigned* bar, unsigned x, unsigned& nloc, unsigned& nx) {
    const unsigned G = gridDim.x * gridDim.y * gridDim.z;
    unsigned sum, cnt, mine, sp = 0u;
    for (;;) {
        sum = 0u; cnt = 0u; mine = 0u;
#pragma unroll
        for (unsigned j = 0; j < 16; ++j) { const unsigned c = xb_ld(&bar[XB_XCNT(j)]); sum += c; cnt += (c > 0u) ? 1u : 0u; mine = (j == x) ? c : mine; }
        if (sum == G) break;
        __builtin_amdgcn_s_sleep(1);
        if ((++sp & 255u) == 0u) { if (xb_ld(&bar[XB_TMO])) break; if (sp > XB_SPIN_CAP) { atomicAdd(&bar[XB_TMO], 1u); break; } }
    }
    nloc = mine > 0u ? mine : 1u; nx = cnt > 0u ? cnt : 1u;
}

__device__ __forceinline__ void xcd_barrier(const XcdBarrier& b) {
    asm volatile("s_waitcnt vmcnt(0)" ::: "memory");
    __syncthreads();
    if (threadIdx.x == 0) {
        unsigned* bar = b.bar;
        __builtin_amdgcn_s_waitcnt(0);
        unsigned nloc = b.st[0], nx = b.st[1];
        if (nloc == 0u) { xcd_barrier_complete(bar, b.x, nloc, nx); b.st[0] = nloc; b.st[1] = nx; }
        const unsigned old = xb_add(&bar[XB_XSUB(b.x)], 1u);
        const unsigned gen = old / nloc;
        if (old + 1u == (gen + 1u) * nloc) {
            __builtin_amdgcn_fence(__ATOMIC_RELEASE, "agent");
            asm volatile("s_waitcnt vmcnt(0)" ::: "memory");
            const unsigned og = xb_add(&bar[XB_TOP], 1u);
            const unsigned tg = og / nx;
            if (og + 1u == (tg + 1u) * nx) xb_add(&bar[XB_TOPGEN], 1u);
            else XB_SPIN(xb_ld(&bar[XB_TOPGEN]) == tg, bar);
            __builtin_amdgcn_fence(__ATOMIC_ACQUIRE, "agent");
            xb_add(&bar[XB_XGEN(b.x)], 1u);
            asm volatile("s_waitcnt vmcnt(0)" ::: "memory");
        } else {
            XB_SPIN(xb_ld(&bar[XB_XGEN(b.x)]) == gen, bar);
            __builtin_amdgcn_fence(__ATOMIC_ACQUIRE, "agent");
            asm volatile("s_waitcnt vmcnt(0)" ::: "memory");
        }
    }
    __syncthreads();
}

#ifndef PROBE_REP
#define PROBE_REP -1
#endif
#ifndef PROBE_SUB
#define PROBE_SUB 0
#endif
__global__ void __launch_bounds__(NTHR, 2) fwd_kernel(Params p) {
    extern __shared__ __attribute__((aligned(16))) unsigned char lds_raw[];
    cg::grid_group grid = cg::this_grid();
    Ctx C{p};
    C.lds = lds_raw; C.tid = threadIdx.x; C.lane = C.tid & 63; C.wid = __builtin_amdgcn_readfirstlane(C.tid >> 6);
    C.gw = blockIdx.x * NWV + C.wid; C.ngw = gridDim.x * NWV;
    const int lo = p.ph_lo, hi = p.ph_hi;
    unsigned* barw = (unsigned*)(p.ws + WS_CTL);
    volatile LAS unsigned* bst = (volatile LAS unsigned*)((LAS unsigned char*)lds_raw + LDS_BYTES - 16);
    if (threadIdx.x < 4) bst[threadIdx.x] = 0u;
    if (blockIdx.x == 0) for (int e = threadIdx.x; e < XCD_BAR_WORDS; e += NTHR) barw[e] = 0u;
    XcdBarrier xbar; xbar.bar = barw; xbar.x = 0; xbar.st = bst;
#define RUN(k) (lo <= (k) && (k) < hi)
#define GSYNC() xcd_barrier(xbar)
#define SEAM(k) do { if (RUN(k) && RUN((k) + 1)) GSYNC(); } while (0)
    if (RUN(0)) phase0(C);
    if (RUN(0) && RUN(1)) { grid.sync(); xbar = xcd_barrier_post(barw, bst); }
#if PROBE_REP == 8
    GSYNC(); GSYNC(); GSYNC(); GSYNC(); GSYNC(); GSYNC(); GSYNC(); GSYNC();
#endif
    if (RUN(1)) { phase1(C); weight_copies(C); }
#if PROBE_REP == 1
    GSYNC(); phase0(C); GSYNC(); phase1(C); weight_copies(C);
#endif
    SEAM(1);
    if (RUN(2)) {
        pg8::Gemm g{C.hn(), C.win_t(), NTOK, NPAD, DM}; pg8::StaticOrder S; S.init(NTOK, NPAD, (int)gridDim.x, (int)blockIdx.x);
        pg8::EpiBf16<0> E{C.proj(), 256, nullptr, 256, (size_t)NTOK * 256};
        pg8::gemm_phase<pg8::EpiBf16<0>, pg8::StaticOrder, false>((PG8_LAS unsigned char*)lds_raw, g, S, E, nullptr);
#if PROBE_REP == 2
        GSYNC(); pg8::gemm_phase<pg8::EpiBf16<0>, pg8::StaticOrder, false>((PG8_LAS unsigned char*)lds_raw, g, S, E, nullptr);
#endif
    }
    SEAM(2);
    if (RUN(3)) phase3(C, 0);
#if PROBE_REP == 3
    GSYNC(); phase3(C, PROBE_SUB);
#endif
    SEAM(3);
#if PROBE_REP == 6
    phase4(C, 3); GSYNC();
#endif
    if (RUN(4)) phase4(C, 0);
#if PROBE_REP == 4
    GSYNC(); phase4(C, PROBE_SUB);
#endif
    SEAM(4);
    if (RUN(5)) phase5(C);
#if PROBE_REP == 5
    GSYNC(); phase5(C);
#endif
    SEAM(5);
    if (RUN(6)) {
        pg8::Gemm g{C.ymix(), C.wout_t(), NTOK, DM, DM}; pg8::StaticOrder S; S.init(NTOK, DM, (int)gridDim.x, (int)blockIdx.x);
        pg8::EpiBf16<0> E{C.mixo(), DM, nullptr, 0, 0};
        pg8::gemm_phase<pg8::EpiBf16<0>, pg8::StaticOrder, false>((PG8_LAS unsigned char*)lds_raw, g, S, E, nullptr);
#if PROBE_REP == 7
        GSYNC(); pg8::gemm_phase<pg8::EpiBf16<0>, pg8::StaticOrder, false>((PG8_LAS unsigned char*)lds_raw, g, S, E, nullptr);
#endif
    }
    SEAM(6);
#if PROBE_REP == 9
    phase7<PROBE_SUB>(C); GSYNC();
#endif
    if (RUN(7)) phase7<0>(C);
#undef RUN
#undef SEAM
}

#ifndef N_LAUNCHES
#define N_LAUNCHES 1
#endif
extern "C" void kernel_launch(void* const* d_in, const int* in_sizes, int n_in, void* d_out, int out_size, void* d_ws, size_t ws_size, hipStream_t stream) {
    static int grid = 0;
    if (grid == 0) {
        if (n_in != 24 || out_size != NTOK * DM || ws_size < WS_END) { fprintf(stderr, "kernel_launch: unexpected shapes (n_in %d, out %d, ws %zu < %zu)\n", n_in, out_size, ws_size, (size_t)WS_END); grid = -1; return; }
        int dev = 0, cus = 0, per_cu = 0;
        hipGetDevice(&dev); hipDeviceGetAttribute(&cus, hipDeviceAttributeMultiprocessorCount, dev);
        if (hipFuncSetAttribute((const void*)fwd_kernel, hipFuncAttributeMaxDynamicSharedMemorySize, LDS_BYTES) != hipSuccess) { fprintf(stderr, "kernel_launch: hipFuncSetAttribute failed\n"); grid = -1; return; }
        if (hipOccupancyMaxActiveBlocksPerMultiprocessor(&per_cu, (const void*)fwd_kernel, NTHR, LDS_BYTES) != hipSuccess || per_cu < 1) { fprintf(stderr, "kernel_launch: occupancy query says %d\n", per_cu); per_cu = 1; }
        (void)hipGetLastError();
        if (cus < 256) { fprintf(stderr, "kernel_launch: this build needs 256 CUs (got %d)\n", cus); grid = -1; return; }
        grid = 256;
        fprintf(stderr, "kernel_launch: grid %d, per_cu %d\n", grid, per_cu);
    }
    if (grid < 0) return;
    Params p{};
    for (int i = 0; i < 24; ++i) p.in[i] = (const float*)d_in[i];
    p.out = (float*)d_out; p.ws = (unsigned char*)d_ws;
    if (N_LAUNCHES == 1) {
        p.ph_lo = 0; p.ph_hi = NPHASE; void* args[] = {&p};
        hipError_t e = hipLaunchCooperativeKernel((const void*)fwd_kernel, dim3(grid), dim3(NTHR), args, LDS_BYTES, stream);
        if (e != hipSuccess) fprintf(stderr, "cooperative launch failed: %s (grid %d)\n", hipGetErrorString(e), grid);
    } else {
        for (int ph = 0; ph < NPHASE; ++ph) { p.ph_lo = ph; p.ph_hi = ph + 1; hipLaunchKernelGGL(fwd_kernel, dim3(grid), dim3(NTHR), LDS_BYTES, stream, p); }
    }
}
```
